# Optimizing an MI355X kernel written in HIP

```python
import math
import jax
import jax.numpy as jnp
from jax import lax
import numpy as np


D_MODEL = 1024
BATCH = 4
SEQ = 4096
DEPTH = 4

HEAD_DIM = 64
N_HEADS_A = 8
N_HEADS_B = 8
N_HEADS_C = 8
N_HEADS_D = 8
MOBA_BLOCK = 256
MOBA_TOPK = 3
MOBA_Q_CHUNK = 32
DILATED_BRANCHES = ((128, 1), (512, 4), (2048, 16))
Q_BLOCK = 128
MLA_Q_RANK = 256
MLA_KV_RANK = 256
MLA_NOPE_DIM = 64
MLA_ROPE_DIM = 32
MLA_V_DIM = 64
ROPE_THETA = 10000.0
REL_BUCKETS = 32
REL_MAX_DIST = 2048
D_FF = 2816
CONV_WIDTH = 3
NORM_EPS = 1e-6
N_EVEN = (DEPTH + 1) // 2
N_ODD = DEPTH // 2
AB_IN = 3 * HEAD_DIM * (N_HEADS_A + N_HEADS_B)
AB_OUT = HEAD_DIM * (N_HEADS_A + N_HEADS_B)
CD_IN = MLA_Q_RANK + MLA_KV_RANK + MLA_ROPE_DIM + 3 * HEAD_DIM * N_HEADS_D
CD_OUT = MLA_V_DIM * N_HEADS_C + HEAD_DIM * N_HEADS_D

kernel_name = 'hybrid_moba_dilated_mla_stickbreaking'


def rmsnorm(x, g):
    x32 = x.astype(jnp.float32)
    y = x32 * lax.rsqrt(jnp.mean(x32 * x32, axis=-1, keepdims=True) + NORM_EPS)
    return (y * g.astype(jnp.float32)).astype(x.dtype)


def t5_bucket(dist):
    dist = jnp.maximum(dist, 0)
    max_exact = REL_BUCKETS // 2
    d_f = jnp.maximum(dist, max_exact).astype(jnp.float32)
    large = max_exact + (jnp.log(d_f / max_exact) / math.log(REL_MAX_DIST / max_exact)
                         * (REL_BUCKETS - max_exact)).astype(jnp.int32)
    large = jnp.minimum(large, REL_BUCKETS - 1)
    return jnp.where(dist < max_exact, dist, large)


def split_cols(t, sizes):
    return jnp.split(t, [int(o) for o in np.cumsum(sizes)[:-1]], axis=-1)


def to_heads(t, n_heads):
    b, s, _ = t.shape
    return t.reshape(b, s, n_heads, -1).transpose(0, 2, 1, 3)


def from_heads(t):
    b, h, s, d = t.shape
    return t.transpose(0, 2, 1, 3).reshape(b, s, h * d)


def query_blocks(q, qb):
    b, h, s, d = q.shape
    return q.reshape(b, h, s // qb, qb, d).transpose(2, 0, 1, 3, 4)


def merge_blocks(o):
    n, b, h, qb, d = o.shape
    return o.transpose(1, 2, 0, 3, 4).reshape(b, h, n * qb, d)


def rope_tables(s):
    inv_freq = 1.0 / (ROPE_THETA ** (jnp.arange(0, MLA_ROPE_DIM, 2, dtype=jnp.float32) / MLA_ROPE_DIM))
    ang = jnp.arange(s, dtype=jnp.float32)[:, None] * inv_freq[None, :]
    return jnp.cos(ang), jnp.sin(ang)


def apply_rope(x, cos, sin):
    cos = cos[:, None, :].astype(x.dtype)
    sin = sin[:, None, :].astype(x.dtype)
    x1, x2 = jnp.split(x, 2, axis=-1)
    return jnp.concatenate([x1 * cos - x2 * sin, x1 * sin + x2 * cos], axis=-1)


def moba_attention(q, k, v, bias_table):
    b, h, s, dh = q.shape
    nb = -(-s // MOBA_BLOCK)
    pad = nb * MOBA_BLOCK - s
    kp = jnp.pad(k, ((0, 0), (0, 0), (0, pad), (0, 0)))
    vp = jnp.pad(v, ((0, 0), (0, 0), (0, pad), (0, 0)))
    kb = kp.reshape(b, h, nb, MOBA_BLOCK, dh)
    vb = vp.reshape(b, h, nb, MOBA_BLOCK, dh)
    k_mean = jnp.mean(kb, axis=3)
    scale = dh ** -0.5
    topk = min(MOBA_TOPK, nb)
    head_idx = jnp.arange(h)[:, None, None, None]
    blk_offsets = jnp.arange(MOBA_BLOCK)
    gather_blocks = jax.vmap(jax.vmap(lambda arr, idx: arr[idx]))

    def chunk_fn(args):
        qc, ci = args
        t = ci * MOBA_Q_CHUNK + jnp.arange(MOBA_Q_CHUNK)
        own = t[0] // MOBA_BLOCK
        gate = jnp.einsum('bhqd,bhnd->bhqn', qc, k_mean).astype(jnp.float32)
        past = jnp.arange(nb)[None, :] < (t // MOBA_BLOCK)[:, None]
        gate = jnp.where(past, gate, -jnp.inf)
        _, sel = lax.top_k(gate, topk)
        sel_valid = sel < own
        k_sel = gather_blocks(kb, sel)
        v_sel = gather_blocks(vb, sel)
        pos_sel = sel[..., None] * MOBA_BLOCK + blk_offsets
        logit_sel = (jnp.einsum('bhqd,bhqkld->bhqkl', qc, k_sel).astype(jnp.float32) * scale
                     + bias_table[head_idx, t5_bucket(t[:, None, None] - pos_sel)].astype(jnp.float32))
        logit_sel = jnp.where(sel_valid[..., None], logit_sel, -jnp.inf)
        k_own = lax.dynamic_slice_in_dim(kp, own * MOBA_BLOCK, MOBA_BLOCK, axis=2)
        v_own = lax.dynamic_slice_in_dim(vp, own * MOBA_BLOCK, MOBA_BLOCK, axis=2)
        pos_own = own * MOBA_BLOCK + blk_offsets
        logit_own = (jnp.einsum('bhqd,bhld->bhql', qc, k_own).astype(jnp.float32) * scale
                     + bias_table[:, t5_bucket(t[:, None] - pos_own[None, :])].astype(jnp.float32))
        logit_own = jnp.where(pos_own[None, :] <= t[:, None], logit_own, -jnp.inf)
        logits = jnp.concatenate([logit_sel.reshape(b, h, MOBA_Q_CHUNK, topk * MOBA_BLOCK), logit_own], axis=-1)
        p = jax.nn.softmax(logits, axis=-1)
        p_sel = p[..., :topk * MOBA_BLOCK].reshape(b, h, MOBA_Q_CHUNK, topk, MOBA_BLOCK).astype(v.dtype)
        p_own = p[..., topk * MOBA_BLOCK:].astype(v.dtype)
        return (jnp.einsum('bhqkl,bhqkld->bhqd', p_sel, v_sel)
                + jnp.einsum('bhql,bhld->bhqd', p_own, v_own))

    n_chunks = s // MOBA_Q_CHUNK
    return merge_blocks(lax.map(chunk_fn, (query_blocks(q, MOBA_Q_CHUNK), jnp.arange(n_chunks))))


def dilated_attention(q, k, v, bias_table):
    b, h, s, dh = q.shape
    scale = dh ** -0.5

    def chunk_fn(args):
        qc, ci = args
        t = ci * Q_BLOCK + jnp.arange(Q_BLOCK)
        lses, outs = [], []
        for window, dil in DILATED_BRANCHES:
            dist = dil * jnp.arange(window // dil + 1)
            pos = t[:, None] - dist[None, :]
            valid = pos >= 0
            pos_c = jnp.maximum(pos, 0)
            k_g = k[:, :, pos_c]
            v_g = v[:, :, pos_c]
            logit = (jnp.einsum('bhqd,bhqmd->bhqm', qc, k_g).astype(jnp.float32) * scale
                     + bias_table[:, t5_bucket(dist)][:, None, :].astype(jnp.float32))
            logit = jnp.where(valid, logit, -jnp.inf)
            lse = jax.nn.logsumexp(logit, axis=-1, keepdims=True)
            p = jnp.exp(logit - lse).astype(v.dtype)
            outs.append(jnp.einsum('bhqm,bhqmd->bhqd', p, v_g))
            lses.append(lse)
        w = jax.nn.softmax(jnp.concatenate(lses, axis=-1), axis=-1).astype(v.dtype)
        return jnp.einsum('bhqr,rbhqd->bhqd', w, jnp.stack(outs))

    n_chunks = s // Q_BLOCK
    return merge_blocks(lax.map(chunk_fn, (query_blocks(q, Q_BLOCK), jnp.arange(n_chunks))))


def causal_softmax_attention(q, k, v):
    s = q.shape[2]
    scale = q.shape[-1] ** -0.5
    kpos = jnp.arange(s)

    def block_fn(args):
        qc, bi = args
        t = bi * Q_BLOCK + jnp.arange(Q_BLOCK)
        logits = jnp.einsum('bhqd,bhsd->bhqs', qc, k).astype(jnp.float32) * scale
        logits = jnp.where(kpos[None, :] <= t[:, None], logits, -jnp.inf)
        p = jax.nn.softmax(logits, axis=-1).astype(v.dtype)
        return jnp.einsum('bhqs,bhsd->bhqd', p, v)

    return merge_blocks(lax.map(block_fn, (query_blocks(q, Q_BLOCK), jnp.arange(s // Q_BLOCK))))


def mla_attention(c_q, c_kv, k_rope, q_norm_g, kv_norm_g, w_uq, w_ukv, cos, sin):
    b, s, _ = c_q.shape
    q = (rmsnorm(c_q, q_norm_g) @ w_uq).reshape(b, s, N_HEADS_C, MLA_NOPE_DIM + MLA_ROPE_DIM)
    kv = (rmsnorm(c_kv, kv_norm_g) @ w_ukv).reshape(b, s, N_HEADS_C, MLA_NOPE_DIM + MLA_V_DIM)
    q_nope, q_pe = q[..., :MLA_NOPE_DIM], q[..., MLA_NOPE_DIM:]
    k_nope, v = kv[..., :MLA_NOPE_DIM], kv[..., MLA_NOPE_DIM:]
    q_pe = apply_rope(q_pe, cos, sin)
    k_pe = apply_rope(k_rope[:, :, None, :], cos, sin)
    k_pe = jnp.broadcast_to(k_pe, (b, s, N_HEADS_C, MLA_ROPE_DIM))
    q_full = jnp.concatenate([q_nope, q_pe], axis=-1).transpose(0, 2, 1, 3)
    k_full = jnp.concatenate([k_nope, k_pe], axis=-1).transpose(0, 2, 1, 3)
    return causal_softmax_attention(q_full, k_full, v.transpose(0, 2, 1, 3))


def stick_breaking_attention(q, k, v):
    s = q.shape[2]
    scale = q.shape[-1] ** -0.5
    kpos = jnp.arange(s)

    def block_fn(args):
        qc, bi = args
        t = bi * Q_BLOCK + jnp.arange(Q_BLOCK)
        z = jnp.einsum('bhqd,bhsd->bhqs', qc, k).astype(jnp.float32) * scale
        strict = kpos[None, :] < t[:, None]
        log_keep = jnp.where(strict, jax.nn.log_sigmoid(-z), 0.0)
        rev = lax.cumsum(log_keep, axis=3, reverse=True)
        after = jnp.concatenate([rev[..., 1:], jnp.zeros_like(rev[..., :1])], axis=-1)
        a = jnp.where(strict, jnp.exp(jax.nn.log_sigmoid(z) + after), 0.0).astype(v.dtype)
        return jnp.einsum('bhqs,bhsd->bhqd', a, v)

    return merge_blocks(lax.map(block_fn, (query_blocks(q, Q_BLOCK), jnp.arange(s // Q_BLOCK))))


def even_mixer(h, w_in, w_out, rel_bias):
    proj = h @ w_in
    wa = N_HEADS_A * HEAD_DIM
    wb = N_HEADS_B * HEAD_DIM
    qa, ka, va, qb, kb, vb = split_cols(proj, [wa, wa, wa, wb, wb, wb])
    o_a = moba_attention(to_heads(qa, N_HEADS_A), to_heads(ka, N_HEADS_A), to_heads(va, N_HEADS_A),
                         rel_bias[:N_HEADS_A])
    o_b = dilated_attention(to_heads(qb, N_HEADS_B), to_heads(kb, N_HEADS_B), to_heads(vb, N_HEADS_B),
                            rel_bias[N_HEADS_A:])
    return jnp.concatenate([from_heads(o_a), from_heads(o_b)], axis=-1) @ w_out


def odd_mixer(h, w_in, q_norm_g, kv_norm_g, w_uq, w_ukv, w_out, cos, sin):
    proj = h @ w_in
    wd = N_HEADS_D * HEAD_DIM
    c_q, c_kv, k_rope, qd, kd, vd = split_cols(proj, [MLA_Q_RANK, MLA_KV_RANK, MLA_ROPE_DIM, wd, wd, wd])
    o_c = mla_attention(c_q, c_kv, k_rope, q_norm_g, kv_norm_g, w_uq, w_ukv, cos, sin)
    o_d = stick_breaking_attention(to_heads(qd, N_HEADS_D), to_heads(kd, N_HEADS_D), to_heads(vd, N_HEADS_D))
    return jnp.concatenate([from_heads(o_c), from_heads(o_d)], axis=-1) @ w_out


def conv_ffn(h, w_up, conv_w, conv_b, w_down):
    s = h.shape[1]
    u = h @ w_up
    up = jnp.pad(u, ((0, 0), (CONV_WIDTH - 1, 0), (0, 0)))
    u = sum(conv_w[j] * up[:, j:j + s] for j in range(CONV_WIDTH)) + conv_b
    gate, val = jnp.split(u, 2, axis=-1)
    return (jax.nn.gelu(gate, approximate=True) * val) @ w_down


def setup_inputs(seed: int = 0) -> dict:
    key = jax.random.key(seed)
    ks = jax.random.split(key, 24)
    f32 = jnp.float32

    def dense(k, shape, fan_in, gain=1.0):
        return jax.random.normal(k, shape, f32) * (gain * fan_in ** -0.5)

    def gain(k, shape):
        return 1.0 + 0.05 * jax.random.normal(k, shape, f32)

    return {
        'x': jax.random.normal(ks[0], (BATCH, SEQ, D_MODEL), f32),
        'c': jax.random.normal(ks[1], (BATCH, D_MODEL), f32),
        'rel_bias': 0.5 * jax.random.normal(ks[2], (N_HEADS_A + N_HEADS_B, REL_BUCKETS), f32),
        'ada_w': dense(ks[3], (DEPTH, D_MODEL, 6 * D_MODEL), D_MODEL, 0.5),
        'ada_b': 0.02 * jax.random.normal(ks[4], (DEPTH, 6 * D_MODEL), f32),
        'mix_pre_g': gain(ks[5], (DEPTH, D_MODEL)),
        'mix_post_g': gain(ks[6], (DEPTH, D_MODEL)),
        'ffn_pre_g': gain(ks[7], (DEPTH, D_MODEL)),
        'ffn_post_g': gain(ks[8], (DEPTH, D_MODEL)),
        'ab_w_in': dense(ks[9], (N_EVEN, D_MODEL, AB_IN), D_MODEL),
        'ab_w_out': dense(ks[10], (N_EVEN, AB_OUT, D_MODEL), AB_OUT),
        'cd_w_in': dense(ks[11], (N_ODD, D_MODEL, CD_IN), D_MODEL),
        'mla_q_norm_g': gain(ks[12], (N_ODD, MLA_Q_RANK)),
        'mla_kv_norm_g': gain(ks[13], (N_ODD, MLA_KV_RANK)),
        'mla_w_uq': dense(ks[14], (N_ODD, MLA_Q_RANK, N_HEADS_C * (MLA_NOPE_DIM + MLA_ROPE_DIM)), MLA_Q_RANK),
        'mla_w_ukv': dense(ks[15], (N_ODD, MLA_KV_RANK, N_HEADS_C * (MLA_NOPE_DIM + MLA_V_DIM)), MLA_KV_RANK),
        'cd_w_out': dense(ks[16], (N_ODD, CD_OUT, D_MODEL), CD_OUT),
        'ffn_w_up': dense(ks[17], (DEPTH, D_MODEL, 2 * D_FF), D_MODEL),
        'ffn_conv_w': dense(ks[18], (DEPTH, CONV_WIDTH, 2 * D_FF), CONV_WIDTH),
        'ffn_conv_b': 0.02 * jax.random.normal(ks[19], (DEPTH, 2 * D_FF), f32),
        'ffn_w_down': dense(ks[20], (DEPTH, D_FF, D_MODEL), D_FF),
    }


def reference(x, c, rel_bias, ada_w, ada_b, mix_pre_g, mix_post_g, ffn_pre_g, ffn_post_g,
              ab_w_in, ab_w_out, cd_w_in, mla_q_norm_g, mla_kv_norm_g, mla_w_uq, mla_w_ukv, cd_w_out,
              ffn_w_up, ffn_conv_w, ffn_conv_b, ffn_w_down):
    s = x.shape[1]
    cos, sin = rope_tables(s)
    cond = jax.nn.silu(c)
    for layer in range(DEPTH):
        mod = cond @ ada_w[layer] + ada_b[layer]
        shift_m, scale_m, gate_m, shift_f, scale_f, gate_f = [m[:, None, :] for m in jnp.split(mod, 6, axis=-1)]
        h = rmsnorm(x, mix_pre_g[layer]) * (1.0 + scale_m) + shift_m
        i = layer // 2
        if layer % 2 == 0:
            y = even_mixer(h, ab_w_in[i], ab_w_out[i], rel_bias)
        else:
            y = odd_mixer(h, cd_w_in[i], mla_q_norm_g[i], mla_kv_norm_g[i], mla_w_uq[i], mla_w_ukv[i],
                          cd_w_out[i], cos, sin)
        x = x + gate_m * rmsnorm(y, mix_post_g[layer])
        h = rmsnorm(x, ffn_pre_g[layer]) * (1.0 + scale_f) + shift_f
        y = conv_ffn(h, ffn_w_up[layer], ffn_conv_w[layer], ffn_conv_b[layer], ffn_w_down[layer])
        x = x + gate_f * rmsnorm(y, ffn_post_g[layer])
    return x
```

```cpp
#include <hip/hip_runtime.h>
#include <cstdio>
#include <cstdint>

constexpr int BATCH = 4, SEQ = 4096, DM = 1024, M = BATCH * SEQ, DEPTH = 4;
constexpr int NH = 8, HD = 64;
constexpr int AB_IN = 3072, CD_IN = 2080, CD_INP = 2304;
constexpr int DFF = 2816, DFF2 = 5632;
constexpr int UP_N = 1792, UP_K = 512;
constexpr int QW = 768, KVW = 1024;
constexpr float NORM_EPS = 1e-6f;

typedef _Float16 f16;
typedef _Float16 f16x2 __attribute__((ext_vector_type(2)));
typedef _Float16 f16x4 __attribute__((ext_vector_type(4)));
typedef _Float16 f16x8 __attribute__((ext_vector_type(8)));
typedef float f32x2 __attribute__((ext_vector_type(2)));
typedef float f32x4 __attribute__((ext_vector_type(4)));
typedef unsigned u32x2 __attribute__((ext_vector_type(2)));
typedef unsigned u32x4 __attribute__((ext_vector_type(4)));

__device__ __forceinline__ unsigned pk_f16(float lo, float hi) { f32x2 v = {lo, hi}; f16x2 h = __builtin_convertvector(v, f16x2); return __builtin_bit_cast(unsigned, h); }

constexpr size_t MiB = 1u << 20;
constexpr size_t WS_CTL = 0, CTL_ZERO_BYTES = 1 * MiB;
constexpr size_t WS_MOD = 1 * MiB;
constexpr size_t WS_KMEAN = 1 * MiB + 512 * 1024;
constexpr size_t WS_ROPE = 2 * MiB;
constexpr size_t WS_UHALO = 3 * MiB;
constexpr size_t WS_HHALO = 6 * MiB;
constexpr size_t WS_W_INAB = 8 * MiB;
constexpr size_t WS_W_OUTAB = 20 * MiB;
constexpr size_t WS_W_INCD = 24 * MiB;
constexpr size_t WS_W_UP2 = 33 * MiB;
constexpr size_t WS_W_OUTCD = 37 * MiB;
constexpr size_t WS_W_FUP = 41 * MiB;
constexpr size_t WS_W_FDN = 85 * MiB;
constexpr size_t WS_H = 108 * MiB;
constexpr size_t WS_ATT = 140 * MiB;
constexpr size_t WS_R2 = 172 * MiB;
constexpr size_t WS_R1 = 236 * MiB;
constexpr size_t WS_END = 332 * MiB;
constexpr int CW_BAR = 4096;
namespace pg8 {
#define PG8_LAS __attribute__((address_space(3)))
constexpr int BM = 256, BK = 64, HALF = 128, HTB = HALF * BK * 2  , STAGE_BYTES = 8 * HTB, NXCD = 8, WGM = 8;

__host__ __device__ __forceinline__ int lds_byte(int r, int c) { const int st = (r >> 4) * 2 + (c >> 5), rr = r & 15, cc = c & 31, ob = rr * 64 + cc * 2; return st * 1024 + (ob ^ (((ob >> 9) & 1) << 5)); }
__host__ __device__ __forceinline__ void stage_rc(int b, int& R, int& C) { const int st = b / 1024, sb = b % 1024, swz = sb ^ (((sb >> 9) & 1) << 5); R = (st >> 1) * 16 + swz / 64; C = (st & 1) * 32 + (swz % 64) / 2; }
__host__ __device__ __forceinline__ int perm32(int rho) { const int n = rho >> 4, i = rho & 15; return 8 * (i >> 2) + 4 * n + (i & 3); }

struct Unit { int pm, pn; };
struct Gemm { const f16* A; const f16* Bt; int M, N, K, lda; };

struct StaticOrder {
    int nM, nN, nwg, G, c;
    __host__ __device__ void init(int M_, int N_, int G_, int c_) { nM = M_ / BM; nN = N_ / BM; nwg = nM * nN; G = G_; c = c_; }
    __host__ __device__ bool next(int i, Unit& u) const {
        const long L = (long)i * G + c; if (L >= nwg) return false;
        int wgid = (int)L; { const int q = nwg / NXCD, r = nwg % NXCD, xcd = wgid % NXCD, off = wgid / NXCD; wgid = (xcd < r ? xcd * (q + 1) : r * (q + 1) + (xcd - r) * q) + off; }
        const int nig = WGM * nN, gid = wgid / nig, fm = gid * WGM, gsz = (nM - fm) < WGM ? (nM - fm) : WGM;
        u.pm = fm + ((wgid % nig) % gsz); u.pn = (wgid % nig) / gsz; return true;
    }
    __device__ __forceinline__ void a_ready(const Unit&) const {}
    __device__ __forceinline__ void done(const Unit&) const {}
};

struct EpiF32 {
    static constexpr bool PERM = false, AFTER_DRAIN = false;
    float* C; int ldc; int row_limit;
    __device__ __forceinline__ void operator()(const f32x4 (&acc)[2][2][4][2], const Unit& u, int wr, int wc, int fr, int fq) const {
        const int row0 = u.pm * BM + wr * 64 + fr, col0 = u.pn * BM + wc * 32 + 4 * fq;
#pragma unroll
        for (int ai = 0; ai < 2; ++ai)
#pragma unroll
            for (int m = 0; m < 4; ++m) { const int row = row0 + ai * HALF + m * 16; if (row >= row_limit) continue; float* rowp = C + (size_t)row * ldc + col0;
#pragma unroll
                for (int bj = 0; bj < 2; ++bj)
#pragma unroll
                    for (int n = 0; n < 2; ++n) *(f32x4*)(rowp + bj * HALF + n * 16) = acc[ai][bj][m][n]; }
    }
};
struct EpiF16 {
    static constexpr bool PERM = true, AFTER_DRAIN = false;
    f16* O; int ldc; int split_col; f16* O2; int ldc2;
    __device__ __forceinline__ void operator()(const f32x4 (&acc)[2][2][4][2], const Unit& u, int wr, int wc, int fr, int fq) const {
        const int row0 = u.pm * BM + wr * 64 + fr; int colt = u.pn * BM; f16* base = O; int ld = ldc;
        if (split_col && colt >= split_col) { base = O2; ld = ldc2; colt -= split_col; }
        const int col0 = colt + wc * 32 + 8 * fq;
#pragma unroll
        for (int ai = 0; ai < 2; ++ai)
#pragma unroll
            for (int m = 0; m < 4; ++m) { f16* rowp = base + (size_t)(row0 + ai * HALF + m * 16) * ld + col0;
#pragma unroll
                for (int bj = 0; bj < 2; ++bj) { const f32x4 v0 = acc[ai][bj][m][0], v1 = acc[ai][bj][m][1];
                    u32x4 w; w.x = pk_f16(v0[0], v0[1]); w.y = pk_f16(v0[2], v0[3]); w.z = pk_f16(v1[0], v1[1]); w.w = pk_f16(v1[2], v1[3]);
                    *(u32x4*)(rowp + bj * HALF) = w; } }
    }
};

template <class Epi, class Sched, bool ALIGN_EPI = false, bool SP2 = false>
__device__ __forceinline__ void gemm_phase(PG8_LAS unsigned char* lds, const Gemm g, const Sched& S, const Epi& E) {
    int tid_o = threadIdx.x; asm volatile("" : "+v"(tid_o));
    const int tid = tid_o, wid = __builtin_amdgcn_readfirstlane(tid >> 6), lane = tid & 63, wr = wid >> 2, wc = wid & 3, fr = lane & 15, fq = lane >> 4;
    const int K = g.K, nt = K / BK;
    unsigned voffA[2], voffB[2];
#pragma unroll
    for (int i = 0; i < 2; ++i) { int R, C; stage_rc(tid * 16 + i * 8192, R, C); const int Rb = Epi::PERM ? ((R & ~31) + perm32(R & 31)) : R;
        voffA[i] = (unsigned)(R * g.lda + C) * 2u; voffB[i] = (unsigned)(Rb * K + C) * 2u; }
    const size_t kstep = (size_t)(BK * 2);
    const size_t hstep = (size_t)HALF * K * 2;
    const size_t tstep = 2 * hstep;
    const size_t hstepA = (size_t)HALF * g.lda * 2, tstepA = 2 * hstepA;
    const unsigned ldsw = (unsigned)wid * 1024u;
    const int aoff = lds_byte(wr * 64 + fr, fq * 8), boff = lds_byte(wc * 32 + fr, fq * 8);
#define PG8_SA(b, h) (((b) * 2 + (h)) * HTB)
#define PG8_SB(b, h) ((4 + (b) * 2 + (h)) * HTB)
#define PG8_STAGE(bufoff, gbase, voff) do { _Pragma("unroll") for (int _i = 0; _i < 2; ++_i) \
        __builtin_amdgcn_global_load_lds((const unsigned*)((const char*)(gbase) + (voff)[_i]), (PG8_LAS unsigned*)(lds + (bufoff) + ldsw + _i * 8192), 16, 0, 0); } while (0)
#define PG8_LDA(dst, b, h) do { _Pragma("unroll") for (int m = 0; m < 4; ++m) _Pragma("unroll") for (int k = 0; k < 2; ++k) dst[m][k] = *(const PG8_LAS f16x8*)(lds + PG8_SA(b, h) + aoff + m * 2048 + k * 1024); } while (0)
#define PG8_LDB(dst, b, h) do { _Pragma("unroll") for (int n = 0; n < 2; ++n) _Pragma("unroll") for (int k = 0; k < 2; ++k) dst[n][k] = *(const PG8_LAS f16x8*)(lds + PG8_SB(b, h) + boff + n * 2048 + k * 1024); } while (0)
#define PG8_MMA(ai, bj, At, Bt) do { __builtin_amdgcn_s_setprio(1); _Pragma("unroll") for (int m = 0; m < 4; ++m) _Pragma("unroll") for (int n = 0; n < 2; ++n) _Pragma("unroll") for (int k = 0; k < 2; ++k) \
        acc[ai][bj][m][n] = __builtin_amdgcn_mfma_f32_16x16x32_f16(Bt[n][k], At[m][k], acc[ai][bj][m][n], 0, 0, 0); __builtin_amdgcn_s_setprio(0); } while (0)
#define PG8_WAIT_V(n) asm volatile("s_waitcnt vmcnt(" #n ")" ::: "memory")
#define PG8_WAIT_L(n) asm volatile("s_waitcnt lgkmcnt(" #n ")" ::: "memory")
#define PG8_BAR __builtin_amdgcn_s_barrier()
#define PG8_SCHED __builtin_amdgcn_sched_barrier(0)
    Unit cur, nxt; int ui = 0;
    if (!S.next(0, cur)) return;
    f32x4 acc[2][2][4][2];
#pragma unroll
    for (int a = 0; a < 2; ++a)
#pragma unroll
        for (int b = 0; b < 2; ++b)
#pragma unroll
            for (int m = 0; m < 4; ++m)
#pragma unroll
                for (int n = 0; n < 2; ++n) acc[a][b][m][n] = (f32x4){0.f, 0.f, 0.f, 0.f};
    f16x8 At[4][2], B0[2][2], B1[2][2];
    const char* cA = (const char*)g.A + (size_t)cur.pm * tstepA; const char* cB = (const char*)g.Bt + (size_t)cur.pn * tstep;
    S.a_ready(cur);
    if constexpr (SP2) {
        PG8_STAGE(PG8_SB(0, 0), cB, voffB); PG8_STAGE(PG8_SB(0, 1), cB + hstep, voffB); PG8_STAGE(PG8_SA(0, 0), cA, voffA); PG8_STAGE(PG8_SA(0, 1), cA + hstepA, voffA);
        if (wr == 1) PG8_BAR;
        PG8_WAIT_V(2); PG8_BAR;
        PG8_STAGE(PG8_SB(1, 0), cB + kstep, voffB); PG8_STAGE(PG8_SA(1, 0), cA + kstep, voffA); PG8_STAGE(PG8_SB(1, 1), cB + hstep + kstep, voffB);
        PG8_WAIT_V(6); PG8_BAR;
    } else {
        PG8_STAGE(PG8_SB(0, 0), cB, voffB); PG8_STAGE(PG8_SA(0, 0), cA, voffA); PG8_STAGE(PG8_SB(0, 1), cB + hstep, voffB); PG8_STAGE(PG8_SA(0, 1), cA + hstepA, voffA);
        if (wr == 1) PG8_BAR;
        PG8_WAIT_V(4); PG8_BAR;
        PG8_STAGE(PG8_SB(1, 0), cB + kstep, voffB); PG8_STAGE(PG8_SA(1, 0), cA + kstep, voffA); PG8_STAGE(PG8_SB(1, 1), cB + hstep + kstep, voffB);
        PG8_WAIT_V(6); PG8_BAR;
    }
    for (;;) {
        const bool has_next = S.next(ui + 1, nxt);
        const char* nA = has_next ? (const char*)g.A + (size_t)nxt.pm * tstepA : cA; const char* nB = has_next ? (const char*)g.Bt + (size_t)nxt.pn * tstep : cB;
        for (int t = 0; t < nt; t += 2) {
            const bool last = (t == nt - 2);
            const char* a1 = cA + (size_t)(t + 1) * kstep;
            const char* a2 = last ? nA : cA + (size_t)(t + 2) * kstep; const char* b2 = last ? nB : cB + (size_t)(t + 2) * kstep;
            const char* a3 = a2 + kstep; const char* b3 = b2 + kstep;
            if (last && has_next) S.a_ready(nxt);
            if constexpr (SP2) {
            PG8_LDB(B0, 0, 0); PG8_LDB(B1, 0, 1); PG8_SCHED; PG8_LDA(At, 0, 0); PG8_STAGE(PG8_SA(1, 1), a1 + hstepA, voffA);
            PG8_WAIT_V(8); PG8_WAIT_L(0); PG8_BAR; PG8_MMA(0, 0, At, B0); PG8_MMA(0, 1, At, B1); PG8_BAR; PG8_SCHED;
            PG8_LDA(At, 0, 1); PG8_STAGE(PG8_SB(0, 0), b2, voffB); PG8_STAGE(PG8_SB(0, 1), b2 + hstep, voffB); PG8_STAGE(PG8_SA(0, 0), a2, voffA);
            PG8_WAIT_V(8); PG8_WAIT_L(0); PG8_BAR; PG8_MMA(1, 0, At, B0); PG8_MMA(1, 1, At, B1); PG8_BAR; PG8_SCHED;
            PG8_LDB(B0, 1, 0); PG8_LDB(B1, 1, 1); PG8_SCHED; PG8_LDA(At, 1, 0); PG8_STAGE(PG8_SA(0, 1), a2 + hstepA, voffA);
            PG8_WAIT_V(8); PG8_WAIT_L(0); PG8_BAR; PG8_MMA(0, 0, At, B0); PG8_MMA(0, 1, At, B1); PG8_BAR; PG8_SCHED;
            PG8_LDA(At, 1, 1); PG8_STAGE(PG8_SB(1, 0), b3, voffB); PG8_STAGE(PG8_SB(1, 1), b3 + hstep, voffB); PG8_STAGE(PG8_SA(1, 0), a3, voffA);
            PG8_WAIT_V(8); PG8_WAIT_L(0); PG8_BAR; PG8_MMA(1, 0, At, B0); PG8_MMA(1, 1, At, B1); PG8_BAR; PG8_SCHED;
            } else {
            PG8_LDB(B0, 0, 0); PG8_SCHED; PG8_LDA(At, 0, 0); PG8_STAGE(PG8_SA(1, 1), a1 + hstepA, voffA);
            PG8_WAIT_L(8); PG8_BAR; PG8_WAIT_L(0); PG8_MMA(0, 0, At, B0); PG8_BAR; PG8_SCHED;
            PG8_LDB(B1, 0, 1); PG8_STAGE(PG8_SB(0, 0), b2, voffB);
            PG8_BAR; PG8_WAIT_L(0); PG8_MMA(0, 1, At, B1); PG8_BAR;
            PG8_LDA(At, 0, 1); PG8_STAGE(PG8_SA(0, 0), a2, voffA);
            PG8_BAR; PG8_WAIT_L(0); PG8_MMA(1, 0, At, B0); PG8_BAR; PG8_SCHED;
            PG8_STAGE(PG8_SB(0, 1), b2 + hstep, voffB);
            PG8_WAIT_V(6); PG8_BAR; PG8_MMA(1, 1, At, B1); PG8_BAR;
            PG8_LDB(B0, 1, 0); PG8_SCHED; PG8_LDA(At, 1, 0); PG8_STAGE(PG8_SA(0, 1), a2 + hstepA, voffA);
            PG8_WAIT_L(8); PG8_BAR; PG8_WAIT_L(0); PG8_MMA(0, 0, At, B0); PG8_BAR; PG8_SCHED;
            PG8_LDB(B1, 1, 1); PG8_STAGE(PG8_SB(1, 0), b3, voffB);
            PG8_BAR; PG8_WAIT_L(0); PG8_MMA(0, 1, At, B1); PG8_BAR;
            PG8_LDA(At, 1, 1); PG8_STAGE(PG8_SA(1, 0), a3, voffA);
            PG8_BAR; PG8_WAIT_L(0); PG8_MMA(1, 0, At, B0); PG8_BAR; PG8_SCHED;
            PG8_STAGE(PG8_SB(1, 1), b3 + hstep, voffB);
            PG8_WAIT_V(6); PG8_BAR; PG8_MMA(1, 1, At, B1); PG8_BAR;
            }
        }
        if constexpr (ALIGN_EPI) { if (wr == 0) PG8_BAR; }
        if constexpr (!Epi::AFTER_DRAIN) { E(acc, cur, wr, wc, fr, fq); S.done(cur); }
        if (!has_next) break;
#pragma unroll
        for (int a = 0; a < 2; ++a)
#pragma unroll
            for (int b = 0; b < 2; ++b)
#pragma unroll
                for (int m = 0; m < 4; ++m)
#pragma unroll
                    for (int n = 0; n < 2; ++n) acc[a][b][m][n] = (f32x4){0.f, 0.f, 0.f, 0.f};
        cur = nxt; cA = nA; cB = nB; ++ui;
        if constexpr (ALIGN_EPI) { if (wr == 1) PG8_BAR; }
    }
    PG8_WAIT_V(0);
    if constexpr (!ALIGN_EPI) { if (wr == 0) PG8_BAR; }
    PG8_BAR;
    if constexpr (Epi::AFTER_DRAIN) { E.fused(acc, cur, wr, wc, fr, fq, lds, wid, lane); S.done(cur); }
#undef PG8_SA
#undef PG8_SB
#undef PG8_STAGE
#undef PG8_LDA
#undef PG8_LDB
#undef PG8_MMA
#undef PG8_WAIT_V
#undef PG8_WAIT_L
#undef PG8_BAR
#undef PG8_SCHED
}
}
#define GAS __attribute__((address_space(1)))
#define LAS __attribute__((address_space(3)))
typedef GAS unsigned gu32;
typedef GAS unsigned long long gu64;
#define RLX_AGENT __ATOMIC_RELAXED, __HIP_MEMORY_SCOPE_AGENT
#define LDS_WAIT() asm volatile("s_waitcnt lgkmcnt(0)" ::: "memory")
#define VM_WAIT() asm volatile("s_waitcnt vmcnt(0)" ::: "memory")
__device__ __forceinline__ unsigned long long rt() { return __builtin_amdgcn_s_memrealtime(); }
#define XB_TMO      128
#define XB_XCNT(j)  (256  + 64 * (j))
#define XB_XSUB(j)  (1280 + 64 * (j))
#define XB_XGEN(j)  (2304 + 64 * (j))
#define XB_TOP      3328
#define XB_TOPGEN   3392
#define XCD_BAR_WORDS 3456
#define XB_SPIN_CAP (1u << 18)

__device__ __forceinline__ unsigned xb_ld(unsigned* p)              { return __hip_atomic_load(p, __ATOMIC_RELAXED, __HIP_MEMORY_SCOPE_AGENT); }
__device__ __forceinline__ unsigned xb_add(unsigned* p, unsigned v) { return __hip_atomic_fetch_add(p, v, __ATOMIC_RELAXED, __HIP_MEMORY_SCOPE_AGENT); }
__device__ __forceinline__ unsigned xb_xcc_id() { return (unsigned)__builtin_amdgcn_s_getreg((3 << 11) | 20) & 0xFu; }
#define XB_SPIN(cond, bar) do { unsigned _sp = 0; while (cond) { __builtin_amdgcn_s_sleep(1); \
    if ((++_sp & 255u) == 0u) { if (xb_ld(&(bar)[XB_TMO])) break; if (_sp > XB_SPIN_CAP) { atomicAdd(&(bar)[XB_TMO], 1u); break; } } } } while (0)

struct XcdBarrier {
    unsigned* bar; unsigned x;
    volatile LAS unsigned* st;
};

__device__ __forceinline__ XcdBarrier xcd_barrier_post(unsigned* bar, volatile LAS unsigned* st) {
    XcdBarrier b; b.bar = bar; b.x = xb_xcc_id(); b.st = st;
    if (threadIdx.x == 0) (void)xb_add(&bar[XB_XCNT(b.x)], 1u);
    return b;
}
__device__ __forceinline__ void xcd_barrier_complete(unsigned* bar, unsigned x, unsigned& nloc, unsigned& nx) {
    const unsigned G = gridDim.x * gridDim.y * gridDim.z;
    unsigned sum, cnt, mine, sp = 0u;
    for (;;) {
        sum = 0u; cnt = 0u; mine = 0u;
#pragma unroll
        for (unsigned j = 0; j < 16; ++j) { const unsigned c = xb_ld(&bar[XB_XCNT(j)]); sum += c; cnt += (c > 0u) ? 1u : 0u; mine = (j == x) ? c : mine; }
        if (sum == G) break;
        __builtin_amdgcn_s_sleep(1);
        if ((++sp & 255u) == 0u) { if (xb_ld(&bar[XB_TMO])) break; if (sp > XB_SPIN_CAP) { atomicAdd(&bar[XB_TMO], 1u); break; } }
    }
    nloc = mine > 0u ? mine : 1u; nx = cnt > 0u ? cnt : 1u;
}

__device__ __forceinline__ void xcd_barrier(const XcdBarrier& b) {
    asm volatile("s_waitcnt vmcnt(0)" ::: "memory");
    __syncthreads();
    if (threadIdx.x == 0) {
        unsigned* bar = b.bar;
        __builtin_amdgcn_s_waitcnt(0);
        unsigned nloc = b.st[0], nx = b.st[1];
        if (nloc == 0u) { xcd_barrier_complete(bar, b.x, nloc, nx); b.st[0] = nloc; b.st[1] = nx; }
        const unsigned old = xb_add(&bar[XB_XSUB(b.x)], 1u);
        const unsigned gen = old / nloc;
        if (old + 1u == (gen + 1u) * nloc) {
            __builtin_amdgcn_fence(__ATOMIC_RELEASE, "agent");
            asm volatile("s_waitcnt vmcnt(0)" ::: "memory");
            const unsigned og = xb_add(&bar[XB_TOP], 1u);
            const unsigned tg = og / nx;
            if (og + 1u == (tg + 1u) * nx) xb_add(&bar[XB_TOPGEN], 1u);
            else XB_SPIN(xb_ld(&bar[XB_TOPGEN]) == tg, bar);
            __builtin_amdgcn_fence(__ATOMIC_ACQUIRE, "agent");
            xb_add(&bar[XB_XGEN(b.x)], 1u);
            asm volatile("s_waitcnt vmcnt(0)" ::: "memory");
        } else {
            XB_SPIN(xb_ld(&bar[XB_XGEN(b.x)]) == gen, bar);
            __builtin_amdgcn_fence(__ATOMIC_ACQUIRE, "agent");
            asm volatile("s_waitcnt vmcnt(0)" ::: "memory");
        }
    }
    __syncthreads();
}
constexpr int NWAVES = 8, NTHR = NWAVES * 64;
constexpr int RING_BYTES = 131072;
constexpr int LDSCTL_OFF = RING_BYTES, MISC_OFF = LDSCTL_OFF + 320;
constexpr int LDS_BYTES = 147456;

struct Args { const float* in[21]; float* out; unsigned char* ws; int ph_lo, ph_hi; };

enum { I_X = 0, I_C, I_RELB, I_ADAW, I_ADAB, I_MIXPRE, I_MIXPOST, I_FFNPRE, I_FFNPOST, I_ABWIN, I_ABWOUT, I_CDWIN, I_QNG, I_KVNG, I_WUQ, I_WUKV, I_CDWOUT, I_WUP, I_CONVW, I_CONVB, I_WDN };

__device__ __forceinline__ float wave_sum(float v) {
#pragma unroll
    for (int o = 1; o < 64; o <<= 1) v += __shfl_xor(v, o);
    return v;
}
__device__ __forceinline__ float quad_sum(float v) { v += __shfl_xor(v, 1); v += __shfl_xor(v, 2); return v; }
__device__ __forceinline__ void load16(const f16* p, float (&o)[16]) {
    const f16x8 a = *(const f16x8*)p, b = *(const f16x8*)(p + 8);
#pragma unroll
    for (int i = 0; i < 8; ++i) { o[i] = (float)a[i]; o[8 + i] = (float)b[i]; }
}
__device__ __forceinline__ void load8(const f16* p, float (&o)[8]) {
    const f16x8 a = *(const f16x8*)p;
#pragma unroll
    for (int i = 0; i < 8; ++i) o[i] = (float)a[i];
}
__device__ __forceinline__ int t5_bucket(int d) {
    if (d < 16) return d;
    return 16 + (d >= 22) + (d >= 30) + (d >= 40) + (d >= 54) + (d >= 73) + (d >= 99) + (d >= 134) + (d >= 182) + (d >= 246) + (d >= 332) + (d >= 450) + (d >= 609) + (d >= 825) + (d >= 1117) + (d >= 1513);
}

__device__ __forceinline__ void p0_mod(const Args& a, LAS unsigned char* lds, int tid, int bid, int G) {
    LAS float* sc = (LAS float*)lds; LAS float* red = (LAS float*)(lds + 16384);
    const float* c = a.in[I_C];
    for (int i = tid; i < BATCH * DM; i += NTHR) { const float v = c[i]; sc[i] = v / (1.f + expf(-v)); }
    __syncthreads();
    const int wave = tid >> 6, lane = tid & 63;
    float* MOD = (float*)(a.ws + WS_MOD);
    for (int it = bid; it < DEPTH * 96; it += G) {
        const int l = it / 96, cg = it % 96, n = cg * 64 + lane;
        const float* W = a.in[I_ADAW] + (size_t)l * DM * 6144 + n;
        float a0 = 0.f, a1 = 0.f, a2 = 0.f, a3 = 0.f;
        const int k0 = wave * 128;
#pragma unroll 8
        for (int k = k0; k < k0 + 128; ++k) { const float w = W[(size_t)k * 6144]; a0 += sc[k] * w; a1 += sc[DM + k] * w; a2 += sc[2 * DM + k] * w; a3 += sc[3 * DM + k] * w; }
        red[(wave * 4 + 0) * 64 + lane] = a0; red[(wave * 4 + 1) * 64 + lane] = a1; red[(wave * 4 + 2) * 64 + lane] = a2; red[(wave * 4 + 3) * 64 + lane] = a3;
        __syncthreads();
        if (tid < 256) { const int b = tid >> 6; float s = 0.f;
#pragma unroll
            for (int w = 0; w < 8; ++w) s += red[(w * 4 + b) * 64 + lane];
            MOD[(size_t)(l * BATCH + b) * 6144 + n] = s + a.in[I_ADAB][l * 6144 + n]; }
        __syncthreads();
    }
}
struct TD { const float* W; int N; f16* dst; int pitch, coloff; const float* gk; int mode, nblk; };
__device__ __forceinline__ void transpose_item(const TD& d, LAS float* scr, int item, int lane) {
    const int kb = item / d.nblk, nb = item % d.nblk, k0 = 64 * kb, n0 = 32 * nb;
#pragma unroll 8
    for (int i = 0; i < 32; ++i) { const int kk = 2 * i + (lane >> 5); scr[kk * 33 + (lane & 31)] = d.W[(size_t)(k0 + kk) * d.N + n0 + (lane & 31)]; }
    LDS_WAIT(); asm volatile("" ::: "memory");
    const int c = lane & 7;
    float gs[8];
#pragma unroll
    for (int i = 0; i < 8; ++i) gs[i] = d.gk ? d.gk[k0 + 8 * c + i] : 1.f;
#pragma unroll
    for (int j = 0; j < 4; ++j) { const int n = (lane >> 3) + 8 * j; const LAS float* s = scr + (8 * c) * 33 + n;
        u32x4 o; o.x = pk_f16(s[0 * 33] * gs[0], s[1 * 33] * gs[1]); o.y = pk_f16(s[2 * 33] * gs[2], s[3 * 33] * gs[3]); o.z = pk_f16(s[4 * 33] * gs[4], s[5 * 33] * gs[5]); o.w = pk_f16(s[6 * 33] * gs[6], s[7 * 33] * gs[7]);
        const int col = n0 + n; int row = col;
        if (d.mode == 1) { const int half = col / DFF, jj = col % DFF; row = (jj >> 7) * 256 + half * 128 + (jj & 127); }
        *(GAS u32x4*)(d.dst + (size_t)row * d.pitch + d.coloff + k0 + 8 * c) = o; }
    LDS_WAIT(); asm volatile("" ::: "memory");
}
__device__ __forceinline__ void p0_weights(const Args& a, LAS unsigned char* lds, int tid, int bid, int G) {
    const int wave = tid >> 6, lane = tid & 63;
    LAS float* scr = (LAS float*)(lds + wave * 16384);
    const int gw = bid * NWAVES + wave, NGW = G * NWAVES;
    constexpr int C0 = 16 * 96, C1 = 16 * 32, C2 = 16 * 65, C3 = 4 * 24, C4 = 4 * 32, C5 = 16 * 32, C6 = 16 * 176, C7 = 44 * 32;
    constexpr int NITEMS = 2 * (C0 + C1 + C2 + C3 + C4 + C5) + 4 * (C6 + C7);
    unsigned char* ws = a.ws;
    for (int it = gw; it < NITEMS; it += NGW) {
        int r = it; TD d; d.gk = nullptr; d.mode = 0; d.coloff = 0;
        if (r < 2 * C0) { const int i = r / C0; r %= C0; d.W = a.in[I_ABWIN] + (size_t)i * DM * AB_IN; d.N = AB_IN; d.dst = (f16*)(ws + WS_W_INAB) + (size_t)i * AB_IN * DM; d.pitch = DM; d.nblk = 96; }
        else if ((r -= 2 * C0) < 2 * C1) { const int i = r / C1; r %= C1; d.W = a.in[I_ABWOUT] + (size_t)i * DM * DM; d.N = DM; d.dst = (f16*)(ws + WS_W_OUTAB) + (size_t)i * DM * DM; d.pitch = DM; d.nblk = 32; }
        else if ((r -= 2 * C1) < 2 * C2) { const int i = r / C2; r %= C2; d.W = a.in[I_CDWIN] + (size_t)i * DM * CD_IN; d.N = CD_IN; d.dst = (f16*)(ws + WS_W_INCD) + (size_t)i * CD_INP * DM; d.pitch = DM; d.nblk = 65; }
        else if ((r -= 2 * C2) < 2 * C3) { const int i = r / C3; r %= C3; d.W = a.in[I_WUQ] + (size_t)i * 256 * QW; d.N = QW; d.dst = (f16*)(ws + WS_W_UP2) + (size_t)i * UP_N * UP_K; d.pitch = UP_K; d.nblk = 24; d.gk = a.in[I_QNG] + i * 256; }
        else if ((r -= 2 * C3) < 2 * C4) { const int i = r / C4; r %= C4; d.W = a.in[I_WUKV] + (size_t)i * 256 * KVW; d.N = KVW; d.dst = (f16*)(ws + WS_W_UP2) + (size_t)i * UP_N * UP_K + (size_t)QW * UP_K; d.pitch = UP_K; d.coloff = 256; d.nblk = 32; d.gk = a.in[I_KVNG] + i * 256; }
        else if ((r -= 2 * C4) < 2 * C5) { const int i = r / C5; r %= C5; d.W = a.in[I_CDWOUT] + (size_t)i * DM * DM; d.N = DM; d.dst = (f16*)(ws + WS_W_OUTCD) + (size_t)i * DM * DM; d.pitch = DM; d.nblk = 32; }
        else if ((r -= 2 * C5) < 4 * C6) { const int i = r / C6; r %= C6; d.W = a.in[I_WUP] + (size_t)i * DM * DFF2; d.N = DFF2; d.dst = (f16*)(ws + WS_W_FUP) + (size_t)i * DFF2 * DM; d.pitch = DM; d.nblk = 176; d.mode = 1; }
        else { r -= 4 * C6; const int i = r / C7; r %= C7; d.W = a.in[I_WDN] + (size_t)i * DFF * DM; d.N = DM; d.dst = (f16*)(ws + WS_W_FDN) + (size_t)i * DM * DFF; d.pitch = DFF; d.nblk = 32; }
        transpose_item(d, scr, r, lane);
    }
    const int gt = bid * NTHR + tid, NGT = G * NTHR;
    const u32x4 z = {0u, 0u, 0u, 0u};
    for (int i = 0; i < 2; ++i) {
        GAS u32x4* p = (GAS u32x4*)((f16*)(ws + WS_W_INCD) + (size_t)i * CD_INP * DM + (size_t)CD_IN * DM);
        for (int e = gt; e < (CD_INP - CD_IN) * DM / 8; e += NGT) p[e] = z;
        f16* u = (f16*)(ws + WS_W_UP2) + (size_t)i * UP_N * UP_K;
        for (int e = gt; e < UP_N * 32; e += NGT) { const int row = e >> 5, c8 = e & 31; const int col = (row < QW ? 256 : 0) + c8 * 8; *(GAS u32x4*)(u + (size_t)row * UP_K + col) = z; }
    }
    float* rc = (float*)(ws + WS_ROPE); float* rs = rc + SEQ * 16;
    for (int e = gt; e < SEQ * 16; e += NGT) { const int t = e >> 4, i = e & 15; const float inv = (float)(1.0 / pow(10000.0, (double)i / 16.0)); const float ang = (float)t * inv;
        rc[e] = (float)cos((double)ang); rs[e] = (float)sin((double)ang); }
}

__device__ __forceinline__ void thin_phase(const float* xin, float* xout, const float* y, const float* gate_l  , const float* gpost,
                                           const float* gpre, const float* ss_l  , f16* H, f16* HHALO, bool has_y, bool write_h, bool halo,
                                           int tid, int bid, int G) {
    const int wave = tid >> 6, lane = tid & 63;
    const int gw = bid * NWAVES + wave, NGW = G * NWAVES;
    for (int row = gw; row < M; row += NGW) {
        const int b = row / SEQ;
        f32x4 xv[4];
#pragma unroll
        for (int j = 0; j < 4; ++j) xv[j] = *(const f32x4*)(xin + (size_t)row * DM + 4 * lane + 256 * j);
        if (has_y) {
            f32x4 yv[4]; float s = 0.f;
#pragma unroll
            for (int j = 0; j < 4; ++j) { yv[j] = *(const f32x4*)(y + (size_t)row * DM + 4 * lane + 256 * j); s += (yv[j].x * yv[j].x + yv[j].y * yv[j].y) + (yv[j].z * yv[j].z + yv[j].w * yv[j].w); }
            const float rstd = 1.0f / sqrtf(wave_sum(s) * (1.f / DM) + NORM_EPS);
#pragma unroll
            for (int j = 0; j < 4; ++j) { const f32x4 g = *(const f32x4*)(gpost + 4 * lane + 256 * j); const f32x4 gt = *(const f32x4*)(gate_l + (size_t)b * 6144 + 4 * lane + 256 * j);
                xv[j] = xv[j] + gt * ((yv[j] * rstd) * g); }
        }
#pragma unroll
        for (int j = 0; j < 4; ++j) *(f32x4*)(xout + (size_t)row * DM + 4 * lane + 256 * j) = xv[j];
        if (write_h) {
            float s = 0.f;
#pragma unroll
            for (int j = 0; j < 4; ++j) s += (xv[j].x * xv[j].x + xv[j].y * xv[j].y) + (xv[j].z * xv[j].z + xv[j].w * xv[j].w);
            const float rstd = 1.0f / sqrtf(wave_sum(s) * (1.f / DM) + NORM_EPS);
            const int rin = row & 255, pmn = (row >> 8) + 1;
            const bool hw = halo && rin >= 254 && (pmn & 15) != 0;
#pragma unroll
            for (int j = 0; j < 4; ++j) { const int col = 4 * lane + 256 * j; const f32x4 g = *(const f32x4*)(gpre + col);
                const f32x4 sh = *(const f32x4*)(ss_l + (size_t)b * 6144 + col), sc = *(const f32x4*)(ss_l + (size_t)b * 6144 + DM + col);
                const f32x4 hv = ((xv[j] * rstd) * g) * (sc + 1.0f) + sh;
                u32x2 w; w.x = pk_f16(hv.x, hv.y); w.y = pk_f16(hv.z, hv.w);
                *(u32x2*)(H + (size_t)row * DM + col) = w;
                if (hw) *(u32x2*)(HHALO + (size_t)(2 * pmn + (rin - 254)) * DM + col) = w; }
        }
    }
}

__device__ __forceinline__ void naive_kmean(const f16* PROJ, float* KMEAN, int gt, int NGT) {
    for (int e = gt; e < BATCH * 16 * 512; e += NGT) { const int col = e & 511, blk = (e >> 9) & 15, b = e >> 13;
        const f16* p = PROJ + ((size_t)b * SEQ + blk * 256) * AB_IN + 512 + col; float s = 0.f;
        for (int r = 0; r < 256; ++r) s += (float)p[(size_t)r * AB_IN];
        KMEAN[e] = s * (1.f / 256.f); }
}
#define OS_UPDATE(s_, vv_) do { const float mn_ = fmaxf(m, (s_)), al_ = expf(m - mn_), pe_ = expf((s_) - mn_); l = l * al_ + pe_; \
    _Pragma("unroll") for (int i_ = 0; i_ < 16; ++i_) acc[i_] = acc[i_] * al_ + pe_ * (vv_)[i_]; m = mn_; } while (0)
__device__ __forceinline__ void naive_moba(const f16* PROJ, const float* KMEAN, const float* relb, f16* ATT, int gt, int NGT) {
    const int sub = gt & 3, ngr = NGT >> 2;
    for (int item = gt >> 2; item < BATCH * NH * SEQ; item += ngr) {
        const int t = item & (SEQ - 1), h = (item >> 12) & 7, b = item >> 15;
        const size_t row = (size_t)b * SEQ + t;
        float q[16]; load16(PROJ + row * AB_IN + h * 64 + sub * 16, q);
        const int own = t >> 8;
        unsigned selmask = 0u;
        {
            float g[16];
#pragma unroll
            for (int j = 0; j < 16; ++j) { float p = 0.f;
                if (j < own) { const float* km = KMEAN + ((size_t)(b * 16 + j) * 512) + h * 64 + sub * 16;
#pragma unroll
                    for (int i = 0; i < 16; ++i) p += q[i] * km[i]; }
                p = quad_sum(p); g[j] = (j < own) ? p : -INFINITY; }
#pragma unroll
            for (int r = 0; r < 3; ++r) { float best = -INFINITY; int bi = -1;
#pragma unroll
                for (int j = 0; j < 16; ++j) { const bool ok = !((selmask >> j) & 1u) && (j < own) && (g[j] > best); if (ok) { best = g[j]; bi = j; } }
                if (bi >= 0) selmask |= 1u << bi; }
        }
        float m = -INFINITY, l = 0.f, acc[16];
#pragma unroll
        for (int i = 0; i < 16; ++i) acc[i] = 0.f;
        const f16* Kb = PROJ + (size_t)b * SEQ * AB_IN + 512 + h * 64 + sub * 16;
        const float* rb = relb + h * 32;
        for (int pos = own * 256; pos <= t; ++pos) { float kk[16], vv[16]; load16(Kb + (size_t)pos * AB_IN, kk); load16(Kb + (size_t)pos * AB_IN + 512, vv); float p = 0.f;
#pragma unroll
            for (int i = 0; i < 16; ++i) p += q[i] * kk[i];
            const float s = quad_sum(p) * 0.125f + rb[t5_bucket(t - pos)]; OS_UPDATE(s, vv); }
        for (int j = 0; j < own; ++j) { if (!((selmask >> j) & 1u)) continue;
            for (int pos = j * 256; pos < j * 256 + 256; ++pos) { float kk[16], vv[16]; load16(Kb + (size_t)pos * AB_IN, kk); load16(Kb + (size_t)pos * AB_IN + 512, vv); float p = 0.f;
#pragma unroll
                for (int i = 0; i < 16; ++i) p += q[i] * kk[i];
                const float s = quad_sum(p) * 0.125f + rb[t5_bucket(t - pos)]; OS_UPDATE(s, vv); } }
        const float il = 1.f / l; u32x4 w0, w1;
        w0.x = pk_f16(acc[0] * il, acc[1] * il); w0.y = pk_f16(acc[2] * il, acc[3] * il); w0.z = pk_f16(acc[4] * il, acc[5] * il); w0.w = pk_f16(acc[6] * il, acc[7] * il);
        w1.x = pk_f16(acc[8] * il, acc[9] * il); w1.y = pk_f16(acc[10] * il, acc[11] * il); w1.z = pk_f16(acc[12] * il, acc[13] * il); w1.w = pk_f16(acc[14] * il, acc[15] * il);
        f16* o = ATT + row * DM + h * 64 + sub * 16; *(u32x4*)o = w0; *(u32x4*)(o + 8) = w1;
    }
}
__device__ __forceinline__ void naive_dilated(const f16* PROJ, const float* relb, f16* ATT, int gt, int NGT) {
    const int sub = gt & 3, ngr = NGT >> 2;
    for (int item = gt >> 2; item < BATCH * NH * SEQ; item += ngr) {
        const int t = item & (SEQ - 1), h = (item >> 12) & 7, b = item >> 15;
        const size_t row = (size_t)b * SEQ + t;
        float q[16]; load16(PROJ + row * AB_IN + 1536 + h * 64 + sub * 16, q);
        float m = -INFINITY, l = 0.f, acc[16];
#pragma unroll
        for (int i = 0; i < 16; ++i) acc[i] = 0.f;
        const f16* Kb = PROJ + (size_t)b * SEQ * AB_IN + 2048 + h * 64 + sub * 16;
        const float* rb = relb + (8 + h) * 32;
        for (int br = 0; br < 3; ++br) { const int dil = br == 0 ? 1 : (br == 1 ? 4 : 16);
            for (int mm = 0; mm <= 128; ++mm) { const int pos = t - dil * mm; if (pos < 0) break;
                float kk[16], vv[16]; load16(Kb + (size_t)pos * AB_IN, kk); load16(Kb + (size_t)pos * AB_IN + 512, vv); float p = 0.f;
#pragma unroll
                for (int i = 0; i < 16; ++i) p += q[i] * kk[i];
                const float s = quad_sum(p) * 0.125f + rb[t5_bucket(dil * mm)]; OS_UPDATE(s, vv); } }
        const float il = 1.f / l; u32x4 w0, w1;
        w0.x = pk_f16(acc[0] * il, acc[1] * il); w0.y = pk_f16(acc[2] * il, acc[3] * il); w0.z = pk_f16(acc[4] * il, acc[5] * il); w0.w = pk_f16(acc[6] * il, acc[7] * il);
        w1.x = pk_f16(acc[8] * il, acc[9] * il); w1.y = pk_f16(acc[10] * il, acc[11] * il); w1.z = pk_f16(acc[12] * il, acc[13] * il); w1.w = pk_f16(acc[14] * il, acc[15] * il);
        f16* o = ATT + row * DM + 512 + h * 64 + sub * 16; *(u32x4*)o = w0; *(u32x4*)(o + 8) = w1;
    }
}
__device__ __forceinline__ void mla_norm_phase(f16* PROJ, f16* KPE, const float* rc, const float* rs, int tid, int bid, int G) {
    const int wave = tid >> 6, lane = tid & 63;
    const int gw = bid * NWAVES + wave, NGW = G * NWAVES;
    for (int row = gw; row < M; row += NGW) {
        f16* p = PROJ + (size_t)row * CD_INP;
        const int t = row & (SEQ - 1);
#pragma unroll
        for (int part = 0; part < 2; ++part) {
            f16x4 v = *(const f16x4*)(p + part * 256 + 4 * lane);
            float f[4] = {(float)v[0], (float)v[1], (float)v[2], (float)v[3]};
            const float s = wave_sum((f[0] * f[0] + f[1] * f[1]) + (f[2] * f[2] + f[3] * f[3]));
            const float rstd = 1.0f / sqrtf(s * (1.f / 256.f) + NORM_EPS);
            u32x2 w; w.x = pk_f16(f[0] * rstd, f[1] * rstd); w.y = pk_f16(f[2] * rstd, f[3] * rstd);
            *(u32x2*)(p + part * 256 + 4 * lane) = w;
        }
        if (lane < 16) { const float x1 = (float)p[512 + lane], x2 = (float)p[528 + lane]; const float c = rc[t * 16 + lane], s = rs[t * 16 + lane];
            KPE[(size_t)row * 32 + lane] = (f16)(x1 * c - x2 * s); KPE[(size_t)row * 32 + 16 + lane] = (f16)(x1 * s + x2 * c); }
    }
}
__device__ __forceinline__ void naive_mla(const f16* Q, const f16* KV, const f16* KPE, const float* rc, const float* rs, f16* ATT, int gt, int NGT) {
    const int sub = gt & 3, ngr = NGT >> 2;
    const float scale = 0.10206207261596575f;
    for (int item = gt >> 2; item < BATCH * NH * SEQ; item += ngr) {
        const int t = item & (SEQ - 1), h = (item >> 12) & 7, b = item >> 15;
        const size_t row = (size_t)b * SEQ + t;
        const f16* qp = Q + row * QW + h * 96;
        float q[16], qr[8]; load16(qp + sub * 16, q);
#pragma unroll
        for (int i = 0; i < 8; ++i) { const int d = 8 * sub + i, dd = d & 15; const float x1 = (float)qp[64 + dd], x2 = (float)qp[80 + dd]; const float c = rc[t * 16 + dd], s = rs[t * 16 + dd];
            qr[i] = (d < 16) ? (x1 * c - x2 * s) : (x1 * s + x2 * c); }
        float m = -INFINITY, l = 0.f, acc[16];
#pragma unroll
        for (int i = 0; i < 16; ++i) acc[i] = 0.f;
        const f16* Kb = KV + (size_t)b * SEQ * KVW + h * 128 + sub * 16;
        const f16* Pb = KPE + (size_t)b * SEQ * 32 + sub * 8;
        for (int pos = 0; pos <= t; ++pos) { float kk[16], kr[8], vv[16]; load16(Kb + (size_t)pos * KVW, kk); load8(Pb + (size_t)pos * 32, kr); load16(Kb + (size_t)pos * KVW + 64, vv); float p = 0.f;
#pragma unroll
            for (int i = 0; i < 16; ++i) p += q[i] * kk[i];
#pragma unroll
            for (int i = 0; i < 8; ++i) p += qr[i] * kr[i];
            const float s = quad_sum(p) * scale; OS_UPDATE(s, vv); }
        const float il = 1.f / l; u32x4 w0, w1;
        w0.x = pk_f16(acc[0] * il, acc[1] * il); w0.y = pk_f16(acc[2] * il, acc[3] * il); w0.z = pk_f16(acc[4] * il, acc[5] * il); w0.w = pk_f16(acc[6] * il, acc[7] * il);
        w1.x = pk_f16(acc[8] * il, acc[9] * il); w1.y = pk_f16(acc[10] * il, acc[11] * il); w1.z = pk_f16(acc[12] * il, acc[13] * il); w1.w = pk_f16(acc[14] * il, acc[15] * il);
        f16* o = ATT + row * DM + h * 64 + sub * 16; *(u32x4*)o = w0; *(u32x4*)(o + 8) = w1;
    }
}
__device__ __forceinline__ float softplusf(float x) { return fmaxf(x, 0.f) + log1pf(expf(-fabsf(x))); }
__device__ __forceinline__ void naive_sb(const f16* PROJ, f16* ATT, int gt, int NGT) {
    const int sub = gt & 3, ngr = NGT >> 2;
    for (int item = gt >> 2; item < BATCH * NH * SEQ; item += ngr) {
        const int t = item & (SEQ - 1), h = (item >> 12) & 7, b = item >> 15;
        const size_t row = (size_t)b * SEQ + t;
        float q[16]; load16(PROJ + row * CD_INP + 544 + h * 64 + sub * 16, q);
        float R = 0.f, acc[16];
#pragma unroll
        for (int i = 0; i < 16; ++i) acc[i] = 0.f;
        const f16* Kb = PROJ + (size_t)b * SEQ * CD_INP + 1056 + h * 64 + sub * 16;
        for (int pos = t - 1; pos >= 0; --pos) { float kk[16], vv[16]; load16(Kb + (size_t)pos * CD_INP, kk); load16(Kb + (size_t)pos * CD_INP + 512, vv); float p = 0.f;
#pragma unroll
            for (int i = 0; i < 16; ++i) p += q[i] * kk[i];
            const float z = quad_sum(p) * 0.125f;
            const float aw = expf(R - softplusf(-z));
#pragma unroll
            for (int i = 0; i < 16; ++i) acc[i] += aw * vv[i];
            R -= softplusf(z); }
        u32x4 w0, w1;
        w0.x = pk_f16(acc[0], acc[1]); w0.y = pk_f16(acc[2], acc[3]); w0.z = pk_f16(acc[4], acc[5]); w0.w = pk_f16(acc[6], acc[7]);
        w1.x = pk_f16(acc[8], acc[9]); w1.y = pk_f16(acc[10], acc[11]); w1.z = pk_f16(acc[12], acc[13]); w1.w = pk_f16(acc[14], acc[15]);
        f16* o = ATT + row * DM + 512 + h * 64 + sub * 16; *(u32x4*)o = w0; *(u32x4*)(o + 8) = w1;
    }
}
__device__ __forceinline__ float gelu_tanh(float g) { return 0.5f * g * (1.f + tanhf(0.7978845608028654f * (g + 0.044715f * g * g * g))); }
__device__ __forceinline__ void naive_convact(const f16* U, int half, const float* cw, const float* cb, f16* ACT, int gt, int NGT) {
    for (int e = gt; e < (M / 2) * DFF; e += NGT) { const int rl = e / DFF, j = e % DFF; const int row = half * (M / 2) + rl, t = row & (SEQ - 1);
        const int ucol = (j >> 7) * 256 + (j & 127);
        float g = cb[j], v = cb[DFF + j];
#pragma unroll
        for (int tap = 0; tap < 3; ++tap) { const int dt = 2 - tap; if (t - dt < 0) continue;
            const f16* up = U + (size_t)(rl - dt) * DFF2 + ucol;
            g += cw[tap * DFF2 + j] * (float)up[0]; v += cw[tap * DFF2 + DFF + j] * (float)up[128]; }
        ACT[(size_t)row * DFF + j] = (f16)(gelu_tanh(g) * v); }
}
#ifndef MK_SPLIT
#define MK_SPLIT 0
#endif
constexpr int N_PHASES = 2 + DEPTH * 12;

__global__ void __launch_bounds__(NTHR, 2) fwd_kernel(Args a) {
    extern __shared__ __attribute__((aligned(16))) unsigned char lds_raw[];
    LAS unsigned char* lds = (LAS unsigned char*)lds_raw;
    const int tid0 = threadIdx.x, bid = blockIdx.x, G = gridDim.x; const int NGT = G * NTHR;
    for (int u = tid0; u < (LDS_BYTES - LDSCTL_OFF) / 4; u += NTHR) ((LAS unsigned*)(lds + LDSCTL_OFF))[u] = 0u;
    __syncthreads();
    volatile LAS unsigned* MISC = (volatile LAS unsigned*)(lds + MISC_OFF);
    unsigned* ctl = (unsigned*)(a.ws + WS_CTL);
    XcdBarrier bar = xcd_barrier_post(ctl + CW_BAR, MISC + 8);
    const int lo = a.ph_lo, hi = a.ph_hi; const bool seams = (hi - lo) > 1;
    int ph = 0;
    unsigned char* ws = a.ws;
    float* X = a.out;
    float* MOD = (float*)(ws + WS_MOD);
    f16* H = (f16*)(ws + WS_H); f16* ATT = (f16*)(ws + WS_ATT); f16* HHALO = (f16*)(ws + WS_HHALO);
    f16* PROJ = (f16*)(ws + WS_R1);
    f16* Qb = (f16*)(ws + WS_R2); f16* KVb = (f16*)(ws + WS_R2 + 24 * MiB); f16* KPE = (f16*)(ws + WS_R2 + 56 * MiB);
    const float* rc = (const float*)(ws + WS_ROPE); const float* rs = rc + SEQ * 16;
#define PH_ON (lo <= ph && ph < hi)
#define PH_LOC int tid = tid0; asm volatile("" : "+v"(tid)); const int gt = bid * NTHR + tid; (void)gt
#define PH_END do { if (seams) xcd_barrier(bar); } while (0)

    if (PH_ON) { PH_LOC; p0_mod(a, lds, tid, bid, G); p0_weights(a, lds, tid, bid, G); PH_END; } ++ph;
    if (PH_ON) { PH_LOC; thin_phase(a.in[I_X], X, nullptr, nullptr, nullptr, a.in[I_MIXPRE], MOD, H, HHALO, false, true, false, tid, bid, G); PH_END; } ++ph;

    for (int l = 0; l < DEPTH; ++l) {
        const int li = l >> 1; const bool odd = (l & 1) != 0;
        const float* modl = MOD + (size_t)l * BATCH * 6144;
        if (PH_ON) { PH_LOC;
            const int N = odd ? CD_INP : AB_IN;
            const f16* Bt = odd ? (const f16*)(ws + WS_W_INCD) + (size_t)li * CD_INP * DM : (const f16*)(ws + WS_W_INAB) + (size_t)li * AB_IN * DM;
            pg8::Gemm g{H, Bt, M, N, DM, DM}; pg8::StaticOrder S; S.init(M, N, G, bid);
            pg8::EpiF16 E{PROJ, N, 0, nullptr, 0};
            pg8::gemm_phase<pg8::EpiF16, pg8::StaticOrder, true, true>(lds, g, S, E);
            PH_END; } ++ph;
        if (PH_ON) { PH_LOC;
            if (!odd) naive_kmean(PROJ, (float*)(ws + WS_KMEAN), gt, NGT);
            else mla_norm_phase(PROJ, KPE, rc, rs, tid, bid, G);
            PH_END; } ++ph;
        if (PH_ON) { PH_LOC;
            if (odd) {
                pg8::Gemm g{PROJ, (const f16*)(ws + WS_W_UP2) + (size_t)li * UP_N * UP_K, M, UP_N, UP_K, CD_INP}; pg8::StaticOrder S; S.init(M, UP_N, G, bid);
                pg8::EpiF16 E{Qb, QW, QW, KVb, KVW};
                pg8::gemm_phase<pg8::EpiF16, pg8::StaticOrder, true, true>(lds, g, S, E);
                PH_END; }
        } ++ph;
        if (PH_ON) { PH_LOC;
            if (!odd) { naive_moba(PROJ, (const float*)(ws + WS_KMEAN), a.in[I_RELB], ATT, gt, NGT); naive_dilated(PROJ, a.in[I_RELB], ATT, gt, NGT); }
            else { naive_mla(Qb, KVb, KPE, rc, rs, ATT, gt, NGT); naive_sb(PROJ, ATT, gt, NGT); }
            PH_END; } ++ph;
        float* Y1 = (float*)(ws + WS_R2); float* Y2 = (float*)(ws + WS_R1);
        if (PH_ON) { PH_LOC;
            const f16* Bt = odd ? (const f16*)(ws + WS_W_OUTCD) + (size_t)li * DM * DM : (const f16*)(ws + WS_W_OUTAB) + (size_t)li * DM * DM;
            pg8::Gemm g{ATT, Bt, M, DM, DM, DM}; pg8::StaticOrder S; S.init(M, DM, G, bid);
            pg8::EpiF32 E{Y1, DM, M};
            pg8::gemm_phase<pg8::EpiF32, pg8::StaticOrder, true, true>(lds, g, S, E);
            PH_END; } ++ph;
        if (PH_ON) { PH_LOC; thin_phase(X, X, Y1, modl + 2 * DM, a.in[I_MIXPOST] + l * DM, a.in[I_FFNPRE] + l * DM, modl + 3 * DM, H, HHALO, true, true, false, tid, bid, G); PH_END; } ++ph;
        f16* U = (f16*)(ws + WS_R1); f16* ACT = (f16*)(ws + WS_ATT);
        for (int half = 0; half < 2; ++half) {
            if (PH_ON) { PH_LOC;
                pg8::Gemm g{H + (size_t)half * (M / 2) * DM, (const f16*)(ws + WS_W_FUP) + (size_t)l * DFF2 * DM, M / 2, DFF2, DM, DM}; pg8::StaticOrder S; S.init(M / 2, DFF2, G, bid);
                pg8::EpiF16 E{U, DFF2, 0, nullptr, 0};
                pg8::gemm_phase<pg8::EpiF16, pg8::StaticOrder, true, true>(lds, g, S, E);
                PH_END; } ++ph;
            if (PH_ON) { PH_LOC; naive_convact(U, half, a.in[I_CONVW] + (size_t)l * 3 * DFF2, a.in[I_CONVB] + (size_t)l * DFF2, ACT, gt, NGT); PH_END; } ++ph;
        }
        if (PH_ON) { PH_LOC;
            pg8::Gemm g{ACT, (const f16*)(ws + WS_W_FDN) + (size_t)l * DM * DFF, M, DM, DFF, DFF}; pg8::StaticOrder S; S.init(M, DM, G, bid);
            pg8::EpiF32 E{Y2, DM, M};
            pg8::gemm_phase<pg8::EpiF32, pg8::StaticOrder, true, true>(lds, g, S, E);
            PH_END; } ++ph;
        if (PH_ON) { PH_LOC;
            const int ln = (l + 1 < DEPTH) ? l + 1 : l;
            thin_phase(X, X, Y2, modl + 5 * DM, a.in[I_FFNPOST] + l * DM, a.in[I_MIXPRE] + ln * DM, MOD + (size_t)ln * BATCH * 6144, H, HHALO, true, l + 1 < DEPTH, false, tid, bid, G);
            PH_END; } ++ph;
    }
#undef PH_ON
#undef PH_END
}

extern "C" void kernel_launch(void* const* d_in, const int* in_sizes, int n_in, void* d_out, int out_size, void* d_ws, size_t ws_size, hipStream_t stream) {
    static int grid = 0;
    if (grid == 0) {
        if (n_in != 21 || in_sizes[0] != M * DM || out_size != M * DM || ws_size < WS_END) { fprintf(stderr, "kernel_launch: unexpected shapes (n_in %d, ws %zu); nothing launched\n", n_in, ws_size); grid = -1; return; }
        int dev = 0, cus = 0, per_cu = 0;
        if (hipGetDevice(&dev) != hipSuccess || hipDeviceGetAttribute(&cus, hipDeviceAttributeMultiprocessorCount, dev) != hipSuccess) { grid = -1; return; }
        if (hipFuncSetAttribute((const void*)fwd_kernel, hipFuncAttributeMaxDynamicSharedMemorySize, LDS_BYTES) != hipSuccess) { fprintf(stderr, "kernel_launch: hipFuncSetAttribute failed\n"); grid = -1; return; }
        if (hipOccupancyMaxActiveBlocksPerMultiprocessor(&per_cu, (const void*)fwd_kernel, NTHR, LDS_BYTES) != hipSuccess || per_cu < 1) { fprintf(stderr, "kernel_launch: occupancy query reports %d\n", per_cu); }
        (void)hipGetLastError();
        grid = cus;
    }
    if (grid < 0) return;
    (void)hipMemsetAsync((char*)d_ws + WS_CTL, 0, CTL_ZERO_BYTES, stream);
    Args a{};
    for (int i = 0; i < 21; ++i) a.in[i] = (const float*)d_in[i];
    a.out = (float*)d_out; a.ws = (unsigned char*)d_ws;
#if MK_SPLIT
    for (int p = 0; p < N_PHASES; ++p) { a.ph_lo = p; a.ph_hi = p + 1; hipLaunchKernelGGL(fwd_kernel, dim3(grid), dim3(NTHR), LDS_BYTES, stream, a); }
#else
    a.ph_lo = 0; a.ph_hi = N_PHASES;
    hipLaunchKernelGGL(fwd_kernel, dim3(grid), dim3(NTHR), LDS_BYTES, stream, a);
#endif
}
```

```cpp
#include <hip/hip_runtime.h>
#include <cstdio>
#include <cstdint>

constexpr int BATCH = 4, SEQ = 4096, DM = 1024, M = BATCH * SEQ, DEPTH = 4;
constexpr int NH = 8, HD = 64;
constexpr int AB_IN = 3072, CD_IN = 2080, CD_INP = 2304;
constexpr int DFF = 2816, DFF2 = 5632;
constexpr int UP_N = 1792, UP_K = 256;
constexpr int QW = 768, KVW = 1024;
constexpr float NORM_EPS = 1e-6f;

typedef _Float16 f16;
typedef _Float16 f16x2 __attribute__((ext_vector_type(2)));
typedef _Float16 f16x4 __attribute__((ext_vector_type(4)));
typedef _Float16 f16x8 __attribute__((ext_vector_type(8)));
typedef float f32x2 __attribute__((ext_vector_type(2)));
typedef float f32x4 __attribute__((ext_vector_type(4)));
typedef unsigned u32x2 __attribute__((ext_vector_type(2)));
typedef unsigned u32x4 __attribute__((ext_vector_type(4)));

__device__ __forceinline__ unsigned pk_f16(float lo, float hi) { f32x2 v = {lo, hi}; f16x2 h = __builtin_convertvector(v, f16x2); return __builtin_bit_cast(unsigned, h); }

constexpr size_t MiB = 1u << 20;
constexpr size_t WS_CTL = 0, CTL_ZERO_BYTES = 1 * MiB;
constexpr size_t WS_MOD = 1 * MiB;
constexpr size_t WS_KMEAN = 1 * MiB + 512 * 1024;
constexpr size_t WS_ROPE = 2 * MiB;
constexpr size_t WS_UHALO = 3 * MiB;
constexpr size_t WS_HHALO = 140 * MiB;
constexpr size_t WS_XB = 6 * MiB;
constexpr size_t WS_W_INAB = 8 * MiB;
constexpr size_t WS_W_OUTAB = 20 * MiB;
constexpr size_t WS_W_INCD = 24 * MiB;
constexpr size_t WS_W_UP2 = 33 * MiB;
constexpr size_t WS_W_OUTCD = 37 * MiB;
constexpr size_t WS_W_FUP = 41 * MiB;
constexpr size_t WS_W_FDN = 85 * MiB;
constexpr size_t WS_H = 108 * MiB;
constexpr size_t WS_ATT = 140 * MiB;
constexpr size_t WS_R2 = 172 * MiB;
constexpr size_t WS_R1 = 236 * MiB;
constexpr size_t WS_END = 332 * MiB;
constexpr int CW_BAR = 4096;
constexpr int CW_PANEL = 32768;
constexpr int CW_HALO = 16384;
namespace pg8 {
#define PG8_LAS __attribute__((address_space(3)))
constexpr int BM = 256, BK = 64, HALF = 128, HTB = HALF * BK * 2  , STAGE_BYTES = 8 * HTB, NXCD = 8, WGM = 8;

__host__ __device__ __forceinline__ int lds_byte(int r, int c) { const int st = (r >> 4) * 2 + (c >> 5), rr = r & 15, cc = c & 31, ob = rr * 64 + cc * 2; return st * 1024 + (ob ^ (((ob >> 9) & 1) << 5)); }
__host__ __device__ __forceinline__ void stage_rc(int b, int& R, int& C) { const int st = b / 1024, sb = b % 1024, swz = sb ^ (((sb >> 9) & 1) << 5); R = (st >> 1) * 16 + swz / 64; C = (st & 1) * 32 + (swz % 64) / 2; }
__host__ __device__ __forceinline__ int perm32(int rho) { const int n = rho >> 4, i = rho & 15; return 8 * (i >> 2) + 4 * n + (i & 3); }

struct Unit { int pm, pn; };
struct Gemm { const f16* A; const f16* Bt; int M, N, K, lda; };

struct StaticOrder {
    int nM, nN, nwg, G, c;
    __host__ __device__ __forceinline__ void init(int M_, int N_, int G_, int c_) { nM = M_ / BM; nN = N_ / BM; nwg = nM * nN; G = G_; c = c_; }
    __host__ __device__ __forceinline__ void map(int wgid, Unit& u) const {
        { const int q = nwg / NXCD, r = nwg % NXCD, xcd = wgid % NXCD, off = wgid / NXCD; wgid = (xcd < r ? xcd * (q + 1) : r * (q + 1) + (xcd - r) * q) + off; }
        const int nig = WGM * nN, gid = wgid / nig, fm = gid * WGM, gsz = (nM - fm) < WGM ? (nM - fm) : WGM;
        u.pm = fm + ((wgid % nig) % gsz); u.pn = (wgid % nig) / gsz;
    }
    __host__ __device__ __forceinline__ bool next(int i, Unit& u) const { const long L = (long)i * G + c; if (L >= nwg) return false; map((int)L, u); return true; }
    __device__ __forceinline__ void a_ready(const Unit&) const {}
    __device__ __forceinline__ void done(const Unit&) const {}
    __device__ __forceinline__ size_t a_off(const Unit&) const { return 0; }
};

struct FfnUpOrder {
    StaticOrder S; int nh;
    __host__ __device__ __forceinline__ void init(int M_, int N_, int G_, int c_) { S.init(M_, N_, G_, c_); nh = N_ / BM; }
    __host__ __device__ __forceinline__ bool next(int i, Unit& u) const { const long L = (long)i * S.G + S.c; if (L >= S.nwg + nh) return false; if (L < nh) { u.pm = S.nM; u.pn = (int)L; return true; } S.map((int)L - nh, u); return true; }
    __device__ __forceinline__ void a_ready(const Unit&) const {}
    __device__ __forceinline__ void done(const Unit&) const {}
    __device__ __forceinline__ size_t a_off(const Unit&) const { return 0; }
};

struct UpOrder {
    StaticOrder S; int split_pn;
    __host__ __device__ __forceinline__ void init(int M_, int N_, int G_, int c_, int sp) { S.init(M_, N_, G_, c_); split_pn = sp; }
    __host__ __device__ __forceinline__ bool next(int i, Unit& u) const { return S.next(i, u); }
    __device__ __forceinline__ void a_ready(const Unit&) const {}
    __device__ __forceinline__ void done(const Unit&) const {}
    __device__ __forceinline__ size_t a_off(const Unit& u) const { return u.pn >= split_pn ? 512 : 0; }
};

struct NoPre {};
struct EpiNull {
    static constexpr bool PERM = true, AFTER_DRAIN = false;
    typedef NoPre Pre; __device__ __forceinline__ void prefetch(Pre&, const Unit&, int) const {}
    __device__ __forceinline__ void operator()(const f32x4 (&acc)[2][2][4][2], const Unit&, int, int, int, int, const Pre&) const {
#pragma unroll
        for (int a = 0; a < 2; ++a)
#pragma unroll
            for (int b = 0; b < 2; ++b)
#pragma unroll
                for (int m = 0; m < 4; ++m) asm volatile("" :: "v"(acc[a][b][m][0]), "v"(acc[a][b][m][1]));
    }
};
struct EpiF32 {
    static constexpr bool PERM = false, AFTER_DRAIN = false;
    float* C; int ldc; int row_limit;
    typedef NoPre Pre; __device__ __forceinline__ void prefetch(Pre&, const Unit&, int) const {}
    __device__ __forceinline__ void operator()(const f32x4 (&acc)[2][2][4][2], const Unit& u, int wr, int wc, int fr_in, int fq_in, const Pre&) const {
        int fr = fr_in, fq = fq_in; asm volatile("" : "+v"(fr), "+v"(fq));
        const int row0 = u.pm * BM + wr * 64 + fr, col0 = u.pn * BM + wc * 32 + 4 * fq;
#pragma unroll
        for (int ai = 0; ai < 2; ++ai)
#pragma unroll
            for (int m = 0; m < 4; ++m) { const int row = row0 + ai * HALF + m * 16; if (row >= row_limit) continue; float* rowp = C + (size_t)row * ldc + col0;
#pragma unroll
                for (int bj = 0; bj < 2; ++bj)
#pragma unroll
                    for (int n = 0; n < 2; ++n) *(f32x4*)(rowp + bj * HALF + n * 16) = acc[ai][bj][m][n]; }
    }
};
struct EpiF16 {
    static constexpr bool PERM = true, AFTER_DRAIN = false;
    f16* O; int ldc; int split_col; f16* O2; int ldc2;
    float* ksum; int ks_lo, ks_hi;
    PG8_LAS float* XR; f16* KPE; const float* rc; const float* rs;
    unsigned* pcnt;
    typedef NoPre Pre; __device__ __forceinline__ void prefetch(Pre&, const Unit&, int) const {}
    __device__ __forceinline__ void operator()(const f32x4 (&acc)[2][2][4][2], const Unit& u, int wr, int wc, int fr_in, int fq_in, const Pre&) const {
        int fr = fr_in, fq = fq_in; asm volatile("" : "+v"(fr), "+v"(fq));
        float rsc[2][4];
#pragma unroll
        for (int ai = 0; ai < 2; ++ai)
#pragma unroll
            for (int m = 0; m < 4; ++m) rsc[ai][m] = 1.0f;
        if (XR != nullptr) {
            const bool nt = u.pn < 2;
            if (nt) {
#pragma unroll
                for (int ai = 0; ai < 2; ++ai)
#pragma unroll
                    for (int m = 0; m < 4; ++m) { float q = 0.f;
#pragma unroll
                        for (int bj = 0; bj < 2; ++bj)
#pragma unroll
                            for (int n = 0; n < 2; ++n) { const f32x4 x = acc[ai][bj][m][n]; q += (x[0] * x[0] + x[1] * x[1]) + (x[2] * x[2] + x[3] * x[3]); }
                        q += __shfl_xor(q, 16); q += __shfl_xor(q, 32);
                        if (fq == 0) XR[(ai * HALF + wr * 64 + m * 16 + fr) * 4 + wc] = q; }
            }
            asm volatile("s_waitcnt lgkmcnt(0)" ::: "memory"); __builtin_amdgcn_s_barrier(); asm volatile("" ::: "memory");
            if (nt) {
#pragma unroll
                for (int ai = 0; ai < 2; ++ai)
#pragma unroll
                    for (int m = 0; m < 4; ++m) { const f32x4 q = *(const PG8_LAS f32x4*)(XR + (ai * HALF + wr * 64 + m * 16 + fr) * 4); rsc[ai][m] = 1.0f / sqrtf(((q[0] + q[1]) + (q[2] + q[3])) * (1.0f / 256.0f) + NORM_EPS); }
            }
            if (u.pn == 2 && wc == 0) {
                const int half = fq >> 1, dd0 = 8 * (fq & 1);
#pragma unroll
                for (int ai = 0; ai < 2; ++ai)
#pragma unroll
                    for (int m = 0; m < 4; ++m) { const int row = u.pm * BM + ai * HALF + wr * 64 + m * 16 + fr, t = row & (SEQ - 1);
#pragma unroll
                        for (int n = 0; n < 2; ++n) { const f32x4 own = acc[ai][0][m][n]; f32x4 par;
#pragma unroll
                            for (int e = 0; e < 4; ++e) par[e] = __shfl_xor(own[e], 32);
                            const f32x4 cs = *(const f32x4*)(rc + t * 16 + dd0 + 4 * n), sn = *(const f32x4*)(rs + t * 16 + dd0 + 4 * n);
                            const f32x4 o = half ? (par * sn + own * cs) : (own * cs - par * sn);
                            u32x2 w; w.x = pk_f16(o[0], o[1]); w.y = pk_f16(o[2], o[3]);
                            *(u32x2*)(KPE + (size_t)row * 32 + 16 * half + dd0 + 4 * n) = w; } }
            }
        }
        if (ksum != nullptr && u.pn * BM >= ks_lo && u.pn * BM < ks_hi) {
#pragma unroll
            for (int bj = 0; bj < 2; ++bj)
#pragma unroll
                for (int n = 0; n < 2; ++n) { f32x4 cs = (acc[0][bj][0][n] + acc[0][bj][1][n]) + (acc[0][bj][2][n] + acc[0][bj][3][n]); cs = cs + ((acc[1][bj][0][n] + acc[1][bj][1][n]) + (acc[1][bj][2][n] + acc[1][bj][3][n]));
#pragma unroll
                    for (int e = 0; e < 4; ++e) { float v = cs[e]; v += __shfl_xor(v, 1); v += __shfl_xor(v, 2); v += __shfl_xor(v, 4); v += __shfl_xor(v, 8);
                        if (fr == 0) atomicAdd(ksum + (size_t)u.pm * (ks_hi - ks_lo) + (u.pn * BM - ks_lo) + bj * HALF + wc * 32 + 8 * fq + 4 * n + e, v); } }
        }
        const int row0 = u.pm * BM + wr * 64 + fr; int colt = u.pn * BM; f16* base = O; int ld = ldc;
        if (split_col && colt >= split_col) { base = O2; ld = ldc2; colt -= split_col; }
        const int col0 = colt + wc * 32 + 8 * fq;
        if (pcnt == nullptr) {
#pragma unroll
            for (int ai = 0; ai < 2; ++ai)
#pragma unroll
                for (int m = 0; m < 4; ++m) { f16* rowp = base + (size_t)(row0 + ai * HALF + m * 16) * ld + col0;
#pragma unroll
                    for (int bj = 0; bj < 2; ++bj) { const f32x4 v0 = acc[ai][bj][m][0] * rsc[ai][m], v1 = acc[ai][bj][m][1] * rsc[ai][m];
                        u32x4 w; w.x = pk_f16(v0[0], v0[1]); w.y = pk_f16(v0[2], v0[3]); w.z = pk_f16(v1[0], v1[1]); w.w = pk_f16(v1[2], v1[3]);
                        *(u32x4*)(rowp + bj * HALF) = w; } }
        } else {
            const __amdgpu_buffer_rsrc_t rsrc = __builtin_amdgcn_make_buffer_rsrc((void*)base, 0, 0x7fffffff, 0x00020000);
#pragma unroll
            for (int ai = 0; ai < 2; ++ai)
#pragma unroll
                for (int m = 0; m < 4; ++m) { const unsigned boff = (unsigned)(((size_t)(row0 + ai * HALF + m * 16) * ld + col0) * 2);
#pragma unroll
                    for (int bj = 0; bj < 2; ++bj) { const f32x4 v0 = acc[ai][bj][m][0] * rsc[ai][m], v1 = acc[ai][bj][m][1] * rsc[ai][m];
                        u32x4 w; w.x = pk_f16(v0[0], v0[1]); w.y = pk_f16(v0[2], v0[3]); w.z = pk_f16(v1[0], v1[1]); w.w = pk_f16(v1[2], v1[3]);
                        __builtin_amdgcn_raw_buffer_store_b128(w, rsrc, boff + bj * HALF * 2, 0, 16); } }
            asm volatile("s_waitcnt vmcnt(0)" ::: "memory");
            if (fr == 0 && fq == 0) __hip_atomic_fetch_add(pcnt + 64 * u.pm, 1u, __ATOMIC_RELAXED, __HIP_MEMORY_SCOPE_AGENT);
        }
    }
};

struct EpiRow {
    static constexpr bool PERM = true, AFTER_DRAIN = true;
    typedef NoPre Pre; __device__ __forceinline__ void prefetch(Pre&, const Unit&, int) const {}
    const f16* xin; f16* xout; float* out32;
    const float* gate_l; const float* gpost;
    const float* gpre; const float* ss_l;
    f16* H; f16* HHALO;
    float* xb1; float* xb2; unsigned* c1; unsigned* c2;
    __device__ __forceinline__ void exchange(float (&q)[2][4], float* xb, unsigned* cnt, const Unit& u, int wr, int wc, int fr, int fq, PG8_LAS unsigned char* lds, int wid, int lane) const {
        PG8_LAS float* P = (PG8_LAS float*)lds;
        PG8_LAS float* S = (PG8_LAS float*)(lds + 8192);
#pragma unroll
        for (int ai = 0; ai < 2; ++ai)
#pragma unroll
            for (int m = 0; m < 4; ++m) { float v = q[ai][m]; v += __shfl_xor(v, 16); v += __shfl_xor(v, 32);
                if (fq == 0) P[(ai * HALF + wr * 64 + m * 16 + fr) * 4 + wc] = v; }
        asm volatile("s_waitcnt lgkmcnt(0)" ::: "memory"); __builtin_amdgcn_s_barrier(); asm volatile("" ::: "memory");
        const int row = wid * 32 + (lane & 31);
        if (lane < 32) { const f32x4 p = *(const PG8_LAS f32x4*)(P + row * 4);
            __hip_atomic_store((unsigned*)(xb + ((size_t)(u.pm * BM + row)) * 4 + u.pn), __builtin_bit_cast(unsigned, (p[0] + p[1]) + (p[2] + p[3])), __ATOMIC_RELAXED, __HIP_MEMORY_SCOPE_AGENT); }
        asm volatile("s_waitcnt vmcnt(0)" ::: "memory");
        if (lane == 0) __hip_atomic_fetch_add(cnt + 64 * u.pm, 1u, __ATOMIC_RELAXED, __HIP_MEMORY_SCOPE_AGENT);
        if (wid == 0) { unsigned spins = 0;
            while ((unsigned)__builtin_amdgcn_readfirstlane(__hip_atomic_load(cnt + 64 * u.pm, __ATOMIC_RELAXED, __HIP_MEMORY_SCOPE_AGENT)) < 32u) { __builtin_amdgcn_s_sleep(1); if (++spins > (1u << 16)) break; }
            __builtin_amdgcn_fence(__ATOMIC_ACQUIRE, "agent"); }
        asm volatile("s_waitcnt vmcnt(0) lgkmcnt(0)" ::: "memory"); __builtin_amdgcn_s_barrier(); asm volatile("" ::: "memory");
        if (lane < 32) { const unsigned* sl = (const unsigned*)(xb + ((size_t)(u.pm * BM + row)) * 4); float t = 0.f;
#pragma unroll
            for (int k = 0; k < 4; ++k) t += __builtin_bit_cast(float, __hip_atomic_load(sl + k, __ATOMIC_RELAXED, __HIP_MEMORY_SCOPE_AGENT));
            S[row] = t; }
        asm volatile("s_waitcnt lgkmcnt(0)" ::: "memory"); __builtin_amdgcn_s_barrier(); asm volatile("" ::: "memory");
#pragma unroll
        for (int ai = 0; ai < 2; ++ai)
#pragma unroll
            for (int m = 0; m < 4; ++m) q[ai][m] = S[ai * HALF + wr * 64 + m * 16 + fr];
        asm volatile("s_waitcnt lgkmcnt(0)" ::: "memory"); __builtin_amdgcn_s_barrier(); asm volatile("" ::: "memory");
    }
    __device__ __forceinline__ void fused(f32x4 (&acc)[2][2][4][2], const Unit& u, int wr, int wc, int fr, int fq, PG8_LAS unsigned char* lds, int wid, int lane) const {
        const int b = (u.pm * BM) / SEQ;
        const int row0 = u.pm * BM + wr * 64 + fr, col0 = u.pn * BM + wc * 32 + 8 * fq;
        float q[2][4];
#pragma unroll
        for (int ai = 0; ai < 2; ++ai)
#pragma unroll
            for (int m = 0; m < 4; ++m) { float v = 0.f;
#pragma unroll
                for (int bj = 0; bj < 2; ++bj)
#pragma unroll
                    for (int n = 0; n < 2; ++n) { const f32x4 x = acc[ai][bj][m][n]; v += (x[0] * x[0] + x[1] * x[1]) + (x[2] * x[2] + x[3] * x[3]); }
                q[ai][m] = v; }
        exchange(q, xb1, c1, u, wr, wc, fr, fq, lds, wid, lane);
#pragma unroll
        for (int ai = 0; ai < 2; ++ai)
#pragma unroll
            for (int m = 0; m < 4; ++m) q[ai][m] = 1.0f / sqrtf(q[ai][m] * (1.0f / 1024.0f) + NORM_EPS);
#pragma unroll
        for (int bj = 0; bj < 2; ++bj) {
            const int col = col0 + bj * HALF;
            const f32x4 ta0 = *(const f32x4*)(gate_l + (size_t)b * 6144 + col) * *(const f32x4*)(gpost + col), ta1 = *(const f32x4*)(gate_l + (size_t)b * 6144 + col + 4) * *(const f32x4*)(gpost + col + 4);
#pragma unroll
            for (int ai = 0; ai < 2; ++ai)
#pragma unroll
                for (int m = 0; m < 4; ++m) { const size_t off = (size_t)(row0 + ai * HALF + m * 16) * 1024 + col;
                    const f16x8 xh = *(const f16x8*)(xin + off);
                    f32x4 x0 = {(float)xh[0], (float)xh[1], (float)xh[2], (float)xh[3]}, x1 = {(float)xh[4], (float)xh[5], (float)xh[6], (float)xh[7]};
                    x0 = x0 + ta0 * (acc[ai][bj][m][0] * q[ai][m]); x1 = x1 + ta1 * (acc[ai][bj][m][1] * q[ai][m]);
                    if (out32 != nullptr) { *(f32x4*)(out32 + off) = x0; *(f32x4*)(out32 + off + 4) = x1; }
                    else { u32x4 w; w.x = pk_f16(x0[0], x0[1]); w.y = pk_f16(x0[2], x0[3]); w.z = pk_f16(x1[0], x1[1]); w.w = pk_f16(x1[2], x1[3]);
                        *(u32x4*)(xout + off) = w;
                        const f16x8 r = __builtin_bit_cast(f16x8, w);
                        x0 = (f32x4){(float)r[0], (float)r[1], (float)r[2], (float)r[3]}; x1 = (f32x4){(float)r[4], (float)r[5], (float)r[6], (float)r[7]}; }
                    acc[ai][bj][m][0] = x0; acc[ai][bj][m][1] = x1; }
            asm volatile("" ::: "memory");
        }
        if (out32 != nullptr) return;
#pragma unroll
        for (int ai = 0; ai < 2; ++ai)
#pragma unroll
            for (int m = 0; m < 4; ++m) { float v = 0.f;
#pragma unroll
                for (int bj = 0; bj < 2; ++bj)
#pragma unroll
                    for (int n = 0; n < 2; ++n) { const f32x4 x = acc[ai][bj][m][n]; v += (x[0] * x[0] + x[1] * x[1]) + (x[2] * x[2] + x[3] * x[3]); }
                q[ai][m] = v; }
        exchange(q, xb2, c2, u, wr, wc, fr, fq, lds, wid, lane);
#pragma unroll
        for (int ai = 0; ai < 2; ++ai)
#pragma unroll
            for (int m = 0; m < 4; ++m) q[ai][m] = 1.0f / sqrtf(q[ai][m] * (1.0f / 1024.0f) + NORM_EPS);
#pragma unroll
        for (int bj = 0; bj < 2; ++bj) {
            const int col = col0 + bj * HALF; const float* sp = ss_l + (size_t)b * 6144 + col;
            const f32x4 tb0 = *(const f32x4*)(gpre + col) * (*(const f32x4*)(sp + 1024) + 1.0f), tb1 = *(const f32x4*)(gpre + col + 4) * (*(const f32x4*)(sp + 1024 + 4) + 1.0f);
            const f32x4 tc0 = *(const f32x4*)sp, tc1 = *(const f32x4*)(sp + 4);
#pragma unroll
            for (int ai = 0; ai < 2; ++ai)
#pragma unroll
                for (int m = 0; m < 4; ++m) { const int row = row0 + ai * HALF + m * 16;
                    const f32x4 h0 = (acc[ai][bj][m][0] * q[ai][m]) * tb0 + tc0, h1 = (acc[ai][bj][m][1] * q[ai][m]) * tb1 + tc1;
                    u32x4 w; w.x = pk_f16(h0[0], h0[1]); w.y = pk_f16(h0[2], h0[3]); w.z = pk_f16(h1[0], h1[1]); w.w = pk_f16(h1[2], h1[3]);
                    *(u32x4*)(H + (size_t)row * 1024 + col) = w;
                    if (HHALO != nullptr && (row & 255) >= 254 && (((row >> 8) + 1) & 15) != 0) *(u32x4*)(HHALO + (size_t)(2 * ((row >> 8) + 1) + ((row & 255) - 254)) * 1024 + col) = w; }
            asm volatile("" ::: "memory");
        }
    }
};

__device__ __forceinline__ float gelu_tanh_f(float g) { const float u = 0.7978845608028654f * (g + 0.044715f * g * g * g); const float e = __builtin_amdgcn_exp2f(u * 2.885390081777927f); return g * (1.0f - __builtin_amdgcn_rcpf(e + 1.0f)); }
__device__ __forceinline__ f32x2 gelu_mul_pk(f32x2 g, f32x2 v) {
    const f32x2 g2 = g * g, t = g2 * (0.044715f * 2.302208198f) + 2.302208198f, u2 = t * g;
    f32x2 e; e.x = __builtin_amdgcn_exp2f(u2.x); e.y = __builtin_amdgcn_exp2f(u2.y);
    const f32x2 d = e + 1.0f; f32x2 r; r.x = __builtin_amdgcn_rcpf(d.x); r.y = __builtin_amdgcn_rcpf(d.y);
    const f32x2 gv = g * v; return gv - gv * r;
}
template <int N> __device__ __forceinline__ float ror16(float v) { return __builtin_bit_cast(float, __builtin_amdgcn_update_dpp(0, __builtin_bit_cast(int, v), 0x120 + N, 0xf, 0xf, false)); }
__device__ __forceinline__ f32x4 ld_agent_f32x4(const float* p) { typedef unsigned long long u64; const u64 a = __hip_atomic_load((u64*)p, __ATOMIC_RELAXED, __HIP_MEMORY_SCOPE_AGENT), b = __hip_atomic_load((u64*)p + 1, __ATOMIC_RELAXED, __HIP_MEMORY_SCOPE_AGENT);
    return (f32x4){__builtin_bit_cast(float, (unsigned)a), __builtin_bit_cast(float, (unsigned)(a >> 32)), __builtin_bit_cast(float, (unsigned)b), __builtin_bit_cast(float, (unsigned)(b >> 32))}; }
struct EpiConv {
    static constexpr bool PERM = true, AFTER_DRAIN = false;
    f16* ACT; float* UHALO; const float* cw; const float* cb; PG8_LAS float* X;
    PG8_LAS float* WL;
    unsigned* hcnt; int halo_pm;
    struct Pre { float w[2]; unsigned hc; };
    __device__ __forceinline__ void prefetch(Pre& p, const Unit& u, int tid) const {
        if (u.pm == halo_pm) return;
        p.hc = ((u.pm & 15) != 0) ? __hip_atomic_load(hcnt + 64 * u.pn, __ATOMIC_RELAXED, __HIP_MEMORY_SCOPE_AGENT) : 8u;
        asm volatile("" : "+v"(tid));
#pragma unroll
        for (int k = 0; k < 2; ++k) { const int idx = tid + 512 * k, q = idx >> 8, bjw = (idx >> 7) & 1, col = idx & 127; const int oc = bjw * 2816 + u.pn * 128 + col;
            p.w[k] = (q < 3) ? cw[q * 5632 + oc] : cb[oc]; }
    }
    __device__ __forceinline__ void operator()(f32x4 (&acc)[2][2][4][2], const Unit& u, int wr, int wc, int fr_in, int fq_in, const Pre& pre) const {
        int fr = fr_in, fq = fq_in; asm volatile("" : "+v"(fr), "+v"(fq));
        const int lane = fr + 16 * fq;
        const int lc = wc * 32 + 8 * fq;
        if (u.pm == halo_pm) {
#pragma unroll
            for (int m = 0; m < 4; ++m)
#pragma unroll
                for (int bj = 0; bj < 2; ++bj)
#pragma unroll
                    for (int n = 0; n < 2; ++n) *(f32x4*)(UHALO + (size_t)(wr * 64 + m * 16 + fr) * 5632 + u.pn * 256 + bj * 128 + lc + 4 * n) = acc[0][bj][m][n];
            __builtin_amdgcn_fence(__ATOMIC_RELEASE, "agent");
            asm volatile("s_waitcnt vmcnt(0)" ::: "memory");
            if (lane == 0) __hip_atomic_fetch_add(hcnt + 64 * u.pn, 1u, __ATOMIC_RELAXED, __HIP_MEMORY_SCOPE_AGENT);
            return;
        }
        if (wr == 0 && (u.pm & 15) != 0) {
            unsigned c = pre.hc, spins = 0;
            while ((unsigned)__builtin_amdgcn_readfirstlane(c) < 8u) { __builtin_amdgcn_s_sleep(2); c = __hip_atomic_load(hcnt + 64 * u.pn, __ATOMIC_RELAXED, __HIP_MEMORY_SCOPE_AGENT); if (++spins > (1u << 14)) break; }
        }
        {
            const int t512 = (wr * 4 + wc) * 64 + lane;
            WL[t512] = pre.w[0]; WL[t512 + 512] = pre.w[1];
        }
        if (fr >= 14) {
#pragma unroll
            for (int ai = 0; ai < 2; ++ai)
#pragma unroll
                for (int bj = 0; bj < 2; ++bj)
#pragma unroll
                    for (int n = 0; n < 2; ++n) *(PG8_LAS f32x4*)(X + (((2 * ai + wr) * 2 + (fr - 14)) * 2 + bj) * 128 + lc + 4 * n) = acc[ai][bj][3][n];
        }
        asm volatile("s_waitcnt lgkmcnt(0)" ::: "memory"); __builtin_amdgcn_s_barrier(); asm volatile("" ::: "memory");
        const bool batch_start = (u.pm & 15) == 0;
#pragma unroll
        for (int bj = 0; bj < 2; ++bj)
#pragma unroll
            for (int n = 0; n < 2; ++n) {
                asm volatile("" ::: "memory");
                const int cl = bj * 128 + lc + 4 * n;
                const f32x4 w0v = *(const PG8_LAS f32x4*)(WL + 0 * 256 + cl), w1v = *(const PG8_LAS f32x4*)(WL + 1 * 256 + cl), w2v = *(const PG8_LAS f32x4*)(WL + 2 * 256 + cl), bbv = *(const PG8_LAS f32x4*)(WL + 3 * 256 + cl);
                f32x4 hq0[2], hq1[2];
#pragma unroll
                for (int ai = 0; ai < 2; ++ai) { const int g = 2 * ai + wr;
                    if (g > 0) { hq0[ai] = *(const PG8_LAS f32x4*)(X + (((g - 1) * 2 + 0) * 2 + bj) * 128 + lc + 4 * n); hq1[ai] = *(const PG8_LAS f32x4*)(X + (((g - 1) * 2 + 1) * 2 + bj) * 128 + lc + 4 * n); }
                    else if (!batch_start) { const float* hp = UHALO + (size_t)(2 * u.pm) * 5632 + u.pn * 256 + bj * 128 + lc + 4 * n; hq0[ai] = ld_agent_f32x4(hp); hq1[ai] = ld_agent_f32x4(hp + 5632); }
                    else { hq0[ai] = (f32x4){0.f, 0.f, 0.f, 0.f}; hq1[ai] = hq0[ai]; } }
#pragma unroll
                for (int ai = 1; ai >= 0; --ai) {
                    const f32x4 h0v = hq0[ai], h1v = hq1[ai];
#pragma unroll
                    for (int e = 0; e < 4; e += 2) {
                        const f32x2 w0 = {w0v[e], w0v[e + 1]}, w1 = {w1v[e], w1v[e + 1]}, w2 = {w2v[e], w2v[e + 1]}, bb = {bbv[e], bbv[e + 1]}, h0 = {h0v[e], h0v[e + 1]}, h1 = {h1v[e], h1v[e + 1]};
                        f32x2 c1 = {ror16<1>(acc[ai][bj][3][n][e]), ror16<1>(acc[ai][bj][3][n][e + 1])}, c2 = {ror16<2>(acc[ai][bj][3][n][e]), ror16<2>(acc[ai][bj][3][n][e + 1])};
#pragma unroll
                        for (int m = 3; m >= 0; --m) {
                            f32x2 p1, p2;
                            if (m > 0) { p1 = (f32x2){ror16<1>(acc[ai][bj][m - 1][n][e]), ror16<1>(acc[ai][bj][m - 1][n][e + 1])}; p2 = (f32x2){ror16<2>(acc[ai][bj][m - 1][n][e]), ror16<2>(acc[ai][bj][m - 1][n][e + 1])}; }
                            else { p1 = h1; p2 = (fr == 0) ? h0 : h1; }
                            const f32x2 r1 = (fr >= 1) ? c1 : p1, r2 = (fr >= 2) ? c2 : p2;
                            const f32x2 cur = {acc[ai][bj][m][n][e], acc[ai][bj][m][n][e + 1]};
                            const f32x2 o = w0 * r2 + (w1 * r1 + (w2 * cur + bb));
                            acc[ai][bj][m][n][e] = o[0]; acc[ai][bj][m][n][e + 1] = o[1];
                            asm volatile("" : "+v"(acc[ai][bj][m][n]));
                            c1 = p1; c2 = p2;
                        }
                    }
                }
            }
        asm volatile("" ::: "memory");
        const int row0 = u.pm * BM + wr * 64 + fr;
#pragma unroll
        for (int ai = 0; ai < 2; ++ai)
#pragma unroll
            for (int m = 0; m < 4; ++m) {
                const f32x4 g0 = acc[ai][0][m][0], g1 = acc[ai][0][m][1], v0 = acc[ai][1][m][0], v1 = acc[ai][1][m][1];
                const f32x2 a0 = gelu_mul_pk((f32x2){g0[0], g0[1]}, (f32x2){v0[0], v0[1]}), a1 = gelu_mul_pk((f32x2){g0[2], g0[3]}, (f32x2){v0[2], v0[3]});
                const f32x2 a2 = gelu_mul_pk((f32x2){g1[0], g1[1]}, (f32x2){v1[0], v1[1]}), a3 = gelu_mul_pk((f32x2){g1[2], g1[3]}, (f32x2){v1[2], v1[3]});
                u32x4 w; w.x = pk_f16(a0.x, a0.y); w.y = pk_f16(a1.x, a1.y); w.z = pk_f16(a2.x, a2.y); w.w = pk_f16(a3.x, a3.y);
                *(u32x4*)(ACT + (size_t)(row0 + ai * HALF + m * 16) * 2816 + u.pn * 128 + lc) = w;
                asm volatile("" ::: "memory");
            }
    }
};

template <class Epi, class Sched, bool ALIGN_EPI = false, bool SP2 = false>
__device__ __forceinline__ void gemm_phase(PG8_LAS unsigned char* lds, const Gemm g, const Sched& S, const Epi& E, int tid_in) {
    int tid_o = tid_in; asm volatile("" : "+v"(tid_o));
    const int tid = tid_o, wid = __builtin_amdgcn_readfirstlane(tid >> 6), lane = tid & 63, wr = wid >> 2, wc = wid & 3, fr = lane & 15, fq = lane >> 4;
    const int K = g.K, nt = K / BK;
    unsigned voffA[2], voffB[2];
#pragma unroll
    for (int i = 0; i < 2; ++i) { int R, C; stage_rc(tid * 16 + i * 8192, R, C); const int Rb = Epi::PERM ? ((R & ~31) + perm32(R & 31)) : R;
        voffA[i] = (unsigned)(R * g.lda + C) * 2u; voffB[i] = (unsigned)(Rb * K + C) * 2u; }
    const size_t kstep = (size_t)(BK * 2);
    const size_t hstep = (size_t)HALF * K * 2;
    const size_t tstep = 2 * hstep;
    const size_t hstepA = (size_t)HALF * g.lda * 2, tstepA = 2 * hstepA;
    const unsigned ldsw = (unsigned)wid * 1024u;
    const int aoff = lds_byte(wr * 64 + fr, fq * 8), boff = lds_byte(wc * 32 + fr, fq * 8);
#define PG8_SA(b, h) (((b) * 2 + (h)) * HTB)
#define PG8_SB(b, h) ((4 + (b) * 2 + (h)) * HTB)
#define PG8_STAGE(bufoff, gbase, voff) do { _Pragma("unroll") for (int _i = 0; _i < 2; ++_i) \
        __builtin_amdgcn_global_load_lds((const unsigned*)((const char*)(gbase) + (voff)[_i]), (PG8_LAS unsigned*)(lds + (bufoff) + ldsw + _i * 8192), 16, 0, 0); } while (0)
#define PG8_LDA(dst, b, h) do { _Pragma("unroll") for (int m = 0; m < 4; ++m) _Pragma("unroll") for (int k = 0; k < 2; ++k) dst[m][k] = *(const PG8_LAS f16x8*)(lds + PG8_SA(b, h) + aoff + m * 2048 + k * 1024); } while (0)
#define PG8_LDB(dst, b, h) do { _Pragma("unroll") for (int n = 0; n < 2; ++n) _Pragma("unroll") for (int k = 0; k < 2; ++k) dst[n][k] = *(const PG8_LAS f16x8*)(lds + PG8_SB(b, h) + boff + n * 2048 + k * 1024); } while (0)
#define PG8_MMA(ai, bj, At, Bt) do { __builtin_amdgcn_s_setprio(1); _Pragma("unroll") for (int m = 0; m < 4; ++m) _Pragma("unroll") for (int n = 0; n < 2; ++n) _Pragma("unroll") for (int k = 0; k < 2; ++k) \
        acc[ai][bj][m][n] = __builtin_amdgcn_mfma_f32_16x16x32_f16(Bt[n][k], At[m][k], acc[ai][bj][m][n], 0, 0, 0); __builtin_amdgcn_s_setprio(0); } while (0)
#define PG8_WAIT_V(n) asm volatile("s_waitcnt vmcnt(" #n ")" ::: "memory")
#define PG8_WAIT_L(n) asm volatile("s_waitcnt lgkmcnt(" #n ")" ::: "memory")
#define PG8_BAR __builtin_amdgcn_s_barrier()
#define PG8_SCHED __builtin_amdgcn_sched_barrier(0)
    Unit cur, nxt; int ui = 0;
    if (!S.next(0, cur)) return;
    typename Epi::Pre pre; E.prefetch(pre, cur, tid);
    f32x4 acc[2][2][4][2];
#pragma unroll
    for (int a = 0; a < 2; ++a)
#pragma unroll
        for (int b = 0; b < 2; ++b)
#pragma unroll
            for (int m = 0; m < 4; ++m)
#pragma unroll
                for (int n = 0; n < 2; ++n) acc[a][b][m][n] = (f32x4){0.f, 0.f, 0.f, 0.f};
    f16x8 At[4][2], B0[2][2], B1[2][2];
    const char* cA = (const char*)g.A + (size_t)cur.pm * tstepA + S.a_off(cur); const char* cB = (const char*)g.Bt + (size_t)cur.pn * tstep;
    S.a_ready(cur);
    if constexpr (SP2) {
        PG8_STAGE(PG8_SB(0, 0), cB, voffB); PG8_STAGE(PG8_SB(0, 1), cB + hstep, voffB); PG8_STAGE(PG8_SA(0, 0), cA, voffA); PG8_STAGE(PG8_SA(0, 1), cA + hstepA, voffA);
        if (wr == 1) PG8_BAR;
        PG8_WAIT_V(2); PG8_BAR;
        PG8_STAGE(PG8_SB(1, 0), cB + kstep, voffB); PG8_STAGE(PG8_SA(1, 0), cA + kstep, voffA); PG8_STAGE(PG8_SB(1, 1), cB + hstep + kstep, voffB);
        PG8_WAIT_V(6); PG8_BAR;
    } else {
        PG8_STAGE(PG8_SB(0, 0), cB, voffB); PG8_STAGE(PG8_SA(0, 0), cA, voffA); PG8_STAGE(PG8_SB(0, 1), cB + hstep, voffB); PG8_STAGE(PG8_SA(0, 1), cA + hstepA, voffA);
        if (wr == 1) PG8_BAR;
        PG8_WAIT_V(4); PG8_BAR;
        PG8_STAGE(PG8_SB(1, 0), cB + kstep, voffB); PG8_STAGE(PG8_SA(1, 0), cA + kstep, voffA); PG8_STAGE(PG8_SB(1, 1), cB + hstep + kstep, voffB);
        PG8_WAIT_V(6); PG8_BAR;
    }
    for (;;) {
        const bool has_next = S.next(ui + 1, nxt);
        const char* nA = has_next ? (const char*)g.A + (size_t)nxt.pm * tstepA + S.a_off(nxt) : cA; const char* nB = has_next ? (const char*)g.Bt + (size_t)nxt.pn * tstep : cB;
#pragma unroll 1
        for (int t = 0; t < nt; t += 2) {
            const bool last = (t == nt - 2);
            const char* a1 = cA + (size_t)(t + 1) * kstep;
            const char* a2 = last ? nA : cA + (size_t)(t + 2) * kstep; const char* b2 = last ? nB : cB + (size_t)(t + 2) * kstep;
            const char* a3 = a2 + kstep; const char* b3 = b2 + kstep;
            if (last && has_next) S.a_ready(nxt);
            if constexpr (SP2) {
            PG8_LDB(B0, 0, 0); PG8_LDB(B1, 0, 1); PG8_SCHED; PG8_LDA(At, 0, 0); PG8_STAGE(PG8_SA(1, 1), a1 + hstepA, voffA);
            PG8_WAIT_V(8); PG8_WAIT_L(0); PG8_BAR; PG8_MMA(0, 0, At, B0); PG8_MMA(0, 1, At, B1); PG8_BAR; PG8_SCHED;
            PG8_LDA(At, 0, 1); PG8_STAGE(PG8_SB(0, 0), b2, voffB); PG8_STAGE(PG8_SB(0, 1), b2 + hstep, voffB); PG8_STAGE(PG8_SA(0, 0), a2, voffA);
            PG8_WAIT_V(8); PG8_WAIT_L(0); PG8_BAR; PG8_MMA(1, 0, At, B0); PG8_MMA(1, 1, At, B1); PG8_BAR; PG8_SCHED;
            PG8_LDB(B0, 1, 0); PG8_LDB(B1, 1, 1); PG8_SCHED; PG8_LDA(At, 1, 0); PG8_STAGE(PG8_SA(0, 1), a2 + hstepA, voffA);
            PG8_WAIT_V(8); PG8_WAIT_L(0); PG8_BAR; PG8_MMA(0, 0, At, B0); PG8_MMA(0, 1, At, B1); PG8_BAR; PG8_SCHED;
            PG8_LDA(At, 1, 1); PG8_STAGE(PG8_SB(1, 0), b3, voffB); PG8_STAGE(PG8_SB(1, 1), b3 + hstep, voffB); PG8_STAGE(PG8_SA(1, 0), a3, voffA);
            PG8_WAIT_V(8); PG8_WAIT_L(0); PG8_BAR; PG8_MMA(1, 0, At, B0); PG8_MMA(1, 1, At, B1); PG8_BAR; PG8_SCHED;
            } else {
            PG8_LDB(B0, 0, 0); PG8_SCHED; PG8_LDA(At, 0, 0); PG8_STAGE(PG8_SA(1, 1), a1 + hstepA, voffA);
            PG8_WAIT_L(8); PG8_BAR; PG8_WAIT_L(0); PG8_MMA(0, 0, At, B0); PG8_BAR; PG8_SCHED;
            PG8_LDB(B1, 0, 1); PG8_STAGE(PG8_SB(0, 0), b2, voffB);
            PG8_BAR; PG8_WAIT_L(0); PG8_MMA(0, 1, At, B1); PG8_BAR;
            PG8_LDA(At, 0, 1); PG8_STAGE(PG8_SA(0, 0), a2, voffA);
            PG8_BAR; PG8_WAIT_L(0); PG8_MMA(1, 0, At, B0); PG8_BAR; PG8_SCHED;
            PG8_STAGE(PG8_SB(0, 1), b2 + hstep, voffB);
            PG8_WAIT_V(6); PG8_BAR; PG8_MMA(1, 1, At, B1); PG8_BAR;
            PG8_LDB(B0, 1, 0); PG8_SCHED; PG8_LDA(At, 1, 0); PG8_STAGE(PG8_SA(0, 1), a2 + hstepA, voffA);
            PG8_WAIT_L(8); PG8_BAR; PG8_WAIT_L(0); PG8_MMA(0, 0, At, B0); PG8_BAR; PG8_SCHED;
            PG8_LDB(B1, 1, 1); PG8_STAGE(PG8_SB(1, 0), b3, voffB);
            PG8_BAR; PG8_WAIT_L(0); PG8_MMA(0, 1, At, B1); PG8_BAR;
            PG8_LDA(At, 1, 1); PG8_STAGE(PG8_SA(1, 0), a3, voffA);
            PG8_BAR; PG8_WAIT_L(0); PG8_MMA(1, 0, At, B0); PG8_BAR; PG8_SCHED;
            PG8_STAGE(PG8_SB(1, 1), b3 + hstep, voffB);
            PG8_WAIT_V(6); PG8_BAR; PG8_MMA(1, 1, At, B1); PG8_BAR;
            }
        }
        if constexpr (ALIGN_EPI) { if (wr == 0) PG8_BAR; }
        if constexpr (!Epi::AFTER_DRAIN) { E(acc, cur, wr, wc, fr, fq, pre); S.done(cur); }
        if (!has_next) break;
#pragma unroll
        for (int a = 0; a < 2; ++a)
#pragma unroll
            for (int b = 0; b < 2; ++b)
#pragma unroll
                for (int m = 0; m < 4; ++m)
#pragma unroll
                    for (int n = 0; n < 2; ++n) acc[a][b][m][n] = (f32x4){0.f, 0.f, 0.f, 0.f};
        cur = nxt; cA = nA; cB = nB; ++ui; E.prefetch(pre, cur, tid);
        if constexpr (ALIGN_EPI) { if (wr == 1) PG8_BAR; }
    }
    PG8_WAIT_V(0);
    if constexpr (!ALIGN_EPI) { if (wr == 0) PG8_BAR; }
    PG8_BAR;
    if constexpr (Epi::AFTER_DRAIN) { E.fused(acc, cur, wr, wc, fr, fq, lds, wid, lane); S.done(cur); }
#undef PG8_SA
#undef PG8_SB
#undef PG8_STAGE
#undef PG8_LDA
#undef PG8_LDB
#undef PG8_MMA
#undef PG8_WAIT_V
#undef PG8_WAIT_L
#undef PG8_BAR
#undef PG8_SCHED
}
}
#define GAS __attribute__((address_space(1)))
#define LAS __attribute__((address_space(3)))
typedef GAS unsigned gu32;
typedef GAS unsigned long long gu64;
#define RLX_AGENT __ATOMIC_RELAXED, __HIP_MEMORY_SCOPE_AGENT
#define LDS_WAIT() asm volatile("s_waitcnt lgkmcnt(0)" ::: "memory")
#define VM_WAIT() asm volatile("s_waitcnt vmcnt(0)" ::: "memory")
__device__ __forceinline__ unsigned long long rt() { return __builtin_amdgcn_s_memrealtime(); }
#define XB_TMO      128
#define XB_XCNT(j)  (256  + 64 * (j))
#define XB_XSUB(j)  (1280 + 64 * (j))
#define XB_XGEN(j)  (2304 + 64 * (j))
#define XB_TOP      3328
#define XB_TOPGEN   3392
#define XCD_BAR_WORDS 3456
#define XB_SPIN_CAP (1u << 18)

__device__ __forceinline__ unsigned xb_ld(unsigned* p)              { return __hip_atomic_load(p, __ATOMIC_RELAXED, __HIP_MEMORY_SCOPE_AGENT); }
__device__ __forceinline__ unsigned xb_add(unsigned* p, unsigned v) { return __hip_atomic_fetch_add(p, v, __ATOMIC_RELAXED, __HIP_MEMORY_SCOPE_AGENT); }
__device__ __forceinline__ unsigned xb_xcc_id() { return (unsigned)__builtin_amdgcn_s_getreg((3 << 11) | 20) & 0xFu; }
#define XB_SPIN(cond, bar) do { unsigned _sp = 0; while (cond) { __builtin_amdgcn_s_sleep(1); \
    if ((++_sp & 255u) == 0u) { if (xb_ld(&(bar)[XB_TMO])) break; if (_sp > XB_SPIN_CAP) { atomicAdd(&(bar)[XB_TMO], 1u); break; } } } } while (0)

struct XcdBarrier {
    unsigned* bar; unsigned x;
    volatile LAS unsigned* st;
};

__device__ __forceinline__ XcdBarrier xcd_barrier_post(unsigned* bar, volatile LAS unsigned* st, int tid) {
    XcdBarrier b; b.bar = bar; b.x = xb_xcc_id(); b.st = st;
    if (tid == 0) (void)xb_add(&bar[XB_XCNT(b.x)], 1u);
    return b;
}
__device__ __forceinline__ void xcd_barrier_complete(unsigned* bar, unsigned x, unsigned& nloc, unsigned& nx) {
    const unsigned G = gridDim.x * gridDim.y * gridDim.z;
    unsigned sum, cnt, mine, sp = 0u;
    for (;;) {
        sum = 0u; cnt = 0u; mine = 0u;
#pragma unroll
        for (unsigned j = 0; j < 16; ++j) { const unsigned c = xb_ld(&bar[XB_XCNT(j)]); sum += c; cnt += (c > 0u) ? 1u : 0u; mine = (j == x) ? c : mine; }
        if (sum == G) break;
        __builtin_amdgcn_s_sleep(1);
        if ((++sp & 255u) == 0u) { if (xb_ld(&bar[XB_TMO])) break; if (sp > XB_SPIN_CAP) { atomicAdd(&bar[XB_TMO], 1u); break; } }
    }
    nloc = mine > 0u ? mine : 1u; nx = cnt > 0u ? cnt : 1u;
}

__device__ __forceinline__ void xcd_barrier(const XcdBarrier& b, int tid) {
    asm volatile("s_waitcnt vmcnt(0)" ::: "memory");
    __syncthreads();
    if (tid == 0) {
        unsigned* bar = b.bar;
        __builtin_amdgcn_s_waitcnt(0);
        unsigned nloc = b.st[0], nx = b.st[1];
        if (nloc == 0u) { xcd_barrier_complete(bar, b.x, nloc, nx); b.st[0] = nloc; b.st[1] = nx; }
        const unsigned old = xb_add(&bar[XB_XSUB(b.x)], 1u);
        const unsigned gen = old / nloc;
        if (old + 1u == (gen + 1u) * nloc) {
            __builtin_amdgcn_fence(__ATOMIC_RELEASE, "agent");
            asm volatile("s_waitcnt vmcnt(0)" ::: "memory");
            const unsigned og = xb_add(&bar[XB_TOP], 1u);
            const unsigned tg = og / nx;
            if (og + 1u == (tg + 1u) * nx) xb_add(&bar[XB_TOPGEN], 1u);
            else XB_SPIN(xb_ld(&bar[XB_TOPGEN]) == tg, bar);
            __builtin_amdgcn_fence(__ATOMIC_ACQUIRE, "agent");
            xb_add(&bar[XB_XGEN(b.x)], 1u);
            asm volatile("s_waitcnt vmcnt(0)" ::: "memory");
        } else {
            XB_SPIN(xb_ld(&bar[XB_XGEN(b.x)]) == gen, bar);
            __builtin_amdgcn_fence(__ATOMIC_ACQUIRE, "agent");
            asm volatile("s_waitcnt vmcnt(0)" ::: "memory");
        }
    }
    __syncthreads();
}
constexpr int NWAVES = 8, NTHR = NWAVES * 64;
constexpr int RING_BYTES = 131072;
constexpr int LDSCTL_OFF = RING_BYTES, MISC_OFF = LDSCTL_OFF + 320;
constexpr int XCH_OFF = RING_BYTES + 1024;
constexpr int LDS_BYTES = 147456;

struct Args { const float* in[21]; float* out; unsigned char* ws; int ph_lo, ph_hi; };

enum { I_X = 0, I_C, I_RELB, I_ADAW, I_ADAB, I_MIXPRE, I_MIXPOST, I_FFNPRE, I_FFNPOST, I_ABWIN, I_ABWOUT, I_CDWIN, I_QNG, I_KVNG, I_WUQ, I_WUKV, I_CDWOUT, I_WUP, I_CONVW, I_CONVB, I_WDN };

__device__ __forceinline__ float wave_sum(float v) {
#pragma unroll
    for (int o = 1; o < 64; o <<= 1) v += __shfl_xor(v, o);
    return v;
}
__device__ __forceinline__ float quad_sum(float v) { v += __shfl_xor(v, 1); v += __shfl_xor(v, 2); return v; }
__device__ __forceinline__ void load16(const f16* p, float (&o)[16]) {
    const f16x8 a = *(const f16x8*)p, b = *(const f16x8*)(p + 8);
#pragma unroll
    for (int i = 0; i < 8; ++i) { o[i] = (float)a[i]; o[8 + i] = (float)b[i]; }
}
__device__ __forceinline__ void load8(const f16* p, float (&o)[8]) {
    const f16x8 a = *(const f16x8*)p;
#pragma unroll
    for (int i = 0; i < 8; ++i) o[i] = (float)a[i];
}
__device__ __forceinline__ int t5_bucket(int d) {
    if (d < 16) return d;
    return 16 + (d >= 22) + (d >= 30) + (d >= 40) + (d >= 54) + (d >= 73) + (d >= 99) + (d >= 134) + (d >= 182) + (d >= 246) + (d >= 332) + (d >= 450) + (d >= 609) + (d >= 825) + (d >= 1117) + (d >= 1513);
}

__device__ __forceinline__ void layer_mod(const Args& a, LAS unsigned char* lds, int tid, int slot, int nslots, int l) {
    LAS float* sc = (LAS float*)lds; LAS float* red = (LAS float*)(lds + 16384);
    const float* c = a.in[I_C];
    for (int i = tid; i < BATCH * DM; i += NTHR) { const float v = c[i]; sc[i] = v / (1.f + expf(-v)); }
    __syncthreads();
    const int wave = tid >> 6, lane = tid & 63;
    float* MOD = (float*)(a.ws + WS_MOD);
    for (int cg = slot; cg < 96; cg += nslots) {
        const int n = cg * 64 + lane;
        const float* W = a.in[I_ADAW] + (size_t)l * DM * 6144 + n;
        float a0 = 0.f, a1 = 0.f, a2 = 0.f, a3 = 0.f;
        const int k0 = wave * 128;
#pragma unroll 1
        for (int kb = k0; kb < k0 + 128; kb += 32) {
            float wv[32];
#pragma unroll
            for (int j = 0; j < 32; ++j) wv[j] = W[(size_t)(kb + j) * 6144];
#pragma unroll
            for (int j = 0; j < 32; ++j) { const int k = kb + j; a0 += sc[k] * wv[j]; a1 += sc[DM + k] * wv[j]; a2 += sc[2 * DM + k] * wv[j]; a3 += sc[3 * DM + k] * wv[j]; }
        }
        red[(wave * 4 + 0) * 64 + lane] = a0; red[(wave * 4 + 1) * 64 + lane] = a1; red[(wave * 4 + 2) * 64 + lane] = a2; red[(wave * 4 + 3) * 64 + lane] = a3;
        __syncthreads();
        if (tid < 256) { const int b = tid >> 6; float s = 0.f;
#pragma unroll
            for (int w = 0; w < 8; ++w) s += red[(w * 4 + b) * 64 + lane];
            MOD[(size_t)(l * BATCH + b) * 6144 + n] = s + a.in[I_ADAB][l * 6144 + n]; }
        __syncthreads();
    }
}
struct TD { const float* W; int N; f16* dst; int pitch, coloff; const float* gk; int mode, nblk; };
__device__ __forceinline__ void transpose_item(const TD& d, LAS float* scr, int item, int lane) {
    const int kb = item / d.nblk, nb = item % d.nblk, k0 = 64 * kb, n0 = 32 * nb;
    float wv[32];
#pragma unroll
    for (int i = 0; i < 32; ++i) { const int kk = 2 * i + (lane >> 5); wv[i] = d.W[(size_t)(k0 + kk) * d.N + n0 + (lane & 31)]; }
#pragma unroll
    for (int i = 0; i < 32; ++i) { const int kk = 2 * i + (lane >> 5); scr[kk * 33 + (lane & 31)] = wv[i]; }
    LDS_WAIT(); asm volatile("" ::: "memory");
    const int c = lane & 7;
    float gs[8];
#pragma unroll
    for (int i = 0; i < 8; ++i) gs[i] = d.gk ? d.gk[k0 + 8 * c + i] : 1.f;
#pragma unroll
    for (int j = 0; j < 4; ++j) { const int n = (lane >> 3) + 8 * j; const LAS float* s = scr + (8 * c) * 33 + n;
        u32x4 o; o.x = pk_f16(s[0 * 33] * gs[0], s[1 * 33] * gs[1]); o.y = pk_f16(s[2 * 33] * gs[2], s[3 * 33] * gs[3]); o.z = pk_f16(s[4 * 33] * gs[4], s[5 * 33] * gs[5]); o.w = pk_f16(s[6 * 33] * gs[6], s[7 * 33] * gs[7]);
        const int col = n0 + n; int row = col;
        if (d.mode == 1) { const int half = col / DFF, jj = col % DFF; row = (jj >> 7) * 256 + half * 128 + (jj & 127); }
        *(GAS u32x4*)(d.dst + (size_t)row * d.pitch + d.coloff + k0 + 8 * c) = o; }
    LDS_WAIT(); asm volatile("" ::: "memory");
}
__device__ __forceinline__ void layer_weights(const Args& a, LAS unsigned char* lds, int tid, int slot, int nslots, int l, int part  ) {
    const int wave = tid >> 6, lane = tid & 63;
    LAS float* scr = (LAS float*)(lds + wave * 16384);
    const int gw = slot * NWAVES + wave, NGW = nslots * NWAVES;
    constexpr int C0 = 16 * 96, C1 = 16 * 32, C2 = 16 * 65, C3 = 4 * 24, C4 = 4 * 32, C5 = 16 * 32, C6 = 16 * 176, C7 = 44 * 32;
    const int i = l >> 1; const bool odd = (l & 1) != 0;
    const int nmix = odd ? (C2 + C3 + C4 + C5) : (C0 + C1);
    unsigned char* ws = a.ws;
    const int it_lo = (part & 1) ? 0 : nmix, it_hi = (part & 2) ? nmix + C6 + C7 : nmix;
    for (int it = it_lo + gw; it < it_hi; it += NGW) {
        int r = it; TD d; d.gk = nullptr; d.mode = 0; d.coloff = 0;
        if (r >= nmix) { r -= nmix;
            if (r < C6) { d.W = a.in[I_WUP] + (size_t)l * DM * DFF2; d.N = DFF2; d.dst = (f16*)(ws + WS_W_FUP) + (size_t)l * DFF2 * DM; d.pitch = DM; d.nblk = 176; d.mode = 1; }
            else { r -= C6; d.W = a.in[I_WDN] + (size_t)l * DFF * DM; d.N = DM; d.dst = (f16*)(ws + WS_W_FDN) + (size_t)l * DM * DFF; d.pitch = DFF; d.nblk = 32; } }
        else if (!odd) {
            if (r < C0) { d.W = a.in[I_ABWIN] + (size_t)i * DM * AB_IN; d.N = AB_IN; d.dst = (f16*)(ws + WS_W_INAB) + (size_t)i * AB_IN * DM; d.pitch = DM; d.nblk = 96; }
            else { r -= C0; d.W = a.in[I_ABWOUT] + (size_t)i * DM * DM; d.N = DM; d.dst = (f16*)(ws + WS_W_OUTAB) + (size_t)i * DM * DM; d.pitch = DM; d.nblk = 32; } }
        else {
            if (r < C2) { d.W = a.in[I_CDWIN] + (size_t)i * DM * CD_IN; d.N = CD_IN; d.dst = (f16*)(ws + WS_W_INCD) + (size_t)i * CD_INP * DM; d.pitch = DM; d.nblk = 65; }
            else if ((r -= C2) < C3) { d.W = a.in[I_WUQ] + (size_t)i * 256 * QW; d.N = QW; d.dst = (f16*)(ws + WS_W_UP2) + (size_t)i * UP_N * UP_K; d.pitch = UP_K; d.nblk = 24; d.gk = a.in[I_QNG] + i * 256; }
            else if ((r -= C3) < C4) { d.W = a.in[I_WUKV] + (size_t)i * 256 * KVW; d.N = KVW; d.dst = (f16*)(ws + WS_W_UP2) + (size_t)i * UP_N * UP_K + (size_t)QW * UP_K; d.pitch = UP_K; d.nblk = 32; d.gk = a.in[I_KVNG] + i * 256; }
            else { r -= C4; d.W = a.in[I_CDWOUT] + (size_t)i * DM * DM; d.N = DM; d.dst = (f16*)(ws + WS_W_OUTCD) + (size_t)i * DM * DM; d.pitch = DM; d.nblk = 32; } }
        transpose_item(d, scr, r, lane);
    }
}
__device__ __forceinline__ void p0_misc(const Args& a, int tid, int bid, int G) {
    unsigned char* ws = a.ws;
    const int gt = bid * NTHR + tid, NGT = G * NTHR;
    const u32x4 z = {0u, 0u, 0u, 0u};
    for (int i = 0; i < 2; ++i) {
        GAS u32x4* p = (GAS u32x4*)((f16*)(ws + WS_W_INCD) + (size_t)i * CD_INP * DM + (size_t)CD_IN * DM);
        for (int e = gt; e < (CD_INP - CD_IN) * DM / 8; e += NGT) p[e] = z;
    }
    float* rc = (float*)(ws + WS_ROPE); float* rs = rc + SEQ * 16;
    for (int e = gt; e < SEQ * 16; e += NGT) { const int t = e >> 4, i = e & 15; const float inv = (float)(1.0 / pow(10000.0, (double)i / 16.0)); const float ang = (float)t * inv;
        rc[e] = (float)cos((double)ang); rs[e] = (float)sin((double)ang); }
}

__device__ __forceinline__ void thin_row(int row, const float* xin32, const f16* xin16, f16* xout16, float* xout32, const f16* y, const float* gate_l  , const float* gpost,
                                         const float* gpre, const float* ss_l  , f16* Hrow, f16* H2row, bool has_y, int lane) {
    const int b = row / SEQ;
    f32x4 xv[4];
    if (xin32 != nullptr) {
#pragma unroll
        for (int j = 0; j < 4; ++j) xv[j] = *(const f32x4*)(xin32 + (size_t)row * DM + 4 * lane + 256 * j);
    } else {
#pragma unroll
        for (int j = 0; j < 4; ++j) { const f16x4 xh = *(const f16x4*)(xin16 + (size_t)row * DM + 4 * lane + 256 * j); xv[j] = (f32x4){(float)xh[0], (float)xh[1], (float)xh[2], (float)xh[3]}; }
    }
    if (has_y) {
        f32x4 yv[4]; float s = 0.f;
#pragma unroll
        for (int j = 0; j < 4; ++j) { const f16x4 yh = *(const f16x4*)(y + (size_t)row * DM + 4 * lane + 256 * j); yv[j] = (f32x4){(float)yh[0], (float)yh[1], (float)yh[2], (float)yh[3]}; s += (yv[j].x * yv[j].x + yv[j].y * yv[j].y) + (yv[j].z * yv[j].z + yv[j].w * yv[j].w); }
        const float rstd = 1.0f / sqrtf(wave_sum(s) * (1.f / DM) + NORM_EPS);
#pragma unroll
        for (int j = 0; j < 4; ++j) { const f32x4 g = *(const f32x4*)(gpost + 4 * lane + 256 * j); const f32x4 gt = *(const f32x4*)(gate_l + (size_t)b * 6144 + 4 * lane + 256 * j);
            xv[j] = xv[j] + gt * ((yv[j] * rstd) * g); }
    }
    if (xout16 != nullptr) {
#pragma unroll
        for (int j = 0; j < 4; ++j) { u32x2 w; w.x = pk_f16(xv[j].x, xv[j].y); w.y = pk_f16(xv[j].z, xv[j].w); *(u32x2*)(xout16 + (size_t)row * DM + 4 * lane + 256 * j) = w;
            if (Hrow != nullptr) { const f16x4 r = __builtin_bit_cast(f16x4, w); xv[j] = (f32x4){(float)r[0], (float)r[1], (float)r[2], (float)r[3]}; } }
    }
    if (xout32 != nullptr) {
#pragma unroll
        for (int j = 0; j < 4; ++j) *(f32x4*)(xout32 + (size_t)row * DM + 4 * lane + 256 * j) = xv[j];
    }
    if (Hrow != nullptr) {
        float s = 0.f;
#pragma unroll
        for (int j = 0; j < 4; ++j) s += (xv[j].x * xv[j].x + xv[j].y * xv[j].y) + (xv[j].z * xv[j].z + xv[j].w * xv[j].w);
        const float rstd = 1.0f / sqrtf(wave_sum(s) * (1.f / DM) + NORM_EPS);
#pragma unroll
        for (int j = 0; j < 4; ++j) { const int col = 4 * lane + 256 * j; const f32x4 g = *(const f32x4*)(gpre + col);
            const f32x4 sh = *(const f32x4*)(ss_l + (size_t)b * 6144 + col), sc = *(const f32x4*)(ss_l + (size_t)b * 6144 + DM + col);
            const f32x4 hv = ((xv[j] * rstd) * g) * (sc + 1.0f) + sh;
            u32x2 w; w.x = pk_f16(hv.x, hv.y); w.y = pk_f16(hv.z, hv.w);
            *(u32x2*)(Hrow + col) = w;
            if (H2row != nullptr) *(u32x2*)(H2row + col) = w; }
    }
}
__device__ __forceinline__ bool is_halo_row(int row) { return (row & 255) >= 254 && (((row >> 8) + 1) & 15) != 0; }
__device__ __forceinline__ int halo_row_of(int hidx) { const int pm = hidx >> 1; return (pm == 0 || (pm & 15) == 0) ? -1 : 256 * pm - 2 + (hidx & 1); }
template <bool X32IN, bool HAS_Y, bool OUT32, bool WH>
__device__ __forceinline__ void thin_phase(const float* xin32, const f16* X16in, f16* X16out, float* out32, const f16* y, const float* gate_l, const float* gpost, const float* gpre, const float* ss_l, f16* H, f16* HHALO  ,
                                           LAS unsigned char* lds, int tid, int gw0, int ngw, int row_end = M) {
    const int lane = tid & 63;
    LAS float* TA = (LAS float*)lds; LAS float* TB = TA + BATCH * DM; LAS float* TC = TB + BATCH * DM;
    for (int idx = tid; idx < BATCH * DM; idx += NTHR) { const int b = idx >> 10, col = idx & (DM - 1);
        if constexpr (HAS_Y) TA[idx] = gate_l[(size_t)b * 6144 + col] * gpost[col];
        if constexpr (WH) { TB[idx] = gpre[col] * (1.0f + ss_l[(size_t)b * 6144 + DM + col]); TC[idx] = ss_l[(size_t)b * 6144 + col]; } }
    __syncthreads();
    for (int row0 = gw0; row0 < row_end; row0 += 2 * ngw) {
        int row[2] = {row0, row0 + ngw}; if (row[1] >= row_end) row[1] = row0;
        const int bq[2] = {row[0] / SEQ, row[1] / SEQ};
        float xv[2][16], yv[2][16];
#pragma unroll
        for (int q = 0; q < 2; ++q)
#pragma unroll
            for (int j = 0; j < 2; ++j) { const size_t off = (size_t)row[q] * DM + 512 * j + 8 * lane;
                if constexpr (X32IN) { const f32x4 a0 = *(const f32x4*)(xin32 + off), a1 = *(const f32x4*)(xin32 + off + 4);
#pragma unroll
                    for (int e = 0; e < 4; ++e) { xv[q][8 * j + e] = a0[e]; xv[q][8 * j + 4 + e] = a1[e]; } }
                else { const f16x8 xh = *(const f16x8*)(X16in + off);
#pragma unroll
                    for (int e = 0; e < 8; ++e) xv[q][8 * j + e] = (float)xh[e]; }
                if constexpr (HAS_Y) { const f16x8 yh = *(const f16x8*)(y + off);
#pragma unroll
                    for (int e = 0; e < 8; ++e) yv[q][8 * j + e] = (float)yh[e]; }
            }
        if constexpr (HAS_Y) {
            float s[2] = {0.f, 0.f};
#pragma unroll
            for (int q = 0; q < 2; ++q)
#pragma unroll
                for (int e = 0; e < 16; ++e) s[q] += yv[q][e] * yv[q][e];
#pragma unroll
            for (int o = 1; o < 64; o <<= 1) { s[0] += __shfl_xor(s[0], o); s[1] += __shfl_xor(s[1], o); }
#pragma unroll
            for (int q = 0; q < 2; ++q) { const float rstd = 1.0f / sqrtf(s[q] * (1.f / DM) + NORM_EPS);
#pragma unroll
                for (int j = 0; j < 2; ++j) { const LAS float* ta = TA + bq[q] * DM + 512 * j + 8 * lane; const f32x4 t0 = *(const LAS f32x4*)ta, t1 = *(const LAS f32x4*)(ta + 4);
#pragma unroll
                    for (int e = 0; e < 4; ++e) { xv[q][8 * j + e] += t0[e] * (yv[q][8 * j + e] * rstd); xv[q][8 * j + 4 + e] += t1[e] * (yv[q][8 * j + 4 + e] * rstd); } } }
        }
#pragma unroll
        for (int q = 0; q < 2; ++q)
#pragma unroll
            for (int j = 0; j < 2; ++j) { const size_t off = (size_t)row[q] * DM + 512 * j + 8 * lane;
                if constexpr (OUT32) { float* o32 = out32;
                    *(f32x4*)(o32 + off) = (f32x4){xv[q][8 * j], xv[q][8 * j + 1], xv[q][8 * j + 2], xv[q][8 * j + 3]}; *(f32x4*)(o32 + off + 4) = (f32x4){xv[q][8 * j + 4], xv[q][8 * j + 5], xv[q][8 * j + 6], xv[q][8 * j + 7]}; }
                else { u32x4 w; w.x = pk_f16(xv[q][8 * j], xv[q][8 * j + 1]); w.y = pk_f16(xv[q][8 * j + 2], xv[q][8 * j + 3]); w.z = pk_f16(xv[q][8 * j + 4], xv[q][8 * j + 5]); w.w = pk_f16(xv[q][8 * j + 6], xv[q][8 * j + 7]);
                    *(u32x4*)(X16out + off) = w;
                    const f16x8 r = __builtin_bit_cast(f16x8, w);
#pragma unroll
                    for (int e = 0; e < 8; ++e) xv[q][8 * j + e] = (float)r[e]; }
            }
        if constexpr (WH) {
            float s[2] = {0.f, 0.f};
#pragma unroll
            for (int q = 0; q < 2; ++q)
#pragma unroll
                for (int e = 0; e < 16; ++e) s[q] += xv[q][e] * xv[q][e];
#pragma unroll
            for (int o = 1; o < 64; o <<= 1) { s[0] += __shfl_xor(s[0], o); s[1] += __shfl_xor(s[1], o); }
#pragma unroll
            for (int q = 0; q < 2; ++q) { const float rstd = 1.0f / sqrtf(s[q] * (1.f / DM) + NORM_EPS);
                f16* h2 = (HHALO != nullptr && is_halo_row(row[q])) ? HHALO + (size_t)(2 * ((row[q] >> 8) + 1) + ((row[q] & 255) - 254)) * DM : nullptr;
#pragma unroll
                for (int j = 0; j < 2; ++j) { const int col = 512 * j + 8 * lane; const LAS float* tb = TB + bq[q] * DM + col; const LAS float* tc = TC + bq[q] * DM + col;
                    const f32x4 b0 = *(const LAS f32x4*)tb, b1 = *(const LAS f32x4*)(tb + 4), c0 = *(const LAS f32x4*)tc, c1 = *(const LAS f32x4*)(tc + 4);
                    float hv[8];
#pragma unroll
                    for (int e = 0; e < 4; ++e) { hv[e] = (xv[q][8 * j + e] * rstd) * b0[e] + c0[e]; hv[4 + e] = (xv[q][8 * j + 4 + e] * rstd) * b1[e] + c1[e]; }
                    u32x4 w; w.x = pk_f16(hv[0], hv[1]); w.y = pk_f16(hv[2], hv[3]); w.z = pk_f16(hv[4], hv[5]); w.w = pk_f16(hv[6], hv[7]);
                    *(u32x4*)(H + (size_t)row[q] * DM + col) = w;
                    if (h2 != nullptr) *(u32x4*)(h2 + col) = w; } }
        }
    }
}

__device__ __forceinline__ void naive_kmean(const f16* PROJ, float* KMEAN, int gt, int NGT) {
    for (int e = gt; e < BATCH * 16 * 512; e += NGT) { const int col = e & 511, blk = (e >> 9) & 15, b = e >> 13;
        const f16* p = PROJ + ((size_t)b * SEQ + blk * 256) * AB_IN + 512 + col; float s = 0.f;
        for (int r = 0; r < 256; ++r) s += (float)p[(size_t)r * AB_IN];
        KMEAN[e] = s * (1.f / 256.f); }
}
#define OS_UPDATE(s_, vv_) do { const float mn_ = fmaxf(m, (s_)), al_ = expf(m - mn_), pe_ = expf((s_) - mn_); l = l * al_ + pe_; \
    _Pragma("unroll") for (int i_ = 0; i_ < 16; ++i_) acc[i_] = acc[i_] * al_ + pe_ * (vv_)[i_]; m = mn_; } while (0)
__device__ __forceinline__ void naive_moba(const f16* PROJ, const float* KMEAN, const float* relb, f16* ATT, int gt, int NGT) {
    const int sub = gt & 3, ngr = NGT >> 2;
    for (int item = gt >> 2; item < BATCH * NH * SEQ; item += ngr) {
        const int t = item & (SEQ - 1), h = (item >> 12) & 7, b = item >> 15;
        const size_t row = (size_t)b * SEQ + t;
        float q[16]; load16(PROJ + row * AB_IN + h * 64 + sub * 16, q);
        const int own = t >> 8;
        unsigned selmask = 0u;
        {
            float g[16];
#pragma unroll
            for (int j = 0; j < 16; ++j) { float p = 0.f;
                if (j < own) { const float* km = KMEAN + ((size_t)(b * 16 + j) * 512) + h * 64 + sub * 16;
#pragma unroll
                    for (int i = 0; i < 16; ++i) p += q[i] * km[i]; }
                p = quad_sum(p); g[j] = (j < own) ? p : -INFINITY; }
#pragma unroll
            for (int r = 0; r < 3; ++r) { float best = -INFINITY; int bi = -1;
#pragma unroll
                for (int j = 0; j < 16; ++j) { const bool ok = !((selmask >> j) & 1u) && (j < own) && (g[j] > best); if (ok) { best = g[j]; bi = j; } }
                if (bi >= 0) selmask |= 1u << bi; }
        }
        float m = -INFINITY, l = 0.f, acc[16];
#pragma unroll
        for (int i = 0; i < 16; ++i) acc[i] = 0.f;
        const f16* Kb = PROJ + (size_t)b * SEQ * AB_IN + 512 + h * 64 + sub * 16;
        const float* rb = relb + h * 32;
        for (int pos = own * 256; pos <= t; ++pos) { float kk[16], vv[16]; load16(Kb + (size_t)pos * AB_IN, kk); load16(Kb + (size_t)pos * AB_IN + 512, vv); float p = 0.f;
#pragma unroll
            for (int i = 0; i < 16; ++i) p += q[i] * kk[i];
            const float s = quad_sum(p) * 0.125f + rb[t5_bucket(t - pos)]; OS_UPDATE(s, vv); }
        for (int j = 0; j < own; ++j) { if (!((selmask >> j) & 1u)) continue;
            for (int pos = j * 256; pos < j * 256 + 256; ++pos) { float kk[16], vv[16]; load16(Kb + (size_t)pos * AB_IN, kk); load16(Kb + (size_t)pos * AB_IN + 512, vv); float p = 0.f;
#pragma unroll
                for (int i = 0; i < 16; ++i) p += q[i] * kk[i];
                const float s = quad_sum(p) * 0.125f + rb[t5_bucket(t - pos)]; OS_UPDATE(s, vv); } }
        const float il = 1.f / l; u32x4 w0, w1;
        w0.x = pk_f16(acc[0] * il, acc[1] * il); w0.y = pk_f16(acc[2] * il, acc[3] * il); w0.z = pk_f16(acc[4] * il, acc[5] * il); w0.w = pk_f16(acc[6] * il, acc[7] * il);
        w1.x = pk_f16(acc[8] * il, acc[9] * il); w1.y = pk_f16(acc[10] * il, acc[11] * il); w1.z = pk_f16(acc[12] * il, acc[13] * il); w1.w = pk_f16(acc[14] * il, acc[15] * il);
        f16* o = ATT + row * DM + h * 64 + sub * 16; *(u32x4*)o = w0; *(u32x4*)(o + 8) = w1;
    }
}
__device__ __forceinline__ void naive_dilated(const f16* PROJ, const float* relb, f16* ATT, int gt, int NGT) {
    const int sub = gt & 3, ngr = NGT >> 2;
    for (int item = gt >> 2; item < BATCH * NH * SEQ; item += ngr) {
        const int t = item & (SEQ - 1), h = (item >> 12) & 7, b = item >> 15;
        const size_t row = (size_t)b * SEQ + t;
        float q[16]; load16(PROJ + row * AB_IN + 1536 + h * 64 + sub * 16, q);
        float m = -INFINITY, l = 0.f, acc[16];
#pragma unroll
        for (int i = 0; i < 16; ++i) acc[i] = 0.f;
        const f16* Kb = PROJ + (size_t)b * SEQ * AB_IN + 2048 + h * 64 + sub * 16;
        const float* rb = relb + (8 + h) * 32;
        for (int br = 0; br < 3; ++br) { const int dil = br == 0 ? 1 : (br == 1 ? 4 : 16);
            for (int mm = 0; mm <= 128; ++mm) { const int pos = t - dil * mm; if (pos < 0) break;
                float kk[16], vv[16]; load16(Kb + (size_t)pos * AB_IN, kk); load16(Kb + (size_t)pos * AB_IN + 512, vv); float p = 0.f;
#pragma unroll
                for (int i = 0; i < 16; ++i) p += q[i] * kk[i];
                const float s = quad_sum(p) * 0.125f + rb[t5_bucket(dil * mm)]; OS_UPDATE(s, vv); } }
        const float il = 1.f / l; u32x4 w0, w1;
        w0.x = pk_f16(acc[0] * il, acc[1] * il); w0.y = pk_f16(acc[2] * il, acc[3] * il); w0.z = pk_f16(acc[4] * il, acc[5] * il); w0.w = pk_f16(acc[6] * il, acc[7] * il);
        w1.x = pk_f16(acc[8] * il, acc[9] * il); w1.y = pk_f16(acc[10] * il, acc[11] * il); w1.z = pk_f16(acc[12] * il, acc[13] * il); w1.w = pk_f16(acc[14] * il, acc[15] * il);
        f16* o = ATT + row * DM + 512 + h * 64 + sub * 16; *(u32x4*)o = w0; *(u32x4*)(o + 8) = w1;
    }
}
__device__ __forceinline__ void mla_norm_phase(f16* PROJ, f16* KPE, const float* rc, const float* rs, int tid, int bid, int G) {
    const int wave = tid >> 6, lane = tid & 63;
    const int gw = bid * NWAVES + wave, NGW = G * NWAVES;
    for (int row = gw; row < M; row += NGW) {
        f16* p = PROJ + (size_t)row * CD_INP;
        const int t = row & (SEQ - 1);
#pragma unroll
        for (int part = 0; part < 2; ++part) {
            f16x4 v = *(const f16x4*)(p + part * 256 + 4 * lane);
            float f[4] = {(float)v[0], (float)v[1], (float)v[2], (float)v[3]};
            const float s = wave_sum((f[0] * f[0] + f[1] * f[1]) + (f[2] * f[2] + f[3] * f[3]));
            const float rstd = 1.0f / sqrtf(s * (1.f / 256.f) + NORM_EPS);
            u32x2 w; w.x = pk_f16(f[0] * rstd, f[1] * rstd); w.y = pk_f16(f[2] * rstd, f[3] * rstd);
            *(u32x2*)(p + part * 256 + 4 * lane) = w;
        }
        if (lane < 16) { const float x1 = (float)p[512 + lane], x2 = (float)p[528 + lane]; const float c = rc[t * 16 + lane], s = rs[t * 16 + lane];
            KPE[(size_t)row * 32 + lane] = (f16)(x1 * c - x2 * s); KPE[(size_t)row * 32 + 16 + lane] = (f16)(x1 * s + x2 * c); }
    }
}
__device__ __forceinline__ void naive_mla(const f16* Q, const f16* KV, const f16* KPE, const float* rc, const float* rs, f16* ATT, int gt, int NGT) {
    const int sub = gt & 3, ngr = NGT >> 2;
    const float scale = 0.10206207261596575f;
    for (int item = gt >> 2; item < BATCH * NH * SEQ; item += ngr) {
        const int t = item & (SEQ - 1), h = (item >> 12) & 7, b = item >> 15;
        const size_t row = (size_t)b * SEQ + t;
        const f16* qp = Q + row * QW + h * 96;
        float q[16], qr[8]; load16(qp + sub * 16, q);
#pragma unroll
        for (int i = 0; i < 8; ++i) { const int d = 8 * sub + i, dd = d & 15; const float x1 = (float)qp[64 + dd], x2 = (float)qp[80 + dd]; const float c = rc[t * 16 + dd], s = rs[t * 16 + dd];
            qr[i] = (d < 16) ? (x1 * c - x2 * s) : (x1 * s + x2 * c); }
        float m = -INFINITY, l = 0.f, acc[16];
#pragma unroll
        for (int i = 0; i < 16; ++i) acc[i] = 0.f;
        const f16* Kb = KV + (size_t)b * SEQ * KVW + h * 128 + sub * 16;
        const f16* Pb = KPE + (size_t)b * SEQ * 32 + sub * 8;
        for (int pos = 0; pos <= t; ++pos) { float kk[16], kr[8], vv[16]; load16(Kb + (size_t)pos * KVW, kk); load8(Pb + (size_t)pos * 32, kr); load16(Kb + (size_t)pos * KVW + 64, vv); float p = 0.f;
#pragma unroll
            for (int i = 0; i < 16; ++i) p += q[i] * kk[i];
#pragma unroll
            for (int i = 0; i < 8; ++i) p += qr[i] * kr[i];
            const float s = quad_sum(p) * scale; OS_UPDATE(s, vv); }
        const float il = 1.f / l; u32x4 w0, w1;
        w0.x = pk_f16(acc[0] * il, acc[1] * il); w0.y = pk_f16(acc[2] * il, acc[3] * il); w0.z = pk_f16(acc[4] * il, acc[5] * il); w0.w = pk_f16(acc[6] * il, acc[7] * il);
        w1.x = pk_f16(acc[8] * il, acc[9] * il); w1.y = pk_f16(acc[10] * il, acc[11] * il); w1.z = pk_f16(acc[12] * il, acc[13] * il); w1.w = pk_f16(acc[14] * il, acc[15] * il);
        f16* o = ATT + row * DM + h * 64 + sub * 16; *(u32x4*)o = w0; *(u32x4*)(o + 8) = w1;
    }
}
__device__ __forceinline__ float softplusf(float x) { return fmaxf(x, 0.f) + log1pf(expf(-fabsf(x))); }
__device__ __forceinline__ void naive_sb(const f16* PROJ, f16* ATT, int gt, int NGT) {
    const int sub = gt & 3, ngr = NGT >> 2;
    for (int item = gt >> 2; item < BATCH * NH * SEQ; item += ngr) {
        const int t = item & (SEQ - 1), h = (item >> 12) & 7, b = item >> 15;
        const size_t row = (size_t)b * SEQ + t;
        float q[16]; load16(PROJ + row * CD_INP + 544 + h * 64 + sub * 16, q);
        float R = 0.f, acc[16];
#pragma unroll
        for (int i = 0; i < 16; ++i) acc[i] = 0.f;
        const f16* Kb = PROJ + (size_t)b * SEQ * CD_INP + 1056 + h * 64 + sub * 16;
        for (int pos = t - 1; pos >= 0; --pos) { float kk[16], vv[16]; load16(Kb + (size_t)pos * CD_INP, kk); load16(Kb + (size_t)pos * CD_INP + 512, vv); float p = 0.f;
#pragma unroll
            for (int i = 0; i < 16; ++i) p += q[i] * kk[i];
            const float z = quad_sum(p) * 0.125f;
            const float aw = expf(R - softplusf(-z));
#pragma unroll
            for (int i = 0; i < 16; ++i) acc[i] += aw * vv[i];
            R -= softplusf(z); }
        u32x4 w0, w1;
        w0.x = pk_f16(acc[0], acc[1]); w0.y = pk_f16(acc[2], acc[3]); w0.z = pk_f16(acc[4], acc[5]); w0.w = pk_f16(acc[6], acc[7]);
        w1.x = pk_f16(acc[8], acc[9]); w1.y = pk_f16(acc[10], acc[11]); w1.z = pk_f16(acc[12], acc[13]); w1.w = pk_f16(acc[14], acc[15]);
        f16* o = ATT + row * DM + 512 + h * 64 + sub * 16; *(u32x4*)o = w0; *(u32x4*)(o + 8) = w1;
    }
}
__device__ __forceinline__ float gelu_tanh(float g) { return 0.5f * g * (1.f + tanhf(0.7978845608028654f * (g + 0.044715f * g * g * g))); }
__device__ __forceinline__ void naive_convact(const f16* U, int half, const float* cw, const float* cb, f16* ACT, int gt, int NGT) {
    for (int e = gt; e < (M / 2) * DFF; e += NGT) { const int rl = e / DFF, j = e % DFF; const int row = half * (M / 2) + rl, t = row & (SEQ - 1);
        const int ucol = (j >> 7) * 256 + (j & 127);
        float g = cb[j], v = cb[DFF + j];
#pragma unroll
        for (int tap = 0; tap < 3; ++tap) { const int dt = 2 - tap; if (t - dt < 0) continue;
            const f16* up = U + (size_t)(rl - dt) * DFF2 + ucol;
            g += cw[tap * DFF2 + j] * (float)up[0]; v += cw[tap * DFF2 + DFF + j] * (float)up[128]; }
        ACT[(size_t)row * DFF + j] = (f16)(gelu_tanh(g) * v); }
}
namespace att {
typedef float f32x16 __attribute__((ext_vector_type(16)));
typedef short s16x4 __attribute__((ext_vector_type(4)));
__device__ __forceinline__ f16x4 tr_read(const LAS f16* p) { return __builtin_bit_cast(f16x4, __builtin_amdgcn_ds_read_tr16_b64_v4i16((LAS s16x4*)p)); }
constexpr int VP = 96;
constexpr int OFF_K = 0, KBUF = 128 * 104 * 2;
constexpr int OFF_V = 2 * KBUF, VBUF = 128 * VP * 2;
constexpr int OFF_BIAS = OFF_V + 2 * VBUF;
constexpr int OFF_KMEAN = OFF_BIAS + 16384;
constexpr int OFF_FLAG = OFF_KMEAN + 4096;
constexpr int ATT_LDS = OFF_FLAG + 64;
constexpr float LOG2E = 1.4426950408889634f, LN2 = 0.6931471805599453f;

struct Src {
    const f16* q; int qp;
    const f16* k; int kp;
    const f16* k2;
    const f16* v; int vp;
    f16* o;
};

template <int KIND  , int PM = 0  >
__device__ __forceinline__ void attn_unit(LAS unsigned char* lds, const Src& T, int b, int h, int qb, const float* rc, const float* rs, const float* KMEAN, const float* relb, int tid) {
    constexpr int DQ = (KIND == 0) ? 96 : 64, NS = DQ / 16, KP = DQ + 8;
    const int lane = tid & 63, r32 = lane & 31, hi = lane >> 5; const int wid = __builtin_amdgcn_readfirstlane(tid >> 6);
    const size_t rowbase = (size_t)b * SEQ;
    const int q0w = qb * 256 + wid * 32;
    const int t = q0w + r32;
    f16x8 qf[NS];
    {
        const f16* qrow = T.q + (rowbase + t) * T.qp;
#pragma unroll
        for (int s = 0; s < 4; ++s) qf[s] = *(const f16x8*)(qrow + 16 * s + 8 * hi);
        if constexpr (KIND == 0) {
            const f16x8 xa = *(const f16x8*)(qrow + 64 + 8 * hi), xb = *(const f16x8*)(qrow + 80 + 8 * hi);
            const f32x4 c0 = *(const f32x4*)(rc + t * 16 + 8 * hi), c1 = *(const f32x4*)(rc + t * 16 + 8 * hi + 4), s0 = *(const f32x4*)(rs + t * 16 + 8 * hi), s1 = *(const f32x4*)(rs + t * 16 + 8 * hi + 4);
#pragma unroll
            for (int j = 0; j < 8; ++j) { const float a = (float)xa[j], bb = (float)xb[j], c = j < 4 ? c0[j & 3] : c1[j & 3], s = j < 4 ? s0[j & 3] : s1[j & 3];
                qf[4][j] = (f16)(a * c - bb * s); qf[5][j] = (f16)(a * s + bb * c); }
        }
    }
    unsigned selmask = 0u;
    LAS float* biasl = (LAS float*)(lds + OFF_BIAS);
    if constexpr (KIND == 1) {
        LAS float* kml = (LAS float*)(lds + OFF_KMEAN);
        for (int d = tid; d < SEQ; d += NTHR) biasl[d] = relb[h * 32 + t5_bucket(d)] * LOG2E;
        for (int e = tid; e < 16 * 64; e += NTHR) kml[e] = KMEAN[((size_t)(b * 16 + (e >> 6)) * 512) + h * 64 + (e & 63)] * (1.f / 256.f);
        __syncthreads();
        float g[16];
#pragma unroll
        for (int j = 0; j < 16; ++j) { float p = 0.f;
            if (j < qb) {
#pragma unroll
                for (int s = 0; s < 4; ++s)
#pragma unroll
                    for (int i = 0; i < 8; ++i) p += (float)qf[s][i] * kml[j * 64 + 16 * s + 8 * hi + i]; }
            p += __shfl_xor(p, 32); g[j] = (j < qb) ? p : -INFINITY; }
#pragma unroll
        for (int r = 0; r < 3; ++r) { float best = -INFINITY; int bi = -1;
#pragma unroll
            for (int j = 0; j < 16; ++j) { const bool ok = !((selmask >> j) & 1u) && (j < qb) && (g[j] > best); if (ok) { best = g[j]; bi = j; } }
            if (bi >= 0) selmask |= 1u << bi; }
    }
    const int NT = 4 * qb + 4;
    auto tile_start = [&](int i) -> int {
        if constexpr (KIND == 0) return 64 * i;
        else if constexpr (KIND == 1) return i < 4 ? 256 * qb + 64 * i : 64 * (i - 4);
        else return 64 * (NT - 1 - i);
    };
    const int kr = tid >> 3, kc = tid & 7;
    const int k2r = tid >> 2, k2c = tid & 3;
    f16x8 kr0, vr0, k2r0, kr1, vr1, k2r1;
    auto gload = [&](int d) {
        const int ts0 = tile_start(2 * d), ts1 = tile_start(2 * d + 1);
        kr0 = *(const f16x8*)(T.k + (rowbase + ts0 + kr) * T.kp + 8 * kc); vr0 = *(const f16x8*)(T.v + (rowbase + ts0 + kr) * T.vp + 8 * kc);
        kr1 = *(const f16x8*)(T.k + (rowbase + ts1 + kr) * T.kp + 8 * kc); vr1 = *(const f16x8*)(T.v + (rowbase + ts1 + kr) * T.vp + 8 * kc);
        if constexpr (KIND == 0) { if (tid < 256) { k2r0 = *(const f16x8*)(T.k2 + (rowbase + ts0 + k2r) * 32 + 8 * k2c); k2r1 = *(const f16x8*)(T.k2 + (rowbase + ts1 + k2r) * 32 + 8 * k2c); } }
    };
    auto lstore = [&](int buf) {
        LAS f16* Kb = (LAS f16*)(lds + OFF_K + buf * KBUF); LAS f16* Vb = (LAS f16*)(lds + OFF_V + buf * VBUF);
        *(LAS f16x8*)(Kb + kr * KP + 8 * kc) = kr0; *(LAS f16x8*)(Kb + (64 + kr) * KP + 8 * kc) = kr1;
        if constexpr (KIND == 0) { if (tid < 256) { *(LAS f16x8*)(Kb + k2r * KP + 64 + 8 * k2c) = k2r0; *(LAS f16x8*)(Kb + (64 + k2r) * KP + 64 + 8 * k2c) = k2r1; } }
        *(LAS f16x8*)(Vb + kr * VP + 8 * kc) = vr0; *(LAS f16x8*)(Vb + (64 + kr) * VP + 8 * kc) = vr1;
    };
    f32x16 o0, o1;
#pragma unroll
    for (int r = 0; r < 16; ++r) { o0[r] = 0.f; o1[r] = 0.f; }
    float m = -1e30f, l = 0.f, R = 0.f;
    const float csc = (KIND == 0 ? 0.10206207261596575f : 0.125f) * (KIND == 2 ? 1.0f : LOG2E);
    LAS unsigned* flags = (LAS unsigned*)(lds + OFF_FLAG);

    const int ND = NT / 2;
    gload(0); lstore(0); gload(1);
    __syncthreads();
    auto tile = [&](int i, int buf, int sub) {
        const int ts = tile_start(i);
        bool active, need_mask;
        if constexpr (KIND == 2) { active = ts < q0w + 31; need_mask = ts + 63 >= q0w; }
        else if constexpr (KIND == 1) { if (i < 4) { active = ts <= q0w + 31; need_mask = ts + 63 > q0w; } else { active = true; need_mask = false; } }
        else { active = ts <= q0w + 31; need_mask = ts + 63 > q0w; }
        bool wave_done = false;
        if constexpr (KIND == 2) { wave_done = __all(R < -152.0f) != 0; if (wave_done) active = false; }
        if (active && PM != 1) {
            const LAS f16* Kb = (const LAS f16*)(lds + OFF_K + buf * KBUF) + sub * 64 * KP; const LAS f16* Vb = (const LAS f16*)(lds + OFF_V + buf * VBUF) + sub * 64 * VP;
            f32x16 p0, p1;
#pragma unroll
            for (int r = 0; r < 16; ++r) { p0[r] = 0.f; p1[r] = 0.f; }
            {
                f16x8 kf[2 * NS];
#pragma unroll
                for (int s = 0; s < NS; ++s) { kf[2 * s] = *(const LAS f16x8*)(Kb + r32 * KP + 16 * s + 8 * hi); kf[2 * s + 1] = *(const LAS f16x8*)(Kb + (32 + r32) * KP + 16 * s + 8 * hi); }
                __builtin_amdgcn_sched_barrier(0);
#pragma unroll
                for (int s = 0; s < NS; ++s) { p0 = __builtin_amdgcn_mfma_f32_32x32x16_f16(kf[2 * s], qf[s], p0, 0, 0, 0); p1 = __builtin_amdgcn_mfma_f32_32x32x16_f16(kf[2 * s + 1], qf[s], p1, 0, 0, 0); }
            }
            f16x4 vlo[8], vhh[8];
            auto vfrag_load = [&]() {
#pragma unroll
            for (int kb = 0; kb < 2; ++kb)
#pragma unroll
                for (int s2 = 0; s2 < 2; ++s2)
#pragma unroll
                    for (int db = 0; db < 2; ++db) {
                        const LAS f16* vp = Vb + (32 * kb + 16 * s2 + 4 * hi + ((lane & 15) >> 2)) * VP + 32 * db + (r32 & 16) + 4 * (lane & 3);
                        vlo[(kb * 2 + s2) * 2 + db] = tr_read(vp); vhh[(kb * 2 + s2) * 2 + db] = tr_read(vp + 8 * VP); }
            };
            if constexpr (PM < 2 && KIND != 2) vfrag_load();
            __builtin_amdgcn_sched_barrier(0);
            const int lim = t - ts - 4 * hi;
            if constexpr (PM == 3) { asm volatile("" :: "v"(p0), "v"(p1)); }
            else if constexpr (KIND != 2) {
                if constexpr (KIND == 1) {
                    const int dbase = lim;
                    float b0[16], b1[16];
                    if (i < 4) {
#pragma unroll
                        for (int r = 0; r < 16; ++r) { const int c = (r & 3) + 8 * (r >> 2); int d0 = dbase - c, d1 = dbase - 32 - c; d0 = d0 < 0 ? 0 : d0; d1 = d1 < 0 ? 0 : d1; b0[r] = biasl[d0]; b1[r] = biasl[d1]; }
                    } else {
#pragma unroll
                        for (int r = 0; r < 16; ++r) { const int c = (r & 3) + 8 * (r >> 2); b0[r] = biasl[dbase - c]; b1[r] = biasl[dbase - 32 - c]; }
                    }
                    __builtin_amdgcn_sched_barrier(0);
#pragma unroll
                    for (int r = 0; r < 16; r += 2) { const f32x2 q0 = (f32x2){p0[r], p0[r + 1]} * csc + (f32x2){b0[r], b0[r + 1]}, q1 = (f32x2){p1[r], p1[r + 1]} * csc + (f32x2){b1[r], b1[r + 1]};
                        p0[r] = q0.x; p0[r + 1] = q0.y; p1[r] = q1.x; p1[r + 1] = q1.y; }
                    if (i >= 4) { const bool sel = (selmask >> (ts >> 8)) & 1u;
                        if (!sel) {
#pragma unroll
                            for (int r = 0; r < 16; ++r) { p0[r] = -INFINITY; p1[r] = -INFINITY; } } }
                }
                if (need_mask) {
#pragma unroll
                    for (int r = 0; r < 16; ++r) { const int c = (r & 3) + 8 * (r >> 2); if (c > lim) p0[r] = -INFINITY; if (c + 32 > lim) p1[r] = -INFINITY; }
                }
                const float esc = (KIND == 1) ? 1.0f : csc;
                float mx = fmaxf(p0[0], p1[0]);
#pragma unroll
                for (int r = 1; r < 16; ++r) mx = fmaxf(mx, fmaxf(p0[r], p1[r]));
                mx = fmaxf(mx, __shfl_xor(mx, 32)) * esc;
                if (__any(mx > m + 8.0f)) {
                    const float mn = fmaxf(m, mx), alpha = __builtin_amdgcn_exp2f(m - mn);
                    m = mn; l *= alpha;
#pragma unroll
                    for (int r = 0; r < 16; ++r) { o0[r] *= alpha; o1[r] *= alpha; }
                }
                f32x2 sum2 = {0.f, 0.f};
#pragma unroll
                for (int r = 0; r < 16; r += 2) {
                    const f32x2 t0 = (f32x2){p0[r], p0[r + 1]} * esc - m, t1 = (f32x2){p1[r], p1[r + 1]} * esc - m;
                    f32x2 e0, e1; e0.x = __builtin_amdgcn_exp2f(t0.x); e0.y = __builtin_amdgcn_exp2f(t0.y); e1.x = __builtin_amdgcn_exp2f(t1.x); e1.y = __builtin_amdgcn_exp2f(t1.y);
                    p0[r] = e0.x; p0[r + 1] = e0.y; p1[r] = e1.x; p1[r + 1] = e1.y; sum2 += e0 + e1; }
                l += sum2.x + sum2.y;
            } else {
                float lk0[16], lk1[16];
#pragma unroll
                for (int r = 0; r < 16; ++r) { const int c = (r & 3) + 8 * (r >> 2);
                    const float z0 = p0[r] * (csc * LOG2E), z1 = p1[r] * (csc * LOG2E);
                    const float e0 = __builtin_amdgcn_exp2f(z0), e1 = __builtin_amdgcn_exp2f(z1);
                    const float g0 = __builtin_amdgcn_logf(1.f + e0), g1 = __builtin_amdgcn_logf(1.f + e1);
                    const float a0 = -(z0 > 64.f ? z0 : g0), a1 = -(z1 > 64.f ? z1 : g1);
                    const bool v0 = !need_mask || (c < lim), v1 = !need_mask || (c + 32 < lim);
                    lk0[r] = v0 ? a0 : 0.f; lk1[r] = v1 ? a1 : 0.f;
                    p0[r] = v0 ? z0 + a0 : -INFINITY; p1[r] = v1 ? z1 + a1 : -INFINITY; }
                float gs[8], gp[8];
#pragma unroll
                for (int g = 0; g < 4; ++g) { gs[g] = (lk0[4 * g] + lk0[4 * g + 1]) + (lk0[4 * g + 2] + lk0[4 * g + 3]); gs[4 + g] = (lk1[4 * g] + lk1[4 * g + 1]) + (lk1[4 * g + 2] + lk1[4 * g + 3]); }
#pragma unroll
                for (int c4 = 0; c4 < 8; ++c4) gp[c4] = __shfl_xor(gs[c4], 32);
                float suf = R;
#pragma unroll
                for (int c4 = 7; c4 >= 0; --c4) {
                    const float ev = hi ? gp[c4] : gs[c4], od = hi ? gs[c4] : gp[c4];
                    const float base = hi ? suf : suf + od;
                    if (c4 < 4) { const int g = c4; float acc = base;
                        p0[4 * g + 3] += acc; acc += lk0[4 * g + 3]; p0[4 * g + 2] += acc; acc += lk0[4 * g + 2]; p0[4 * g + 1] += acc; acc += lk0[4 * g + 1]; p0[4 * g] += acc; }
                    else { const int g = c4 - 4; float acc = base;
                        p1[4 * g + 3] += acc; acc += lk1[4 * g + 3]; p1[4 * g + 2] += acc; acc += lk1[4 * g + 2]; p1[4 * g + 1] += acc; acc += lk1[4 * g + 1]; p1[4 * g] += acc; }
                    suf += ev + od;
                }
                R = suf;
#pragma unroll
                for (int r = 0; r < 16; ++r) { p0[r] = __builtin_amdgcn_exp2f(p0[r]); p1[r] = __builtin_amdgcn_exp2f(p1[r]); }
            }
            if constexpr (PM < 2 && KIND == 2) { vfrag_load(); __builtin_amdgcn_sched_barrier(0); }
            if constexpr (PM >= 2) { asm volatile("" :: "v"(p0), "v"(p1)); }
            else
#pragma unroll
            for (int kb = 0; kb < 2; ++kb)
#pragma unroll
                for (int s2 = 0; s2 < 2; ++s2) {
                    f16x8 bf;
#pragma unroll
                    for (int j = 0; j < 8; ++j) bf[j] = (f16)(kb ? p1[8 * s2 + j] : p0[8 * s2 + j]);
#pragma unroll
                    for (int db = 0; db < 2; ++db) {
                        const f16x4 lo = vlo[(kb * 2 + s2) * 2 + db], hh = vhh[(kb * 2 + s2) * 2 + db];
                        const f16x8 af = {lo[0], lo[1], lo[2], lo[3], hh[0], hh[1], hh[2], hh[3]};
                        if (db == 0) o0 = __builtin_amdgcn_mfma_f32_32x32x16_f16(af, bf, o0, 0, 0, 0); else o1 = __builtin_amdgcn_mfma_f32_32x32x16_f16(af, bf, o1, 0, 0, 0);
                    }
                }
        }
    };
    for (int d = 0; d < ND; ++d) {
        const int buf = d & 1;
        tile(2 * d, buf, 0);
        tile(2 * d + 1, buf, 1);
        if constexpr (KIND == 2) { if (lane == 0) flags[buf * 8 + wid] = (__all(R < -152.0f) != 0) ? 1u : 0u; }
        if (d + 1 < ND) lstore(buf ^ 1);
        if (d + 2 < ND) gload(d + 2);
        __syncthreads();
        if constexpr (KIND == 2) {
            unsigned alld = 1u;
#pragma unroll
            for (int w = 0; w < 8; ++w) alld &= flags[buf * 8 + w];
            if (alld) break;
        }
    }
    float inv = 1.f;
    if constexpr (KIND != 2) { l += __shfl_xor(l, 32); inv = 1.f / l; }
    f16* orow = T.o + (rowbase + t) * DM;
    if constexpr (PM == 0)
#pragma unroll
    for (int g = 0; g < 4; ++g) {
        u32x2 w0, w1;
        w0.x = pk_f16(o0[4 * g] * inv, o0[4 * g + 1] * inv); w0.y = pk_f16(o0[4 * g + 2] * inv, o0[4 * g + 3] * inv);
        w1.x = pk_f16(o1[4 * g] * inv, o1[4 * g + 1] * inv); w1.y = pk_f16(o1[4 * g + 2] * inv, o1[4 * g + 3] * inv);
        *(u32x2*)(orow + 8 * g + 4 * hi) = w0; *(u32x2*)(orow + 32 + 8 * g + 4 * hi) = w1;
    }
    __syncthreads();
}
}
namespace dil {
typedef float f32x16 __attribute__((ext_vector_type(16)));
constexpr int KPW = 72, VPW = 96;
constexpr int WAVE_LDS = 32 * KPW * 2 + 32 * VPW * 2;
constexpr int OFF_BIASD = 8 * WAVE_LDS;
constexpr float LOG2E = 1.4426950408889634f;

__device__ __forceinline__ void dilated_unit(LAS unsigned char* lds, const f16* PROJ, const float* relb, f16* ATT, float* stAo, float* stAml, float* stBo, float* stBml, int b, int h, int sp, int tid) {
    const int lane = tid & 63, r32 = lane & 31, hi = lane >> 5; const int wid = __builtin_amdgcn_readfirstlane(tid >> 6);
    LAS float* biasd = (LAS float*)(lds + OFF_BIASD);
    for (int e = tid; e < 3 * 129; e += NTHR) { const int br = e / 129, mm = e % 129; const int dl = br == 0 ? 16 : (br == 1 ? 4 : 1); biasd[br * 132 + mm] = relb[(8 + h) * 32 + t5_bucket(dl * mm)] * LOG2E; }
    __syncthreads();
    LAS f16* Kb = (LAS f16*)(lds + wid * WAVE_LDS); LAS f16* Vb = Kb + 32 * KPW;
    const size_t rowbase = (size_t)b * SEQ; const int T0 = sp * 512;
    const f16* Kg = PROJ + 2048 + h * 64; const f16* Vg = PROJ + 2560 + h * 64;
    const size_t gtok0 = ((size_t)(b * NH + h)) * SEQ;
    const float csc = 0.125f * LOG2E;
#pragma unroll 1
    for (int pass = 0; pass < 3; ++pass) {
        const int dl = pass == 0 ? 16 : (pass == 1 ? 4 : 1);
        const float* ldo = pass == 1 ? stAo : stBo; const float* ldml = pass == 1 ? stAml : stBml;
        float* sto = pass == 0 ? stAo : stBo; float* stml = pass == 0 ? stAml : stBml;
        const LAS float* bt = biasd + pass * 132;
#pragma unroll 1
        for (int jj = 0; jj < 2; ++jj) {
            const int j = wid + 8 * jj;
            const int tq0 = pass == 0 ? T0 + j : (pass == 1 ? T0 + (j >> 2) + 128 * (j & 3) : T0 + 32 * j);
            const int t = tq0 + dl * r32;
            f16x8 qf[4];
            { const f16* qrow = PROJ + (rowbase + t) * AB_IN + 1536 + h * 64;
#pragma unroll
              for (int s = 0; s < 4; ++s) qf[s] = *(const f16x8*)(qrow + 16 * s + 8 * hi); }
            f32x16 o0, o1; float m, l;
            const size_t sidx = (gtok0 + t) * 2 + hi;
            if (pass == 0) {
#pragma unroll
                for (int r = 0; r < 16; ++r) { o0[r] = 0.f; o1[r] = 0.f; }
                m = -1e30f; l = 0.f;
            } else {
                const f32x4* po = (const f32x4*)(ldo + sidx * 32);
#pragma unroll
                for (int g = 0; g < 4; ++g) { const f32x4 a = po[g], c = po[4 + g];
                    o0[4 * g] = a[0]; o0[4 * g + 1] = a[1]; o0[4 * g + 2] = a[2]; o0[4 * g + 3] = a[3]; o1[4 * g] = c[0]; o1[4 * g + 1] = c[1]; o1[4 * g + 2] = c[2]; o1[4 * g + 3] = c[3]; }
                const f32x2 ml = *(const f32x2*)(ldml + sidx * 2); m = ml[0]; l = ml[1];
            }
            f16x8 kA[4], vA[4], kB[4], vB[4];
            auto gload = [&](int kbk, f16x8 (&kreg)[4], f16x8 (&vreg)[4]) {
#pragma unroll
                for (int i = 0; i < 4; ++i) { const int id = lane + 64 * i, c = id >> 3, ch = id & 7; int pos = tq0 + dl * (-128 + 32 * kbk + c); pos = pos < 0 ? 0 : pos;
                    kreg[i] = *(const f16x8*)(Kg + (rowbase + pos) * AB_IN + 8 * ch); vreg[i] = *(const f16x8*)(Vg + (rowbase + pos) * AB_IN + 8 * ch); }
            };
            auto lstore = [&](const f16x8 (&kreg)[4], const f16x8 (&vreg)[4]) {
#pragma unroll
                for (int i = 0; i < 4; ++i) { const int id = lane + 64 * i, c = id >> 3, ch = id & 7;
                    *(LAS f16x8*)(Kb + c * KPW + 8 * ch) = kreg[i];
                    *(LAS f16x8*)(Vb + c * VPW + 8 * ch) = vreg[i]; }
            };
            int kb0 = 0;
            while (kb0 < 4 && tq0 + dl * (-128 + 32 * kb0 + 31) < 0) ++kb0;
            gload(kb0, kA, vA); if (kb0 + 1 < 5) gload(kb0 + 1, kB, vB);
            auto step = [&](int kbk, f16x8 (&kreg)[4], f16x8 (&vreg)[4]) {
                asm volatile("s_waitcnt lgkmcnt(0)" ::: "memory");
                lstore(kreg, vreg);
                if (kbk + 2 < 5) gload(kbk + 2, kreg, vreg);
                asm volatile("s_waitcnt lgkmcnt(0)" ::: "memory");
                f32x16 p;
#pragma unroll
                for (int r = 0; r < 16; ++r) p[r] = 0.f;
                f16x4 vlo[4], vhh[4];
                {
                    f16x8 kf[4];
#pragma unroll
                    for (int s = 0; s < 4; ++s) kf[s] = *(const LAS f16x8*)(Kb + r32 * KPW + 16 * s + 8 * hi);
#pragma unroll
                    for (int s2 = 0; s2 < 2; ++s2)
#pragma unroll
                        for (int db = 0; db < 2; ++db) { const LAS f16* vp = Vb + (16 * s2 + 4 * hi + ((lane & 15) >> 2)) * VPW + 32 * db + (r32 & 16) + 4 * (lane & 3); vlo[s2 * 2 + db] = att::tr_read(vp); vhh[s2 * 2 + db] = att::tr_read(vp + 8 * VPW); }
                    __builtin_amdgcn_sched_barrier(0);
#pragma unroll
                    for (int s = 0; s < 4; ++s) p = __builtin_amdgcn_mfma_f32_32x32x16_f16(kf[s], qf[s], p, 0, 0, 0);
                }
                const int basepos = tq0 + dl * (-128 + 32 * kbk);
                const int bmm = r32 + 128 - 32 * kbk - 4 * hi;
                const int bpos = basepos + dl * 4 * hi;
                const bool edge = (kbk == 0) || (kbk == 4) || (basepos < 0);
                if (edge) {
#pragma unroll
                    for (int r = 0; r < 16; ++r) { const int c = (r & 3) + 8 * (r >> 2); const int mm = bmm - c; const bool ok = (mm >= 0) && (mm <= 128) && (bpos + dl * c >= 0);
                        const int mc = mm < 0 ? 0 : (mm > 128 ? 128 : mm);
                        p[r] = ok ? p[r] * csc + bt[mc] : -INFINITY; }
                } else {
                    float bb[16];
#pragma unroll
                    for (int r = 0; r < 16; ++r) { const int c = (r & 3) + 8 * (r >> 2); bb[r] = bt[bmm - c]; }
                    __builtin_amdgcn_sched_barrier(0);
#pragma unroll
                    for (int r = 0; r < 16; ++r) p[r] = p[r] * csc + bb[r];
                }
                float mx = p[0];
#pragma unroll
                for (int r = 1; r < 16; ++r) mx = fmaxf(mx, p[r]);
                mx = fmaxf(mx, __shfl_xor(mx, 32));
                if (__any(mx > m + 8.0f)) {
                    const float mn = fmaxf(m, mx), alpha = __builtin_amdgcn_exp2f(m - mn);
                    m = mn; l *= alpha;
#pragma unroll
                    for (int r = 0; r < 16; ++r) { o0[r] *= alpha; o1[r] *= alpha; }
                }
                float sum = 0.f;
#pragma unroll
                for (int r = 0; r < 16; ++r) { p[r] = __builtin_amdgcn_exp2f(p[r] - m); sum += p[r]; }
                l += sum;
#pragma unroll
                for (int s2 = 0; s2 < 2; ++s2) {
                    f16x8 bf;
#pragma unroll
                    for (int e = 0; e < 8; ++e) bf[e] = (f16)p[8 * s2 + e];
#pragma unroll
                    for (int db = 0; db < 2; ++db) {
                        const f16x4 lo = vlo[s2 * 2 + db], hh = vhh[s2 * 2 + db];
                        const f16x8 af = {lo[0], lo[1], lo[2], lo[3], hh[0], hh[1], hh[2], hh[3]};
                        if (db == 0) o0 = __builtin_amdgcn_mfma_f32_32x32x16_f16(af, bf, o0, 0, 0, 0); else o1 = __builtin_amdgcn_mfma_f32_32x32x16_f16(af, bf, o1, 0, 0, 0);
                    }
                }
            };
#pragma unroll 1
            for (int kbk = kb0; kbk < 5; kbk += 2) { step(kbk, kA, vA); if (kbk + 1 < 5) step(kbk + 1, kB, vB); }
            if (pass < 2) {
                f32x4* po = (f32x4*)(sto + sidx * 32);
#pragma unroll
                for (int g = 0; g < 4; ++g) { po[g] = (f32x4){o0[4 * g], o0[4 * g + 1], o0[4 * g + 2], o0[4 * g + 3]}; po[4 + g] = (f32x4){o1[4 * g], o1[4 * g + 1], o1[4 * g + 2], o1[4 * g + 3]}; }
                *(f32x2*)(stml + sidx * 2) = (f32x2){m, l};
            } else {
                l += __shfl_xor(l, 32); const float inv = 1.f / l;
                f16* orow = ATT + (rowbase + t) * DM + 512 + h * 64;
#pragma unroll
                for (int g = 0; g < 4; ++g) {
                    u32x2 w0, w1;
                    w0.x = pk_f16(o0[4 * g] * inv, o0[4 * g + 1] * inv); w0.y = pk_f16(o0[4 * g + 2] * inv, o0[4 * g + 3] * inv);
                    w1.x = pk_f16(o1[4 * g] * inv, o1[4 * g + 1] * inv); w1.y = pk_f16(o1[4 * g + 2] * inv, o1[4 * g + 3] * inv);
                    *(u32x2*)(orow + 8 * g + 4 * hi) = w0; *(u32x2*)(orow + 32 + 8 * g + 4 * hi) = w1;
                }
            }
        }
        asm volatile("s_waitcnt vmcnt(0) lgkmcnt(0)" ::: "memory");
        __syncthreads();
    }
}
}
#ifndef USE_MFMA_MOBA
#define USE_MFMA_MOBA 1
#endif
#ifndef USE_MFMA_MLA
#define USE_MFMA_MLA 1
#endif
#ifndef USE_MFMA_SB
#define USE_MFMA_SB 1
#endif
#ifndef USE_MFMA_DIL
#define USE_MFMA_DIL 1
#endif
#ifndef REP_MOBA
#define REP_MOBA 1
#endif
#ifndef REP_DIL
#define REP_DIL 1
#endif
#ifndef REP_MLA
#define REP_MLA 1
#endif
#ifndef REP_SB
#define REP_SB 1
#endif
#ifndef REP_P0
#define REP_P0 1
#endif
#ifndef REP_THIN
#define REP_THIN 1
#endif
#ifndef REP_INPROJ
#define REP_INPROJ 1
#endif
#ifndef REP_OUTPROJ
#define REP_OUTPROJ 1
#endif
#ifndef REP_FUP
#define REP_FUP 1
#endif
#ifndef REP_FDN
#define REP_FDN 1
#endif
#ifndef PROBE_XBAR
#define PROBE_XBAR 0
#endif
#ifndef HALO_IN_THIN1
#define HALO_IN_THIN1 0
#endif
#ifndef HALO_IN_FUP
#define HALO_IN_FUP 1
#endif
#ifndef PROBE_PM
#define PROBE_PM 0
#endif
#ifndef DEFER_W
#define DEFER_W 1
#endif
#ifndef PROBE_STAMP
#define PROBE_STAMP (-1)
#endif
#ifndef PROBE_BLK
#define PROBE_BLK 0
#endif
#ifndef PROBE_FUP
#define PROBE_FUP 0
#endif
#ifndef SEAM_FUSE
#define SEAM_FUSE 2
#endif
#ifndef MK_SPLIT
#define MK_SPLIT 0
#endif
constexpr int N_PHASES = 2 + DEPTH * 12;

__device__ __forceinline__ void panel_wait(unsigned* cnt, unsigned want, int tid) {
    if (tid < 64) { unsigned spins = 0;
        while ((unsigned)__builtin_amdgcn_readfirstlane(__hip_atomic_load(cnt, __ATOMIC_RELAXED, __HIP_MEMORY_SCOPE_AGENT)) < want) { __builtin_amdgcn_s_sleep(2); if (++spins > (1u << 16)) break; }
        __builtin_amdgcn_fence(__ATOMIC_ACQUIRE, "agent");
        asm volatile("s_waitcnt vmcnt(0)" ::: "memory"); }
    __syncthreads();
}
__device__ __forceinline__ int lane_now() { int l; asm volatile("v_mbcnt_lo_u32_b32 %0, -1, 0\n\tv_mbcnt_hi_u32_b32 %0, -1, %0" : "=v"(l)); return l; }
__global__ void __launch_bounds__(NTHR, 2) fwd_kernel(Args a) {
    extern __shared__ __attribute__((aligned(16))) unsigned char lds_raw[];
    LAS unsigned char* lds = (LAS unsigned char*)lds_raw;
    const int wave0 = __builtin_amdgcn_readfirstlane((int)threadIdx.x >> 6);
#define TID_NOW (wave0 * 64 + lane_now())
    const int bid = blockIdx.x, G = gridDim.x; const int NGT = G * NTHR;
    for (int u = TID_NOW; u < (LDS_BYTES - LDSCTL_OFF) / 4; u += NTHR) ((LAS unsigned*)(lds + LDSCTL_OFF))[u] = 0u;
    __syncthreads();
    volatile LAS unsigned* MISC = (volatile LAS unsigned*)(lds + MISC_OFF);
    XcdBarrier bar = xcd_barrier_post((unsigned*)(a.ws + WS_CTL) + CW_BAR, MISC + 8, TID_NOW);
    const int lo = a.ph_lo, hi = a.ph_hi; const bool seams = (hi - lo) > 1;
    int ph = 0;
    unsigned long long pacc = 0ull; int pkind = 0; (void)pkind;
    unsigned char* const ws0 = a.ws;
#define X16B ((f16*)(ws + WS_R2 + 32 * MiB))
#define X16 ((f16*)xout0)
#define MOD ((float*)(ws + WS_MOD))
#define H ((f16*)(ws + WS_H))
#define ATT ((f16*)(ws + WS_ATT))
#define HHALO ((f16*)(ws + WS_HHALO))
#define PROJ ((f16*)(ws + WS_R1))
#define Qb ((f16*)(ws + WS_R2))
#define KVb ((f16*)(ws + WS_R2 + 24 * MiB))
#define KPE ((f16*)(ws + WS_R2 + 56 * MiB))
#define rc ((const float*)(ws + WS_ROPE))
#define rs (((const float*)(ws + WS_ROPE)) + SEQ * 16)
#define ctl ((unsigned*)(ws + WS_CTL))
#define Y1 ((f16*)(ws + WS_R2))
#define Y2 ((f16*)(ws + WS_R2))
#define ACT ((f16*)(ws + WS_R1))
    float* const xout0 = a.out;
#define PH_ON (lo <= ph && ph < hi)
#define PH_LOC int tid = TID_NOW; asm volatile("" : "+v"(tid)); const int gt = bid * NTHR + tid; (void)gt; unsigned char* ws = ws0; asm volatile("" : "+s"(ws)); const unsigned long long t_ph0 = (PROBE_STAMP >= 0) ? rt() : 0ull; (void)t_ph0
#define PH_END do { const unsigned long long t1_ = (PROBE_STAMP >= 0) ? rt() : 0ull; if (seams) xcd_barrier(bar, TID_NOW); if (PROBE_STAMP >= 0) { const unsigned long long t2_ = rt(); if (PROBE_STAMP == 0) pacc += t2_ - t1_; else if (PROBE_STAMP == 20) pacc += t2_ - t_ph0; else if (PROBE_STAMP >= 100) { if (pkind == PROBE_STAMP - 100) pacc += t2_ - t1_; } else if (pkind == PROBE_STAMP) pacc += t1_ - t_ph0; } } while (0)

    pkind = 1;
    const int nmodw = (DEFER_W && G >= 192) ? 96 : 0;
    if (PH_ON) { PH_LOC;
        if (nmodw == 0) { for (int ll = 0; ll < (DEFER_W ? 1 : DEPTH); ++ll) layer_mod(a, lds, tid, bid, G, ll); }
        else if (bid < nmodw) layer_mod(a, lds, tid, bid, nmodw, 0);
        else { layer_weights(a, lds, tid, bid - nmodw, G - nmodw, 0, 3); p0_misc(a, tid, bid - nmodw, G - nmodw); }
        PH_END; } ++ph;
    pkind = 2;
    if (PH_ON) { PH_LOC; if (gt < BATCH * 16 * 512) ((float*)(ws + WS_KMEAN))[gt] = 0.f;
        if (nmodw == 0) { for (int ll = 0; ll < (DEFER_W ? 1 : DEPTH); ++ll) { layer_weights(a, lds, tid, bid, G, ll, 3); __syncthreads(); } p0_misc(a, tid, bid, G); }
        __syncthreads();
        thin_phase<true, false, false, true>(a.in[I_X], nullptr, X16, nullptr, nullptr, nullptr, nullptr, a.in[I_MIXPRE], MOD, H, nullptr, lds, tid, bid * NWAVES + (tid >> 6), G * NWAVES); PH_END; } ++ph;

    for (int l = 0; l < DEPTH; ++l) {
        const int li = l >> 1; const bool odd = (l & 1) != 0;
#define modl (MOD + (size_t)l * BATCH * 6144)
        for (int xb = 0; xb < PROBE_XBAR; ++xb) if (seams) xcd_barrier(bar, TID_NOW);
        pkind = 3;
        if (PH_ON) { PH_LOC;
            const int N = odd ? CD_INP : AB_IN;
            const f16* Bt = odd ? (const f16*)(ws + WS_W_INCD) + (size_t)li * CD_INP * DM : (const f16*)(ws + WS_W_INAB) + (size_t)li * AB_IN * DM;
            pg8::Gemm g{H, Bt, M, N, DM, DM}; pg8::StaticOrder S; S.init(M, N, G, bid);
            pg8::EpiF16 E{PROJ, N, 0, nullptr, 0, odd ? nullptr : (float*)(ws + WS_KMEAN), 512, 1024, odd ? (PG8_LAS float*)(lds + XCH_OFF) : (PG8_LAS float*)nullptr, KPE, rc, rs, nullptr};
            for (int rep = 0; rep < REP_INPROJ; ++rep) pg8::gemm_phase<pg8::EpiF16, pg8::StaticOrder, true, true>(lds, g, S, E, tid);
            if (DEFER_W && odd) {
                const int total = (M / 256) * (N / 256), rounds = (total + G - 1) / G; int first_short = total - (rounds - 1) * G; if (first_short >= G) first_short = 0;
                if (bid >= first_short) { const int tid2 = TID_NOW; layer_weights(a, lds, tid2, bid - first_short, G - first_short, l, 2); if (l == 1) layer_weights(a, lds, tid2, bid - first_short, G - first_short, 2, 2); }
            }
            PH_END; } ++ph;
        pkind = 4;
        if (PH_ON) { PH_LOC;
            (void)tid; } ++ph;
        if (PH_ON) { PH_LOC;
            if (odd) {
                pg8::Gemm g{PROJ, (const f16*)(ws + WS_W_UP2) + (size_t)li * UP_N * UP_K, M, UP_N, UP_K, CD_INP}; pg8::UpOrder S; S.init(M, UP_N, G, bid, QW / 256);
                pg8::EpiF16 E{Qb, QW, QW, KVb, KVW, nullptr, 0, 0, nullptr, nullptr, nullptr, nullptr, nullptr};
                pg8::gemm_phase<pg8::EpiF16, pg8::UpOrder, true, true>(lds, g, S, E, tid);
                PH_END; }
        } ++ph;
        pkind = odd ? 6 : 5;
        if (PH_ON) { PH_LOC;
            const int vcu = (G % 8 == 0) ? (bid % 8) * (G / 8) + bid / 8 : bid;
            if (!odd) {
#pragma unroll 1
                for (int step = 0; step < 2; ++step) {
                    if ((step == 0) == ((vcu & 1) != 0)) {
                        for (int u = vcu; u < 256; u += G) { const int bh = u >> 3, sp = u & 7;
                            dil::dilated_unit(lds, PROJ, a.in[I_RELB], ATT, (float*)(ws + WS_R2), (float*)(ws + WS_R2 + 32 * MiB), (float*)(ws + WS_H), (float*)(ws + WS_R2 + 34 * MiB), bh >> 3, bh & 7, sp, tid); }
                    } else {
                        for (int p = vcu; p < 256; p += G) { const int bh = p >> 3, s = p & 7, b = bh >> 3, h = bh & 7;
                            att::Src T{PROJ + h * 64, AB_IN, PROJ + 512 + h * 64, AB_IN, nullptr, PROJ + 1024 + h * 64, AB_IN, ATT + h * 64};
                            att::attn_unit<1>(lds, T, b, h, s, rc, rs, (const float*)(ws + WS_KMEAN), a.in[I_RELB], tid);
                            att::attn_unit<1>(lds, T, b, h, 15 - s, rc, rs, (const float*)(ws + WS_KMEAN), a.in[I_RELB], tid); }
                    }
                }
            } else {
#if USE_MFMA_MLA
                for (int rep = 1; rep < REP_MLA; ++rep)
                for (int p = vcu; p < 256; p += G) { const int bh = p >> 3, s = p & 7, b = bh >> 3, h = bh & 7;
                    att::Src T{Qb + h * 96, QW, KVb + h * 128, KVW, KPE, KVb + h * 128 + 64, KVW, ATT + h * 64};
                    att::attn_unit<0, PROBE_PM>(lds, T, b, h, s, rc, rs, nullptr, nullptr, tid);
                    att::attn_unit<0, PROBE_PM>(lds, T, b, h, 15 - s, rc, rs, nullptr, nullptr, tid); }
                for (int p = vcu; p < 256; p += G) { const int bh = p >> 3, s = p & 7, b = bh >> 3, h = bh & 7;
                    att::Src T{Qb + h * 96, QW, KVb + h * 128, KVW, KPE, KVb + h * 128 + 64, KVW, ATT + h * 64};
                    att::attn_unit<0>(lds, T, b, h, s, rc, rs, nullptr, nullptr, tid);
                    att::attn_unit<0>(lds, T, b, h, 15 - s, rc, rs, nullptr, nullptr, tid); }
#else
                naive_mla(Qb, KVb, KPE, rc, rs, ATT, gt, NGT);
#endif
#if USE_MFMA_SB
                for (int rep = 0; rep < REP_SB; ++rep)
                for (int p = vcu; p < 256; p += G) { const int bh = p >> 3, s = p & 7, b = bh >> 3, h = bh & 7;
                    att::Src T{PROJ + 544 + h * 64, CD_INP, PROJ + 1056 + h * 64, CD_INP, nullptr, PROJ + 1568 + h * 64, CD_INP, ATT + 512 + h * 64};
                    att::attn_unit<2>(lds, T, b, h, s, rc, rs, nullptr, nullptr, tid);
                    att::attn_unit<2>(lds, T, b, h, 15 - s, rc, rs, nullptr, nullptr, tid); }
#else
                naive_sb(PROJ, ATT, gt, NGT);
#endif
            }
            PH_END; } ++ph;
        pkind = 7;
        if (PH_ON) { PH_LOC;
            const f16* Bt = odd ? (const f16*)(ws + WS_W_OUTCD) + (size_t)li * DM * DM : (const f16*)(ws + WS_W_OUTAB) + (size_t)li * DM * DM;
            pg8::Gemm g{ATT, Bt, M, DM, DM, DM}; pg8::StaticOrder S; S.init(M, DM, G, bid);
#if SEAM_FUSE == 2
            if (G == 256) {
                pg8::EpiRow ER{X16, (l + 1 == DEPTH) ? X16B : X16, nullptr, modl + 2 * DM, a.in[I_MIXPOST] + l * DM, a.in[I_FFNPRE] + l * DM, modl + 3 * DM, H, HHALO,
                               (float*)(ws + WS_XB), (float*)(ws + WS_XB + 256 * 1024), ctl + CW_PANEL + 64 * (((2 * l + 0) * 2 + 0) * 64), ctl + CW_PANEL + 64 * (((2 * l + 0) * 2 + 1) * 64)};
                pg8::gemm_phase<pg8::EpiRow, pg8::StaticOrder, false, true>(lds, g, S, ER, tid);
            } else
#endif
            {
            const bool fuse = SEAM_FUSE == 1 && G == 256;
            unsigned* pc = ctl + CW_PANEL + 64 * ((2 * l + 0) * 64);
            pg8::EpiF16 E{Y1, DM, 0, nullptr, 0, nullptr, 0, 0, nullptr, nullptr, nullptr, nullptr, fuse ? pc : nullptr};
            pg8::gemm_phase<pg8::EpiF16, pg8::StaticOrder, true, true>(lds, g, S, E, tid);
            if (fuse) { pg8::Unit u; S.next(0, u);
                panel_wait(pc + 64 * u.pm, 32u, tid);
                thin_phase<false, true, false, true>(nullptr, X16, (l + 1 == DEPTH) ? X16B : X16, nullptr, Y1, modl + 2 * DM, a.in[I_MIXPOST] + l * DM, a.in[I_FFNPRE] + l * DM, modl + 3 * DM, H, HHALO, lds, tid,
                                                     u.pm * 256 + u.pn * 64 + (tid >> 6), NWAVES, u.pm * 256 + u.pn * 64 + 64); }
            }
            PH_END; } ++ph;
        pkind = 2;
        if (PH_ON) { PH_LOC;
            if (!(SEAM_FUSE != 0 && G == 256)) {
            const float* gpost = a.in[I_MIXPOST] + l * DM; const float* gpre = a.in[I_FFNPRE] + l * DM;
            thin_phase<false, true, false, true>(nullptr, X16, (l + 1 == DEPTH) ? X16B : X16, nullptr, Y1, modl + 2 * DM, gpost, gpre, modl + 3 * DM, H, HHALO, lds, tid, bid * NWAVES + (tid >> 6), G * NWAVES);
            PH_END; } } ++ph;
#if !HALO_IN_FUP
        if (PH_ON) { PH_LOC;
            pg8::Gemm g{HHALO, (const f16*)(ws + WS_W_FUP) + (size_t)l * DFF2 * DM, 256, DFF2, DM, DM}; pg8::StaticOrder S; S.init(256, DFF2, G, bid);
            pg8::EpiF32 E{(float*)(ws + WS_UHALO), DFF2, 128};
            pg8::gemm_phase<pg8::EpiF32, pg8::StaticOrder, true, true>(lds, g, S, E, tid);
            PH_END; }
#endif
        ++ph;
        pkind = 8;
        if (PH_ON) { PH_LOC;
            pg8::Gemm g{H, (const f16*)(ws + WS_W_FUP) + (size_t)l * DFF2 * DM, M, DFF2, DM, DM};
#if HALO_IN_FUP
            pg8::FfnUpOrder S; S.init(M, DFF2, G, bid);
            pg8::EpiConv E{ACT, (float*)(ws + WS_UHALO), a.in[I_CONVW] + (size_t)l * 3 * DFF2, a.in[I_CONVB] + (size_t)l * DFF2, (PG8_LAS float*)(lds + XCH_OFF), (PG8_LAS float*)(lds + XCH_OFF + 8192), ctl + CW_HALO + 64 * 22 * l, M / 256};
            pg8::gemm_phase<pg8::EpiConv, pg8::FfnUpOrder, true, true>(lds, g, S, E, tid);
#if PROBE_FUP == 1
            pg8::gemm_phase<pg8::EpiConv, pg8::FfnUpOrder, true, true>(lds, g, S, E, tid);
#elif PROBE_FUP == 3
            { pg8::StaticOrder S2; S2.init(M, DFF2, G, bid); pg8::EpiNull E2{}; pg8::gemm_phase<pg8::EpiNull, pg8::StaticOrder, true, true>(lds, g, S2, E2, tid); }
#elif PROBE_FUP == 2
            { pg8::StaticOrder S2; S2.init(M, DFF2, G, bid); pg8::EpiF16 E2{(f16*)(ws + WS_R2), 1024, 0, nullptr, 0, nullptr, 0, 0, nullptr, nullptr, nullptr, nullptr, nullptr};
              pg8::gemm_phase<pg8::EpiF16, pg8::StaticOrder, true, true>(lds, g, S2, E2, tid); }
#endif
            if (DEFER_W && l + 1 < DEPTH) {
                const int total = (M / 256) * (DFF2 / 256) + DFF2 / 256, rounds = (total + G - 1) / G; int first_short = total - (rounds - 1) * G; if (first_short >= G) first_short = 0;
                if (bid >= first_short) { const int tid2 = TID_NOW;
                    layer_mod(a, lds, tid2, bid - first_short, G - first_short, l + 1); layer_weights(a, lds, tid2, bid - first_short, G - first_short, l + 1, 1); }
            }
#else
            pg8::StaticOrder S; S.init(M, DFF2, G, bid);
            pg8::EpiConv E{ACT, (float*)(ws + WS_UHALO), a.in[I_CONVW] + (size_t)l * 3 * DFF2, a.in[I_CONVB] + (size_t)l * DFF2, (PG8_LAS float*)(lds + XCH_OFF), (PG8_LAS float*)(lds + XCH_OFF + 8192), ctl + CW_HALO, -1};
            for (int rep = 0; rep < REP_FUP; ++rep) pg8::gemm_phase<pg8::EpiConv, pg8::StaticOrder, true, true>(lds, g, S, E, tid);
#endif
            PH_END; } ++ph;
        ++ph; ++ph;
        pkind = 9;
        if (PH_ON) { PH_LOC;
            pg8::Gemm g{ACT, (const f16*)(ws + WS_W_FDN) + (size_t)l * DM * DFF, M, DM, DFF, DFF}; pg8::StaticOrder S; S.init(M, DM, G, bid);
#if SEAM_FUSE == 2
            if (G == 256) {
                const int ln2 = (l + 1 < DEPTH) ? l + 1 : l; const bool last = l + 1 == DEPTH;
                pg8::EpiRow ER{last ? X16B : X16, last ? (f16*)nullptr : X16, last ? xout0 : (float*)nullptr, modl + 5 * DM, a.in[I_FFNPOST] + l * DM, a.in[I_MIXPRE] + ln2 * DM, MOD + (size_t)ln2 * BATCH * 6144, H, nullptr,
                               (float*)(ws + WS_XB), (float*)(ws + WS_XB + 256 * 1024), ctl + CW_PANEL + 64 * (((2 * l + 1) * 2 + 0) * 64), ctl + CW_PANEL + 64 * (((2 * l + 1) * 2 + 1) * 64)};
                pg8::gemm_phase<pg8::EpiRow, pg8::StaticOrder, false, true>(lds, g, S, ER, tid);
                if (gt < BATCH * 16 * 512) ((float*)(ws + WS_KMEAN))[gt] = 0.f;
            } else
#endif
            {
            const bool fuse = SEAM_FUSE == 1 && G == 256;
            unsigned* pc = ctl + CW_PANEL + 64 * ((2 * l + 1) * 64);
            pg8::EpiF16 E{Y2, DM, 0, nullptr, 0, nullptr, 0, 0, nullptr, nullptr, nullptr, nullptr, fuse ? pc : nullptr};
            pg8::gemm_phase<pg8::EpiF16, pg8::StaticOrder, true, true>(lds, g, S, E, tid);
            if (fuse) { pg8::Unit u; S.next(0, u);
                panel_wait(pc + 64 * u.pm, 32u, tid);
                const int ln = (l + 1 < DEPTH) ? l + 1 : l; const int r0 = u.pm * 256 + u.pn * 64;
                if (l + 1 < DEPTH) thin_phase<false, true, false, true>(nullptr, X16, X16, nullptr, Y2, modl + 5 * DM, a.in[I_FFNPOST] + l * DM, a.in[I_MIXPRE] + ln * DM, MOD + (size_t)ln * BATCH * 6144, H, nullptr, lds, tid, r0 + (tid >> 6), NWAVES, r0 + 64);
                else thin_phase<false, true, true, false>(nullptr, X16B, nullptr, xout0, Y2, modl + 5 * DM, a.in[I_FFNPOST] + l * DM, nullptr, nullptr, nullptr, nullptr, lds, tid, r0 + (tid >> 6), NWAVES, r0 + 64);
                if (gt < BATCH * 16 * 512) ((float*)(ws + WS_KMEAN))[gt] = 0.f; }
            }
            PH_END; } ++ph;
        pkind = 2;
        if (PH_ON) { PH_LOC;
            if (!(SEAM_FUSE != 0 && G == 256)) {
            const int ln = (l + 1 < DEPTH) ? l + 1 : l;
            if (gt < BATCH * 16 * 512) ((float*)(ws + WS_KMEAN))[gt] = 0.f;
            if (l + 1 < DEPTH) thin_phase<false, true, false, true>(nullptr, X16, X16, nullptr, Y2, modl + 5 * DM, a.in[I_FFNPOST] + l * DM, a.in[I_MIXPRE] + ln * DM, MOD + (size_t)ln * BATCH * 6144, H, nullptr, lds, tid, bid * NWAVES + (tid >> 6), G * NWAVES);
            else thin_phase<false, true, true, false>(nullptr, X16B, nullptr, xout0, Y2, modl + 5 * DM, a.in[I_FFNPOST] + l * DM, nullptr, nullptr, nullptr, nullptr, lds, tid, bid * NWAVES + (tid >> 6), G * NWAVES);
            PH_END; } } ++ph;
    }
    if (PROBE_STAMP >= 0 && bid == PROBE_BLK) { const unsigned long long t0_ = rt(); while (rt() - t0_ < pacc) __builtin_amdgcn_s_sleep(10); }
#undef PH_ON
#undef PH_END
#undef X16
#undef X16B
#undef MOD
#undef H
#undef ATT
#undef HHALO
#undef PROJ
#undef Qb
#undef KVb
#undef KPE
#undef rc
#undef rs
#undef ctl
#undef Y1
#undef Y2
#undef ACT
#undef modl
}

extern "C" void kernel_launch(void* const* d_in, const int* in_sizes, int n_in, void* d_out, int out_size, void* d_ws, size_t ws_size, hipStream_t stream) {
    static int grid = 0;
    if (grid == 0) {
        if (n_in != 21 || in_sizes[0] != M * DM || out_size != M * DM || ws_size < WS_END) { fprintf(stderr, "kernel_launch: unexpected shapes (n_in %d, ws %zu); nothing launched\n", n_in, ws_size); grid = -1; return; }
        int dev = 0, cus = 0, per_cu = 0;
        if (hipGetDevice(&dev) != hipSuccess || hipDeviceGetAttribute(&cus, hipDeviceAttributeMultiprocessorCount, dev) != hipSuccess) { grid = -1; return; }
        if (hipFuncSetAttribute((const void*)fwd_kernel, hipFuncAttributeMaxDynamicSharedMemorySize, LDS_BYTES) != hipSuccess) { fprintf(stderr, "kernel_launch: hipFuncSetAttribute failed\n"); grid = -1; return; }
        if (hipOccupancyMaxActiveBlocksPerMultiprocessor(&per_cu, (const void*)fwd_kernel, NTHR, LDS_BYTES) != hipSuccess || per_cu < 1) { fprintf(stderr, "kernel_launch: occupancy query reports %d\n", per_cu); }
        (void)hipGetLastError();
        grid = cus;
        if (grid < 64) { fprintf(stderr, "kernel_launch: %d CUs: too few\n", cus); grid = -1; return; }
    }
    if (grid < 0) return;
    (void)hipMemsetAsync((char*)d_ws + WS_CTL, 0, CTL_ZERO_BYTES, stream);
    Args a{};
    for (int i = 0; i < 21; ++i) a.in[i] = (const float*)d_in[i];
    a.out = (float*)d_out; a.ws = (unsigned char*)d_ws;
#if MK_SPLIT
    for (int p = 0; p < N_PHASES; ++p) { a.ph_lo = p; a.ph_hi = p + 1; hipLaunchKernelGGL(fwd_kernel, dim3(grid), dim3(NTHR), LDS_BYTES, stream, a); }
#else
    a.ph_lo = 0; a.ph_hi = N_PHASES;
    hipLaunchKernelGGL(fwd_kernel, dim3(grid), dim3(NTHR), LDS_BYTES, stream, a);
#endif
}
```

```cpp
#include <hip/hip_runtime.h>
#include <cstdio>
#include <cstdint>

constexpr int BATCH = 4, SEQ = 4096, DM = 1024, M = BATCH * SEQ, DEPTH = 4;
constexpr int NH = 8, HD = 64;
constexpr int AB_IN = 3072, CD_IN = 2080, CD_INP = 2304;
constexpr int DFF = 2816, DFF2 = 5632;
constexpr int UP_N = 1792, UP_K = 256;
constexpr int QW = 768, KVW = 1024;
constexpr float NORM_EPS = 1e-6f;

typedef _Float16 f16;
typedef _Float16 f16x2 __attribute__((ext_vector_type(2)));
typedef _Float16 f16x4 __attribute__((ext_vector_type(4)));
typedef _Float16 f16x8 __attribute__((ext_vector_type(8)));
typedef float f32x2 __attribute__((ext_vector_type(2)));
typedef float f32x4 __attribute__((ext_vector_type(4)));
typedef unsigned u32x2 __attribute__((ext_vector_type(2)));
typedef unsigned u32x4 __attribute__((ext_vector_type(4)));

__device__ __forceinline__ unsigned pk_f16(float lo, float hi) { f32x2 v = {lo, hi}; f16x2 h = __builtin_convertvector(v, f16x2); return __builtin_bit_cast(unsigned, h); }

constexpr size_t MiB = 1u << 20;
constexpr size_t WS_CTL = 0, CTL_ZERO_BYTES = 1 * MiB;
constexpr size_t WS_MOD = 1 * MiB;
constexpr size_t WS_KMEAN = 1 * MiB + 512 * 1024;
constexpr size_t WS_ROPE = 2 * MiB;
constexpr size_t WS_UHALO = 3 * MiB;
constexpr size_t WS_HHALO = 140 * MiB;
constexpr size_t WS_XB = 6 * MiB;
constexpr size_t WS_W_INAB = 8 * MiB;
constexpr size_t WS_W_OUTAB = 20 * MiB;
constexpr size_t WS_W_INCD = 24 * MiB;
constexpr size_t WS_W_UP2 = 33 * MiB;
constexpr size_t WS_W_OUTCD = 37 * MiB;
constexpr size_t WS_W_FUP = 41 * MiB;
constexpr size_t WS_W_FDN = 85 * MiB;
constexpr size_t WS_H = 108 * MiB;
constexpr size_t WS_ATT = 140 * MiB;
constexpr size_t WS_R2 = 172 * MiB;
constexpr size_t WS_R1 = 236 * MiB;
constexpr size_t WS_END = 332 * MiB;
constexpr int CW_BAR = 4096;
constexpr int CW_PANEL = 32768;
constexpr int CW_HALO = 16384;
namespace pg8 {
#define PG8_LAS __attribute__((address_space(3)))
constexpr int BM = 256, BK = 64, HALF = 128, HTB = HALF * BK * 2  , STAGE_BYTES = 8 * HTB, NXCD = 8, WGM = 8;

__host__ __device__ __forceinline__ int lds_byte(int r, int c) { const int st = (r >> 4) * 2 + (c >> 5), rr = r & 15, cc = c & 31, ob = rr * 64 + cc * 2; return st * 1024 + (ob ^ (((ob >> 9) & 1) << 5)); }
__host__ __device__ __forceinline__ void stage_rc(int b, int& R, int& C) { const int st = b / 1024, sb = b % 1024, swz = sb ^ (((sb >> 9) & 1) << 5); R = (st >> 1) * 16 + swz / 64; C = (st & 1) * 32 + (swz % 64) / 2; }
__host__ __device__ __forceinline__ int perm32(int rho) { const int n = rho >> 4, i = rho & 15; return 8 * (i >> 2) + 4 * n + (i & 3); }

struct Unit { int pm, pn; };
struct Gemm { const f16* A; const f16* Bt; int M, N, K, lda; };

struct StaticOrder {
    int nM, nN, nwg, G, c;
    __host__ __device__ __forceinline__ void init(int M_, int N_, int G_, int c_) { nM = M_ / BM; nN = N_ / BM; nwg = nM * nN; G = G_; c = c_; }
    __host__ __device__ __forceinline__ void map(int wgid, Unit& u) const {
        { const int q = nwg / NXCD, r = nwg % NXCD, xcd = wgid % NXCD, off = wgid / NXCD; wgid = (xcd < r ? xcd * (q + 1) : r * (q + 1) + (xcd - r) * q) + off; }
        const int nig = WGM * nN, gid = wgid / nig, fm = gid * WGM, gsz = (nM - fm) < WGM ? (nM - fm) : WGM;
        u.pm = fm + ((wgid % nig) % gsz); u.pn = (wgid % nig) / gsz;
    }
    __host__ __device__ __forceinline__ bool next(int i, Unit& u) const { const long L = (long)i * G + c; if (L >= nwg) return false; map((int)L, u); return true; }
    __device__ __forceinline__ void a_ready(const Unit&) const {}
    __device__ __forceinline__ void done(const Unit&) const {}
    __device__ __forceinline__ size_t a_off(const Unit&) const { return 0; }
};

struct FfnUpOrder {
    StaticOrder S; int nh;
    __host__ __device__ __forceinline__ void init(int M_, int N_, int G_, int c_) { S.init(M_, N_, G_, c_); nh = N_ / BM; }
    __host__ __device__ __forceinline__ bool next(int i, Unit& u) const { const long L = (long)i * S.G + S.c; if (L >= S.nwg + nh) return false; if (L < nh) { u.pm = S.nM; u.pn = (int)L; return true; } S.map((int)L - nh, u); return true; }
    __device__ __forceinline__ void a_ready(const Unit&) const {}
    __device__ __forceinline__ void done(const Unit&) const {}
    __device__ __forceinline__ size_t a_off(const Unit&) const { return 0; }
};

struct UpOrder {
    StaticOrder S; int split_pn;
    __host__ __device__ __forceinline__ void init(int M_, int N_, int G_, int c_, int sp) { S.init(M_, N_, G_, c_); split_pn = sp; }
    __host__ __device__ __forceinline__ bool next(int i, Unit& u) const { return S.next(i, u); }
    __device__ __forceinline__ void a_ready(const Unit&) const {}
    __device__ __forceinline__ void done(const Unit&) const {}
    __device__ __forceinline__ size_t a_off(const Unit& u) const { return u.pn >= split_pn ? 512 : 0; }
};

struct NoPre {};
struct EpiNull {
    static constexpr bool PERM = true, AFTER_DRAIN = false;
    typedef NoPre Pre; __device__ __forceinline__ void prefetch(Pre&, const Unit&, int) const {}
    __device__ __forceinline__ void operator()(const f32x4 (&acc)[2][2][4][2], const Unit&, int, int, int, int, const Pre&) const {
#pragma unroll
        for (int a = 0; a < 2; ++a)
#pragma unroll
            for (int b = 0; b < 2; ++b)
#pragma unroll
                for (int m = 0; m < 4; ++m) asm volatile("" :: "v"(acc[a][b][m][0]), "v"(acc[a][b][m][1]));
    }
};
struct EpiF32 {
    static constexpr bool PERM = false, AFTER_DRAIN = false;
    float* C; int ldc; int row_limit;
    typedef NoPre Pre; __device__ __forceinline__ void prefetch(Pre&, const Unit&, int) const {}
    __device__ __forceinline__ void operator()(const f32x4 (&acc)[2][2][4][2], const Unit& u, int wr, int wc, int fr_in, int fq_in, const Pre&) const {
        int fr = fr_in, fq = fq_in; asm volatile("" : "+v"(fr), "+v"(fq));
        const int row0 = u.pm * BM + wr * 64 + fr, col0 = u.pn * BM + wc * 32 + 4 * fq;
#pragma unroll
        for (int ai = 0; ai < 2; ++ai)
#pragma unroll
            for (int m = 0; m < 4; ++m) { const int row = row0 + ai * HALF + m * 16; if (row >= row_limit) continue; float* rowp = C + (size_t)row * ldc + col0;
#pragma unroll
                for (int bj = 0; bj < 2; ++bj)
#pragma unroll
                    for (int n = 0; n < 2; ++n) *(f32x4*)(rowp + bj * HALF + n * 16) = acc[ai][bj][m][n]; }
    }
};
struct EpiF16 {
    static constexpr bool PERM = true, AFTER_DRAIN = false;
    f16* O; int ldc; int split_col; f16* O2; int ldc2;
    float* ksum; int ks_lo, ks_hi;
    PG8_LAS float* XR; f16* KPE; const float* rc; const float* rs;
    unsigned* pcnt;
    typedef NoPre Pre; __device__ __forceinline__ void prefetch(Pre&, const Unit&, int) const {}
    __device__ __forceinline__ void operator()(const f32x4 (&acc)[2][2][4][2], const Unit& u, int wr, int wc, int fr_in, int fq_in, const Pre&) const {
        int fr = fr_in, fq = fq_in; asm volatile("" : "+v"(fr), "+v"(fq));
        float rsc[2][4];
#pragma unroll
        for (int ai = 0; ai < 2; ++ai)
#pragma unroll
            for (int m = 0; m < 4; ++m) rsc[ai][m] = 1.0f;
        if (XR != nullptr) {
            const bool nt = u.pn < 2;
            if (nt) {
#pragma unroll
                for (int ai = 0; ai < 2; ++ai)
#pragma unroll
                    for (int m = 0; m < 4; ++m) { float q = 0.f;
#pragma unroll
                        for (int bj = 0; bj < 2; ++bj)
#pragma unroll
                            for (int n = 0; n < 2; ++n) { const f32x4 x = acc[ai][bj][m][n]; q += (x[0] * x[0] + x[1] * x[1]) + (x[2] * x[2] + x[3] * x[3]); }
                        q += __shfl_xor(q, 16); q += __shfl_xor(q, 32);
                        if (fq == 0) XR[(ai * HALF + wr * 64 + m * 16 + fr) * 4 + wc] = q; }
            }
            asm volatile("s_waitcnt lgkmcnt(0)" ::: "memory"); __builtin_amdgcn_s_barrier(); asm volatile("" ::: "memory");
            if (nt) {
#pragma unroll
                for (int ai = 0; ai < 2; ++ai)
#pragma unroll
                    for (int m = 0; m < 4; ++m) { const f32x4 q = *(const PG8_LAS f32x4*)(XR + (ai * HALF + wr * 64 + m * 16 + fr) * 4); rsc[ai][m] = 1.0f / sqrtf(((q[0] + q[1]) + (q[2] + q[3])) * (1.0f / 256.0f) + NORM_EPS); }
            }
            if (u.pn == 2 && wc == 0) {
                const int half = fq >> 1, dd0 = 8 * (fq & 1);
#pragma unroll
                for (int ai = 0; ai < 2; ++ai)
#pragma unroll
                    for (int m = 0; m < 4; ++m) { const int row = u.pm * BM + ai * HALF + wr * 64 + m * 16 + fr, t = row & (SEQ - 1);
#pragma unroll
                        for (int n = 0; n < 2; ++n) { const f32x4 own = acc[ai][0][m][n]; f32x4 par;
#pragma unroll
                            for (int e = 0; e < 4; ++e) par[e] = __shfl_xor(own[e], 32);
                            const f32x4 cs = *(const f32x4*)(rc + t * 16 + dd0 + 4 * n), sn = *(const f32x4*)(rs + t * 16 + dd0 + 4 * n);
                            const f32x4 o = half ? (par * sn + own * cs) : (own * cs - par * sn);
                            u32x2 w; w.x = pk_f16(o[0], o[1]); w.y = pk_f16(o[2], o[3]);
                            *(u32x2*)(KPE + (size_t)row * 32 + 16 * half + dd0 + 4 * n) = w; } }
            }
        }
        if (ksum != nullptr && u.pn * BM >= ks_lo && u.pn * BM < ks_hi) {
#pragma unroll
            for (int bj = 0; bj < 2; ++bj)
#pragma unroll
                for (int n = 0; n < 2; ++n) { f32x4 cs = (acc[0][bj][0][n] + acc[0][bj][1][n]) + (acc[0][bj][2][n] + acc[0][bj][3][n]); cs = cs + ((acc[1][bj][0][n] + acc[1][bj][1][n]) + (acc[1][bj][2][n] + acc[1][bj][3][n]));
#pragma unroll
                    for (int e = 0; e < 4; ++e) { float v = cs[e]; v += __shfl_xor(v, 1); v += __shfl_xor(v, 2); v += __shfl_xor(v, 4); v += __shfl_xor(v, 8);
                        if (fr == 0) atomicAdd(ksum + (size_t)u.pm * (ks_hi - ks_lo) + (u.pn * BM - ks_lo) + bj * HALF + wc * 32 + 8 * fq + 4 * n + e, v); } }
        }
        const int row0 = u.pm * BM + wr * 64 + fr; int colt = u.pn * BM; f16* base = O; int ld = ldc;
        if (split_col && colt >= split_col) { base = O2; ld = ldc2; colt -= split_col; }
        const int col0 = colt + wc * 32 + 8 * fq;
        if (pcnt == nullptr) {
#pragma unroll
            for (int ai = 0; ai < 2; ++ai)
#pragma unroll
                for (int m = 0; m < 4; ++m) { f16* rowp = base + (size_t)(row0 + ai * HALF + m * 16) * ld + col0;
#pragma unroll
                    for (int bj = 0; bj < 2; ++bj) { const f32x4 v0 = acc[ai][bj][m][0] * rsc[ai][m], v1 = acc[ai][bj][m][1] * rsc[ai][m];
                        u32x4 w; w.x = pk_f16(v0[0], v0[1]); w.y = pk_f16(v0[2], v0[3]); w.z = pk_f16(v1[0], v1[1]); w.w = pk_f16(v1[2], v1[3]);
                        *(u32x4*)(rowp + bj * HALF) = w; } }
        } else {
            const __amdgpu_buffer_rsrc_t rsrc = __builtin_amdgcn_make_buffer_rsrc((void*)base, 0, 0x7fffffff, 0x00020000);
#pragma unroll
            for (int ai = 0; ai < 2; ++ai)
#pragma unroll
                for (int m = 0; m < 4; ++m) { const unsigned boff = (unsigned)(((size_t)(row0 + ai * HALF + m * 16) * ld + col0) * 2);
#pragma unroll
                    for (int bj = 0; bj < 2; ++bj) { const f32x4 v0 = acc[ai][bj][m][0] * rsc[ai][m], v1 = acc[ai][bj][m][1] * rsc[ai][m];
                        u32x4 w; w.x = pk_f16(v0[0], v0[1]); w.y = pk_f16(v0[2], v0[3]); w.z = pk_f16(v1[0], v1[1]); w.w = pk_f16(v1[2], v1[3]);
                        __builtin_amdgcn_raw_buffer_store_b128(w, rsrc, boff + bj * HALF * 2, 0, 16); } }
            asm volatile("s_waitcnt vmcnt(0)" ::: "memory");
            if (fr == 0 && fq == 0) __hip_atomic_fetch_add(pcnt + 64 * u.pm, 1u, __ATOMIC_RELAXED, __HIP_MEMORY_SCOPE_AGENT);
        }
    }
};

struct EpiRow {
    static constexpr bool PERM = true, AFTER_DRAIN = true;
    typedef NoPre Pre; __device__ __forceinline__ void prefetch(Pre&, const Unit&, int) const {}
    const f16* xin; f16* xout; float* out32;
    const float* gate_l; const float* gpost;
    const float* gpre; const float* ss_l;
    f16* H; f16* HHALO;
    float* xb1; float* xb2; unsigned* c1; unsigned* c2;
    __device__ __forceinline__ void exchange(float (&q)[2][4], float* xb, unsigned* cnt, const Unit& u, int wr, int wc, int fr, int fq, PG8_LAS unsigned char* lds, int wid, int lane) const {
        PG8_LAS float* P = (PG8_LAS float*)lds;
        PG8_LAS float* S = (PG8_LAS float*)(lds + 8192);
#pragma unroll
        for (int ai = 0; ai < 2; ++ai)
#pragma unroll
            for (int m = 0; m < 4; ++m) { float v = q[ai][m]; v += __shfl_xor(v, 16); v += __shfl_xor(v, 32);
                if (fq == 0) P[(ai * HALF + wr * 64 + m * 16 + fr) * 4 + wc] = v; }
        asm volatile("s_waitcnt lgkmcnt(0)" ::: "memory"); __builtin_amdgcn_s_barrier(); asm volatile("" ::: "memory");
        const int row = wid * 32 + (lane & 31);
        if (lane < 32) { const f32x4 p = *(const PG8_LAS f32x4*)(P + row * 4);
            __hip_atomic_store((unsigned*)(xb + ((size_t)(u.pm * BM + row)) * 4 + u.pn), __builtin_bit_cast(unsigned, (p[0] + p[1]) + (p[2] + p[3])), __ATOMIC_RELAXED, __HIP_MEMORY_SCOPE_AGENT); }
        asm volatile("s_waitcnt vmcnt(0)" ::: "memory");
        if (lane == 0) __hip_atomic_fetch_add(cnt + 64 * u.pm, 1u, __ATOMIC_RELAXED, __HIP_MEMORY_SCOPE_AGENT);
        if (wid == 0) { unsigned spins = 0;
            while ((unsigned)__builtin_amdgcn_readfirstlane(__hip_atomic_load(cnt + 64 * u.pm, __ATOMIC_RELAXED, __HIP_MEMORY_SCOPE_AGENT)) < 32u) { __builtin_amdgcn_s_sleep(1); if (++spins > (1u << 16)) break; }
            __builtin_amdgcn_fence(__ATOMIC_ACQUIRE, "agent"); }
        asm volatile("s_waitcnt vmcnt(0) lgkmcnt(0)" ::: "memory"); __builtin_amdgcn_s_barrier(); asm volatile("" ::: "memory");
        if (lane < 32) { const unsigned* sl = (const unsigned*)(xb + ((size_t)(u.pm * BM + row)) * 4); float t = 0.f;
#pragma unroll
            for (int k = 0; k < 4; ++k) t += __builtin_bit_cast(float, __hip_atomic_load(sl + k, __ATOMIC_RELAXED, __HIP_MEMORY_SCOPE_AGENT));
            S[row] = t; }
        asm volatile("s_waitcnt lgkmcnt(0)" ::: "memory"); __builtin_amdgcn_s_barrier(); asm volatile("" ::: "memory");
#pragma unroll
        for (int ai = 0; ai < 2; ++ai)
#pragma unroll
            for (int m = 0; m < 4; ++m) q[ai][m] = S[ai * HALF + wr * 64 + m * 16 + fr];
        asm volatile("s_waitcnt lgkmcnt(0)" ::: "memory"); __builtin_amdgcn_s_barrier(); asm volatile("" ::: "memory");
    }
    __device__ __forceinline__ void fused(f32x4 (&acc)[2][2][4][2], const Unit& u, int wr, int wc, int fr, int fq, PG8_LAS unsigned char* lds, int wid, int lane) const {
        const int b = (u.pm * BM) / SEQ;
        const int row0 = u.pm * BM + wr * 64 + fr, col0 = u.pn * BM + wc * 32 + 8 * fq;
        float q[2][4];
#pragma unroll
        for (int ai = 0; ai < 2; ++ai)
#pragma unroll
            for (int m = 0; m < 4; ++m) { float v = 0.f;
#pragma unroll
                for (int bj = 0; bj < 2; ++bj)
#pragma unroll
                    for (int n = 0; n < 2; ++n) { const f32x4 x = acc[ai][bj][m][n]; v += (x[0] * x[0] + x[1] * x[1]) + (x[2] * x[2] + x[3] * x[3]); }
                q[ai][m] = v; }
        exchange(q, xb1, c1, u, wr, wc, fr, fq, lds, wid, lane);
#pragma unroll
        for (int ai = 0; ai < 2; ++ai)
#pragma unroll
            for (int m = 0; m < 4; ++m) q[ai][m] = 1.0f / sqrtf(q[ai][m] * (1.0f / 1024.0f) + NORM_EPS);
#pragma unroll
        for (int bj = 0; bj < 2; ++bj) {
            const int col = col0 + bj * HALF;
            const f32x4 ta0 = *(const f32x4*)(gate_l + (size_t)b * 6144 + col) * *(const f32x4*)(gpost + col), ta1 = *(const f32x4*)(gate_l + (size_t)b * 6144 + col + 4) * *(const f32x4*)(gpost + col + 4);
#pragma unroll
            for (int ai = 0; ai < 2; ++ai)
#pragma unroll
                for (int m = 0; m < 4; ++m) { const size_t off = (size_t)(row0 + ai * HALF + m * 16) * 1024 + col;
                    const f16x8 xh = *(const f16x8*)(xin + off);
                    f32x4 x0 = {(float)xh[0], (float)xh[1], (float)xh[2], (float)xh[3]}, x1 = {(float)xh[4], (float)xh[5], (float)xh[6], (float)xh[7]};
                    x0 = x0 + ta0 * (acc[ai][bj][m][0] * q[ai][m]); x1 = x1 + ta1 * (acc[ai][bj][m][1] * q[ai][m]);
                    if (out32 != nullptr) { *(f32x4*)(out32 + off) = x0; *(f32x4*)(out32 + off + 4) = x1; }
                    else { u32x4 w; w.x = pk_f16(x0[0], x0[1]); w.y = pk_f16(x0[2], x0[3]); w.z = pk_f16(x1[0], x1[1]); w.w = pk_f16(x1[2], x1[3]);
                        *(u32x4*)(xout + off) = w;
                        const f16x8 r = __builtin_bit_cast(f16x8, w);
                        x0 = (f32x4){(float)r[0], (float)r[1], (float)r[2], (float)r[3]}; x1 = (f32x4){(float)r[4], (float)r[5], (float)r[6], (float)r[7]}; }
                    acc[ai][bj][m][0] = x0; acc[ai][bj][m][1] = x1; }
            asm volatile("" ::: "memory");
        }
        if (out32 != nullptr) return;
#pragma unroll
        for (int ai = 0; ai < 2; ++ai)
#pragma unroll
            for (int m = 0; m < 4; ++m) { float v = 0.f;
#pragma unroll
                for (int bj = 0; bj < 2; ++bj)
#pragma unroll
                    for (int n = 0; n < 2; ++n) { const f32x4 x = acc[ai][bj][m][n]; v += (x[0] * x[0] + x[1] * x[1]) + (x[2] * x[2] + x[3] * x[3]); }
                q[ai][m] = v; }
        exchange(q, xb2, c2, u, wr, wc, fr, fq, lds, wid, lane);
#pragma unroll
        for (int ai = 0; ai < 2; ++ai)
#pragma unroll
            for (int m = 0; m < 4; ++m) q[ai][m] = 1.0f / sqrtf(q[ai][m] * (1.0f / 1024.0f) + NORM_EPS);
#pragma unroll
        for (int bj = 0; bj < 2; ++bj) {
            const int col = col0 + bj * HALF; const float* sp = ss_l + (size_t)b * 6144 + col;
            const f32x4 tb0 = *(const f32x4*)(gpre + col) * (*(const f32x4*)(sp + 1024) + 1.0f), tb1 = *(const f32x4*)(gpre + col + 4) * (*(const f32x4*)(sp + 1024 + 4) + 1.0f);
            const f32x4 tc0 = *(const f32x4*)sp, tc1 = *(const f32x4*)(sp + 4);
#pragma unroll
            for (int ai = 0; ai < 2; ++ai)
#pragma unroll
                for (int m = 0; m < 4; ++m) { const int row = row0 + ai * HALF + m * 16;
                    const f32x4 h0 = (acc[ai][bj][m][0] * q[ai][m]) * tb0 + tc0, h1 = (acc[ai][bj][m][1] * q[ai][m]) * tb1 + tc1;
                    u32x4 w; w.x = pk_f16(h0[0], h0[1]); w.y = pk_f16(h0[2], h0[3]); w.z = pk_f16(h1[0], h1[1]); w.w = pk_f16(h1[2], h1[3]);
                    *(u32x4*)(H + (size_t)row * 1024 + col) = w;
                    if (HHALO != nullptr && (row & 255) >= 254 && (((row >> 8) + 1) & 15) != 0) *(u32x4*)(HHALO + (size_t)(2 * ((row >> 8) + 1) + ((row & 255) - 254)) * 1024 + col) = w; }
            asm volatile("" ::: "memory");
        }
    }
};

__device__ __forceinline__ float gelu_tanh_f(float g) { const float u = 0.7978845608028654f * (g + 0.044715f * g * g * g); const float e = __builtin_amdgcn_exp2f(u * 2.885390081777927f); return g * (1.0f - __builtin_amdgcn_rcpf(e + 1.0f)); }
__device__ __forceinline__ f32x2 gelu_mul_pk(f32x2 g, f32x2 v) {
    const f32x2 g2 = g * g, t = g2 * (0.044715f * 2.302208198f) + 2.302208198f, u2 = t * g;
    f32x2 e; e.x = __builtin_amdgcn_exp2f(u2.x); e.y = __builtin_amdgcn_exp2f(u2.y);
    const f32x2 d = e + 1.0f; f32x2 r; r.x = __builtin_amdgcn_rcpf(d.x); r.y = __builtin_amdgcn_rcpf(d.y);
    const f32x2 gv = g * v; return gv - gv * r;
}
template <int N> __device__ __forceinline__ float ror16(float v) { return __builtin_bit_cast(float, __builtin_amdgcn_update_dpp(0, __builtin_bit_cast(int, v), 0x120 + N, 0xf, 0xf, false)); }
__device__ __forceinline__ f32x4 ld_agent_f32x4(const float* p) { typedef unsigned long long u64; const u64 a = __hip_atomic_load((u64*)p, __ATOMIC_RELAXED, __HIP_MEMORY_SCOPE_AGENT), b = __hip_atomic_load((u64*)p + 1, __ATOMIC_RELAXED, __HIP_MEMORY_SCOPE_AGENT);
    return (f32x4){__builtin_bit_cast(float, (unsigned)a), __builtin_bit_cast(float, (unsigned)(a >> 32)), __builtin_bit_cast(float, (unsigned)b), __builtin_bit_cast(float, (unsigned)(b >> 32))}; }
struct EpiConv {
    static constexpr bool PERM = true, AFTER_DRAIN = false;
    f16* ACT; float* UHALO; const float* cw; const float* cb; PG8_LAS float* X;
    PG8_LAS float* WL;
    unsigned* hcnt; int halo_pm;
    struct Pre { float w[2]; unsigned hc; };
    __device__ __forceinline__ void prefetch(Pre& p, const Unit& u, int tid) const {
        if (u.pm == halo_pm) return;
        p.hc = ((u.pm & 15) != 0) ? __hip_atomic_load(hcnt + 64 * u.pn, __ATOMIC_RELAXED, __HIP_MEMORY_SCOPE_AGENT) : 8u;
        asm volatile("" : "+v"(tid));
#pragma unroll
        for (int k = 0; k < 2; ++k) { const int idx = tid + 512 * k, q = idx >> 8, bjw = (idx >> 7) & 1, col = idx & 127; const int oc = bjw * 2816 + u.pn * 128 + col;
            p.w[k] = (q < 3) ? cw[q * 5632 + oc] : cb[oc]; }
    }
    __device__ __forceinline__ void operator()(f32x4 (&acc)[2][2][4][2], const Unit& u, int wr, int wc, int fr_in, int fq_in, const Pre& pre) const {
        int fr = fr_in, fq = fq_in; asm volatile("" : "+v"(fr), "+v"(fq));
        const int lane = fr + 16 * fq;
        const int lc = wc * 32 + 8 * fq;
        if (u.pm == halo_pm) {
#pragma unroll
            for (int m = 0; m < 4; ++m)
#pragma unroll
                for (int bj = 0; bj < 2; ++bj)
#pragma unroll
                    for (int n = 0; n < 2; ++n) *(f32x4*)(UHALO + (size_t)(wr * 64 + m * 16 + fr) * 5632 + u.pn * 256 + bj * 128 + lc + 4 * n) = acc[0][bj][m][n];
            __builtin_amdgcn_fence(__ATOMIC_RELEASE, "agent");
            asm volatile("s_waitcnt vmcnt(0)" ::: "memory");
            if (lane == 0) __hip_atomic_fetch_add(hcnt + 64 * u.pn, 1u, __ATOMIC_RELAXED, __HIP_MEMORY_SCOPE_AGENT);
            return;
        }
        if (wr == 0 && (u.pm & 15) != 0) {
            unsigned c = pre.hc, spins = 0;
            while ((unsigned)__builtin_amdgcn_readfirstlane(c) < 8u) { __builtin_amdgcn_s_sleep(2); c = __hip_atomic_load(hcnt + 64 * u.pn, __ATOMIC_RELAXED, __HIP_MEMORY_SCOPE_AGENT); if (++spins > (1u << 14)) break; }
        }
        {
            const int t512 = (wr * 4 + wc) * 64 + lane;
            WL[t512] = pre.w[0]; WL[t512 + 512] = pre.w[1];
        }
        if (fr >= 14) {
#pragma unroll
            for (int ai = 0; ai < 2; ++ai)
#pragma unroll
                for (int bj = 0; bj < 2; ++bj)
#pragma unroll
                    for (int n = 0; n < 2; ++n) *(PG8_LAS f32x4*)(X + (((2 * ai + wr) * 2 + (fr - 14)) * 2 + bj) * 128 + lc + 4 * n) = acc[ai][bj][3][n];
        }
        asm volatile("s_waitcnt lgkmcnt(0)" ::: "memory"); __builtin_amdgcn_s_barrier(); asm volatile("" ::: "memory");
        const bool batch_start = (u.pm & 15) == 0;
#pragma unroll
        for (int bj = 0; bj < 2; ++bj)
#pragma unroll
            for (int n = 0; n < 2; ++n) {
                asm volatile("" ::: "memory");
                const int cl = bj * 128 + lc + 4 * n;
                const f32x4 w0v = *(const PG8_LAS f32x4*)(WL + 0 * 256 + cl), w1v = *(const PG8_LAS f32x4*)(WL + 1 * 256 + cl), w2v = *(const PG8_LAS f32x4*)(WL + 2 * 256 + cl), bbv = *(const PG8_LAS f32x4*)(WL + 3 * 256 + cl);
                f32x4 hq0[2], hq1[2];
#pragma unroll
                for (int ai = 0; ai < 2; ++ai) { const int g = 2 * ai + wr;
                    if (g > 0) { hq0[ai] = *(const PG8_LAS f32x4*)(X + (((g - 1) * 2 + 0) * 2 + bj) * 128 + lc + 4 * n); hq1[ai] = *(const PG8_LAS f32x4*)(X + (((g - 1) * 2 + 1) * 2 + bj) * 128 + lc + 4 * n); }
                    else if (!batch_start) { const float* hp = UHALO + (size_t)(2 * u.pm) * 5632 + u.pn * 256 + bj * 128 + lc + 4 * n; hq0[ai] = ld_agent_f32x4(hp); hq1[ai] = ld_agent_f32x4(hp + 5632); }
                    else { hq0[ai] = (f32x4){0.f, 0.f, 0.f, 0.f}; hq1[ai] = hq0[ai]; } }
#pragma unroll
                for (int ai = 1; ai >= 0; --ai) {
                    const f32x4 h0v = hq0[ai], h1v = hq1[ai];
#pragma unroll
                    for (int e = 0; e < 4; e += 2) {
                        const f32x2 w0 = {w0v[e], w0v[e + 1]}, w1 = {w1v[e], w1v[e + 1]}, w2 = {w2v[e], w2v[e + 1]}, bb = {bbv[e], bbv[e + 1]}, h0 = {h0v[e], h0v[e + 1]}, h1 = {h1v[e], h1v[e + 1]};
                        f32x2 c1 = {ror16<1>(acc[ai][bj][3][n][e]), ror16<1>(acc[ai][bj][3][n][e + 1])}, c2 = {ror16<2>(acc[ai][bj][3][n][e]), ror16<2>(acc[ai][bj][3][n][e + 1])};
#pragma unroll
                        for (int m = 3; m >= 0; --m) {
                            f32x2 p1, p2;
                            if (m > 0) { p1 = (f32x2){ror16<1>(acc[ai][bj][m - 1][n][e]), ror16<1>(acc[ai][bj][m - 1][n][e + 1])}; p2 = (f32x2){ror16<2>(acc[ai][bj][m - 1][n][e]), ror16<2>(acc[ai][bj][m - 1][n][e + 1])}; }
                            else { p1 = h1; p2 = (fr == 0) ? h0 : h1; }
                            const f32x2 r1 = (fr >= 1) ? c1 : p1, r2 = (fr >= 2) ? c2 : p2;
                            const f32x2 cur = {acc[ai][bj][m][n][e], acc[ai][bj][m][n][e + 1]};
                            const f32x2 o = w0 * r2 + (w1 * r1 + (w2 * cur + bb));
                            acc[ai][bj][m][n][e] = o[0]; acc[ai][bj][m][n][e + 1] = o[1];
                            asm volatile("" : "+v"(acc[ai][bj][m][n]));
                            c1 = p1; c2 = p2;
                        }
                    }
                }
            }
        asm volatile("" ::: "memory");
        const int row0 = u.pm * BM + wr * 64 + fr;
#pragma unroll
        for (int ai = 0; ai < 2; ++ai)
#pragma unroll
            for (int m = 0; m < 4; ++m) {
                const f32x4 g0 = acc[ai][0][m][0], g1 = acc[ai][0][m][1], v0 = acc[ai][1][m][0], v1 = acc[ai][1][m][1];
                const f32x2 a0 = gelu_mul_pk((f32x2){g0[0], g0[1]}, (f32x2){v0[0], v0[1]}), a1 = gelu_mul_pk((f32x2){g0[2], g0[3]}, (f32x2){v0[2], v0[3]});
                const f32x2 a2 = gelu_mul_pk((f32x2){g1[0], g1[1]}, (f32x2){v1[0], v1[1]}), a3 = gelu_mul_pk((f32x2){g1[2], g1[3]}, (f32x2){v1[2], v1[3]});
                u32x4 w; w.x = pk_f16(a0.x, a0.y); w.y = pk_f16(a1.x, a1.y); w.z = pk_f16(a2.x, a2.y); w.w = pk_f16(a3.x, a3.y);
                *(u32x4*)(ACT + (size_t)(row0 + ai * HALF + m * 16) * 2816 + u.pn * 128 + lc) = w;
                asm volatile("" ::: "memory");
            }
    }
};

template <class Epi, class Sched, bool ALIGN_EPI = false, bool SP2 = false>
__device__ __forceinline__ void gemm_phase(PG8_LAS unsigned char* lds, const Gemm g, const Sched& S, const Epi& E, int tid_in) {
    int tid_o = tid_in; asm volatile("" : "+v"(tid_o));
    const int tid = tid_o, wid = __builtin_amdgcn_readfirstlane(tid >> 6), lane = tid & 63, wr = wid >> 2, wc = wid & 3, fr = lane & 15, fq = lane >> 4;
    const int K = g.K, nt = K / BK;
    unsigned voffA[2], voffB[2];
#pragma unroll
    for (int i = 0; i < 2; ++i) { int R, C; stage_rc(tid * 16 + i * 8192, R, C); const int Rb = Epi::PERM ? ((R & ~31) + perm32(R & 31)) : R;
        voffA[i] = (unsigned)(R * g.lda + C) * 2u; voffB[i] = (unsigned)(Rb * K + C) * 2u; }
    const size_t kstep = (size_t)(BK * 2);
    const size_t hstep = (size_t)HALF * K * 2;
    const size_t tstep = 2 * hstep;
    const size_t hstepA = (size_t)HALF * g.lda * 2, tstepA = 2 * hstepA;
    const unsigned ldsw = (unsigned)wid * 1024u;
    const int aoff = lds_byte(wr * 64 + fr, fq * 8), boff = lds_byte(wc * 32 + fr, fq * 8);
#define PG8_SA(b, h) (((b) * 2 + (h)) * HTB)
#define PG8_SB(b, h) ((4 + (b) * 2 + (h)) * HTB)
#define PG8_STAGE(bufoff, gbase, voff) do { _Pragma("unroll") for (int _i = 0; _i < 2; ++_i) \
        __builtin_amdgcn_global_load_lds((const unsigned*)((const char*)(gbase) + (voff)[_i]), (PG8_LAS unsigned*)(lds + (bufoff) + ldsw + _i * 8192), 16, 0, 0); } while (0)
#define PG8_LDA(dst, b, h) do { _Pragma("unroll") for (int m = 0; m < 4; ++m) _Pragma("unroll") for (int k = 0; k < 2; ++k) dst[m][k] = *(const PG8_LAS f16x8*)(lds + PG8_SA(b, h) + aoff + m * 2048 + k * 1024); } while (0)
#define PG8_LDB(dst, b, h) do { _Pragma("unroll") for (int n = 0; n < 2; ++n) _Pragma("unroll") for (int k = 0; k < 2; ++k) dst[n][k] = *(const PG8_LAS f16x8*)(lds + PG8_SB(b, h) + boff + n * 2048 + k * 1024); } while (0)
#define PG8_MMA(ai, bj, At, Bt) do { __builtin_amdgcn_s_setprio(1); _Pragma("unroll") for (int m = 0; m < 4; ++m) _Pragma("unroll") for (int n = 0; n < 2; ++n) _Pragma("unroll") for (int k = 0; k < 2; ++k) \
        acc[ai][bj][m][n] = __builtin_amdgcn_mfma_f32_16x16x32_f16(Bt[n][k], At[m][k], acc[ai][bj][m][n], 0, 0, 0); __builtin_amdgcn_s_setprio(0); } while (0)
#define PG8_WAIT_V(n) asm volatile("s_waitcnt vmcnt(" #n ")" ::: "memory")
#define PG8_WAIT_L(n) asm volatile("s_waitcnt lgkmcnt(" #n ")" ::: "memory")
#define PG8_BAR __builtin_amdgcn_s_barrier()
#define PG8_SCHED __builtin_amdgcn_sched_barrier(0)
    Unit cur, nxt; int ui = 0;
    if (!S.next(0, cur)) return;
    typename Epi::Pre pre; E.prefetch(pre, cur, tid);
    f32x4 acc[2][2][4][2];
#pragma unroll
    for (int a = 0; a < 2; ++a)
#pragma unroll
        for (int b = 0; b < 2; ++b)
#pragma unroll
            for (int m = 0; m < 4; ++m)
#pragma unroll
                for (int n = 0; n < 2; ++n) acc[a][b][m][n] = (f32x4){0.f, 0.f, 0.f, 0.f};
    f16x8 At[4][2], B0[2][2], B1[2][2];
    const char* cA = (const char*)g.A + (size_t)cur.pm * tstepA + S.a_off(cur); const char* cB = (const char*)g.Bt + (size_t)cur.pn * tstep;
    S.a_ready(cur);
    if constexpr (SP2) {
        PG8_STAGE(PG8_SB(0, 0), cB, voffB); PG8_STAGE(PG8_SB(0, 1), cB + hstep, voffB); PG8_STAGE(PG8_SA(0, 0), cA, voffA); PG8_STAGE(PG8_SA(0, 1), cA + hstepA, voffA);
        if (wr == 1) PG8_BAR;
        PG8_WAIT_V(2); PG8_BAR;
        PG8_STAGE(PG8_SB(1, 0), cB + kstep, voffB); PG8_STAGE(PG8_SA(1, 0), cA + kstep, voffA); PG8_STAGE(PG8_SB(1, 1), cB + hstep + kstep, voffB);
        PG8_WAIT_V(6); PG8_BAR;
    } else {
        PG8_STAGE(PG8_SB(0, 0), cB, voffB); PG8_STAGE(PG8_SA(0, 0), cA, voffA); PG8_STAGE(PG8_SB(0, 1), cB + hstep, voffB); PG8_STAGE(PG8_SA(0, 1), cA + hstepA, voffA);
        if (wr == 1) PG8_BAR;
        PG8_WAIT_V(4); PG8_BAR;
        PG8_STAGE(PG8_SB(1, 0), cB + kstep, voffB); PG8_STAGE(PG8_SA(1, 0), cA + kstep, voffA); PG8_STAGE(PG8_SB(1, 1), cB + hstep + kstep, voffB);
        PG8_WAIT_V(6); PG8_BAR;
    }
    for (;;) {
        const bool has_next = S.next(ui + 1, nxt);
        const char* nA = has_next ? (const char*)g.A + (size_t)nxt.pm * tstepA + S.a_off(nxt) : cA; const char* nB = has_next ? (const char*)g.Bt + (size_t)nxt.pn * tstep : cB;
#pragma unroll 1
        for (int t = 0; t < nt; t += 2) {
            const bool last = (t == nt - 2);
            const char* a1 = cA + (size_t)(t + 1) * kstep;
            const char* a2 = last ? nA : cA + (size_t)(t + 2) * kstep; const char* b2 = last ? nB : cB + (size_t)(t + 2) * kstep;
            const char* a3 = a2 + kstep; const char* b3 = b2 + kstep;
            if (last && has_next) S.a_ready(nxt);
            if constexpr (SP2) {
            PG8_LDB(B0, 0, 0); PG8_LDB(B1, 0, 1); PG8_SCHED; PG8_LDA(At, 0, 0); PG8_STAGE(PG8_SA(1, 1), a1 + hstepA, voffA);
            PG8_WAIT_V(8); PG8_WAIT_L(0); PG8_BAR; PG8_MMA(0, 0, At, B0); PG8_MMA(0, 1, At, B1); PG8_BAR; PG8_SCHED;
            PG8_LDA(At, 0, 1); PG8_STAGE(PG8_SB(0, 0), b2, voffB); PG8_STAGE(PG8_SB(0, 1), b2 + hstep, voffB); PG8_STAGE(PG8_SA(0, 0), a2, voffA);
            PG8_WAIT_V(8); PG8_WAIT_L(0); PG8_BAR; PG8_MMA(1, 0, At, B0); PG8_MMA(1, 1, At, B1); PG8_BAR; PG8_SCHED;
            PG8_LDB(B0, 1, 0); PG8_LDB(B1, 1, 1); PG8_SCHED; PG8_LDA(At, 1, 0); PG8_STAGE(PG8_SA(0, 1), a2 + hstepA, voffA);
            PG8_WAIT_V(8); PG8_WAIT_L(0); PG8_BAR; PG8_MMA(0, 0, At, B0); PG8_MMA(0, 1, At, B1); PG8_BAR; PG8_SCHED;
            PG8_LDA(At, 1, 1); PG8_STAGE(PG8_SB(1, 0), b3, voffB); PG8_STAGE(PG8_SB(1, 1), b3 + hstep, voffB); PG8_STAGE(PG8_SA(1, 0), a3, voffA);
            PG8_WAIT_V(8); PG8_WAIT_L(0); PG8_BAR; PG8_MMA(1, 0, At, B0); PG8_MMA(1, 1, At, B1); PG8_BAR; PG8_SCHED;
            } else {
            PG8_LDB(B0, 0, 0); PG8_SCHED; PG8_LDA(At, 0, 0); PG8_STAGE(PG8_SA(1, 1), a1 + hstepA, voffA);
            PG8_WAIT_L(8); PG8_BAR; PG8_WAIT_L(0); PG8_MMA(0, 0, At, B0); PG8_BAR; PG8_SCHED;
            PG8_LDB(B1, 0, 1); PG8_STAGE(PG8_SB(0, 0), b2, voffB);
            PG8_BAR; PG8_WAIT_L(0); PG8_MMA(0, 1, At, B1); PG8_BAR;
            PG8_LDA(At, 0, 1); PG8_STAGE(PG8_SA(0, 0), a2, voffA);
            PG8_BAR; PG8_WAIT_L(0); PG8_MMA(1, 0, At, B0); PG8_BAR; PG8_SCHED;
            PG8_STAGE(PG8_SB(0, 1), b2 + hstep, voffB);
            PG8_WAIT_V(6); PG8_BAR; PG8_MMA(1, 1, At, B1); PG8_BAR;
            PG8_LDB(B0, 1, 0); PG8_SCHED; PG8_LDA(At, 1, 0); PG8_STAGE(PG8_SA(0, 1), a2 + hstepA, voffA);
            PG8_WAIT_L(8); PG8_BAR; PG8_WAIT_L(0); PG8_MMA(0, 0, At, B0); PG8_BAR; PG8_SCHED;
            PG8_LDB(B1, 1, 1); PG8_STAGE(PG8_SB(1, 0), b3, voffB);
            PG8_BAR; PG8_WAIT_L(0); PG8_MMA(0, 1, At, B1); PG8_BAR;
            PG8_LDA(At, 1, 1); PG8_STAGE(PG8_SA(1, 0), a3, voffA);
            PG8_BAR; PG8_WAIT_L(0); PG8_MMA(1, 0, At, B0); PG8_BAR; PG8_SCHED;
            PG8_STAGE(PG8_SB(1, 1), b3 + hstep, voffB);
            PG8_WAIT_V(6); PG8_BAR; PG8_MMA(1, 1, At, B1); PG8_BAR;
            }
        }
        if constexpr (ALIGN_EPI) { if (wr == 0) PG8_BAR; }
        if constexpr (!Epi::AFTER_DRAIN) { E(acc, cur, wr, wc, fr, fq, pre); S.done(cur); }
        if (!has_next) break;
#pragma unroll
        for (int a = 0; a < 2; ++a)
#pragma unroll
            for (int b = 0; b < 2; ++b)
#pragma unroll
                for (int m = 0; m < 4; ++m)
#pragma unroll
                    for (int n = 0; n < 2; ++n) acc[a][b][m][n] = (f32x4){0.f, 0.f, 0.f, 0.f};
        cur = nxt; cA = nA; cB = nB; ++ui; E.prefetch(pre, cur, tid);
        if constexpr (ALIGN_EPI) { if (wr == 1) PG8_BAR; }
    }
    PG8_WAIT_V(0);
    if constexpr (!ALIGN_EPI) { if (wr == 0) PG8_BAR; }
    PG8_BAR;
    if constexpr (Epi::AFTER_DRAIN) { E.fused(acc, cur, wr, wc, fr, fq, lds, wid, lane); S.done(cur); }
#undef PG8_SA
#undef PG8_SB
#undef PG8_STAGE
#undef PG8_LDA
#undef PG8_LDB
#undef PG8_MMA
#undef PG8_WAIT_V
#undef PG8_WAIT_L
#undef PG8_BAR
#undef PG8_SCHED
}
}
#define GAS __attribute__((address_space(1)))
#define LAS __attribute__((address_space(3)))
typedef GAS unsigned gu32;
typedef GAS unsigned long long gu64;
#define RLX_AGENT __ATOMIC_RELAXED, __HIP_MEMORY_SCOPE_AGENT
#define LDS_WAIT() asm volatile("s_waitcnt lgkmcnt(0)" ::: "memory")
#define VM_WAIT() asm volatile("s_waitcnt vmcnt(0)" ::: "memory")
__device__ __forceinline__ unsigned long long rt() { return __builtin_amdgcn_s_memrealtime(); }
#define XB_TMO      128
#define XB_XCNT(j)  (256  + 64 * (j))
#define XB_XSUB(j)  (1280 + 64 * (j))
#define XB_XGEN(j)  (2304 + 64 * (j))
#define XB_TOP      3328
#define XB_TOPGEN   3392
#define XCD_BAR_WORDS 3456
#define XB_SPIN_CAP (1u << 18)

__device__ __forceinline__ unsigned xb_ld(unsigned* p)              { return __hip_atomic_load(p, __ATOMIC_RELAXED, __HIP_MEMORY_SCOPE_AGENT); }
__device__ __forceinline__ unsigned xb_add(unsigned* p, unsigned v) { return __hip_atomic_fetch_add(p, v, __ATOMIC_RELAXED, __HIP_MEMORY_SCOPE_AGENT); }
__device__ __forceinline__ unsigned xb_xcc_id() { return (unsigned)__builtin_amdgcn_s_getreg((3 << 11) | 20) & 0xFu; }
#define XB_SPIN(cond, bar) do { unsigned _sp = 0; while (cond) { __builtin_amdgcn_s_sleep(1); \
    if ((++_sp & 255u) == 0u) { if (xb_ld(&(bar)[XB_TMO])) break; if (_sp > XB_SPIN_CAP) { atomicAdd(&(bar)[XB_TMO], 1u); break; } } } } while (0)

struct XcdBarrier {
    unsigned* bar; unsigned x;
    volatile LAS unsigned* st;
};

__device__ __forceinline__ XcdBarrier xcd_barrier_post(unsigned* bar, volatile LAS unsigned* st, int tid) {
    XcdBarrier b; b.bar = bar; b.x = xb_xcc_id(); b.st = st;
    if (tid == 0) (void)xb_add(&bar[XB_XCNT(b.x)], 1u);
    return b;
}
__device__ __forceinline__ void xcd_barrier_complete(unsigned* bar, unsigned x, unsigned& nloc, unsigned& nx) {
    const unsigned G = gridDim.x * gridDim.y * gridDim.z;
    unsigned sum, cnt, mine, sp = 0u;
    for (;;) {
        sum = 0u; cnt = 0u; mine = 0u;
#pragma unroll
        for (unsigned j = 0; j < 16; ++j) { const unsigned c = xb_ld(&bar[XB_XCNT(j)]); sum += c; cnt += (c > 0u) ? 1u : 0u; mine = (j == x) ? c : mine; }
        if (sum == G) break;
        __builtin_amdgcn_s_sleep(1);
        if ((++sp & 255u) == 0u) { if (xb_ld(&bar[XB_TMO])) break; if (sp > XB_SPIN_CAP) { atomicAdd(&bar[XB_TMO], 1u); break; } }
    }
    nloc = mine > 0u ? mine : 1u; nx = cnt > 0u ? cnt : 1u;
}

__device__ __forceinline__ void xcd_barrier(const XcdBarrier& b, int tid) {
    asm volatile("s_waitcnt vmcnt(0)" ::: "memory");
    __syncthreads();
    if (tid == 0) {
        unsigned* bar = b.bar;
        __builtin_amdgcn_s_waitcnt(0);
        unsigned nloc = b.st[0], nx = b.st[1];
        if (nloc == 0u) { xcd_barrier_complete(bar, b.x, nloc, nx); b.st[0] = nloc; b.st[1] = nx; }
        const unsigned old = xb_add(&bar[XB_XSUB(b.x)], 1u);
        const unsigned gen = old / nloc;
        if (old + 1u == (gen + 1u) * nloc) {
            __builtin_amdgcn_fence(__ATOMIC_RELEASE, "agent");
            asm volatile("s_waitcnt vmcnt(0)" ::: "memory");
            const unsigned og = xb_add(&bar[XB_TOP], 1u);
            const unsigned tg = og / nx;
            if (og + 1u == (tg + 1u) * nx) xb_add(&bar[XB_TOPGEN], 1u);
            else XB_SPIN(xb_ld(&bar[XB_TOPGEN]) == tg, bar);
            __builtin_amdgcn_fence(__ATOMIC_ACQUIRE, "agent");
            xb_add(&bar[XB_XGEN(b.x)], 1u);
            asm volatile("s_waitcnt vmcnt(0)" ::: "memory");
        } else {
            XB_SPIN(xb_ld(&bar[XB_XGEN(b.x)]) == gen, bar);
            __builtin_amdgcn_fence(__ATOMIC_ACQUIRE, "agent");
            asm volatile("s_waitcnt vmcnt(0)" ::: "memory");
        }
    }
    __syncthreads();
}
constexpr int NWAVES = 8, NTHR = NWAVES * 64;
constexpr int RING_BYTES = 131072;
constexpr int LDSCTL_OFF = RING_BYTES, MISC_OFF = LDSCTL_OFF + 320;
constexpr int XCH_OFF = RING_BYTES + 1024;
constexpr int LDS_BYTES = 147456;

struct Args { const float* in[21]; float* out; unsigned char* ws; int ph_lo, ph_hi; };

enum { I_X = 0, I_C, I_RELB, I_ADAW, I_ADAB, I_MIXPRE, I_MIXPOST, I_FFNPRE, I_FFNPOST, I_ABWIN, I_ABWOUT, I_CDWIN, I_QNG, I_KVNG, I_WUQ, I_WUKV, I_CDWOUT, I_WUP, I_CONVW, I_CONVB, I_WDN };

__device__ __forceinline__ float wave_sum(float v) {
#pragma unroll
    for (int o = 1; o < 64; o <<= 1) v += __shfl_xor(v, o);
    return v;
}
__device__ __forceinline__ float quad_sum(float v) { v += __shfl_xor(v, 1); v += __shfl_xor(v, 2); return v; }
__device__ __forceinline__ void load16(const f16* p, float (&o)[16]) {
    const f16x8 a = *(const f16x8*)p, b = *(const f16x8*)(p + 8);
#pragma unroll
    for (int i = 0; i < 8; ++i) { o[i] = (float)a[i]; o[8 + i] = (float)b[i]; }
}
__device__ __forceinline__ void load8(const f16* p, float (&o)[8]) {
    const f16x8 a = *(const f16x8*)p;
#pragma unroll
    for (int i = 0; i < 8; ++i) o[i] = (float)a[i];
}
__device__ __forceinline__ int t5_bucket(int d) {
    if (d < 16) return d;
    return 16 + (d >= 22) + (d >= 30) + (d >= 40) + (d >= 54) + (d >= 73) + (d >= 99) + (d >= 134) + (d >= 182) + (d >= 246) + (d >= 332) + (d >= 450) + (d >= 609) + (d >= 825) + (d >= 1117) + (d >= 1513);
}

__device__ __forceinline__ void layer_mod(const Args& a, LAS unsigned char* lds, int tid, int slot, int nslots, int l) {
    LAS float* sc = (LAS float*)lds; LAS float* red = (LAS float*)(lds + 16384);
    const float* c = a.in[I_C];
    for (int i = tid; i < BATCH * DM; i += NTHR) { const float v = c[i]; sc[i] = v / (1.f + expf(-v)); }
    __syncthreads();
    const int wave = tid >> 6, lane = tid & 63;
    float* MOD = (float*)(a.ws + WS_MOD);
    for (int cg = slot; cg < 96; cg += nslots) {
        const int n = cg * 64 + lane;
        const float* W = a.in[I_ADAW] + (size_t)l * DM * 6144 + n;
        float a0 = 0.f, a1 = 0.f, a2 = 0.f, a3 = 0.f;
        const int k0 = wave * 128;
#pragma unroll 1
        for (int kb = k0; kb < k0 + 128; kb += 64) {
            float wv[64];
#pragma unroll
            for (int j = 0; j < 64; ++j) wv[j] = W[(size_t)(kb + j) * 6144];
#pragma unroll
            for (int j = 0; j < 64; ++j) { const int k = kb + j; a0 += sc[k] * wv[j]; a1 += sc[DM + k] * wv[j]; a2 += sc[2 * DM + k] * wv[j]; a3 += sc[3 * DM + k] * wv[j]; }
        }
        red[(wave * 4 + 0) * 64 + lane] = a0; red[(wave * 4 + 1) * 64 + lane] = a1; red[(wave * 4 + 2) * 64 + lane] = a2; red[(wave * 4 + 3) * 64 + lane] = a3;
        __syncthreads();
        if (tid < 256) { const int b = tid >> 6; float s = 0.f;
#pragma unroll
            for (int w = 0; w < 8; ++w) s += red[(w * 4 + b) * 64 + lane];
            MOD[(size_t)(l * BATCH + b) * 6144 + n] = s + a.in[I_ADAB][l * 6144 + n]; }
        __syncthreads();
    }
}
struct TD { const float* W; int N; f16* dst; int pitch, coloff; const float* gk; int mode, nblk; };
__device__ __forceinline__ void transpose_item(const TD& d, LAS float* scr, int item, int lane) {
    const int kb = item / d.nblk, nb = item % d.nblk, k0 = 64 * kb, n0 = 32 * nb;
    float wv[32];
#pragma unroll
    for (int i = 0; i < 32; ++i) { const int kk = 2 * i + (lane >> 5); wv[i] = d.W[(size_t)(k0 + kk) * d.N + n0 + (lane & 31)]; }
#pragma unroll
    for (int i = 0; i < 32; ++i) { const int kk = 2 * i + (lane >> 5); scr[kk * 33 + (lane & 31)] = wv[i]; }
    LDS_WAIT(); asm volatile("" ::: "memory");
    const int c = lane & 7;
    float gs[8];
#pragma unroll
    for (int i = 0; i < 8; ++i) gs[i] = d.gk ? d.gk[k0 + 8 * c + i] : 1.f;
#pragma unroll
    for (int j = 0; j < 4; ++j) { const int n = (lane >> 3) + 8 * j; const LAS float* s = scr + (8 * c) * 33 + n;
        u32x4 o; o.x = pk_f16(s[0 * 33] * gs[0], s[1 * 33] * gs[1]); o.y = pk_f16(s[2 * 33] * gs[2], s[3 * 33] * gs[3]); o.z = pk_f16(s[4 * 33] * gs[4], s[5 * 33] * gs[5]); o.w = pk_f16(s[6 * 33] * gs[6], s[7 * 33] * gs[7]);
        const int col = n0 + n; int row = col;
        if (d.mode == 1) { const int half = col / DFF, jj = col % DFF; row = (jj >> 7) * 256 + half * 128 + (jj & 127); }
        *(GAS u32x4*)(d.dst + (size_t)row * d.pitch + d.coloff + k0 + 8 * c) = o; }
    LDS_WAIT(); asm volatile("" ::: "memory");
}
__device__ __forceinline__ void layer_weights(const Args& a, LAS unsigned char* lds, int tid, int slot, int nslots, int l, int part  ) {
    const int wave = tid >> 6, lane = tid & 63;
    LAS float* scr = (LAS float*)(lds + wave * 16384);
    const int gw = slot * NWAVES + wave, NGW = nslots * NWAVES;
    constexpr int C0 = 16 * 96, C1 = 16 * 32, C2 = 16 * 65, C3 = 4 * 24, C4 = 4 * 32, C5 = 16 * 32, C6 = 16 * 176, C7 = 44 * 32;
    const int i = l >> 1; const bool odd = (l & 1) != 0;
    const int nmix = odd ? (C2 + C3 + C4 + C5) : (C0 + C1);
    unsigned char* ws = a.ws;
    const int it_lo = (part & 1) ? 0 : nmix, it_hi = (part & 2) ? nmix + C6 + C7 : nmix;
    for (int it = it_lo + gw; it < it_hi; it += NGW) {
        int r = it; TD d; d.gk = nullptr; d.mode = 0; d.coloff = 0;
        if (r >= nmix) { r -= nmix;
            if (r < C6) { d.W = a.in[I_WUP] + (size_t)l * DM * DFF2; d.N = DFF2; d.dst = (f16*)(ws + WS_W_FUP) + (size_t)l * DFF2 * DM; d.pitch = DM; d.nblk = 176; d.mode = 1; }
            else { r -= C6; d.W = a.in[I_WDN] + (size_t)l * DFF * DM; d.N = DM; d.dst = (f16*)(ws + WS_W_FDN) + (size_t)l * DM * DFF; d.pitch = DFF; d.nblk = 32; } }
        else if (!odd) {
            if (r < C0) { d.W = a.in[I_ABWIN] + (size_t)i * DM * AB_IN; d.N = AB_IN; d.dst = (f16*)(ws + WS_W_INAB) + (size_t)i * AB_IN * DM; d.pitch = DM; d.nblk = 96; }
            else { r -= C0; d.W = a.in[I_ABWOUT] + (size_t)i * DM * DM; d.N = DM; d.dst = (f16*)(ws + WS_W_OUTAB) + (size_t)i * DM * DM; d.pitch = DM; d.nblk = 32; } }
        else {
            if (r < C2) { d.W = a.in[I_CDWIN] + (size_t)i * DM * CD_IN; d.N = CD_IN; d.dst = (f16*)(ws + WS_W_INCD) + (size_t)i * CD_INP * DM; d.pitch = DM; d.nblk = 65; }
            else if ((r -= C2) < C3) { d.W = a.in[I_WUQ] + (size_t)i * 256 * QW; d.N = QW; d.dst = (f16*)(ws + WS_W_UP2) + (size_t)i * UP_N * UP_K; d.pitch = UP_K; d.nblk = 24; d.gk = a.in[I_QNG] + i * 256; }
            else if ((r -= C3) < C4) { d.W = a.in[I_WUKV] + (size_t)i * 256 * KVW; d.N = KVW; d.dst = (f16*)(ws + WS_W_UP2) + (size_t)i * UP_N * UP_K + (size_t)QW * UP_K; d.pitch = UP_K; d.nblk = 32; d.gk = a.in[I_KVNG] + i * 256; }
            else { r -= C4; d.W = a.in[I_CDWOUT] + (size_t)i * DM * DM; d.N = DM; d.dst = (f16*)(ws + WS_W_OUTCD) + (size_t)i * DM * DM; d.pitch = DM; d.nblk = 32; } }
        transpose_item(d, scr, r, lane);
    }
}
__device__ __forceinline__ void p0_misc(const Args& a, int tid, int bid, int G) {
    unsigned char* ws = a.ws;
    const int gt = bid * NTHR + tid, NGT = G * NTHR;
    const u32x4 z = {0u, 0u, 0u, 0u};
    for (int i = 0; i < 2; ++i) {
        GAS u32x4* p = (GAS u32x4*)((f16*)(ws + WS_W_INCD) + (size_t)i * CD_INP * DM + (size_t)CD_IN * DM);
        for (int e = gt; e < (CD_INP - CD_IN) * DM / 8; e += NGT) p[e] = z;
    }
    float* rc = (float*)(ws + WS_ROPE); float* rs = rc + SEQ * 16;
    for (int e = gt; e < SEQ * 16; e += NGT) { const int t = e >> 4, i = e & 15; const float inv = (float)(1.0 / pow(10000.0, (double)i / 16.0)); const float ang = (float)t * inv;
        rc[e] = (float)cos((double)ang); rs[e] = (float)sin((double)ang); }
}

__device__ __forceinline__ void thin_row(int row, const float* xin32, const f16* xin16, f16* xout16, float* xout32, const f16* y, const float* gate_l  , const float* gpost,
                                         const float* gpre, const float* ss_l  , f16* Hrow, f16* H2row, bool has_y, int lane) {
    const int b = row / SEQ;
    f32x4 xv[4];
    if (xin32 != nullptr) {
#pragma unroll
        for (int j = 0; j < 4; ++j) xv[j] = *(const f32x4*)(xin32 + (size_t)row * DM + 4 * lane + 256 * j);
    } else {
#pragma unroll
        for (int j = 0; j < 4; ++j) { const f16x4 xh = *(const f16x4*)(xin16 + (size_t)row * DM + 4 * lane + 256 * j); xv[j] = (f32x4){(float)xh[0], (float)xh[1], (float)xh[2], (float)xh[3]}; }
    }
    if (has_y) {
        f32x4 yv[4]; float s = 0.f;
#pragma unroll
        for (int j = 0; j < 4; ++j) { const f16x4 yh = *(const f16x4*)(y + (size_t)row * DM + 4 * lane + 256 * j); yv[j] = (f32x4){(float)yh[0], (float)yh[1], (float)yh[2], (float)yh[3]}; s += (yv[j].x * yv[j].x + yv[j].y * yv[j].y) + (yv[j].z * yv[j].z + yv[j].w * yv[j].w); }
        const float rstd = 1.0f / sqrtf(wave_sum(s) * (1.f / DM) + NORM_EPS);
#pragma unroll
        for (int j = 0; j < 4; ++j) { const f32x4 g = *(const f32x4*)(gpost + 4 * lane + 256 * j); const f32x4 gt = *(const f32x4*)(gate_l + (size_t)b * 6144 + 4 * lane + 256 * j);
            xv[j] = xv[j] + gt * ((yv[j] * rstd) * g); }
    }
    if (xout16 != nullptr) {
#pragma unroll
        for (int j = 0; j < 4; ++j) { u32x2 w; w.x = pk_f16(xv[j].x, xv[j].y); w.y = pk_f16(xv[j].z, xv[j].w); *(u32x2*)(xout16 + (size_t)row * DM + 4 * lane + 256 * j) = w;
            if (Hrow != nullptr) { const f16x4 r = __builtin_bit_cast(f16x4, w); xv[j] = (f32x4){(float)r[0], (float)r[1], (float)r[2], (float)r[3]}; } }
    }
    if (xout32 != nullptr) {
#pragma unroll
        for (int j = 0; j < 4; ++j) *(f32x4*)(xout32 + (size_t)row * DM + 4 * lane + 256 * j) = xv[j];
    }
    if (Hrow != nullptr) {
        float s = 0.f;
#pragma unroll
        for (int j = 0; j < 4; ++j) s += (xv[j].x * xv[j].x + xv[j].y * xv[j].y) + (xv[j].z * xv[j].z + xv[j].w * xv[j].w);
        const float rstd = 1.0f / sqrtf(wave_sum(s) * (1.f / DM) + NORM_EPS);
#pragma unroll
        for (int j = 0; j < 4; ++j) { const int col = 4 * lane + 256 * j; const f32x4 g = *(const f32x4*)(gpre + col);
            const f32x4 sh = *(const f32x4*)(ss_l + (size_t)b * 6144 + col), sc = *(const f32x4*)(ss_l + (size_t)b * 6144 + DM + col);
            const f32x4 hv = ((xv[j] * rstd) * g) * (sc + 1.0f) + sh;
            u32x2 w; w.x = pk_f16(hv.x, hv.y); w.y = pk_f16(hv.z, hv.w);
            *(u32x2*)(Hrow + col) = w;
            if (H2row != nullptr) *(u32x2*)(H2row + col) = w; }
    }
}
__device__ __forceinline__ bool is_halo_row(int row) { return (row & 255) >= 254 && (((row >> 8) + 1) & 15) != 0; }
__device__ __forceinline__ int halo_row_of(int hidx) { const int pm = hidx >> 1; return (pm == 0 || (pm & 15) == 0) ? -1 : 256 * pm - 2 + (hidx & 1); }
template <bool X32IN, bool HAS_Y, bool OUT32, bool WH>
__device__ __forceinline__ void thin_phase(const float* xin32, const f16* X16in, f16* X16out, float* out32, const f16* y, const float* gate_l, const float* gpost, const float* gpre, const float* ss_l, f16* H, f16* HHALO  ,
                                           LAS unsigned char* lds, int tid, int gw0, int ngw, int row_end = M) {
    const int lane = tid & 63;
    LAS float* TA = (LAS float*)lds; LAS float* TB = TA + BATCH * DM; LAS float* TC = TB + BATCH * DM;
    for (int idx = tid; idx < BATCH * DM; idx += NTHR) { const int b = idx >> 10, col = idx & (DM - 1);
        if constexpr (HAS_Y) TA[idx] = gate_l[(size_t)b * 6144 + col] * gpost[col];
        if constexpr (WH) { TB[idx] = gpre[col] * (1.0f + ss_l[(size_t)b * 6144 + DM + col]); TC[idx] = ss_l[(size_t)b * 6144 + col]; } }
    __syncthreads();
    for (int row0 = gw0; row0 < row_end; row0 += 2 * ngw) {
        int row[2] = {row0, row0 + ngw}; if (row[1] >= row_end) row[1] = row0;
        const int bq[2] = {row[0] / SEQ, row[1] / SEQ};
        float xv[2][16], yv[2][16];
#pragma unroll
        for (int q = 0; q < 2; ++q)
#pragma unroll
            for (int j = 0; j < 2; ++j) { const size_t off = (size_t)row[q] * DM + 512 * j + 8 * lane;
                if constexpr (X32IN) { const f32x4 a0 = *(const f32x4*)(xin32 + off), a1 = *(const f32x4*)(xin32 + off + 4);
#pragma unroll
                    for (int e = 0; e < 4; ++e) { xv[q][8 * j + e] = a0[e]; xv[q][8 * j + 4 + e] = a1[e]; } }
                else { const f16x8 xh = *(const f16x8*)(X16in + off);
#pragma unroll
                    for (int e = 0; e < 8; ++e) xv[q][8 * j + e] = (float)xh[e]; }
                if constexpr (HAS_Y) { const f16x8 yh = *(const f16x8*)(y + off);
#pragma unroll
                    for (int e = 0; e < 8; ++e) yv[q][8 * j + e] = (float)yh[e]; }
            }
        if constexpr (HAS_Y) {
            float s[2] = {0.f, 0.f};
#pragma unroll
            for (int q = 0; q < 2; ++q)
#pragma unroll
                for (int e = 0; e < 16; ++e) s[q] += yv[q][e] * yv[q][e];
#pragma unroll
            for (int o = 1; o < 64; o <<= 1) { s[0] += __shfl_xor(s[0], o); s[1] += __shfl_xor(s[1], o); }
#pragma unroll
            for (int q = 0; q < 2; ++q) { const float rstd = 1.0f / sqrtf(s[q] * (1.f / DM) + NORM_EPS);
#pragma unroll
                for (int j = 0; j < 2; ++j) { const LAS float* ta = TA + bq[q] * DM + 512 * j + 8 * lane; const f32x4 t0 = *(const LAS f32x4*)ta, t1 = *(const LAS f32x4*)(ta + 4);
#pragma unroll
                    for (int e = 0; e < 4; ++e) { xv[q][8 * j + e] += t0[e] * (yv[q][8 * j + e] * rstd); xv[q][8 * j + 4 + e] += t1[e] * (yv[q][8 * j + 4 + e] * rstd); } } }
        }
#pragma unroll
        for (int q = 0; q < 2; ++q)
#pragma unroll
            for (int j = 0; j < 2; ++j) { const size_t off = (size_t)row[q] * DM + 512 * j + 8 * lane;
                if constexpr (OUT32) { float* o32 = out32;
                    *(f32x4*)(o32 + off) = (f32x4){xv[q][8 * j], xv[q][8 * j + 1], xv[q][8 * j + 2], xv[q][8 * j + 3]}; *(f32x4*)(o32 + off + 4) = (f32x4){xv[q][8 * j + 4], xv[q][8 * j + 5], xv[q][8 * j + 6], xv[q][8 * j + 7]}; }
                else { u32x4 w; w.x = pk_f16(xv[q][8 * j], xv[q][8 * j + 1]); w.y = pk_f16(xv[q][8 * j + 2], xv[q][8 * j + 3]); w.z = pk_f16(xv[q][8 * j + 4], xv[q][8 * j + 5]); w.w = pk_f16(xv[q][8 * j + 6], xv[q][8 * j + 7]);
                    *(u32x4*)(X16out + off) = w;
                    const f16x8 r = __builtin_bit_cast(f16x8, w);
#pragma unroll
                    for (int e = 0; e < 8; ++e) xv[q][8 * j + e] = (float)r[e]; }
            }
        if constexpr (WH) {
            float s[2] = {0.f, 0.f};
#pragma unroll
            for (int q = 0; q < 2; ++q)
#pragma unroll
                for (int e = 0; e < 16; ++e) s[q] += xv[q][e] * xv[q][e];
#pragma unroll
            for (int o = 1; o < 64; o <<= 1) { s[0] += __shfl_xor(s[0], o); s[1] += __shfl_xor(s[1], o); }
#pragma unroll
            for (int q = 0; q < 2; ++q) { const float rstd = 1.0f / sqrtf(s[q] * (1.f / DM) + NORM_EPS);
                f16* h2 = (HHALO != nullptr && is_halo_row(row[q])) ? HHALO + (size_t)(2 * ((row[q] >> 8) + 1) + ((row[q] & 255) - 254)) * DM : nullptr;
#pragma unroll
                for (int j = 0; j < 2; ++j) { const int col = 512 * j + 8 * lane; const LAS float* tb = TB + bq[q] * DM + col; const LAS float* tc = TC + bq[q] * DM + col;
                    const f32x4 b0 = *(const LAS f32x4*)tb, b1 = *(const LAS f32x4*)(tb + 4), c0 = *(const LAS f32x4*)tc, c1 = *(const LAS f32x4*)(tc + 4);
                    float hv[8];
#pragma unroll
                    for (int e = 0; e < 4; ++e) { hv[e] = (xv[q][8 * j + e] * rstd) * b0[e] + c0[e]; hv[4 + e] = (xv[q][8 * j + 4 + e] * rstd) * b1[e] + c1[e]; }
                    u32x4 w; w.x = pk_f16(hv[0], hv[1]); w.y = pk_f16(hv[2], hv[3]); w.z = pk_f16(hv[4], hv[5]); w.w = pk_f16(hv[6], hv[7]);
                    *(u32x4*)(H + (size_t)row[q] * DM + col) = w;
                    if (h2 != nullptr) *(u32x4*)(h2 + col) = w; } }
        }
    }
}

__device__ __forceinline__ void naive_kmean(const f16* PROJ, float* KMEAN, int gt, int NGT) {
    for (int e = gt; e < BATCH * 16 * 512; e += NGT) { const int col = e & 511, blk = (e >> 9) & 15, b = e >> 13;
        const f16* p = PROJ + ((size_t)b * SEQ + blk * 256) * AB_IN + 512 + col; float s = 0.f;
        for (int r = 0; r < 256; ++r) s += (float)p[(size_t)r * AB_IN];
        KMEAN[e] = s * (1.f / 256.f); }
}
#define OS_UPDATE(s_, vv_) do { const float mn_ = fmaxf(m, (s_)), al_ = expf(m - mn_), pe_ = expf((s_) - mn_); l = l * al_ + pe_; \
    _Pragma("unroll") for (int i_ = 0; i_ < 16; ++i_) acc[i_] = acc[i_] * al_ + pe_ * (vv_)[i_]; m = mn_; } while (0)
__device__ __forceinline__ void naive_moba(const f16* PROJ, const float* KMEAN, const float* relb, f16* ATT, int gt, int NGT) {
    const int sub = gt & 3, ngr = NGT >> 2;
    for (int item = gt >> 2; item < BATCH * NH * SEQ; item += ngr) {
        const int t = item & (SEQ - 1), h = (item >> 12) & 7, b = item >> 15;
        const size_t row = (size_t)b * SEQ + t;
        float q[16]; load16(PROJ + row * AB_IN + h * 64 + sub * 16, q);
        const int own = t >> 8;
        unsigned selmask = 0u;
        {
            float g[16];
#pragma unroll
            for (int j = 0; j < 16; ++j) { float p = 0.f;
                if (j < own) { const float* km = KMEAN + ((size_t)(b * 16 + j) * 512) + h * 64 + sub * 16;
#pragma unroll
                    for (int i = 0; i < 16; ++i) p += q[i] * km[i]; }
                p = quad_sum(p); g[j] = (j < own) ? p : -INFINITY; }
#pragma unroll
            for (int r = 0; r < 3; ++r) { float best = -INFINITY; int bi = -1;
#pragma unroll
                for (int j = 0; j < 16; ++j) { const bool ok = !((selmask >> j) & 1u) && (j < own) && (g[j] > best); if (ok) { best = g[j]; bi = j; } }
                if (bi >= 0) selmask |= 1u << bi; }
        }
        float m = -INFINITY, l = 0.f, acc[16];
#pragma unroll
        for (int i = 0; i < 16; ++i) acc[i] = 0.f;
        const f16* Kb = PROJ + (size_t)b * SEQ * AB_IN + 512 + h * 64 + sub * 16;
        const float* rb = relb + h * 32;
        for (int pos = own * 256; pos <= t; ++pos) { float kk[16], vv[16]; load16(Kb + (size_t)pos * AB_IN, kk); load16(Kb + (size_t)pos * AB_IN + 512, vv); float p = 0.f;
#pragma unroll
            for (int i = 0; i < 16; ++i) p += q[i] * kk[i];
            const float s = quad_sum(p) * 0.125f + rb[t5_bucket(t - pos)]; OS_UPDATE(s, vv); }
        for (int j = 0; j < own; ++j) { if (!((selmask >> j) & 1u)) continue;
            for (int pos = j * 256; pos < j * 256 + 256; ++pos) { float kk[16], vv[16]; load16(Kb + (size_t)pos * AB_IN, kk); load16(Kb + (size_t)pos * AB_IN + 512, vv); float p = 0.f;
#pragma unroll
                for (int i = 0; i < 16; ++i) p += q[i] * kk[i];
                const float s = quad_sum(p) * 0.125f + rb[t5_bucket(t - pos)]; OS_UPDATE(s, vv); } }
        const float il = 1.f / l; u32x4 w0, w1;
        w0.x = pk_f16(acc[0] * il, acc[1] * il); w0.y = pk_f16(acc[2] * il, acc[3] * il); w0.z = pk_f16(acc[4] * il, acc[5] * il); w0.w = pk_f16(acc[6] * il, acc[7] * il);
        w1.x = pk_f16(acc[8] * il, acc[9] * il); w1.y = pk_f16(acc[10] * il, acc[11] * il); w1.z = pk_f16(acc[12] * il, acc[13] * il); w1.w = pk_f16(acc[14] * il, acc[15] * il);
        f16* o = ATT + row * DM + h * 64 + sub * 16; *(u32x4*)o = w0; *(u32x4*)(o + 8) = w1;
    }
}
__device__ __forceinline__ void naive_dilated(const f16* PROJ, const float* relb, f16* ATT, int gt, int NGT) {
    const int sub = gt & 3, ngr = NGT >> 2;
    for (int item = gt >> 2; item < BATCH * NH * SEQ; item += ngr) {
        const int t = item & (SEQ - 1), h = (item >> 12) & 7, b = item >> 15;
        const size_t row = (size_t)b * SEQ + t;
        float q[16]; load16(PROJ + row * AB_IN + 1536 + h * 64 + sub * 16, q);
        float m = -INFINITY, l = 0.f, acc[16];
#pragma unroll
        for (int i = 0; i < 16; ++i) acc[i] = 0.f;
        const f16* Kb = PROJ + (size_t)b * SEQ * AB_IN + 2048 + h * 64 + sub * 16;
        const float* rb = relb + (8 + h) * 32;
        for (int br = 0; br < 3; ++br) { const int dil = br == 0 ? 1 : (br == 1 ? 4 : 16);
            for (int mm = 0; mm <= 128; ++mm) { const int pos = t - dil * mm; if (pos < 0) break;
                float kk[16], vv[16]; load16(Kb + (size_t)pos * AB_IN, kk); load16(Kb + (size_t)pos * AB_IN + 512, vv); float p = 0.f;
#pragma unroll
                for (int i = 0; i < 16; ++i) p += q[i] * kk[i];
                const float s = quad_sum(p) * 0.125f + rb[t5_bucket(dil * mm)]; OS_UPDATE(s, vv); } }
        const float il = 1.f / l; u32x4 w0, w1;
        w0.x = pk_f16(acc[0] * il, acc[1] * il); w0.y = pk_f16(acc[2] * il, acc[3] * il); w0.z = pk_f16(acc[4] * il, acc[5] * il); w0.w = pk_f16(acc[6] * il, acc[7] * il);
        w1.x = pk_f16(acc[8] * il, acc[9] * il); w1.y = pk_f16(acc[10] * il, acc[11] * il); w1.z = pk_f16(acc[12] * il, acc[13] * il); w1.w = pk_f16(acc[14] * il, acc[15] * il);
        f16* o = ATT + row * DM + 512 + h * 64 + sub * 16; *(u32x4*)o = w0; *(u32x4*)(o + 8) = w1;
    }
}
__device__ __forceinline__ void mla_norm_phase(f16* PROJ, f16* KPE, const float* rc, const float* rs, int tid, int bid, int G) {
    const int wave = tid >> 6, lane = tid & 63;
    const int gw = bid * NWAVES + wave, NGW = G * NWAVES;
    for (int row = gw; row < M; row += NGW) {
        f16* p = PROJ + (size_t)row * CD_INP;
        const int t = row & (SEQ - 1);
#pragma unroll
        for (int part = 0; part < 2; ++part) {
            f16x4 v = *(const f16x4*)(p + part * 256 + 4 * lane);
            float f[4] = {(float)v[0], (float)v[1], (float)v[2], (float)v[3]};
            const float s = wave_sum((f[0] * f[0] + f[1] * f[1]) + (f[2] * f[2] + f[3] * f[3]));
            const float rstd = 1.0f / sqrtf(s * (1.f / 256.f) + NORM_EPS);
            u32x2 w; w.x = pk_f16(f[0] * rstd, f[1] * rstd); w.y = pk_f16(f[2] * rstd, f[3] * rstd);
            *(u32x2*)(p + part * 256 + 4 * lane) = w;
        }
        if (lane < 16) { const float x1 = (float)p[512 + lane], x2 = (float)p[528 + lane]; const float c = rc[t * 16 + lane], s = rs[t * 16 + lane];
            KPE[(size_t)row * 32 + lane] = (f16)(x1 * c - x2 * s); KPE[(size_t)row * 32 + 16 + lane] = (f16)(x1 * s + x2 * c); }
    }
}
__device__ __forceinline__ void naive_mla(const f16* Q, const f16* KV, const f16* KPE, const float* rc, const float* rs, f16* ATT, int gt, int NGT) {
    const int sub = gt & 3, ngr = NGT >> 2;
    const float scale = 0.10206207261596575f;
    for (int item = gt >> 2; item < BATCH * NH * SEQ; item += ngr) {
        const int t = item & (SEQ - 1), h = (item >> 12) & 7, b = item >> 15;
        const size_t row = (size_t)b * SEQ + t;
        const f16* qp = Q + row * QW + h * 96;
        float q[16], qr[8]; load16(qp + sub * 16, q);
#pragma unroll
        for (int i = 0; i < 8; ++i) { const int d = 8 * sub + i, dd = d & 15; const float x1 = (float)qp[64 + dd], x2 = (float)qp[80 + dd]; const float c = rc[t * 16 + dd], s = rs[t * 16 + dd];
            qr[i] = (d < 16) ? (x1 * c - x2 * s) : (x1 * s + x2 * c); }
        float m = -INFINITY, l = 0.f, acc[16];
#pragma unroll
        for (int i = 0; i < 16; ++i) acc[i] = 0.f;
        const f16* Kb = KV + (size_t)b * SEQ * KVW + h * 128 + sub * 16;
        const f16* Pb = KPE + (size_t)b * SEQ * 32 + sub * 8;
        for (int pos = 0; pos <= t; ++pos) { float kk[16], kr[8], vv[16]; load16(Kb + (size_t)pos * KVW, kk); load8(Pb + (size_t)pos * 32, kr); load16(Kb + (size_t)pos * KVW + 64, vv); float p = 0.f;
#pragma unroll
            for (int i = 0; i < 16; ++i) p += q[i] * kk[i];
#pragma unroll
            for (int i = 0; i < 8; ++i) p += qr[i] * kr[i];
            const float s = quad_sum(p) * scale; OS_UPDATE(s, vv); }
        const float il = 1.f / l; u32x4 w0, w1;
        w0.x = pk_f16(acc[0] * il, acc[1] * il); w0.y = pk_f16(acc[2] * il, acc[3] * il); w0.z = pk_f16(acc[4] * il, acc[5] * il); w0.w = pk_f16(acc[6] * il, acc[7] * il);
        w1.x = pk_f16(acc[8] * il, acc[9] * il); w1.y = pk_f16(acc[10] * il, acc[11] * il); w1.z = pk_f16(acc[12] * il, acc[13] * il); w1.w = pk_f16(acc[14] * il, acc[15] * il);
        f16* o = ATT + row * DM + h * 64 + sub * 16; *(u32x4*)o = w0; *(u32x4*)(o + 8) = w1;
    }
}
__device__ __forceinline__ float softplusf(float x) { return fmaxf(x, 0.f) + log1pf(expf(-fabsf(x))); }
__device__ __forceinline__ void naive_sb(const f16* PROJ, f16* ATT, int gt, int NGT) {
    const int sub = gt & 3, ngr = NGT >> 2;
    for (int item = gt >> 2; item < BATCH * NH * SEQ; item += ngr) {
        const int t = item & (SEQ - 1), h = (item >> 12) & 7, b = item >> 15;
        const size_t row = (size_t)b * SEQ + t;
        float q[16]; load16(PROJ + row * CD_INP + 544 + h * 64 + sub * 16, q);
        float R = 0.f, acc[16];
#pragma unroll
        for (int i = 0; i < 16; ++i) acc[i] = 0.f;
        const f16* Kb = PROJ + (size_t)b * SEQ * CD_INP + 1056 + h * 64 + sub * 16;
        for (int pos = t - 1; pos >= 0; --pos) { float kk[16], vv[16]; load16(Kb + (size_t)pos * CD_INP, kk); load16(Kb + (size_t)pos * CD_INP + 512, vv); float p = 0.f;
#pragma unroll
            for (int i = 0; i < 16; ++i) p += q[i] * kk[i];
            const float z = quad_sum(p) * 0.125f;
            const float aw = expf(R - softplusf(-z));
#pragma unroll
            for (int i = 0; i < 16; ++i) acc[i] += aw * vv[i];
            R -= softplusf(z); }
        u32x4 w0, w1;
        w0.x = pk_f16(acc[0], acc[1]); w0.y = pk_f16(acc[2], acc[3]); w0.z = pk_f16(acc[4], acc[5]); w0.w = pk_f16(acc[6], acc[7]);
        w1.x = pk_f16(acc[8], acc[9]); w1.y = pk_f16(acc[10], acc[11]); w1.z = pk_f16(acc[12], acc[13]); w1.w = pk_f16(acc[14], acc[15]);
        f16* o = ATT + row * DM + 512 + h * 64 + sub * 16; *(u32x4*)o = w0; *(u32x4*)(o + 8) = w1;
    }
}
__device__ __forceinline__ float gelu_tanh(float g) { return 0.5f * g * (1.f + tanhf(0.7978845608028654f * (g + 0.044715f * g * g * g))); }
__device__ __forceinline__ void naive_convact(const f16* U, int half, const float* cw, const float* cb, f16* ACT, int gt, int NGT) {
    for (int e = gt; e < (M / 2) * DFF; e += NGT) { const int rl = e / DFF, j = e % DFF; const int row = half * (M / 2) + rl, t = row & (SEQ - 1);
        const int ucol = (j >> 7) * 256 + (j & 127);
        float g = cb[j], v = cb[DFF + j];
#pragma unroll
        for (int tap = 0; tap < 3; ++tap) { const int dt = 2 - tap; if (t - dt < 0) continue;
            const f16* up = U + (size_t)(rl - dt) * DFF2 + ucol;
            g += cw[tap * DFF2 + j] * (float)up[0]; v += cw[tap * DFF2 + DFF + j] * (float)up[128]; }
        ACT[(size_t)row * DFF + j] = (f16)(gelu_tanh(g) * v); }
}
namespace att {
typedef float f32x16 __attribute__((ext_vector_type(16)));
typedef short s16x4 __attribute__((ext_vector_type(4)));
__device__ __forceinline__ f16x4 tr_read(const LAS f16* p) { return __builtin_bit_cast(f16x4, __builtin_amdgcn_ds_read_tr16_b64_v4i16((LAS s16x4*)p)); }
constexpr int VP = 96;
constexpr int OFF_K = 0, KBUF = 128 * 104 * 2;
constexpr int OFF_V = 2 * KBUF, VBUF = 128 * VP * 2;
constexpr int OFF_BIAS = OFF_V + 2 * VBUF;
constexpr int OFF_KMEAN = OFF_BIAS + 16384;
constexpr int OFF_FLAG = OFF_KMEAN + 4096;
constexpr int ATT_LDS = OFF_FLAG + 64;
constexpr float LOG2E = 1.4426950408889634f, LN2 = 0.6931471805599453f;

struct Src {
    const f16* q; int qp;
    const f16* k; int kp;
    const f16* k2;
    const f16* v; int vp;
    f16* o;
};

template <int KIND  , int PM = 0  >
__device__ __forceinline__ void attn_unit(LAS unsigned char* lds, const Src& T, int b, int h, int qb, const float* rc, const float* rs, const float* KMEAN, const float* relb, int tid) {
    constexpr int DQ = (KIND == 0) ? 96 : 64, NS = DQ / 16, KP = DQ + 8;
    const int lane = tid & 63, r32 = lane & 31, hi = lane >> 5; const int wid = __builtin_amdgcn_readfirstlane(tid >> 6);
    const size_t rowbase = (size_t)b * SEQ;
    const int q0w = qb * 256 + wid * 32;
    const int t = q0w + r32;
    f16x8 qf[NS];
    {
        const f16* qrow = T.q + (rowbase + t) * T.qp;
#pragma unroll
        for (int s = 0; s < 4; ++s) qf[s] = *(const f16x8*)(qrow + 16 * s + 8 * hi);
        if constexpr (KIND == 0) {
            const f16x8 xa = *(const f16x8*)(qrow + 64 + 8 * hi), xb = *(const f16x8*)(qrow + 80 + 8 * hi);
            const f32x4 c0 = *(const f32x4*)(rc + t * 16 + 8 * hi), c1 = *(const f32x4*)(rc + t * 16 + 8 * hi + 4), s0 = *(const f32x4*)(rs + t * 16 + 8 * hi), s1 = *(const f32x4*)(rs + t * 16 + 8 * hi + 4);
#pragma unroll
            for (int j = 0; j < 8; ++j) { const float a = (float)xa[j], bb = (float)xb[j], c = j < 4 ? c0[j & 3] : c1[j & 3], s = j < 4 ? s0[j & 3] : s1[j & 3];
                qf[4][j] = (f16)(a * c - bb * s); qf[5][j] = (f16)(a * s + bb * c); }
        }
    }
    unsigned selmask = 0u;
    LAS float* biasl = (LAS float*)(lds + OFF_BIAS);
    if constexpr (KIND == 1) {
        LAS float* kml = (LAS float*)(lds + OFF_KMEAN);
        for (int d = tid; d < SEQ; d += NTHR) biasl[d] = relb[h * 32 + t5_bucket(d)] * LOG2E;
        for (int e = tid; e < 16 * 64; e += NTHR) kml[e] = KMEAN[((size_t)(b * 16 + (e >> 6)) * 512) + h * 64 + (e & 63)] * (1.f / 256.f);
        __syncthreads();
        float g[16];
#pragma unroll
        for (int j = 0; j < 16; ++j) { float p = 0.f;
            if (j < qb) {
#pragma unroll
                for (int s = 0; s < 4; ++s)
#pragma unroll
                    for (int i = 0; i < 8; ++i) p += (float)qf[s][i] * kml[j * 64 + 16 * s + 8 * hi + i]; }
            p += __shfl_xor(p, 32); g[j] = (j < qb) ? p : -INFINITY; }
#pragma unroll
        for (int r = 0; r < 3; ++r) { float best = -INFINITY; int bi = -1;
#pragma unroll
            for (int j = 0; j < 16; ++j) { const bool ok = !((selmask >> j) & 1u) && (j < qb) && (g[j] > best); if (ok) { best = g[j]; bi = j; } }
            if (bi >= 0) selmask |= 1u << bi; }
    }
    const int NT = 4 * qb + 4;
    auto tile_start = [&](int i) -> int {
        if constexpr (KIND == 0) return 64 * i;
        else if constexpr (KIND == 1) return i < 4 ? 256 * qb + 64 * i : 64 * (i - 4);
        else return 64 * (NT - 1 - i);
    };
    const int kr = tid >> 3, kc = tid & 7;
    const int k2r = tid >> 2, k2c = tid & 3;
    f16x8 kr0, vr0, k2r0, kr1, vr1, k2r1;
    auto gload = [&](int d) {
        const int ts0 = tile_start(2 * d), ts1 = tile_start(2 * d + 1);
        kr0 = *(const f16x8*)(T.k + (rowbase + ts0 + kr) * T.kp + 8 * kc); vr0 = *(const f16x8*)(T.v + (rowbase + ts0 + kr) * T.vp + 8 * kc);
        kr1 = *(const f16x8*)(T.k + (rowbase + ts1 + kr) * T.kp + 8 * kc); vr1 = *(const f16x8*)(T.v + (rowbase + ts1 + kr) * T.vp + 8 * kc);
        if constexpr (KIND == 0) { if (tid < 256) { k2r0 = *(const f16x8*)(T.k2 + (rowbase + ts0 + k2r) * 32 + 8 * k2c); k2r1 = *(const f16x8*)(T.k2 + (rowbase + ts1 + k2r) * 32 + 8 * k2c); } }
    };
    auto lstore = [&](int buf) {
        LAS f16* Kb = (LAS f16*)(lds + OFF_K + buf * KBUF); LAS f16* Vb = (LAS f16*)(lds + OFF_V + buf * VBUF);
        *(LAS f16x8*)(Kb + kr * KP + 8 * kc) = kr0; *(LAS f16x8*)(Kb + (64 + kr) * KP + 8 * kc) = kr1;
        if constexpr (KIND == 0) { if (tid < 256) { *(LAS f16x8*)(Kb + k2r * KP + 64 + 8 * k2c) = k2r0; *(LAS f16x8*)(Kb + (64 + k2r) * KP + 64 + 8 * k2c) = k2r1; } }
        *(LAS f16x8*)(Vb + kr * VP + 8 * kc) = vr0; *(LAS f16x8*)(Vb + (64 + kr) * VP + 8 * kc) = vr1;
    };
    f32x16 o0, o1;
#pragma unroll
    for (int r = 0; r < 16; ++r) { o0[r] = 0.f; o1[r] = 0.f; }
    float m = -1e30f, l = 0.f, R = 0.f;
    const float csc = (KIND == 0 ? 0.10206207261596575f : 0.125f) * (KIND == 2 ? 1.0f : LOG2E);
    LAS unsigned* flags = (LAS unsigned*)(lds + OFF_FLAG);

    const int ND = NT / 2;
    gload(0); lstore(0); gload(1);
    __syncthreads();
    auto tile = [&](int i, int buf, int sub) {
        const int ts = tile_start(i);
        bool active, need_mask;
        if constexpr (KIND == 2) { active = ts < q0w + 31; need_mask = ts + 63 >= q0w; }
        else if constexpr (KIND == 1) { if (i < 4) { active = ts <= q0w + 31; need_mask = ts + 63 > q0w; } else { active = true; need_mask = false; } }
        else { active = ts <= q0w + 31; need_mask = ts + 63 > q0w; }
        bool wave_done = false;
        if constexpr (KIND == 2) { wave_done = __all(R < -152.0f) != 0; if (wave_done) active = false; }
        if (active && PM != 1) {
            const LAS f16* Kb = (const LAS f16*)(lds + OFF_K + buf * KBUF) + sub * 64 * KP; const LAS f16* Vb = (const LAS f16*)(lds + OFF_V + buf * VBUF) + sub * 64 * VP;
            f32x16 p0, p1;
#pragma unroll
            for (int r = 0; r < 16; ++r) { p0[r] = 0.f; p1[r] = 0.f; }
            {
                f16x8 kf[2 * NS];
#pragma unroll
                for (int s = 0; s < NS; ++s) { kf[2 * s] = *(const LAS f16x8*)(Kb + r32 * KP + 16 * s + 8 * hi); kf[2 * s + 1] = *(const LAS f16x8*)(Kb + (32 + r32) * KP + 16 * s + 8 * hi); }
                __builtin_amdgcn_sched_barrier(0);
#pragma unroll
                for (int s = 0; s < NS; ++s) { p0 = __builtin_amdgcn_mfma_f32_32x32x16_f16(kf[2 * s], qf[s], p0, 0, 0, 0); p1 = __builtin_amdgcn_mfma_f32_32x32x16_f16(kf[2 * s + 1], qf[s], p1, 0, 0, 0); }
            }
            f16x4 vlo[8], vhh[8];
            auto vfrag_load = [&]() {
#pragma unroll
            for (int kb = 0; kb < 2; ++kb)
#pragma unroll
                for (int s2 = 0; s2 < 2; ++s2)
#pragma unroll
                    for (int db = 0; db < 2; ++db) {
                        const LAS f16* vp = Vb + (32 * kb + 16 * s2 + 4 * hi + ((lane & 15) >> 2)) * VP + 32 * db + (r32 & 16) + 4 * (lane & 3);
                        vlo[(kb * 2 + s2) * 2 + db] = tr_read(vp); vhh[(kb * 2 + s2) * 2 + db] = tr_read(vp + 8 * VP); }
            };
            if constexpr (PM < 2 && KIND != 2) vfrag_load();
            __builtin_amdgcn_sched_barrier(0);
            const int lim = t - ts - 4 * hi;
            if constexpr (PM == 3) { asm volatile("" :: "v"(p0), "v"(p1)); }
            else if constexpr (KIND != 2) {
                if constexpr (KIND == 1) {
                    const int dbase = lim;
                    float b0[16], b1[16];
                    if (i < 4) {
#pragma unroll
                        for (int r = 0; r < 16; ++r) { const int c = (r & 3) + 8 * (r >> 2); int d0 = dbase - c, d1 = dbase - 32 - c; d0 = d0 < 0 ? 0 : d0; d1 = d1 < 0 ? 0 : d1; b0[r] = biasl[d0]; b1[r] = biasl[d1]; }
                    } else {
#pragma unroll
                        for (int r = 0; r < 16; ++r) { const int c = (r & 3) + 8 * (r >> 2); b0[r] = biasl[dbase - c]; b1[r] = biasl[dbase - 32 - c]; }
                    }
                    __builtin_amdgcn_sched_barrier(0);
#pragma unroll
                    for (int r = 0; r < 16; r += 2) { const f32x2 q0 = (f32x2){p0[r], p0[r + 1]} * csc + (f32x2){b0[r], b0[r + 1]}, q1 = (f32x2){p1[r], p1[r + 1]} * csc + (f32x2){b1[r], b1[r + 1]};
                        p0[r] = q0.x; p0[r + 1] = q0.y; p1[r] = q1.x; p1[r + 1] = q1.y; }
                    if (i >= 4) { const bool sel = (selmask >> (ts >> 8)) & 1u;
                        if (!sel) {
#pragma unroll
                            for (int r = 0; r < 16; ++r) { p0[r] = -INFINITY; p1[r] = -INFINITY; } } }
                }
                if (need_mask) {
#pragma unroll
                    for (int r = 0; r < 16; ++r) { const int c = (r & 3) + 8 * (r >> 2); if (c > lim) p0[r] = -INFINITY; if (c + 32 > lim) p1[r] = -INFINITY; }
                }
                const float esc = (KIND == 1) ? 1.0f : csc;
                float mx = fmaxf(p0[0], p1[0]);
#pragma unroll
                for (int r = 1; r < 16; ++r) mx = fmaxf(mx, fmaxf(p0[r], p1[r]));
                mx = fmaxf(mx, __shfl_xor(mx, 32)) * esc;
                if (__any(mx > m + 8.0f)) {
                    const float mn = fmaxf(m, mx), alpha = __builtin_amdgcn_exp2f(m - mn);
                    m = mn; l *= alpha;
#pragma unroll
                    for (int r = 0; r < 16; ++r) { o0[r] *= alpha; o1[r] *= alpha; }
                }
                f32x2 sum2 = {0.f, 0.f};
#pragma unroll
                for (int r = 0; r < 16; r += 2) {
                    const f32x2 t0 = (f32x2){p0[r], p0[r + 1]} * esc - m, t1 = (f32x2){p1[r], p1[r + 1]} * esc - m;
                    f32x2 e0, e1; e0.x = __builtin_amdgcn_exp2f(t0.x); e0.y = __builtin_amdgcn_exp2f(t0.y); e1.x = __builtin_amdgcn_exp2f(t1.x); e1.y = __builtin_amdgcn_exp2f(t1.y);
                    p0[r] = e0.x; p0[r + 1] = e0.y; p1[r] = e1.x; p1[r + 1] = e1.y; sum2 += e0 + e1; }
                l += sum2.x + sum2.y;
            } else {
                float lk0[16], lk1[16];
#pragma unroll
                for (int r = 0; r < 16; ++r) { const int c = (r & 3) + 8 * (r >> 2);
                    const float z0 = p0[r] * (csc * LOG2E), z1 = p1[r] * (csc * LOG2E);
                    const float e0 = __builtin_amdgcn_exp2f(z0), e1 = __builtin_amdgcn_exp2f(z1);
                    const float g0 = __builtin_amdgcn_logf(1.f + e0), g1 = __builtin_amdgcn_logf(1.f + e1);
                    const float a0 = -(z0 > 64.f ? z0 : g0), a1 = -(z1 > 64.f ? z1 : g1);
                    const bool v0 = !need_mask || (c < lim), v1 = !need_mask || (c + 32 < lim);
                    lk0[r] = v0 ? a0 : 0.f; lk1[r] = v1 ? a1 : 0.f;
                    p0[r] = v0 ? z0 + a0 : -INFINITY; p1[r] = v1 ? z1 + a1 : -INFINITY; }
                float gs[8], gp[8];
#pragma unroll
                for (int g = 0; g < 4; ++g) { gs[g] = (lk0[4 * g] + lk0[4 * g + 1]) + (lk0[4 * g + 2] + lk0[4 * g + 3]); gs[4 + g] = (lk1[4 * g] + lk1[4 * g + 1]) + (lk1[4 * g + 2] + lk1[4 * g + 3]); }
#pragma unroll
                for (int c4 = 0; c4 < 8; ++c4) gp[c4] = __shfl_xor(gs[c4], 32);
                float suf = R;
#pragma unroll
                for (int c4 = 7; c4 >= 0; --c4) {
                    const float ev = hi ? gp[c4] : gs[c4], od = hi ? gs[c4] : gp[c4];
                    const float base = hi ? suf : suf + od;
                    if (c4 < 4) { const int g = c4; float acc = base;
                        p0[4 * g + 3] += acc; acc += lk0[4 * g + 3]; p0[4 * g + 2] += acc; acc += lk0[4 * g + 2]; p0[4 * g + 1] += acc; acc += lk0[4 * g + 1]; p0[4 * g] += acc; }
                    else { const int g = c4 - 4; float acc = base;
                        p1[4 * g + 3] += acc; acc += lk1[4 * g + 3]; p1[4 * g + 2] += acc; acc += lk1[4 * g + 2]; p1[4 * g + 1] += acc; acc += lk1[4 * g + 1]; p1[4 * g] += acc; }
                    suf += ev + od;
                }
                R = suf;
#pragma unroll
                for (int r = 0; r < 16; ++r) { p0[r] = __builtin_amdgcn_exp2f(p0[r]); p1[r] = __builtin_amdgcn_exp2f(p1[r]); }
            }
            if constexpr (PM < 2 && KIND == 2) { vfrag_load(); __builtin_amdgcn_sched_barrier(0); }
            if constexpr (PM >= 2) { asm volatile("" :: "v"(p0), "v"(p1)); }
            else
#pragma unroll
            for (int kb = 0; kb < 2; ++kb)
#pragma unroll
                for (int s2 = 0; s2 < 2; ++s2) {
                    f16x8 bf;
#pragma unroll
                    for (int j = 0; j < 8; ++j) bf[j] = (f16)(kb ? p1[8 * s2 + j] : p0[8 * s2 + j]);
#pragma unroll
                    for (int db = 0; db < 2; ++db) {
                        const f16x4 lo = vlo[(kb * 2 + s2) * 2 + db], hh = vhh[(kb * 2 + s2) * 2 + db];
                        const f16x8 af = {lo[0], lo[1], lo[2], lo[3], hh[0], hh[1], hh[2], hh[3]};
                        if (db == 0) o0 = __builtin_amdgcn_mfma_f32_32x32x16_f16(af, bf, o0, 0, 0, 0); else o1 = __builtin_amdgcn_mfma_f32_32x32x16_f16(af, bf, o1, 0, 0, 0);
                    }
                }
        }
    };
    for (int d = 0; d < ND; ++d) {
        const int buf = d & 1;
        tile(2 * d, buf, 0);
        tile(2 * d + 1, buf, 1);
        if constexpr (KIND == 2) { if (lane == 0) flags[buf * 8 + wid] = (__all(R < -152.0f) != 0) ? 1u : 0u; }
        if (d + 1 < ND) lstore(buf ^ 1);
        if (d + 2 < ND) gload(d + 2);
        __syncthreads();
        if constexpr (KIND == 2) {
            unsigned alld = 1u;
#pragma unroll
            for (int w = 0; w < 8; ++w) alld &= flags[buf * 8 + w];
            if (alld) break;
        }
    }
    float inv = 1.f;
    if constexpr (KIND != 2) { l += __shfl_xor(l, 32); inv = 1.f / l; }
    f16* orow = T.o + (rowbase + t) * DM;
    if constexpr (PM == 0)
#pragma unroll
    for (int g = 0; g < 4; ++g) {
        u32x2 w0, w1;
        w0.x = pk_f16(o0[4 * g] * inv, o0[4 * g + 1] * inv); w0.y = pk_f16(o0[4 * g + 2] * inv, o0[4 * g + 3] * inv);
        w1.x = pk_f16(o1[4 * g] * inv, o1[4 * g + 1] * inv); w1.y = pk_f16(o1[4 * g + 2] * inv, o1[4 * g + 3] * inv);
        *(u32x2*)(orow + 8 * g + 4 * hi) = w0; *(u32x2*)(orow + 32 + 8 * g + 4 * hi) = w1;
    }
    __syncthreads();
}
}
namespace dil {
typedef float f32x16 __attribute__((ext_vector_type(16)));
constexpr int KPW = 72, VPW = 96;
constexpr int WAVE_LDS = 32 * KPW * 2 + 32 * VPW * 2;
constexpr int OFF_BIASD = 8 * WAVE_LDS;
constexpr float LOG2E = 1.4426950408889634f;

__device__ __forceinline__ void dilated_unit(LAS unsigned char* lds, const f16* PROJ, const float* relb, f16* ATT, float* stAo, float* stAml, float* stBo, float* stBml, int b, int h, int sp, int tid) {
    const int lane = tid & 63, r32 = lane & 31, hi = lane >> 5; const int wid = __builtin_amdgcn_readfirstlane(tid >> 6);
    LAS float* biasd = (LAS float*)(lds + OFF_BIASD);
    for (int e = tid; e < 3 * 129; e += NTHR) { const int br = e / 129, mm = e % 129; const int dl = br == 0 ? 16 : (br == 1 ? 4 : 1); biasd[br * 132 + mm] = relb[(8 + h) * 32 + t5_bucket(dl * mm)] * LOG2E; }
    __syncthreads();
    LAS f16* Kb = (LAS f16*)(lds + wid * WAVE_LDS); LAS f16* Vb = Kb + 32 * KPW;
    const size_t rowbase = (size_t)b * SEQ; const int T0 = sp * 512;
    const f16* Kg = PROJ + 2048 + h * 64; const f16* Vg = PROJ + 2560 + h * 64;
    const size_t gtok0 = ((size_t)(b * NH + h)) * SEQ;
    const float csc = 0.125f * LOG2E;
#pragma unroll 1
    for (int pass = 0; pass < 3; ++pass) {
        const int dl = pass == 0 ? 16 : (pass == 1 ? 4 : 1);
        const float* ldo = pass == 1 ? stAo : stBo; const float* ldml = pass == 1 ? stAml : stBml;
        float* sto = pass == 0 ? stAo : stBo; float* stml = pass == 0 ? stAml : stBml;
        const LAS float* bt = biasd + pass * 132;
#pragma unroll 1
        for (int jj = 0; jj < 2; ++jj) {
            const int j = wid + 8 * jj;
            const int tq0 = pass == 0 ? T0 + j : (pass == 1 ? T0 + (j >> 2) + 128 * (j & 3) : T0 + 32 * j);
            const int t = tq0 + dl * r32;
            f16x8 qf[4];
            { const f16* qrow = PROJ + (rowbase + t) * AB_IN + 1536 + h * 64;
#pragma unroll
              for (int s = 0; s < 4; ++s) qf[s] = *(const f16x8*)(qrow + 16 * s + 8 * hi); }
            f32x16 o0, o1; float m, l;
            const size_t sidx = (gtok0 + t) * 2 + hi;
            if (pass == 0) {
#pragma unroll
                for (int r = 0; r < 16; ++r) { o0[r] = 0.f; o1[r] = 0.f; }
                m = -1e30f; l = 0.f;
            } else {
                const f32x4* po = (const f32x4*)(ldo + sidx * 32);
#pragma unroll
                for (int g = 0; g < 4; ++g) { const f32x4 a = po[g], c = po[4 + g];
                    o0[4 * g] = a[0]; o0[4 * g + 1] = a[1]; o0[4 * g + 2] = a[2]; o0[4 * g + 3] = a[3]; o1[4 * g] = c[0]; o1[4 * g + 1] = c[1]; o1[4 * g + 2] = c[2]; o1[4 * g + 3] = c[3]; }
                const f32x2 ml = *(const f32x2*)(ldml + sidx * 2); m = ml[0]; l = ml[1];
            }
            f16x8 kA[4], vA[4], kB[4], vB[4];
            auto gload = [&](int kbk, f16x8 (&kreg)[4], f16x8 (&vreg)[4]) {
#pragma unroll
                for (int i = 0; i < 4; ++i) { const int id = lane + 64 * i, c = id >> 3, ch = id & 7; int pos = tq0 + dl * (-128 + 32 * kbk + c); pos = pos < 0 ? 0 : pos;
                    kreg[i] = *(const f16x8*)(Kg + (rowbase + pos) * AB_IN + 8 * ch); vreg[i] = *(const f16x8*)(Vg + (rowbase + pos) * AB_IN + 8 * ch); }
            };
            auto lstore = [&](const f16x8 (&kreg)[4], const f16x8 (&vreg)[4]) {
#pragma unroll
                for (int i = 0; i < 4; ++i) { const int id = lane + 64 * i, c = id >> 3, ch = id & 7;
                    *(LAS f16x8*)(Kb + c * KPW + 8 * ch) = kreg[i];
                    *(LAS f16x8*)(Vb + c * VPW + 8 * ch) = vreg[i]; }
            };
            int kb0 = 0;
            while (kb0 < 4 && tq0 + dl * (-128 + 32 * kb0 + 31) < 0) ++kb0;
            gload(kb0, kA, vA); if (kb0 + 1 < 5) gload(kb0 + 1, kB, vB);
            auto step = [&](int kbk, f16x8 (&kreg)[4], f16x8 (&vreg)[4]) {
                asm volatile("s_waitcnt lgkmcnt(0)" ::: "memory");
                lstore(kreg, vreg);
                if (kbk + 2 < 5) gload(kbk + 2, kreg, vreg);
                asm volatile("s_waitcnt lgkmcnt(0)" ::: "memory");
                f32x16 p;
#pragma unroll
                for (int r = 0; r < 16; ++r) p[r] = 0.f;
                f16x4 vlo[4], vhh[4];
                {
                    f16x8 kf[4];
#pragma unroll
                    for (int s = 0; s < 4; ++s) kf[s] = *(const LAS f16x8*)(Kb + r32 * KPW + 16 * s + 8 * hi);
#pragma unroll
                    for (int s2 = 0; s2 < 2; ++s2)
#pragma unroll
                        for (int db = 0; db < 2; ++db) { const LAS f16* vp = Vb + (16 * s2 + 4 * hi + ((lane & 15) >> 2)) * VPW + 32 * db + (r32 & 16) + 4 * (lane & 3); vlo[s2 * 2 + db] = att::tr_read(vp); vhh[s2 * 2 + db] = att::tr_read(vp + 8 * VPW); }
                    __builtin_amdgcn_sched_barrier(0);
#pragma unroll
                    for (int s = 0; s < 4; ++s) p = __builtin_amdgcn_mfma_f32_32x32x16_f16(kf[s], qf[s], p, 0, 0, 0);
                }
                const int basepos = tq0 + dl * (-128 + 32 * kbk);
                const int bmm = r32 + 128 - 32 * kbk - 4 * hi;
                const int bpos = basepos + dl * 4 * hi;
                const bool edge = (kbk == 0) || (kbk == 4) || (basepos < 0);
                if (edge) {
#pragma unroll
                    for (int r = 0; r < 16; ++r) { const int c = (r & 3) + 8 * (r >> 2); const int mm = bmm - c; const bool ok = (mm >= 0) && (mm <= 128) && (bpos + dl * c >= 0);
                        const int mc = mm < 0 ? 0 : (mm > 128 ? 128 : mm);
                        p[r] = ok ? p[r] * csc + bt[mc] : -INFINITY; }
                } else {
                    float bb[16];
#pragma unroll
                    for (int r = 0; r < 16; ++r) { const int c = (r & 3) + 8 * (r >> 2); bb[r] = bt[bmm - c]; }
                    __builtin_amdgcn_sched_barrier(0);
#pragma unroll
                    for (int r = 0; r < 16; ++r) p[r] = p[r] * csc + bb[r];
                }
                float mx = p[0];
#pragma unroll
                for (int r = 1; r < 16; ++r) mx = fmaxf(mx, p[r]);
                mx = fmaxf(mx, __shfl_xor(mx, 32));
                if (__any(mx > m + 8.0f)) {
                    const float mn = fmaxf(m, mx), alpha = __builtin_amdgcn_exp2f(m - mn);
                    m = mn; l *= alpha;
#pragma unroll
                    for (int r = 0; r < 16; ++r) { o0[r] *= alpha; o1[r] *= alpha; }
                }
                float sum = 0.f;
#pragma unroll
                for (int r = 0; r < 16; ++r) { p[r] = __builtin_amdgcn_exp2f(p[r] - m); sum += p[r]; }
                l += sum;
#pragma unroll
                for (int s2 = 0; s2 < 2; ++s2) {
                    f16x8 bf;
#pragma unroll
                    for (int e = 0; e < 8; ++e) bf[e] = (f16)p[8 * s2 + e];
#pragma unroll
                    for (int db = 0; db < 2; ++db) {
                        const f16x4 lo = vlo[s2 * 2 + db], hh = vhh[s2 * 2 + db];
                        const f16x8 af = {lo[0], lo[1], lo[2], lo[3], hh[0], hh[1], hh[2], hh[3]};
                        if (db == 0) o0 = __builtin_amdgcn_mfma_f32_32x32x16_f16(af, bf, o0, 0, 0, 0); else o1 = __builtin_amdgcn_mfma_f32_32x32x16_f16(af, bf, o1, 0, 0, 0);
                    }
                }
            };
#pragma unroll 1
            for (int kbk = kb0; kbk < 5; kbk += 2) { step(kbk, kA, vA); if (kbk + 1 < 5) step(kbk + 1, kB, vB); }
            if (pass < 2) {
                f32x4* po = (f32x4*)(sto + sidx * 32);
#pragma unroll
                for (int g = 0; g < 4; ++g) { po[g] = (f32x4){o0[4 * g], o0[4 * g + 1], o0[4 * g + 2], o0[4 * g + 3]}; po[4 + g] = (f32x4){o1[4 * g], o1[4 * g + 1], o1[4 * g + 2], o1[4 * g + 3]}; }
                *(f32x2*)(stml + sidx * 2) = (f32x2){m, l};
            } else {
                l += __shfl_xor(l, 32); const float inv = 1.f / l;
                f16* orow = ATT + (rowbase + t) * DM + 512 + h * 64;
#pragma unroll
                for (int g = 0; g < 4; ++g) {
                    u32x2 w0, w1;
                    w0.x = pk_f16(o0[4 * g] * inv, o0[4 * g + 1] * inv); w0.y = pk_f16(o0[4 * g + 2] * inv, o0[4 * g + 3] * inv);
                    w1.x = pk_f16(o1[4 * g] * inv, o1[4 * g + 1] * inv); w1.y = pk_f16(o1[4 * g + 2] * inv, o1[4 * g + 3] * inv);
                    *(u32x2*)(orow + 8 * g + 4 * hi) = w0; *(u32x2*)(orow + 32 + 8 * g + 4 * hi) = w1;
                }
            }
        }
        asm volatile("s_waitcnt vmcnt(0) lgkmcnt(0)" ::: "memory");
        __syncthreads();
    }
}
}
#ifndef USE_MFMA_MOBA
#define USE_MFMA_MOBA 1
#endif
#ifndef USE_MFMA_MLA
#define USE_MFMA_MLA 1
#endif
#ifndef USE_MFMA_SB
#define USE_MFMA_SB 1
#endif
#ifndef USE_MFMA_DIL
#define USE_MFMA_DIL 1
#endif
#ifndef REP_MOBA
#define REP_MOBA 1
#endif
#ifndef REP_DIL
#define REP_DIL 1
#endif
#ifndef REP_MLA
#define REP_MLA 1
#endif
#ifndef REP_SB
#define REP_SB 1
#endif
#ifndef REP_P0
#define REP_P0 1
#endif
#ifndef REP_THIN
#define REP_THIN 1
#endif
#ifndef REP_INPROJ
#define REP_INPROJ 1
#endif
#ifndef REP_OUTPROJ
#define REP_OUTPROJ 1
#endif
#ifndef REP_FUP
#define REP_FUP 1
#endif
#ifndef REP_FDN
#define REP_FDN 1
#endif
#ifndef PROBE_XBAR
#define PROBE_XBAR 0
#endif
#ifndef HALO_IN_THIN1
#define HALO_IN_THIN1 0
#endif
#ifndef HALO_IN_FUP
#define HALO_IN_FUP 1
#endif
#ifndef PROBE_PM
#define PROBE_PM 0
#endif
#ifndef DEFER_W
#ifndef P0_SPLIT
#define P0_SPLIT 0
#endif
#define DEFER_W 1
#endif
#ifndef PROBE_STAMP
#define PROBE_STAMP (-1)
#endif
#ifndef PROBE_BLK
#define PROBE_BLK 0
#endif
#ifndef PROBE_FUP
#define PROBE_FUP 0
#endif
#ifndef SEAM_FUSE
#define SEAM_FUSE 2
#endif
#ifndef MK_SPLIT
#define MK_SPLIT 0
#endif
constexpr int N_PHASES = 2 + DEPTH * 12;

__device__ __forceinline__ void panel_wait(unsigned* cnt, unsigned want, int tid) {
    if (tid < 64) { unsigned spins = 0;
        while ((unsigned)__builtin_amdgcn_readfirstlane(__hip_atomic_load(cnt, __ATOMIC_RELAXED, __HIP_MEMORY_SCOPE_AGENT)) < want) { __builtin_amdgcn_s_sleep(2); if (++spins > (1u << 16)) break; }
        __builtin_amdgcn_fence(__ATOMIC_ACQUIRE, "agent");
        asm volatile("s_waitcnt vmcnt(0)" ::: "memory"); }
    __syncthreads();
}
__device__ __forceinline__ int lane_now() { int l; asm volatile("v_mbcnt_lo_u32_b32 %0, -1, 0\n\tv_mbcnt_hi_u32_b32 %0, -1, %0" : "=v"(l)); return l; }
__global__ void __launch_bounds__(NTHR, 2) fwd_kernel(Args a) {
    extern __shared__ __attribute__((aligned(16))) unsigned char lds_raw[];
    LAS unsigned char* lds = (LAS unsigned char*)lds_raw;
    const int wave0 = __builtin_amdgcn_readfirstlane((int)threadIdx.x >> 6);
#define TID_NOW (wave0 * 64 + lane_now())
    const int bid = blockIdx.x, G = gridDim.x; const int NGT = G * NTHR;
    for (int u = TID_NOW; u < (LDS_BYTES - LDSCTL_OFF) / 4; u += NTHR) ((LAS unsigned*)(lds + LDSCTL_OFF))[u] = 0u;
    __syncthreads();
    volatile LAS unsigned* MISC = (volatile LAS unsigned*)(lds + MISC_OFF);
    XcdBarrier bar = xcd_barrier_post((unsigned*)(a.ws + WS_CTL) + CW_BAR, MISC + 8, TID_NOW);
    const int lo = a.ph_lo, hi = a.ph_hi; const bool seams = (hi - lo) > 1;
    int ph = 0;
    unsigned long long pacc = 0ull; int pkind = 0; (void)pkind;
    unsigned char* const ws0 = a.ws;
#define X16B ((f16*)(ws + WS_R2 + 32 * MiB))
#define X16 ((f16*)xout0)
#define MOD ((float*)(ws + WS_MOD))
#define H ((f16*)(ws + WS_H))
#define ATT ((f16*)(ws + WS_ATT))
#define HHALO ((f16*)(ws + WS_HHALO))
#define PROJ ((f16*)(ws + WS_R1))
#define Qb ((f16*)(ws + WS_R2))
#define KVb ((f16*)(ws + WS_R2 + 24 * MiB))
#define KPE ((f16*)(ws + WS_R2 + 56 * MiB))
#define rc ((const float*)(ws + WS_ROPE))
#define rs (((const float*)(ws + WS_ROPE)) + SEQ * 16)
#define ctl ((unsigned*)(ws + WS_CTL))
#define Y1 ((f16*)(ws + WS_R2))
#define Y2 ((f16*)(ws + WS_R2))
#define ACT ((f16*)(ws + WS_R1))
    float* const xout0 = a.out;
#define PH_ON (lo <= ph && ph < hi)
#define PH_LOC int tid = TID_NOW; asm volatile("" : "+v"(tid)); const int gt = bid * NTHR + tid; (void)gt; unsigned char* ws = ws0; asm volatile("" : "+s"(ws)); const unsigned long long t_ph0 = (PROBE_STAMP >= 0) ? rt() : 0ull; (void)t_ph0
#define PH_END do { const unsigned long long t1_ = (PROBE_STAMP >= 0) ? rt() : 0ull; if (seams) xcd_barrier(bar, TID_NOW); if (PROBE_STAMP >= 0) { const unsigned long long t2_ = rt(); if (PROBE_STAMP == 0) pacc += t2_ - t1_; else if (PROBE_STAMP == 20) pacc += t2_ - t_ph0; else if (PROBE_STAMP >= 100) { if (pkind == PROBE_STAMP - 100) pacc += t2_ - t1_; } else if (pkind == PROBE_STAMP) pacc += t1_ - t_ph0; } } while (0)

    pkind = 1;
    const int nmodw = (P0_SPLIT && DEFER_W && G >= 192) ? 96 : 0;
    if (PH_ON) { PH_LOC;
        if (nmodw == 0) { for (int ll = 0; ll < (DEFER_W ? 1 : DEPTH); ++ll) layer_mod(a, lds, tid, bid, G, ll); }
        else if (bid < nmodw) layer_mod(a, lds, tid, bid, nmodw, 0);
        else { layer_weights(a, lds, tid, bid - nmodw, G - nmodw, 0, 3); p0_misc(a, tid, bid - nmodw, G - nmodw); }
        PH_END; } ++ph;
    pkind = 2;
    if (PH_ON) { PH_LOC; if (gt < BATCH * 16 * 512) ((float*)(ws + WS_KMEAN))[gt] = 0.f;
        if (nmodw == 0) { for (int ll = 0; ll < (DEFER_W ? 1 : DEPTH); ++ll) { layer_weights(a, lds, tid, bid, G, ll, 3); __syncthreads(); } p0_misc(a, tid, bid, G); }
        __syncthreads();
        thin_phase<true, false, false, true>(a.in[I_X], nullptr, X16, nullptr, nullptr, nullptr, nullptr, a.in[I_MIXPRE], MOD, H, nullptr, lds, tid, bid * NWAVES + (tid >> 6), G * NWAVES); PH_END; } ++ph;

    for (int l = 0; l < DEPTH; ++l) {
        const int li = l >> 1; const bool odd = (l & 1) != 0;
#define modl (MOD + (size_t)l * BATCH * 6144)
        for (int xb = 0; xb < PROBE_XBAR; ++xb) if (seams) xcd_barrier(bar, TID_NOW);
        pkind = 3;
        if (PH_ON) { PH_LOC;
            const int N = odd ? CD_INP : AB_IN;
            const f16* Bt = odd ? (const f16*)(ws + WS_W_INCD) + (size_t)li * CD_INP * DM : (const f16*)(ws + WS_W_INAB) + (size_t)li * AB_IN * DM;
            pg8::Gemm g{H, Bt, M, N, DM, DM}; pg8::StaticOrder S; S.init(M, N, G, bid);
            pg8::EpiF16 E{PROJ, N, 0, nullptr, 0, odd ? nullptr : (float*)(ws + WS_KMEAN), 512, 1024, odd ? (PG8_LAS float*)(lds + XCH_OFF) : (PG8_LAS float*)nullptr, KPE, rc, rs, nullptr};
            for (int rep = 0; rep < REP_INPROJ; ++rep) pg8::gemm_phase<pg8::EpiF16, pg8::StaticOrder, true, true>(lds, g, S, E, tid);
            if (DEFER_W && odd) {
                const int total = (M / 256) * (N / 256), rounds = (total + G - 1) / G; int first_short = total - (rounds - 1) * G; if (first_short >= G) first_short = 0;
                if (bid >= first_short) { const int tid2 = TID_NOW; layer_weights(a, lds, tid2, bid - first_short, G - first_short, l, 2); if (l == 1) layer_weights(a, lds, tid2, bid - first_short, G - first_short, 2, 2); }
            }
            PH_END; } ++ph;
        pkind = 4;
        if (PH_ON) { PH_LOC;
            (void)tid; } ++ph;
        if (PH_ON) { PH_LOC;
            if (odd) {
                pg8::Gemm g{PROJ, (const f16*)(ws + WS_W_UP2) + (size_t)li * UP_N * UP_K, M, UP_N, UP_K, CD_INP}; pg8::UpOrder S; S.init(M, UP_N, G, bid, QW / 256);
                pg8::EpiF16 E{Qb, QW, QW, KVb, KVW, nullptr, 0, 0, nullptr, nullptr, nullptr, nullptr, nullptr};
                pg8::gemm_phase<pg8::EpiF16, pg8::UpOrder, true, true>(lds, g, S, E, tid);
                PH_END; }
        } ++ph;
        pkind = odd ? 6 : 5;
        if (PH_ON) { PH_LOC;
            const int vcu = (G % 8 == 0) ? (bid % 8) * (G / 8) + bid / 8 : bid;
            if (!odd) {
#pragma unroll 1
                for (int step = 0; step < 2; ++step) {
                    if ((step == 0) == ((vcu & 1) != 0)) {
                        for (int u = vcu; u < 256; u += G) { const int bh = u >> 3, sp = u & 7;
                            dil::dilated_unit(lds, PROJ, a.in[I_RELB], ATT, (float*)(ws + WS_R2), (float*)(ws + WS_R2 + 32 * MiB), (float*)(ws + WS_H), (float*)(ws + WS_R2 + 34 * MiB), bh >> 3, bh & 7, sp, tid); }
                    } else {
                        for (int p = vcu; p < 256; p += G) { const int bh = p >> 3, s = p & 7, b = bh >> 3, h = bh & 7;
                            att::Src T{PROJ + h * 64, AB_IN, PROJ + 512 + h * 64, AB_IN, nullptr, PROJ + 1024 + h * 64, AB_IN, ATT + h * 64};
                            att::attn_unit<1>(lds, T, b, h, s, rc, rs, (const float*)(ws + WS_KMEAN), a.in[I_RELB], tid);
                            att::attn_unit<1>(lds, T, b, h, 15 - s, rc, rs, (const float*)(ws + WS_KMEAN), a.in[I_RELB], tid); }
                    }
                }
            } else {
#if USE_MFMA_MLA
                for (int rep = 1; rep < REP_MLA; ++rep)
                for (int p = vcu; p < 256; p += G) { const int bh = p >> 3, s = p & 7, b = bh >> 3, h = bh & 7;
                    att::Src T{Qb + h * 96, QW, KVb + h * 128, KVW, KPE, KVb + h * 128 + 64, KVW, ATT + h * 64};
                    att::attn_unit<0, PROBE_PM>(lds, T, b, h, s, rc, rs, nullptr, nullptr, tid);
                    att::attn_unit<0, PROBE_PM>(lds, T, b, h, 15 - s, rc, rs, nullptr, nullptr, tid); }
                for (int p = vcu; p < 256; p += G) { const int bh = p >> 3, s = p & 7, b = bh >> 3, h = bh & 7;
                    att::Src T{Qb + h * 96, QW, KVb + h * 128, KVW, KPE, KVb + h * 128 + 64, KVW, ATT + h * 64};
                    att::attn_unit<0>(lds, T, b, h, s, rc, rs, nullptr, nullptr, tid);
                    att::attn_unit<0>(lds, T, b, h, 15 - s, rc, rs, nullptr, nullptr, tid); }
#else
                naive_mla(Qb, KVb, KPE, rc, rs, ATT, gt, NGT);
#endif
#if USE_MFMA_SB
                for (int rep = 0; rep < REP_SB; ++rep)
                for (int p = vcu; p < 256; p += G) { const int bh = p >> 3, s = p & 7, b = bh >> 3, h = bh & 7;
                    att::Src T{PROJ + 544 + h * 64, CD_INP, PROJ + 1056 + h * 64, CD_INP, nullptr, PROJ + 1568 + h * 64, CD_INP, ATT + 512 + h * 64};
                    att::attn_unit<2>(lds, T, b, h, s, rc, rs, nullptr, nullptr, tid);
                    att::attn_unit<2>(lds, T, b, h, 15 - s, rc, rs, nullptr, nullptr, tid); }
#else
                naive_sb(PROJ, ATT, gt, NGT);
#endif
            }
            PH_END; } ++ph;
        pkind = 7;
        if (PH_ON) { PH_LOC;
            const f16* Bt = odd ? (const f16*)(ws + WS_W_OUTCD) + (size_t)li * DM * DM : (const f16*)(ws + WS_W_OUTAB) + (size_t)li * DM * DM;
            pg8::Gemm g{ATT, Bt, M, DM, DM, DM}; pg8::StaticOrder S; S.init(M, DM, G, bid);
#if SEAM_FUSE == 2
            if (G == 256) {
                pg8::EpiRow ER{X16, (l + 1 == DEPTH) ? X16B : X16, nullptr, modl + 2 * DM, a.in[I_MIXPOST] + l * DM, a.in[I_FFNPRE] + l * DM, modl + 3 * DM, H, HHALO,
                               (float*)(ws + WS_XB), (float*)(ws + WS_XB + 256 * 1024), ctl + CW_PANEL + 64 * (((2 * l + 0) * 2 + 0) * 64), ctl + CW_PANEL + 64 * (((2 * l + 0) * 2 + 1) * 64)};
                pg8::gemm_phase<pg8::EpiRow, pg8::StaticOrder, false, true>(lds, g, S, ER, tid);
            } else
#endif
            {
            const bool fuse = SEAM_FUSE == 1 && G == 256;
            unsigned* pc = ctl + CW_PANEL + 64 * ((2 * l + 0) * 64);
            pg8::EpiF16 E{Y1, DM, 0, nullptr, 0, nullptr, 0, 0, nullptr, nullptr, nullptr, nullptr, fuse ? pc : nullptr};
            pg8::gemm_phase<pg8::EpiF16, pg8::StaticOrder, true, true>(lds, g, S, E, tid);
            if (fuse) { pg8::Unit u; S.next(0, u);
                panel_wait(pc + 64 * u.pm, 32u, tid);
                thin_phase<false, true, false, true>(nullptr, X16, (l + 1 == DEPTH) ? X16B : X16, nullptr, Y1, modl + 2 * DM, a.in[I_MIXPOST] + l * DM, a.in[I_FFNPRE] + l * DM, modl + 3 * DM, H, HHALO, lds, tid,
                                                     u.pm * 256 + u.pn * 64 + (tid >> 6), NWAVES, u.pm * 256 + u.pn * 64 + 64); }
            }
            PH_END; } ++ph;
        pkind = 2;
        if (PH_ON) { PH_LOC;
            if (!(SEAM_FUSE != 0 && G == 256)) {
            const float* gpost = a.in[I_MIXPOST] + l * DM; const float* gpre = a.in[I_FFNPRE] + l * DM;
            thin_phase<false, true, false, true>(nullptr, X16, (l + 1 == DEPTH) ? X16B : X16, nullptr, Y1, modl + 2 * DM, gpost, gpre, modl + 3 * DM, H, HHALO, lds, tid, bid * NWAVES + (tid >> 6), G * NWAVES);
            PH_END; } } ++ph;
#if !HALO_IN_FUP
        if (PH_ON) { PH_LOC;
            pg8::Gemm g{HHALO, (const f16*)(ws + WS_W_FUP) + (size_t)l * DFF2 * DM, 256, DFF2, DM, DM}; pg8::StaticOrder S; S.init(256, DFF2, G, bid);
            pg8::EpiF32 E{(float*)(ws + WS_UHALO), DFF2, 128};
            pg8::gemm_phase<pg8::EpiF32, pg8::StaticOrder, true, true>(lds, g, S, E, tid);
            PH_END; }
#endif
        ++ph;
        pkind = 8;
        if (PH_ON) { PH_LOC;
            pg8::Gemm g{H, (const f16*)(ws + WS_W_FUP) + (size_t)l * DFF2 * DM, M, DFF2, DM, DM};
#if HALO_IN_FUP
            pg8::FfnUpOrder S; S.init(M, DFF2, G, bid);
            pg8::EpiConv E{ACT, (float*)(ws + WS_UHALO), a.in[I_CONVW] + (size_t)l * 3 * DFF2, a.in[I_CONVB] + (size_t)l * DFF2, (PG8_LAS float*)(lds + XCH_OFF), (PG8_LAS float*)(lds + XCH_OFF + 8192), ctl + CW_HALO + 64 * 22 * l, M / 256};
            pg8::gemm_phase<pg8::EpiConv, pg8::FfnUpOrder, true, true>(lds, g, S, E, tid);
#if PROBE_FUP == 1
            pg8::gemm_phase<pg8::EpiConv, pg8::FfnUpOrder, true, true>(lds, g, S, E, tid);
#elif PROBE_FUP == 3
            { pg8::StaticOrder S2; S2.init(M, DFF2, G, bid); pg8::EpiNull E2{}; pg8::gemm_phase<pg8::EpiNull, pg8::StaticOrder, true, true>(lds, g, S2, E2, tid); }
#elif PROBE_FUP == 2
            { pg8::StaticOrder S2; S2.init(M, DFF2, G, bid); pg8::EpiF16 E2{(f16*)(ws + WS_R2), 1024, 0, nullptr, 0, nullptr, 0, 0, nullptr, nullptr, nullptr, nullptr, nullptr};
              pg8::gemm_phase<pg8::EpiF16, pg8::StaticOrder, true, true>(lds, g, S2, E2, tid); }
#endif
            if (DEFER_W && l + 1 < DEPTH) {
                const int total = (M / 256) * (DFF2 / 256) + DFF2 / 256, rounds = (total + G - 1) / G; int first_short = total - (rounds - 1) * G; if (first_short >= G) first_short = 0;
                if (bid >= first_short) { const int tid2 = TID_NOW;
                    layer_mod(a, lds, tid2, bid - first_short, G - first_short, l + 1); layer_weights(a, lds, tid2, bid - first_short, G - first_short, l + 1, 1); }
            }
#else
            pg8::StaticOrder S; S.init(M, DFF2, G, bid);
            pg8::EpiConv E{ACT, (float*)(ws + WS_UHALO), a.in[I_CONVW] + (size_t)l * 3 * DFF2, a.in[I_CONVB] + (size_t)l * DFF2, (PG8_LAS float*)(lds + XCH_OFF), (PG8_LAS float*)(lds + XCH_OFF + 8192), ctl + CW_HALO, -1};
            for (int rep = 0; rep < REP_FUP; ++rep) pg8::gemm_phase<pg8::EpiConv, pg8::StaticOrder, true, true>(lds, g, S, E, tid);
#endif
            PH_END; } ++ph;
        ++ph; ++ph;
        pkind = 9;
        if (PH_ON) { PH_LOC;
            pg8::Gemm g{ACT, (const f16*)(ws + WS_W_FDN) + (size_t)l * DM * DFF, M, DM, DFF, DFF}; pg8::StaticOrder S; S.init(M, DM, G, bid);
#if SEAM_FUSE == 2
            if (G == 256) {
                const int ln2 = (l + 1 < DEPTH) ? l + 1 : l; const bool last = l + 1 == DEPTH;
                pg8::EpiRow ER{last ? X16B : X16, last ? (f16*)nullptr : X16, last ? xout0 : (float*)nullptr, modl + 5 * DM, a.in[I_FFNPOST] + l * DM, a.in[I_MIXPRE] + ln2 * DM, MOD + (size_t)ln2 * BATCH * 6144, H, nullptr,
                               (float*)(ws + WS_XB), (float*)(ws + WS_XB + 256 * 1024), ctl + CW_PANEL + 64 * (((2 * l + 1) * 2 + 0) * 64), ctl + CW_PANEL + 64 * (((2 * l + 1) * 2 + 1) * 64)};
                pg8::gemm_phase<pg8::EpiRow, pg8::StaticOrder, false, true>(lds, g, S, ER, tid);
                if (gt < BATCH * 16 * 512) ((float*)(ws + WS_KMEAN))[gt] = 0.f;
            } else
#endif
            {
            const bool fuse = SEAM_FUSE == 1 && G == 256;
            unsigned* pc = ctl + CW_PANEL + 64 * ((2 * l + 1) * 64);
            pg8::EpiF16 E{Y2, DM, 0, nullptr, 0, nullptr, 0, 0, nullptr, nullptr, nullptr, nullptr, fuse ? pc : nullptr};
            pg8::gemm_phase<pg8::EpiF16, pg8::StaticOrder, true, true>(lds, g, S, E, tid);
            if (fuse) { pg8::Unit u; S.next(0, u);
                panel_wait(pc + 64 * u.pm, 32u, tid);
                const int ln = (l + 1 < DEPTH) ? l + 1 : l; const int r0 = u.pm * 256 + u.pn * 64;
                if (l + 1 < DEPTH) thin_phase<false, true, false, true>(nullptr, X16, X16, nullptr, Y2, modl + 5 * DM, a.in[I_FFNPOST] + l * DM, a.in[I_MIXPRE] + ln * DM, MOD + (size_t)ln * BATCH * 6144, H, nullptr, lds, tid, r0 + (tid >> 6), NWAVES, r0 + 64);
                else thin_phase<false, true, true, false>(nullptr, X16B, nullptr, xout0, Y2, modl + 5 * DM, a.in[I_FFNPOST] + l * DM, nullptr, nullptr, nullptr, nullptr, lds, tid, r0 + (tid >> 6), NWAVES, r0 + 64);
                if (gt < BATCH * 16 * 512) ((float*)(ws + WS_KMEAN))[gt] = 0.f; }
            }
            PH_END; } ++ph;
        pkind = 2;
        if (PH_ON) { PH_LOC;
            if (!(SEAM_FUSE != 0 && G == 256)) {
            const int ln = (l + 1 < DEPTH) ? l + 1 : l;
            if (gt < BATCH * 16 * 512) ((float*)(ws + WS_KMEAN))[gt] = 0.f;
            if (l + 1 < DEPTH) thin_phase<false, true, false, true>(nullptr, X16, X16, nullptr, Y2, modl + 5 * DM, a.in[I_FFNPOST] + l * DM, a.in[I_MIXPRE] + ln * DM, MOD + (size_t)ln * BATCH * 6144, H, nullptr, lds, tid, bid * NWAVES + (tid >> 6), G * NWAVES);
            else thin_phase<false, true, true, false>(nullptr, X16B, nullptr, xout0, Y2, modl + 5 * DM, a.in[I_FFNPOST] + l * DM, nullptr, nullptr, nullptr, nullptr, lds, tid, bid * NWAVES + (tid >> 6), G * NWAVES);
            PH_END; } } ++ph;
    }
    if (PROBE_STAMP >= 0 && bid == PROBE_BLK) { const unsigned long long t0_ = rt(); while (rt() - t0_ < pacc) __builtin_amdgcn_s_sleep(10); }
#undef PH_ON
#undef PH_END
#undef X16
#undef X16B
#undef MOD
#undef H
#undef ATT
#undef HHALO
#undef PROJ
#undef Qb
#undef KVb
#undef KPE
#undef rc
#undef rs
#undef ctl
#undef Y1
#undef Y2
#undef ACT
#undef modl
}

extern "C" void kernel_launch(void* const* d_in, const int* in_sizes, int n_in, void* d_out, int out_size, void* d_ws, size_t ws_size, hipStream_t stream) {
    static int grid = 0;
    if (grid == 0) {
        if (n_in != 21 || in_sizes[0] != M * DM || out_size != M * DM || ws_size < WS_END) { fprintf(stderr, "kernel_launch: unexpected shapes (n_in %d, ws %zu); nothing launched\n", n_in, ws_size); grid = -1; return; }
        int dev = 0, cus = 0, per_cu = 0;
        if (hipGetDevice(&dev) != hipSuccess || hipDeviceGetAttribute(&cus, hipDeviceAttributeMultiprocessorCount, dev) != hipSuccess) { grid = -1; return; }
        if (hipFuncSetAttribute((const void*)fwd_kernel, hipFuncAttributeMaxDynamicSharedMemorySize, LDS_BYTES) != hipSuccess) { fprintf(stderr, "kernel_launch: hipFuncSetAttribute failed\n"); grid = -1; return; }
        if (hipOccupancyMaxActiveBlocksPerMultiprocessor(&per_cu, (const void*)fwd_kernel, NTHR, LDS_BYTES) != hipSuccess || per_cu < 1) { fprintf(stderr, "kernel_launch: occupancy query reports %d\n", per_cu); }
        (void)hipGetLastError();
        grid = cus;
        if (grid < 64) { fprintf(stderr, "kernel_launch: %d CUs: too few\n", cus); grid = -1; return; }
    }
    if (grid < 0) return;
    (void)hipMemsetAsync((char*)d_ws + WS_CTL, 0, CTL_ZERO_BYTES, stream);
    Args a{};
    for (int i = 0; i < 21; ++i) a.in[i] = (const float*)d_in[i];
    a.out = (float*)d_out; a.ws = (unsigned char*)d_ws;
#if MK_SPLIT
    for (int p = 0; p < N_PHASES; ++p) { a.ph_lo = p; a.ph_hi = p + 1; hipLaunchKernelGGL(fwd_kernel, dim3(grid), dim3(NTHR), LDS_BYTES, stream, a); }
#else
    a.ph_lo = 0; a.ph_hi = N_PHASES;
    hipLaunchKernelGGL(fwd_kernel, dim3(grid), dim3(NTHR), LDS_BYTES, stream, a);
#endif
}
```

```cpp
#include <hip/hip_runtime.h>
#include <cstdio>
#include <cstdint>

constexpr int BATCH = 4, SEQ = 4096, DM = 1024, M = BATCH * SEQ, DEPTH = 4;
constexpr int NH = 8, HD = 64;
constexpr int AB_IN = 3072, CD_IN = 2080, CD_INP = 2304;
constexpr int DFF = 2816, DFF2 = 5632;
constexpr int UP_N = 1792, UP_K = 256;
constexpr int QW = 768, KVW = 1024;
constexpr float NORM_EPS = 1e-6f;

typedef _Float16 f16;
typedef _Float16 f16x2 __attribute__((ext_vector_type(2)));
typedef _Float16 f16x4 __attribute__((ext_vector_type(4)));
typedef _Float16 f16x8 __attribute__((ext_vector_type(8)));
typedef float f32x2 __attribute__((ext_vector_type(2)));
typedef float f32x4 __attribute__((ext_vector_type(4)));
typedef unsigned u32x2 __attribute__((ext_vector_type(2)));
typedef unsigned u32x4 __attribute__((ext_vector_type(4)));

__device__ __forceinline__ unsigned pk_f16(float lo, float hi) { f32x2 v = {lo, hi}; f16x2 h = __builtin_convertvector(v, f16x2); return __builtin_bit_cast(unsigned, h); }

constexpr size_t MiB = 1u << 20;
constexpr size_t WS_CTL = 0, CTL_ZERO_BYTES = 1 * MiB;
constexpr size_t WS_MOD = 1 * MiB;
constexpr size_t WS_KMEAN = 1 * MiB + 512 * 1024;
constexpr size_t WS_ROPE = 2 * MiB;
constexpr size_t WS_UHALO = 3 * MiB;
constexpr size_t WS_HHALO = 140 * MiB;
constexpr size_t WS_XB = 6 * MiB;
constexpr size_t WS_W_INAB = 8 * MiB;
constexpr size_t WS_W_OUTAB = 20 * MiB;
constexpr size_t WS_W_INCD = 24 * MiB;
constexpr size_t WS_W_UP2 = 33 * MiB;
constexpr size_t WS_W_OUTCD = 37 * MiB;
constexpr size_t WS_W_FUP = 41 * MiB;
constexpr size_t WS_W_FDN = 85 * MiB;
constexpr size_t WS_H = 108 * MiB;
constexpr size_t WS_ATT = 140 * MiB;
constexpr size_t WS_R2 = 172 * MiB;
constexpr size_t WS_R1 = 236 * MiB;
constexpr size_t WS_END = 332 * MiB;
constexpr int CW_BAR = 4096;
constexpr int CW_PANEL = 32768;
constexpr int CW_HALO = 16384;
namespace pg8 {
#define PG8_LAS __attribute__((address_space(3)))
constexpr int BM = 256, BK = 64, HALF = 128, HTB = HALF * BK * 2  , STAGE_BYTES = 8 * HTB, NXCD = 8, WGM = 8;

__host__ __device__ __forceinline__ int lds_byte(int r, int c) { const int st = (r >> 4) * 2 + (c >> 5), rr = r & 15, cc = c & 31, ob = rr * 64 + cc * 2; return st * 1024 + (ob ^ (((ob >> 9) & 1) << 5)); }
__host__ __device__ __forceinline__ void stage_rc(int b, int& R, int& C) { const int st = b / 1024, sb = b % 1024, swz = sb ^ (((sb >> 9) & 1) << 5); R = (st >> 1) * 16 + swz / 64; C = (st & 1) * 32 + (swz % 64) / 2; }
__host__ __device__ __forceinline__ int perm32(int rho) { const int n = rho >> 4, i = rho & 15; return 8 * (i >> 2) + 4 * n + (i & 3); }

struct Unit { int pm, pn; };
struct Gemm { const f16* A; const f16* Bt; int M, N, K, lda; };

struct StaticOrder {
    int nM, nN, nwg, G, c;
    __host__ __device__ __forceinline__ void init(int M_, int N_, int G_, int c_) { nM = M_ / BM; nN = N_ / BM; nwg = nM * nN; G = G_; c = c_; }
    __host__ __device__ __forceinline__ void map(int wgid, Unit& u) const {
        { const int q = nwg / NXCD, r = nwg % NXCD, xcd = wgid % NXCD, off = wgid / NXCD; wgid = (xcd < r ? xcd * (q + 1) : r * (q + 1) + (xcd - r) * q) + off; }
        const int nig = WGM * nN, gid = wgid / nig, fm = gid * WGM, gsz = (nM - fm) < WGM ? (nM - fm) : WGM;
        u.pm = fm + ((wgid % nig) % gsz); u.pn = (wgid % nig) / gsz;
    }
    __host__ __device__ __forceinline__ bool next(int i, Unit& u) const { const long L = (long)i * G + c; if (L >= nwg) return false; map((int)L, u); return true; }
    __device__ __forceinline__ void a_ready(const Unit&) const {}
    __device__ __forceinline__ void done(const Unit&) const {}
    __device__ __forceinline__ size_t a_off(const Unit&) const { return 0; }
};

struct FfnUpOrder {
    StaticOrder S; int nh;
    __host__ __device__ __forceinline__ void init(int M_, int N_, int G_, int c_) { S.init(M_, N_, G_, c_); nh = N_ / BM; }
    __host__ __device__ __forceinline__ bool next(int i, Unit& u) const { const long L = (long)i * S.G + S.c; if (L >= S.nwg + nh) return false; if (L < nh) { u.pm = S.nM; u.pn = (int)L; return true; } S.map((int)L - nh, u); return true; }
    __device__ __forceinline__ void a_ready(const Unit&) const {}
    __device__ __forceinline__ void done(const Unit&) const {}
    __device__ __forceinline__ size_t a_off(const Unit&) const { return 0; }
};

struct UpOrder {
    StaticOrder S; int split_pn;
    __host__ __device__ __forceinline__ void init(int M_, int N_, int G_, int c_, int sp) { S.init(M_, N_, G_, c_); split_pn = sp; }
    __host__ __device__ __forceinline__ bool next(int i, Unit& u) const { return S.next(i, u); }
    __device__ __forceinline__ void a_ready(const Unit&) const {}
    __device__ __forceinline__ void done(const Unit&) const {}
    __device__ __forceinline__ size_t a_off(const Unit& u) const { return u.pn >= split_pn ? 512 : 0; }
};

struct NoPre {};
struct EpiNull {
    static constexpr bool PERM = true, AFTER_DRAIN = false;
    typedef NoPre Pre; __device__ __forceinline__ void prefetch(Pre&, const Unit&, int) const {}
    __device__ __forceinline__ void operator()(const f32x4 (&acc)[2][2][4][2], const Unit&, int, int, int, int, const Pre&) const {
#pragma unroll
        for (int a = 0; a < 2; ++a)
#pragma unroll
            for (int b = 0; b < 2; ++b)
#pragma unroll
                for (int m = 0; m < 4; ++m) asm volatile("" :: "v"(acc[a][b][m][0]), "v"(acc[a][b][m][1]));
    }
};
struct EpiF32 {
    static constexpr bool PERM = false, AFTER_DRAIN = false;
    float* C; int ldc; int row_limit;
    typedef NoPre Pre; __device__ __forceinline__ void prefetch(Pre&, const Unit&, int) const {}
    __device__ __forceinline__ void operator()(const f32x4 (&acc)[2][2][4][2], const Unit& u, int wr, int wc, int fr_in, int fq_in, const Pre&) const {
        int fr = fr_in, fq = fq_in; asm volatile("" : "+v"(fr), "+v"(fq));
        const int row0 = u.pm * BM + wr * 64 + fr, col0 = u.pn * BM + wc * 32 + 4 * fq;
#pragma unroll
        for (int ai = 0; ai < 2; ++ai)
#pragma unroll
            for (int m = 0; m < 4; ++m) { const int row = row0 + ai * HALF + m * 16; if (row >= row_limit) continue; float* rowp = C + (size_t)row * ldc + col0;
#pragma unroll
                for (int bj = 0; bj < 2; ++bj)
#pragma unroll
                    for (int n = 0; n < 2; ++n) *(f32x4*)(rowp + bj * HALF + n * 16) = acc[ai][bj][m][n]; }
    }
};
struct EpiF16 {
    static constexpr bool PERM = true, AFTER_DRAIN = false;
    f16* O; int ldc; int split_col; f16* O2; int ldc2;
    float* ksum; int ks_lo, ks_hi;
    PG8_LAS float* XR; f16* KPE; const float* rc; const float* rs;
    unsigned* pcnt;
    typedef NoPre Pre; __device__ __forceinline__ void prefetch(Pre&, const Unit&, int) const {}
    __device__ __forceinline__ void operator()(const f32x4 (&acc)[2][2][4][2], const Unit& u, int wr, int wc, int fr_in, int fq_in, const Pre&) const {
        int fr = fr_in, fq = fq_in; asm volatile("" : "+v"(fr), "+v"(fq));
        float rsc[2][4];
#pragma unroll
        for (int ai = 0; ai < 2; ++ai)
#pragma unroll
            for (int m = 0; m < 4; ++m) rsc[ai][m] = 1.0f;
        if (XR != nullptr) {
            const bool nt = u.pn < 2;
            if (nt) {
#pragma unroll
                for (int ai = 0; ai < 2; ++ai)
#pragma unroll
                    for (int m = 0; m < 4; ++m) { float q = 0.f;
#pragma unroll
                        for (int bj = 0; bj < 2; ++bj)
#pragma unroll
                            for (int n = 0; n < 2; ++n) { const f32x4 x = acc[ai][bj][m][n]; q += (x[0] * x[0] + x[1] * x[1]) + (x[2] * x[2] + x[3] * x[3]); }
                        q += __shfl_xor(q, 16); q += __shfl_xor(q, 32);
                        if (fq == 0) XR[(ai * HALF + wr * 64 + m * 16 + fr) * 4 + wc] = q; }
            }
            asm volatile("s_waitcnt lgkmcnt(0)" ::: "memory"); __builtin_amdgcn_s_barrier(); asm volatile("" ::: "memory");
            if (nt) {
#pragma unroll
                for (int ai = 0; ai < 2; ++ai)
#pragma unroll
                    for (int m = 0; m < 4; ++m) { const f32x4 q = *(const PG8_LAS f32x4*)(XR + (ai * HALF + wr * 64 + m * 16 + fr) * 4); rsc[ai][m] = 1.0f / sqrtf(((q[0] + q[1]) + (q[2] + q[3])) * (1.0f / 256.0f) + NORM_EPS); }
            }
            if (u.pn == 2 && wc == 0) {
                const int half = fq >> 1, dd0 = 8 * (fq & 1);
#pragma unroll
                for (int ai = 0; ai < 2; ++ai)
#pragma unroll
                    for (int m = 0; m < 4; ++m) { const int row = u.pm * BM + ai * HALF + wr * 64 + m * 16 + fr, t = row & (SEQ - 1);
#pragma unroll
                        for (int n = 0; n < 2; ++n) { const f32x4 own = acc[ai][0][m][n]; f32x4 par;
#pragma unroll
                            for (int e = 0; e < 4; ++e) par[e] = __shfl_xor(own[e], 32);
                            const f32x4 cs = *(const f32x4*)(rc + t * 16 + dd0 + 4 * n), sn = *(const f32x4*)(rs + t * 16 + dd0 + 4 * n);
                            const f32x4 o = half ? (par * sn + own * cs) : (own * cs - par * sn);
                            u32x2 w; w.x = pk_f16(o[0], o[1]); w.y = pk_f16(o[2], o[3]);
                            *(u32x2*)(KPE + (size_t)row * 32 + 16 * half + dd0 + 4 * n) = w; } }
            }
        }
        if (ksum != nullptr && u.pn * BM >= ks_lo && u.pn * BM < ks_hi) {
#pragma unroll
            for (int bj = 0; bj < 2; ++bj)
#pragma unroll
                for (int n = 0; n < 2; ++n) { f32x4 cs = (acc[0][bj][0][n] + acc[0][bj][1][n]) + (acc[0][bj][2][n] + acc[0][bj][3][n]); cs = cs + ((acc[1][bj][0][n] + acc[1][bj][1][n]) + (acc[1][bj][2][n] + acc[1][bj][3][n]));
#pragma unroll
                    for (int e = 0; e < 4; ++e) { float v = cs[e]; v += __shfl_xor(v, 1); v += __shfl_xor(v, 2); v += __shfl_xor(v, 4); v += __shfl_xor(v, 8);
                        if (fr == 0) atomicAdd(ksum + (size_t)u.pm * (ks_hi - ks_lo) + (u.pn * BM - ks_lo) + bj * HALF + wc * 32 + 8 * fq + 4 * n + e, v); } }
        }
        const int row0 = u.pm * BM + wr * 64 + fr; int colt = u.pn * BM; f16* base = O; int ld = ldc;
        if (split_col && colt >= split_col) { base = O2; ld = ldc2; colt -= split_col; }
        const int col0 = colt + wc * 32 + 8 * fq;
        if (pcnt == nullptr) {
#pragma unroll
            for (int ai = 0; ai < 2; ++ai)
#pragma unroll
                for (int m = 0; m < 4; ++m) { f16* rowp = base + (size_t)(row0 + ai * HALF + m * 16) * ld + col0;
#pragma unroll
                    for (int bj = 0; bj < 2; ++bj) { const f32x4 v0 = acc[ai][bj][m][0] * rsc[ai][m], v1 = acc[ai][bj][m][1] * rsc[ai][m];
                        u32x4 w; w.x = pk_f16(v0[0], v0[1]); w.y = pk_f16(v0[2], v0[3]); w.z = pk_f16(v1[0], v1[1]); w.w = pk_f16(v1[2], v1[3]);
                        *(u32x4*)(rowp + bj * HALF) = w; } }
        } else {
            const __amdgpu_buffer_rsrc_t rsrc = __builtin_amdgcn_make_buffer_rsrc((void*)base, 0, 0x7fffffff, 0x00020000);
#pragma unroll
            for (int ai = 0; ai < 2; ++ai)
#pragma unroll
                for (int m = 0; m < 4; ++m) { const unsigned boff = (unsigned)(((size_t)(row0 + ai * HALF + m * 16) * ld + col0) * 2);
#pragma unroll
                    for (int bj = 0; bj < 2; ++bj) { const f32x4 v0 = acc[ai][bj][m][0] * rsc[ai][m], v1 = acc[ai][bj][m][1] * rsc[ai][m];
                        u32x4 w; w.x = pk_f16(v0[0], v0[1]); w.y = pk_f16(v0[2], v0[3]); w.z = pk_f16(v1[0], v1[1]); w.w = pk_f16(v1[2], v1[3]);
                        __builtin_amdgcn_raw_buffer_store_b128(w, rsrc, boff + bj * HALF * 2, 0, 16); } }
            asm volatile("s_waitcnt vmcnt(0)" ::: "memory");
            if (fr == 0 && fq == 0) __hip_atomic_fetch_add(pcnt + 64 * u.pm, 1u, __ATOMIC_RELAXED, __HIP_MEMORY_SCOPE_AGENT);
        }
    }
};

struct EpiRow {
    static constexpr bool PERM = true, AFTER_DRAIN = true;
    typedef NoPre Pre; __device__ __forceinline__ void prefetch(Pre&, const Unit&, int) const {}
    const f16* xin; f16* xout; float* out32;
    const float* gate_l; const float* gpost;
    const float* gpre; const float* ss_l;
    f16* H; f16* HHALO;
    float* xb1; float* xb2; unsigned* c1; unsigned* c2;
    __device__ __forceinline__ void exchange(float (&q)[2][4], float* xb, unsigned* cnt, const Unit& u, int wr, int wc, int fr, int fq, PG8_LAS unsigned char* lds, int wid, int lane) const {
        PG8_LAS float* P = (PG8_LAS float*)lds;
        PG8_LAS float* S = (PG8_LAS float*)(lds + 8192);
#pragma unroll
        for (int ai = 0; ai < 2; ++ai)
#pragma unroll
            for (int m = 0; m < 4; ++m) { float v = q[ai][m]; v += __shfl_xor(v, 16); v += __shfl_xor(v, 32);
                if (fq == 0) P[(ai * HALF + wr * 64 + m * 16 + fr) * 4 + wc] = v; }
        asm volatile("s_waitcnt lgkmcnt(0)" ::: "memory"); __builtin_amdgcn_s_barrier(); asm volatile("" ::: "memory");
        const int row = wid * 32 + (lane & 31);
        if (lane < 32) { const f32x4 p = *(const PG8_LAS f32x4*)(P + row * 4);
            __hip_atomic_store((unsigned*)(xb + ((size_t)(u.pm * BM + row)) * 4 + u.pn), __builtin_bit_cast(unsigned, (p[0] + p[1]) + (p[2] + p[3])), __ATOMIC_RELAXED, __HIP_MEMORY_SCOPE_AGENT); }
        asm volatile("s_waitcnt vmcnt(0)" ::: "memory");
        if (lane == 0) __hip_atomic_fetch_add(cnt + 64 * u.pm, 1u, __ATOMIC_RELAXED, __HIP_MEMORY_SCOPE_AGENT);
        if (wid == 0) { unsigned spins = 0;
            while ((unsigned)__builtin_amdgcn_readfirstlane(__hip_atomic_load(cnt + 64 * u.pm, __ATOMIC_RELAXED, __HIP_MEMORY_SCOPE_AGENT)) < 32u) { __builtin_amdgcn_s_sleep(1); if (++spins > (1u << 16)) break; }
            __builtin_amdgcn_fence(__ATOMIC_ACQUIRE, "agent"); }
        asm volatile("s_waitcnt vmcnt(0) lgkmcnt(0)" ::: "memory"); __builtin_amdgcn_s_barrier(); asm volatile("" ::: "memory");
        if (lane < 32) { const unsigned* sl = (const unsigned*)(xb + ((size_t)(u.pm * BM + row)) * 4); float t = 0.f;
#pragma unroll
            for (int k = 0; k < 4; ++k) t += __builtin_bit_cast(float, __hip_atomic_load(sl + k, __ATOMIC_RELAXED, __HIP_MEMORY_SCOPE_AGENT));
            S[row] = t; }
        asm volatile("s_waitcnt lgkmcnt(0)" ::: "memory"); __builtin_amdgcn_s_barrier(); asm volatile("" ::: "memory");
#pragma unroll
        for (int ai = 0; ai < 2; ++ai)
#pragma unroll
            for (int m = 0; m < 4; ++m) q[ai][m] = S[ai * HALF + wr * 64 + m * 16 + fr];
        asm volatile("s_waitcnt lgkmcnt(0)" ::: "memory"); __builtin_amdgcn_s_barrier(); asm volatile("" ::: "memory");
    }
    __device__ __forceinline__ void fused(f32x4 (&acc)[2][2][4][2], const Unit& u, int wr, int wc, int fr, int fq, PG8_LAS unsigned char* lds, int wid, int lane) const {
        const int b = (u.pm * BM) / SEQ;
        const int row0 = u.pm * BM + wr * 64 + fr, col0 = u.pn * BM + wc * 32 + 8 * fq;
        float q[2][4];
#pragma unroll
        for (int ai = 0; ai < 2; ++ai)
#pragma unroll
            for (int m = 0; m < 4; ++m) { float v = 0.f;
#pragma unroll
                for (int bj = 0; bj < 2; ++bj)
#pragma unroll
                    for (int n = 0; n < 2; ++n) { const f32x4 x = acc[ai][bj][m][n]; v += (x[0] * x[0] + x[1] * x[1]) + (x[2] * x[2] + x[3] * x[3]); }
                q[ai][m] = v; }
        exchange(q, xb1, c1, u, wr, wc, fr, fq, lds, wid, lane);
#pragma unroll
        for (int ai = 0; ai < 2; ++ai)
#pragma unroll
            for (int m = 0; m < 4; ++m) q[ai][m] = 1.0f / sqrtf(q[ai][m] * (1.0f / 1024.0f) + NORM_EPS);
#pragma unroll
        for (int bj = 0; bj < 2; ++bj) {
            const int col = col0 + bj * HALF;
            const f32x4 ta0 = *(const f32x4*)(gate_l + (size_t)b * 6144 + col) * *(const f32x4*)(gpost + col), ta1 = *(const f32x4*)(gate_l + (size_t)b * 6144 + col + 4) * *(const f32x4*)(gpost + col + 4);
#pragma unroll
            for (int ai = 0; ai < 2; ++ai)
#pragma unroll
                for (int m = 0; m < 4; ++m) { const size_t off = (size_t)(row0 + ai * HALF + m * 16) * 1024 + col;
                    const f16x8 xh = *(const f16x8*)(xin + off);
                    f32x4 x0 = {(float)xh[0], (float)xh[1], (float)xh[2], (float)xh[3]}, x1 = {(float)xh[4], (float)xh[5], (float)xh[6], (float)xh[7]};
                    x0 = x0 + ta0 * (acc[ai][bj][m][0] * q[ai][m]); x1 = x1 + ta1 * (acc[ai][bj][m][1] * q[ai][m]);
                    if (out32 != nullptr) { *(f32x4*)(out32 + off) = x0; *(f32x4*)(out32 + off + 4) = x1; }
                    else { u32x4 w; w.x = pk_f16(x0[0], x0[1]); w.y = pk_f16(x0[2], x0[3]); w.z = pk_f16(x1[0], x1[1]); w.w = pk_f16(x1[2], x1[3]);
                        *(u32x4*)(xout + off) = w;
                        const f16x8 r = __builtin_bit_cast(f16x8, w);
                        x0 = (f32x4){(float)r[0], (float)r[1], (float)r[2], (float)r[3]}; x1 = (f32x4){(float)r[4], (float)r[5], (float)r[6], (float)r[7]}; }
                    acc[ai][bj][m][0] = x0; acc[ai][bj][m][1] = x1; }
            asm volatile("" ::: "memory");
        }
        if (out32 != nullptr) return;
#pragma unroll
        for (int ai = 0; ai < 2; ++ai)
#pragma unroll
            for (int m = 0; m < 4; ++m) { float v = 0.f;
#pragma unroll
                for (int bj = 0; bj < 2; ++bj)
#pragma unroll
                    for (int n = 0; n < 2; ++n) { const f32x4 x = acc[ai][bj][m][n]; v += (x[0] * x[0] + x[1] * x[1]) + (x[2] * x[2] + x[3] * x[3]); }
                q[ai][m] = v; }
        exchange(q, xb2, c2, u, wr, wc, fr, fq, lds, wid, lane);
#pragma unroll
        for (int ai = 0; ai < 2; ++ai)
#pragma unroll
            for (int m = 0; m < 4; ++m) q[ai][m] = 1.0f / sqrtf(q[ai][m] * (1.0f / 1024.0f) + NORM_EPS);
#pragma unroll
        for (int bj = 0; bj < 2; ++bj) {
            const int col = col0 + bj * HALF; const float* sp = ss_l + (size_t)b * 6144 + col;
            const f32x4 tb0 = *(const f32x4*)(gpre + col) * (*(const f32x4*)(sp + 1024) + 1.0f), tb1 = *(const f32x4*)(gpre + col + 4) * (*(const f32x4*)(sp + 1024 + 4) + 1.0f);
            const f32x4 tc0 = *(const f32x4*)sp, tc1 = *(const f32x4*)(sp + 4);
#pragma unroll
            for (int ai = 0; ai < 2; ++ai)
#pragma unroll
                for (int m = 0; m < 4; ++m) { const int row = row0 + ai * HALF + m * 16;
                    const f32x4 h0 = (acc[ai][bj][m][0] * q[ai][m]) * tb0 + tc0, h1 = (acc[ai][bj][m][1] * q[ai][m]) * tb1 + tc1;
                    u32x4 w; w.x = pk_f16(h0[0], h0[1]); w.y = pk_f16(h0[2], h0[3]); w.z = pk_f16(h1[0], h1[1]); w.w = pk_f16(h1[2], h1[3]);
                    *(u32x4*)(H + (size_t)row * 1024 + col) = w;
                    if (HHALO != nullptr && (row & 255) >= 254 && (((row >> 8) + 1) & 15) != 0) *(u32x4*)(HHALO + (size_t)(2 * ((row >> 8) + 1) + ((row & 255) - 254)) * 1024 + col) = w; }
            asm volatile("" ::: "memory");
        }
    }
};

__device__ __forceinline__ float gelu_tanh_f(float g) { const float u = 0.7978845608028654f * (g + 0.044715f * g * g * g); const float e = __builtin_amdgcn_exp2f(u * 2.885390081777927f); return g * (1.0f - __builtin_amdgcn_rcpf(e + 1.0f)); }
__device__ __forceinline__ f32x2 gelu_mul_pk(f32x2 g, f32x2 v) {
    const f32x2 g2 = g * g, t = g2 * (0.044715f * 2.302208198f) + 2.302208198f, u2 = t * g;
    f32x2 e; e.x = __builtin_amdgcn_exp2f(u2.x); e.y = __builtin_amdgcn_exp2f(u2.y);
    const f32x2 d = e + 1.0f; f32x2 r; r.x = __builtin_amdgcn_rcpf(d.x); r.y = __builtin_amdgcn_rcpf(d.y);
    const f32x2 gv = g * v; return gv - gv * r;
}
template <int N> __device__ __forceinline__ float ror16(float v) { return __builtin_bit_cast(float, __builtin_amdgcn_update_dpp(0, __builtin_bit_cast(int, v), 0x120 + N, 0xf, 0xf, false)); }
__device__ __forceinline__ f32x4 ld_agent_f32x4(const float* p) { typedef unsigned long long u64; const u64 a = __hip_atomic_load((u64*)p, __ATOMIC_RELAXED, __HIP_MEMORY_SCOPE_AGENT), b = __hip_atomic_load((u64*)p + 1, __ATOMIC_RELAXED, __HIP_MEMORY_SCOPE_AGENT);
    return (f32x4){__builtin_bit_cast(float, (unsigned)a), __builtin_bit_cast(float, (unsigned)(a >> 32)), __builtin_bit_cast(float, (unsigned)b), __builtin_bit_cast(float, (unsigned)(b >> 32))}; }
struct EpiConv {
    static constexpr bool PERM = true, AFTER_DRAIN = false;
    f16* ACT; float* UHALO; const float* cw; const float* cb; PG8_LAS float* X;
    PG8_LAS float* WL;
    unsigned* hcnt; int halo_pm;
    struct Pre { float w[2]; unsigned hc; };
    __device__ __forceinline__ void prefetch(Pre& p, const Unit& u, int tid) const {
        if (u.pm == halo_pm) return;
        p.hc = ((u.pm & 15) != 0) ? __hip_atomic_load(hcnt + 64 * u.pn, __ATOMIC_RELAXED, __HIP_MEMORY_SCOPE_AGENT) : 8u;
        asm volatile("" : "+v"(tid));
#pragma unroll
        for (int k = 0; k < 2; ++k) { const int idx = tid + 512 * k, q = idx >> 8, bjw = (idx >> 7) & 1, col = idx & 127; const int oc = bjw * 2816 + u.pn * 128 + col;
            p.w[k] = (q < 3) ? cw[q * 5632 + oc] : cb[oc]; }
    }
    __device__ __forceinline__ void operator()(f32x4 (&acc)[2][2][4][2], const Unit& u, int wr, int wc, int fr_in, int fq_in, const Pre& pre) const {
        int fr = fr_in, fq = fq_in; asm volatile("" : "+v"(fr), "+v"(fq));
        const int lane = fr + 16 * fq;
        const int lc = wc * 32 + 8 * fq;
        if (u.pm == halo_pm) {
#pragma unroll
            for (int m = 0; m < 4; ++m)
#pragma unroll
                for (int bj = 0; bj < 2; ++bj)
#pragma unroll
                    for (int n = 0; n < 2; ++n) *(f32x4*)(UHALO + (size_t)(wr * 64 + m * 16 + fr) * 5632 + u.pn * 256 + bj * 128 + lc + 4 * n) = acc[0][bj][m][n];
            __builtin_amdgcn_fence(__ATOMIC_RELEASE, "agent");
            asm volatile("s_waitcnt vmcnt(0)" ::: "memory");
            if (lane == 0) __hip_atomic_fetch_add(hcnt + 64 * u.pn, 1u, __ATOMIC_RELAXED, __HIP_MEMORY_SCOPE_AGENT);
            return;
        }
        if (wr == 0 && (u.pm & 15) != 0) {
            unsigned c = pre.hc, spins = 0;
            while ((unsigned)__builtin_amdgcn_readfirstlane(c) < 8u) { __builtin_amdgcn_s_sleep(2); c = __hip_atomic_load(hcnt + 64 * u.pn, __ATOMIC_RELAXED, __HIP_MEMORY_SCOPE_AGENT); if (++spins > (1u << 14)) break; }
        }
        {
            const int t512 = (wr * 4 + wc) * 64 + lane;
            WL[t512] = pre.w[0]; WL[t512 + 512] = pre.w[1];
        }
        if (fr >= 14) {
#pragma unroll
            for (int ai = 0; ai < 2; ++ai)
#pragma unroll
                for (int bj = 0; bj < 2; ++bj)
#pragma unroll
                    for (int n = 0; n < 2; ++n) *(PG8_LAS f32x4*)(X + (((2 * ai + wr) * 2 + (fr - 14)) * 2 + bj) * 128 + lc + 4 * n) = acc[ai][bj][3][n];
        }
        asm volatile("s_waitcnt lgkmcnt(0)" ::: "memory"); __builtin_amdgcn_s_barrier(); asm volatile("" ::: "memory");
        const bool batch_start = (u.pm & 15) == 0;
#pragma unroll
        for (int bj = 0; bj < 2; ++bj)
#pragma unroll
            for (int n = 0; n < 2; ++n) {
                asm volatile("" ::: "memory");
                const int cl = bj * 128 + lc + 4 * n;
                const f32x4 w0v = *(const PG8_LAS f32x4*)(WL + 0 * 256 + cl), w1v = *(const PG8_LAS f32x4*)(WL + 1 * 256 + cl), w2v = *(const PG8_LAS f32x4*)(WL + 2 * 256 + cl), bbv = *(const PG8_LAS f32x4*)(WL + 3 * 256 + cl);
                f32x4 hq0[2], hq1[2];
#pragma unroll
                for (int ai = 0; ai < 2; ++ai) { const int g = 2 * ai + wr;
                    if (g > 0) { hq0[ai] = *(const PG8_LAS f32x4*)(X + (((g - 1) * 2 + 0) * 2 + bj) * 128 + lc + 4 * n); hq1[ai] = *(const PG8_LAS f32x4*)(X + (((g - 1) * 2 + 1) * 2 + bj) * 128 + lc + 4 * n); }
                    else if (!batch_start) { const float* hp = UHALO + (size_t)(2 * u.pm) * 5632 + u.pn * 256 + bj * 128 + lc + 4 * n; hq0[ai] = ld_agent_f32x4(hp); hq1[ai] = ld_agent_f32x4(hp + 5632); }
                    else { hq0[ai] = (f32x4){0.f, 0.f, 0.f, 0.f}; hq1[ai] = hq0[ai]; } }
#pragma unroll
                for (int ai = 1; ai >= 0; --ai) {
                    const f32x4 h0v = hq0[ai], h1v = hq1[ai];
#pragma unroll
                    for (int e = 0; e < 4; e += 2) {
                        const f32x2 w0 = {w0v[e], w0v[e + 1]}, w1 = {w1v[e], w1v[e + 1]}, w2 = {w2v[e], w2v[e + 1]}, bb = {bbv[e], bbv[e + 1]}, h0 = {h0v[e], h0v[e + 1]}, h1 = {h1v[e], h1v[e + 1]};
                        f32x2 c1 = {ror16<1>(acc[ai][bj][3][n][e]), ror16<1>(acc[ai][bj][3][n][e + 1])}, c2 = {ror16<2>(acc[ai][bj][3][n][e]), ror16<2>(acc[ai][bj][3][n][e + 1])};
#pragma unroll
                        for (int m = 3; m >= 0; --m) {
                            f32x2 p1, p2;
                            if (m > 0) { p1 = (f32x2){ror16<1>(acc[ai][bj][m - 1][n][e]), ror16<1>(acc[ai][bj][m - 1][n][e + 1])}; p2 = (f32x2){ror16<2>(acc[ai][bj][m - 1][n][e]), ror16<2>(acc[ai][bj][m - 1][n][e + 1])}; }
                            else { p1 = h1; p2 = (fr == 0) ? h0 : h1; }
                            const f32x2 r1 = (fr >= 1) ? c1 : p1, r2 = (fr >= 2) ? c2 : p2;
                            const f32x2 cur = {acc[ai][bj][m][n][e], acc[ai][bj][m][n][e + 1]};
                            const f32x2 o = w0 * r2 + (w1 * r1 + (w2 * cur + bb));
                            acc[ai][bj][m][n][e] = o[0]; acc[ai][bj][m][n][e + 1] = o[1];
                            asm volatile("" : "+v"(acc[ai][bj][m][n]));
                            c1 = p1; c2 = p2;
                        }
                    }
                }
            }
        asm volatile("" ::: "memory");
        const int row0 = u.pm * BM + wr * 64 + fr;
#pragma unroll
        for (int ai = 0; ai < 2; ++ai)
#pragma unroll
            for (int m = 0; m < 4; ++m) {
                const f32x4 g0 = acc[ai][0][m][0], g1 = acc[ai][0][m][1], v0 = acc[ai][1][m][0], v1 = acc[ai][1][m][1];
                const f32x2 a0 = gelu_mul_pk((f32x2){g0[0], g0[1]}, (f32x2){v0[0], v0[1]}), a1 = gelu_mul_pk((f32x2){g0[2], g0[3]}, (f32x2){v0[2], v0[3]});
                const f32x2 a2 = gelu_mul_pk((f32x2){g1[0], g1[1]}, (f32x2){v1[0], v1[1]}), a3 = gelu_mul_pk((f32x2){g1[2], g1[3]}, (f32x2){v1[2], v1[3]});
                u32x4 w; w.x = pk_f16(a0.x, a0.y); w.y = pk_f16(a1.x, a1.y); w.z = pk_f16(a2.x, a2.y); w.w = pk_f16(a3.x, a3.y);
                *(u32x4*)(ACT + (size_t)(row0 + ai * HALF + m * 16) * 2816 + u.pn * 128 + lc) = w;
                asm volatile("" ::: "memory");
            }
    }
};

template <class Epi, class Sched, bool ALIGN_EPI = false, bool SP2 = false>
__device__ __forceinline__ void gemm_phase(PG8_LAS unsigned char* lds, const Gemm g, const Sched& S, const Epi& E, int tid_in) {
    int tid_o = tid_in; asm volatile("" : "+v"(tid_o));
    const int tid = tid_o, wid = __builtin_amdgcn_readfirstlane(tid >> 6), lane = tid & 63, wr = wid >> 2, wc = wid & 3, fr = lane & 15, fq = lane >> 4;
    const int K = g.K, nt = K / BK;
    unsigned voffA[2], voffB[2];
#pragma unroll
    for (int i = 0; i < 2; ++i) { int R, C; stage_rc(tid * 16 + i * 8192, R, C); const int Rb = Epi::PERM ? ((R & ~31) + perm32(R & 31)) : R;
        voffA[i] = (unsigned)(R * g.lda + C) * 2u; voffB[i] = (unsigned)(Rb * K + C) * 2u; }
    const size_t kstep = (size_t)(BK * 2);
    const size_t hstep = (size_t)HALF * K * 2;
    const size_t tstep = 2 * hstep;
    const size_t hstepA = (size_t)HALF * g.lda * 2, tstepA = 2 * hstepA;
    const unsigned ldsw = (unsigned)wid * 1024u;
    const int aoff = lds_byte(wr * 64 + fr, fq * 8), boff = lds_byte(wc * 32 + fr, fq * 8);
#define PG8_SA(b, h) (((b) * 2 + (h)) * HTB)
#define PG8_SB(b, h) ((4 + (b) * 2 + (h)) * HTB)
#define PG8_STAGE(bufoff, gbase, voff) do { _Pragma("unroll") for (int _i = 0; _i < 2; ++_i) \
        __builtin_amdgcn_global_load_lds((const unsigned*)((const char*)(gbase) + (voff)[_i]), (PG8_LAS unsigned*)(lds + (bufoff) + ldsw + _i * 8192), 16, 0, 0); } while (0)
#define PG8_LDA(dst, b, h) do { _Pragma("unroll") for (int m = 0; m < 4; ++m) _Pragma("unroll") for (int k = 0; k < 2; ++k) dst[m][k] = *(const PG8_LAS f16x8*)(lds + PG8_SA(b, h) + aoff + m * 2048 + k * 1024); } while (0)
#define PG8_LDB(dst, b, h) do { _Pragma("unroll") for (int n = 0; n < 2; ++n) _Pragma("unroll") for (int k = 0; k < 2; ++k) dst[n][k] = *(const PG8_LAS f16x8*)(lds + PG8_SB(b, h) + boff + n * 2048 + k * 1024); } while (0)
#define PG8_MMA(ai, bj, At, Bt) do { __builtin_amdgcn_s_setprio(1); _Pragma("unroll") for (int m = 0; m < 4; ++m) _Pragma("unroll") for (int n = 0; n < 2; ++n) _Pragma("unroll") for (int k = 0; k < 2; ++k) \
        acc[ai][bj][m][n] = __builtin_amdgcn_mfma_f32_16x16x32_f16(Bt[n][k], At[m][k], acc[ai][bj][m][n], 0, 0, 0); __builtin_amdgcn_s_setprio(0); } while (0)
#define PG8_WAIT_V(n) asm volatile("s_waitcnt vmcnt(" #n ")" ::: "memory")
#define PG8_WAIT_L(n) asm volatile("s_waitcnt lgkmcnt(" #n ")" ::: "memory")
#define PG8_BAR __builtin_amdgcn_s_barrier()
#define PG8_SCHED __builtin_amdgcn_sched_barrier(0)
    Unit cur, nxt; int ui = 0;
    if (!S.next(0, cur)) return;
    typename Epi::Pre pre; E.prefetch(pre, cur, tid);
    f32x4 acc[2][2][4][2];
#pragma unroll
    for (int a = 0; a < 2; ++a)
#pragma unroll
        for (int b = 0; b < 2; ++b)
#pragma unroll
            for (int m = 0; m < 4; ++m)
#pragma unroll
                for (int n = 0; n < 2; ++n) acc[a][b][m][n] = (f32x4){0.f, 0.f, 0.f, 0.f};
    f16x8 At[4][2], B0[2][2], B1[2][2];
    const char* cA = (const char*)g.A + (size_t)cur.pm * tstepA + S.a_off(cur); const char* cB = (const char*)g.Bt + (size_t)cur.pn * tstep;
    S.a_ready(cur);
    if constexpr (SP2) {
        PG8_STAGE(PG8_SB(0, 0), cB, voffB); PG8_STAGE(PG8_SB(0, 1), cB + hstep, voffB); PG8_STAGE(PG8_SA(0, 0), cA, voffA); PG8_STAGE(PG8_SA(0, 1), cA + hstepA, voffA);
        if (wr == 1) PG8_BAR;
        PG8_WAIT_V(2); PG8_BAR;
        PG8_STAGE(PG8_SB(1, 0), cB + kstep, voffB); PG8_STAGE(PG8_SA(1, 0), cA + kstep, voffA); PG8_STAGE(PG8_SB(1, 1), cB + hstep + kstep, voffB);
        PG8_WAIT_V(6); PG8_BAR;
    } else {
        PG8_STAGE(PG8_SB(0, 0), cB, voffB); PG8_STAGE(PG8_SA(0, 0), cA, voffA); PG8_STAGE(PG8_SB(0, 1), cB + hstep, voffB); PG8_STAGE(PG8_SA(0, 1), cA + hstepA, voffA);
        if (wr == 1) PG8_BAR;
        PG8_WAIT_V(4); PG8_BAR;
        PG8_STAGE(PG8_SB(1, 0), cB + kstep, voffB); PG8_STAGE(PG8_SA(1, 0), cA + kstep, voffA); PG8_STAGE(PG8_SB(1, 1), cB + hstep + kstep, voffB);
        PG8_WAIT_V(6); PG8_BAR;
    }
    for (;;) {
        const bool has_next = S.next(ui + 1, nxt);
        const char* nA = has_next ? (const char*)g.A + (size_t)nxt.pm * tstepA + S.a_off(nxt) : cA; const char* nB = has_next ? (const char*)g.Bt + (size_t)nxt.pn * tstep : cB;
#pragma unroll 1
        for (int t = 0; t < nt; t += 2) {
            const bool last = (t == nt - 2);
            const char* a1 = cA + (size_t)(t + 1) * kstep;
            const char* a2 = last ? nA : cA + (size_t)(t + 2) * kstep; const char* b2 = last ? nB : cB + (size_t)(t + 2) * kstep;
            const char* a3 = a2 + kstep; const char* b3 = b2 + kstep;
            if (last && has_next) S.a_ready(nxt);
            if constexpr (SP2) {
            PG8_LDB(B0, 0, 0); PG8_LDB(B1, 0, 1); PG8_SCHED; PG8_LDA(At, 0, 0); PG8_STAGE(PG8_SA(1, 1), a1 + hstepA, voffA);
            PG8_WAIT_V(8); PG8_WAIT_L(0); PG8_BAR; PG8_MMA(0, 0, At, B0); PG8_MMA(0, 1, At, B1); PG8_BAR; PG8_SCHED;
            PG8_LDA(At, 0, 1); PG8_STAGE(PG8_SB(0, 0), b2, voffB); PG8_STAGE(PG8_SB(0, 1), b2 + hstep, voffB); PG8_STAGE(PG8_SA(0, 0), a2, voffA);
            PG8_WAIT_V(8); PG8_WAIT_L(0); PG8_BAR; PG8_MMA(1, 0, At, B0); PG8_MMA(1, 1, At, B1); PG8_BAR; PG8_SCHED;
            PG8_LDB(B0, 1, 0); PG8_LDB(B1, 1, 1); PG8_SCHED; PG8_LDA(At, 1, 0); PG8_STAGE(PG8_SA(0, 1), a2 + hstepA, voffA);
            PG8_WAIT_V(8); PG8_WAIT_L(0); PG8_BAR; PG8_MMA(0, 0, At, B0); PG8_MMA(0, 1, At, B1); PG8_BAR; PG8_SCHED;
            PG8_LDA(At, 1, 1); PG8_STAGE(PG8_SB(1, 0), b3, voffB); PG8_STAGE(PG8_SB(1, 1), b3 + hstep, voffB); PG8_STAGE(PG8_SA(1, 0), a3, voffA);
            PG8_WAIT_V(8); PG8_WAIT_L(0); PG8_BAR; PG8_MMA(1, 0, At, B0); PG8_MMA(1, 1, At, B1); PG8_BAR; PG8_SCHED;
            } else {
            PG8_LDB(B0, 0, 0); PG8_SCHED; PG8_LDA(At, 0, 0); PG8_STAGE(PG8_SA(1, 1), a1 + hstepA, voffA);
            PG8_WAIT_L(8); PG8_BAR; PG8_WAIT_L(0); PG8_MMA(0, 0, At, B0); PG8_BAR; PG8_SCHED;
            PG8_LDB(B1, 0, 1); PG8_STAGE(PG8_SB(0, 0), b2, voffB);
            PG8_BAR; PG8_WAIT_L(0); PG8_MMA(0, 1, At, B1); PG8_BAR;
            PG8_LDA(At, 0, 1); PG8_STAGE(PG8_SA(0, 0), a2, voffA);
            PG8_BAR; PG8_WAIT_L(0); PG8_MMA(1, 0, At, B0); PG8_BAR; PG8_SCHED;
            PG8_STAGE(PG8_SB(0, 1), b2 + hstep, voffB);
            PG8_WAIT_V(6); PG8_BAR; PG8_MMA(1, 1, At, B1); PG8_BAR;
            PG8_LDB(B0, 1, 0); PG8_SCHED; PG8_LDA(At, 1, 0); PG8_STAGE(PG8_SA(0, 1), a2 + hstepA, voffA);
            PG8_WAIT_L(8); PG8_BAR; PG8_WAIT_L(0); PG8_MMA(0, 0, At, B0); PG8_BAR; PG8_SCHED;
            PG8_LDB(B1, 1, 1); PG8_STAGE(PG8_SB(1, 0), b3, voffB);
            PG8_BAR; PG8_WAIT_L(0); PG8_MMA(0, 1, At, B1); PG8_BAR;
            PG8_LDA(At, 1, 1); PG8_STAGE(PG8_SA(1, 0), a3, voffA);
            PG8_BAR; PG8_WAIT_L(0); PG8_MMA(1, 0, At, B0); PG8_BAR; PG8_SCHED;
            PG8_STAGE(PG8_SB(1, 1), b3 + hstep, voffB);
            PG8_WAIT_V(6); PG8_BAR; PG8_MMA(1, 1, At, B1); PG8_BAR;
            }
        }
        if constexpr (ALIGN_EPI) { if (wr == 0) PG8_BAR; }
        if constexpr (!Epi::AFTER_DRAIN) { E(acc, cur, wr, wc, fr, fq, pre); S.done(cur); }
        if (!has_next) break;
#pragma unroll
        for (int a = 0; a < 2; ++a)
#pragma unroll
            for (int b = 0; b < 2; ++b)
#pragma unroll
                for (int m = 0; m < 4; ++m)
#pragma unroll
                    for (int n = 0; n < 2; ++n) acc[a][b][m][n] = (f32x4){0.f, 0.f, 0.f, 0.f};
        cur = nxt; cA = nA; cB = nB; ++ui; E.prefetch(pre, cur, tid);
        if constexpr (ALIGN_EPI) { if (wr == 1) PG8_BAR; }
    }
    PG8_WAIT_V(0);
    if constexpr (!ALIGN_EPI) { if (wr == 0) PG8_BAR; }
    PG8_BAR;
    if constexpr (Epi::AFTER_DRAIN) { E.fused(acc, cur, wr, wc, fr, fq, lds, wid, lane); S.done(cur); }
#undef PG8_SA
#undef PG8_SB
#undef PG8_STAGE
#undef PG8_LDA
#undef PG8_LDB
#undef PG8_MMA
#undef PG8_WAIT_V
#undef PG8_WAIT_L
#undef PG8_BAR
#undef PG8_SCHED
}
}
#define GAS __attribute__((address_space(1)))
#define LAS __attribute__((address_space(3)))
typedef GAS unsigned gu32;
typedef GAS unsigned long long gu64;
#define RLX_AGENT __ATOMIC_RELAXED, __HIP_MEMORY_SCOPE_AGENT
#define LDS_WAIT() asm volatile("s_waitcnt lgkmcnt(0)" ::: "memory")
#define VM_WAIT() asm volatile("s_waitcnt vmcnt(0)" ::: "memory")
__device__ __forceinline__ unsigned long long rt() { return __builtin_amdgcn_s_memrealtime(); }
#define XB_TMO      128
#define XB_XCNT(j)  (256  + 64 * (j))
#define XB_XSUB(j)  (1280 + 64 * (j))
#define XB_XGEN(j)  (2304 + 64 * (j))
#define XB_TOP      3328
#define XB_TOPGEN   3392
#define XCD_BAR_WORDS 3456
#define XB_SPIN_CAP (1u << 18)

__device__ __forceinline__ unsigned xb_ld(unsigned* p)              { return __hip_atomic_load(p, __ATOMIC_RELAXED, __HIP_MEMORY_SCOPE_AGENT); }
__device__ __forceinline__ unsigned xb_add(unsigned* p, unsigned v) { return __hip_atomic_fetch_add(p, v, __ATOMIC_RELAXED, __HIP_MEMORY_SCOPE_AGENT); }
__device__ __forceinline__ unsigned xb_xcc_id() { return (unsigned)__builtin_amdgcn_s_getreg((3 << 11) | 20) & 0xFu; }
#define XB_SPIN(cond, bar) do { unsigned _sp = 0; while (cond) { __builtin_amdgcn_s_sleep(1); \
    if ((++_sp & 255u) == 0u) { if (xb_ld(&(bar)[XB_TMO])) break; if (_sp > XB_SPIN_CAP) { atomicAdd(&(bar)[XB_TMO], 1u); break; } } } } while (0)

struct XcdBarrier {
    unsigned* bar; unsigned x;
    volatile LAS unsigned* st;
};

__device__ __forceinline__ XcdBarrier xcd_barrier_post(unsigned* bar, volatile LAS unsigned* st, int tid) {
    XcdBarrier b; b.bar = bar; b.x = xb_xcc_id(); b.st = st;
    if (tid == 0) (void)xb_add(&bar[XB_XCNT(b.x)], 1u);
    return b;
}
__device__ __forceinline__ void xcd_barrier_complete(unsigned* bar, unsigned x, unsigned& nloc, unsigned& nx) {
    const unsigned G = gridDim.x * gridDim.y * gridDim.z;
    unsigned sum, cnt, mine, sp = 0u;
    for (;;) {
        sum = 0u; cnt = 0u; mine = 0u;
#pragma unroll
        for (unsigned j = 0; j < 16; ++j) { const unsigned c = xb_ld(&bar[XB_XCNT(j)]); sum += c; cnt += (c > 0u) ? 1u : 0u; mine = (j == x) ? c : mine; }
        if (sum == G) break;
        __builtin_amdgcn_s_sleep(1);
        if ((++sp & 255u) == 0u) { if (xb_ld(&bar[XB_TMO])) break; if (sp > XB_SPIN_CAP) { atomicAdd(&bar[XB_TMO], 1u); break; } }
    }
    nloc = mine > 0u ? mine : 1u; nx = cnt > 0u ? cnt : 1u;
}

__device__ __forceinline__ void xcd_barrier(const XcdBarrier& b, int tid) {
    asm volatile("s_waitcnt vmcnt(0)" ::: "memory");
    __syncthreads();
    if (tid == 0) {
        unsigned* bar = b.bar;
        __builtin_amdgcn_s_waitcnt(0);
        unsigned nloc = b.st[0], nx = b.st[1];
        if (nloc == 0u) { xcd_barrier_complete(bar, b.x, nloc, nx); b.st[0] = nloc; b.st[1] = nx; }
        const unsigned old = xb_add(&bar[XB_XSUB(b.x)], 1u);
        const unsigned gen = old / nloc;
        if (old + 1u == (gen + 1u) * nloc) {
            __builtin_amdgcn_fence(__ATOMIC_RELEASE, "agent");
            asm volatile("s_waitcnt vmcnt(0)" ::: "memory");
            const unsigned og = xb_add(&bar[XB_TOP], 1u);
            const unsigned tg = og / nx;
            if (og + 1u == (tg + 1u) * nx) xb_add(&bar[XB_TOPGEN], 1u);
            else XB_SPIN(xb_ld(&bar[XB_TOPGEN]) == tg, bar);
            __builtin_amdgcn_fence(__ATOMIC_ACQUIRE, "agent");
            xb_add(&bar[XB_XGEN(b.x)], 1u);
            asm volatile("s_waitcnt vmcnt(0)" ::: "memory");
        } else {
            XB_SPIN(xb_ld(&bar[XB_XGEN(b.x)]) == gen, bar);
            __builtin_amdgcn_fence(__ATOMIC_ACQUIRE, "agent");
            asm volatile("s_waitcnt vmcnt(0)" ::: "memory");
        }
    }
    __syncthreads();
}
constexpr int NWAVES = 8, NTHR = NWAVES * 64;
constexpr int RING_BYTES = 131072;
constexpr int LDSCTL_OFF = RING_BYTES, MISC_OFF = LDSCTL_OFF + 320;
constexpr int XCH_OFF = RING_BYTES + 1024;
constexpr int LDS_BYTES = 147456;

struct Args { const float* in[21]; float* out; unsigned char* ws; int ph_lo, ph_hi; };

enum { I_X = 0, I_C, I_RELB, I_ADAW, I_ADAB, I_MIXPRE, I_MIXPOST, I_FFNPRE, I_FFNPOST, I_ABWIN, I_ABWOUT, I_CDWIN, I_QNG, I_KVNG, I_WUQ, I_WUKV, I_CDWOUT, I_WUP, I_CONVW, I_CONVB, I_WDN };

__device__ __forceinline__ float wave_sum(float v) {
#pragma unroll
    for (int o = 1; o < 64; o <<= 1) v += __shfl_xor(v, o);
    return v;
}
__device__ __forceinline__ float quad_sum(float v) { v += __shfl_xor(v, 1); v += __shfl_xor(v, 2); return v; }
__device__ __forceinline__ void load16(const f16* p, float (&o)[16]) {
    const f16x8 a = *(const f16x8*)p, b = *(const f16x8*)(p + 8);
#pragma unroll
    for (int i = 0; i < 8; ++i) { o[i] = (float)a[i]; o[8 + i] = (float)b[i]; }
}
__device__ __forceinline__ void load8(const f16* p, float (&o)[8]) {
    const f16x8 a = *(const f16x8*)p;
#pragma unroll
    for (int i = 0; i < 8; ++i) o[i] = (float)a[i];
}
__device__ __forceinline__ int t5_bucket(int d) {
    if (d < 16) return d;
    return 16 + (d >= 22) + (d >= 30) + (d >= 40) + (d >= 54) + (d >= 73) + (d >= 99) + (d >= 134) + (d >= 182) + (d >= 246) + (d >= 332) + (d >= 450) + (d >= 609) + (d >= 825) + (d >= 1117) + (d >= 1513);
}

__device__ __forceinline__ void layer_mod(const Args& a, LAS unsigned char* lds, int tid, int slot, int nslots, int l) {
    LAS float* sc = (LAS float*)lds; LAS float* red = (LAS float*)(lds + 16384);
    const float* c = a.in[I_C];
    for (int i = tid; i < BATCH * DM; i += NTHR) { const float v = c[i]; sc[i] = v / (1.f + expf(-v)); }
    __syncthreads();
    const int wave = tid >> 6, lane = tid & 63;
    float* MOD = (float*)(a.ws + WS_MOD);
    for (int cg = slot; cg < 96; cg += nslots) {
        const int n = cg * 64 + lane;
        const float* W = a.in[I_ADAW] + (size_t)l * DM * 6144 + n;
        float a0 = 0.f, a1 = 0.f, a2 = 0.f, a3 = 0.f;
        const int k0 = wave * 128;
#pragma unroll 1
        for (int kb = k0; kb < k0 + 128; kb += 64) {
            float wv[64];
#pragma unroll
            for (int j = 0; j < 64; ++j) wv[j] = W[(size_t)(kb + j) * 6144];
#pragma unroll
            for (int j = 0; j < 64; ++j) { const int k = kb + j; a0 += sc[k] * wv[j]; a1 += sc[DM + k] * wv[j]; a2 += sc[2 * DM + k] * wv[j]; a3 += sc[3 * DM + k] * wv[j]; }
        }
        red[(wave * 4 + 0) * 64 + lane] = a0; red[(wave * 4 + 1) * 64 + lane] = a1; red[(wave * 4 + 2) * 64 + lane] = a2; red[(wave * 4 + 3) * 64 + lane] = a3;
        __syncthreads();
        if (tid < 256) { const int b = tid >> 6; float s = 0.f;
#pragma unroll
            for (int w = 0; w < 8; ++w) s += red[(w * 4 + b) * 64 + lane];
            MOD[(size_t)(l * BATCH + b) * 6144 + n] = s + a.in[I_ADAB][l * 6144 + n]; }
        __syncthreads();
    }
}
struct TD { const float* W; int N; f16* dst; int pitch, coloff; const float* gk; int mode, nblk; };
__device__ __forceinline__ void transpose_item(const TD& d, LAS float* scr, int item, int lane) {
    const int kb = item / d.nblk, nb = item % d.nblk, k0 = 64 * kb, n0 = 32 * nb;
    float wv[32];
#pragma unroll
    for (int i = 0; i < 32; ++i) { const int kk = 2 * i + (lane >> 5); wv[i] = d.W[(size_t)(k0 + kk) * d.N + n0 + (lane & 31)]; }
#pragma unroll
    for (int i = 0; i < 32; ++i) { const int kk = 2 * i + (lane >> 5); scr[kk * 33 + (lane & 31)] = wv[i]; }
    LDS_WAIT(); asm volatile("" ::: "memory");
    const int c = lane & 7;
    float gs[8];
#pragma unroll
    for (int i = 0; i < 8; ++i) gs[i] = d.gk ? d.gk[k0 + 8 * c + i] : 1.f;
#pragma unroll
    for (int j = 0; j < 4; ++j) { const int n = (lane >> 3) + 8 * j; const LAS float* s = scr + (8 * c) * 33 + n;
        u32x4 o; o.x = pk_f16(s[0 * 33] * gs[0], s[1 * 33] * gs[1]); o.y = pk_f16(s[2 * 33] * gs[2], s[3 * 33] * gs[3]); o.z = pk_f16(s[4 * 33] * gs[4], s[5 * 33] * gs[5]); o.w = pk_f16(s[6 * 33] * gs[6], s[7 * 33] * gs[7]);
        const int col = n0 + n; int row = col;
        if (d.mode == 1) { const int half = col / DFF, jj = col % DFF; row = (jj >> 7) * 256 + half * 128 + (jj & 127); }
        *(GAS u32x4*)(d.dst + (size_t)row * d.pitch + d.coloff + k0 + 8 * c) = o; }
    LDS_WAIT(); asm volatile("" ::: "memory");
}
__device__ __forceinline__ void layer_weights(const Args& a, LAS unsigned char* lds, int tid, int slot, int nslots, int l, int part  ) {
    const int wave = tid >> 6, lane = tid & 63;
    LAS float* scr = (LAS float*)(lds + wave * 16384);
    const int gw = slot * NWAVES + wave, NGW = nslots * NWAVES;
    constexpr int C0 = 16 * 96, C1 = 16 * 32, C2 = 16 * 65, C3 = 4 * 24, C4 = 4 * 32, C5 = 16 * 32, C6 = 16 * 176, C7 = 44 * 32;
    const int i = l >> 1; const bool odd = (l & 1) != 0;
    const int nmix = odd ? (C2 + C3 + C4 + C5) : (C0 + C1);
    unsigned char* ws = a.ws;
    const int it_lo = (part & 1) ? 0 : nmix, it_hi = (part & 2) ? nmix + C6 + C7 : nmix;
    for (int it = it_lo + gw; it < it_hi; it += NGW) {
        int r = it; TD d; d.gk = nullptr; d.mode = 0; d.coloff = 0;
        if (r >= nmix) { r -= nmix;
            if (r < C6) { d.W = a.in[I_WUP] + (size_t)l * DM * DFF2; d.N = DFF2; d.dst = (f16*)(ws + WS_W_FUP) + (size_t)l * DFF2 * DM; d.pitch = DM; d.nblk = 176; d.mode = 1; }
            else { r -= C6; d.W = a.in[I_WDN] + (size_t)l * DFF * DM; d.N = DM; d.dst = (f16*)(ws + WS_W_FDN) + (size_t)l * DM * DFF; d.pitch = DFF; d.nblk = 32; } }
        else if (!odd) {
            if (r < C0) { d.W = a.in[I_ABWIN] + (size_t)i * DM * AB_IN; d.N = AB_IN; d.dst = (f16*)(ws + WS_W_INAB) + (size_t)i * AB_IN * DM; d.pitch = DM; d.nblk = 96; }
            else { r -= C0; d.W = a.in[I_ABWOUT] + (size_t)i * DM * DM; d.N = DM; d.dst = (f16*)(ws + WS_W_OUTAB) + (size_t)i * DM * DM; d.pitch = DM; d.nblk = 32; } }
        else {
            if (r < C2) { d.W = a.in[I_CDWIN] + (size_t)i * DM * CD_IN; d.N = CD_IN; d.dst = (f16*)(ws + WS_W_INCD) + (size_t)i * CD_INP * DM; d.pitch = DM; d.nblk = 65; }
            else if ((r -= C2) < C3) { d.W = a.in[I_WUQ] + (size_t)i * 256 * QW; d.N = QW; d.dst = (f16*)(ws + WS_W_UP2) + (size_t)i * UP_N * UP_K; d.pitch = UP_K; d.nblk = 24; d.gk = a.in[I_QNG] + i * 256; }
            else if ((r -= C3) < C4) { d.W = a.in[I_WUKV] + (size_t)i * 256 * KVW; d.N = KVW; d.dst = (f16*)(ws + WS_W_UP2) + (size_t)i * UP_N * UP_K + (size_t)QW * UP_K; d.pitch = UP_K; d.nblk = 32; d.gk = a.in[I_KVNG] + i * 256; }
            else { r -= C4; d.W = a.in[I_CDWOUT] + (size_t)i * DM * DM; d.N = DM; d.dst = (f16*)(ws + WS_W_OUTCD) + (size_t)i * DM * DM; d.pitch = DM; d.nblk = 32; } }
        transpose_item(d, scr, r, lane);
    }
}
__device__ __forceinline__ void p0_misc(const Args& a, int tid, int bid, int G) {
    unsigned char* ws = a.ws;
    const int gt = bid * NTHR + tid, NGT = G * NTHR;
    const u32x4 z = {0u, 0u, 0u, 0u};
    for (int i = 0; i < 2; ++i) {
        GAS u32x4* p = (GAS u32x4*)((f16*)(ws + WS_W_INCD) + (size_t)i * CD_INP * DM + (size_t)CD_IN * DM);
        for (int e = gt; e < (CD_INP - CD_IN) * DM / 8; e += NGT) p[e] = z;
    }
    float* rc = (float*)(ws + WS_ROPE); float* rs = rc + SEQ * 16;
    for (int e = gt; e < SEQ * 16; e += NGT) { const int t = e >> 4, i = e & 15; const float inv = (float)(1.0 / pow(10000.0, (double)i / 16.0)); const float ang = (float)t * inv;
        rc[e] = (float)cos((double)ang); rs[e] = (float)sin((double)ang); }
}

__device__ __forceinline__ void thin_row(int row, const float* xin32, const f16* xin16, f16* xout16, float* xout32, const f16* y, const float* gate_l  , const float* gpost,
                                         const float* gpre, const float* ss_l  , f16* Hrow, f16* H2row, bool has_y, int lane) {
    const int b = row / SEQ;
    f32x4 xv[4];
    if (xin32 != nullptr) {
#pragma unroll
        for (int j = 0; j < 4; ++j) xv[j] = *(const f32x4*)(xin32 + (size_t)row * DM + 4 * lane + 256 * j);
    } else {
#pragma unroll
        for (int j = 0; j < 4; ++j) { const f16x4 xh = *(const f16x4*)(xin16 + (size_t)row * DM + 4 * lane + 256 * j); xv[j] = (f32x4){(float)xh[0], (float)xh[1], (float)xh[2], (float)xh[3]}; }
    }
    if (has_y) {
        f32x4 yv[4]; float s = 0.f;
#pragma unroll
        for (int j = 0; j < 4; ++j) { const f16x4 yh = *(const f16x4*)(y + (size_t)row * DM + 4 * lane + 256 * j); yv[j] = (f32x4){(float)yh[0], (float)yh[1], (float)yh[2], (float)yh[3]}; s += (yv[j].x * yv[j].x + yv[j].y * yv[j].y) + (yv[j].z * yv[j].z + yv[j].w * yv[j].w); }
        const float rstd = 1.0f / sqrtf(wave_sum(s) * (1.f / DM) + NORM_EPS);
#pragma unroll
        for (int j = 0; j < 4; ++j) { const f32x4 g = *(const f32x4*)(gpost + 4 * lane + 256 * j); const f32x4 gt = *(const f32x4*)(gate_l + (size_t)b * 6144 + 4 * lane + 256 * j);
            xv[j] = xv[j] + gt * ((yv[j] * rstd) * g); }
    }
    if (xout16 != nullptr) {
#pragma unroll
        for (int j = 0; j < 4; ++j) { u32x2 w; w.x = pk_f16(xv[j].x, xv[j].y); w.y = pk_f16(xv[j].z, xv[j].w); *(u32x2*)(xout16 + (size_t)row * DM + 4 * lane + 256 * j) = w;
            if (Hrow != nullptr) { const f16x4 r = __builtin_bit_cast(f16x4, w); xv[j] = (f32x4){(float)r[0], (float)r[1], (float)r[2], (float)r[3]}; } }
    }
    if (xout32 != nullptr) {
#pragma unroll
        for (int j = 0; j < 4; ++j) *(f32x4*)(xout32 + (size_t)row * DM + 4 * lane + 256 * j) = xv[j];
    }
    if (Hrow != nullptr) {
        float s = 0.f;
#pragma unroll
        for (int j = 0; j < 4; ++j) s += (xv[j].x * xv[j].x + xv[j].y * xv[j].y) + (xv[j].z * xv[j].z + xv[j].w * xv[j].w);
        const float rstd = 1.0f / sqrtf(wave_sum(s) * (1.f / DM) + NORM_EPS);
#pragma unroll
        for (int j = 0; j < 4; ++j) { const int col = 4 * lane + 256 * j; const f32x4 g = *(const f32x4*)(gpre + col);
            const f32x4 sh = *(const f32x4*)(ss_l + (size_t)b * 6144 + col), sc = *(const f32x4*)(ss_l + (size_t)b * 6144 + DM + col);
            const f32x4 hv = ((xv[j] * rstd) * g) * (sc + 1.0f) + sh;
            u32x2 w; w.x = pk_f16(hv.x, hv.y); w.y = pk_f16(hv.z, hv.w);
            *(u32x2*)(Hrow + col) = w;
            if (H2row != nullptr) *(u32x2*)(H2row + col) = w; }
    }
}
__device__ __forceinline__ bool is_halo_row(int row) { return (row & 255) >= 254 && (((row >> 8) + 1) & 15) != 0; }
__device__ __forceinline__ int halo_row_of(int hidx) { const int pm = hidx >> 1; return (pm == 0 || (pm & 15) == 0) ? -1 : 256 * pm - 2 + (hidx & 1); }
template <bool X32IN, bool HAS_Y, bool OUT32, bool WH>
__device__ __forceinline__ void thin_phase(const float* xin32, const f16* X16in, f16* X16out, float* out32, const f16* y, const float* gate_l, const float* gpost, const float* gpre, const float* ss_l, f16* H, f16* HHALO  ,
                                           LAS unsigned char* lds, int tid, int gw0, int ngw, int row_end = M) {
    const int lane = tid & 63;
    LAS float* TA = (LAS float*)lds; LAS float* TB = TA + BATCH * DM; LAS float* TC = TB + BATCH * DM;
    for (int idx = tid; idx < BATCH * DM; idx += NTHR) { const int b = idx >> 10, col = idx & (DM - 1);
        if constexpr (HAS_Y) TA[idx] = gate_l[(size_t)b * 6144 + col] * gpost[col];
        if constexpr (WH) { TB[idx] = gpre[col] * (1.0f + ss_l[(size_t)b * 6144 + DM + col]); TC[idx] = ss_l[(size_t)b * 6144 + col]; } }
    __syncthreads();
    for (int row0 = gw0; row0 < row_end; row0 += 2 * ngw) {
        int row[2] = {row0, row0 + ngw}; if (row[1] >= row_end) row[1] = row0;
        const int bq[2] = {row[0] / SEQ, row[1] / SEQ};
        float xv[2][16], yv[2][16];
#pragma unroll
        for (int q = 0; q < 2; ++q)
#pragma unroll
            for (int j = 0; j < 2; ++j) { const size_t off = (size_t)row[q] * DM + 512 * j + 8 * lane;
                if constexpr (X32IN) { const f32x4 a0 = *(const f32x4*)(xin32 + off), a1 = *(const f32x4*)(xin32 + off + 4);
#pragma unroll
                    for (int e = 0; e < 4; ++e) { xv[q][8 * j + e] = a0[e]; xv[q][8 * j + 4 + e] = a1[e]; } }
                else { const f16x8 xh = *(const f16x8*)(X16in + off);
#pragma unroll
                    for (int e = 0; e < 8; ++e) xv[q][8 * j + e] = (float)xh[e]; }
                if constexpr (HAS_Y) { const f16x8 yh = *(const f16x8*)(y + off);
#pragma unroll
                    for (int e = 0; e < 8; ++e) yv[q][8 * j + e] = (float)yh[e]; }
            }
        if constexpr (HAS_Y) {
            float s[2] = {0.f, 0.f};
#pragma unroll
            for (int q = 0; q < 2; ++q)
#pragma unroll
                for (int e = 0; e < 16; ++e) s[q] += yv[q][e] * yv[q][e];
#pragma unroll
            for (int o = 1; o < 64; o <<= 1) { s[0] += __shfl_xor(s[0], o); s[1] += __shfl_xor(s[1], o); }
#pragma unroll
            for (int q = 0; q < 2; ++q) { const float rstd = 1.0f / sqrtf(s[q] * (1.f / DM) + NORM_EPS);
#pragma unroll
                for (int j = 0; j < 2; ++j) { const LAS float* ta = TA + bq[q] * DM + 512 * j + 8 * lane; const f32x4 t0 = *(const LAS f32x4*)ta, t1 = *(const LAS f32x4*)(ta + 4);
#pragma unroll
                    for (int e = 0; e < 4; ++e) { xv[q][8 * j + e] += t0[e] * (yv[q][8 * j + e] * rstd); xv[q][8 * j + 4 + e] += t1[e] * (yv[q][8 * j + 4 + e] * rstd); } } }
        }
#pragma unroll
        for (int q = 0; q < 2; ++q)
#pragma unroll
            for (int j = 0; j < 2; ++j) { const size_t off = (size_t)row[q] * DM + 512 * j + 8 * lane;
                if constexpr (OUT32) { float* o32 = out32;
                    *(f32x4*)(o32 + off) = (f32x4){xv[q][8 * j], xv[q][8 * j + 1], xv[q][8 * j + 2], xv[q][8 * j + 3]}; *(f32x4*)(o32 + off + 4) = (f32x4){xv[q][8 * j + 4], xv[q][8 * j + 5], xv[q][8 * j + 6], xv[q][8 * j + 7]}; }
                else { u32x4 w; w.x = pk_f16(xv[q][8 * j], xv[q][8 * j + 1]); w.y = pk_f16(xv[q][8 * j + 2], xv[q][8 * j + 3]); w.z = pk_f16(xv[q][8 * j + 4], xv[q][8 * j + 5]); w.w = pk_f16(xv[q][8 * j + 6], xv[q][8 * j + 7]);
                    *(u32x4*)(X16out + off) = w;
                    const f16x8 r = __builtin_bit_cast(f16x8, w);
#pragma unroll
                    for (int e = 0; e < 8; ++e) xv[q][8 * j + e] = (float)r[e]; }
            }
        if constexpr (WH) {
            float s[2] = {0.f, 0.f};
#pragma unroll
            for (int q = 0; q < 2; ++q)
#pragma unroll
                for (int e = 0; e < 16; ++e) s[q] += xv[q][e] * xv[q][e];
#pragma unroll
            for (int o = 1; o < 64; o <<= 1) { s[0] += __shfl_xor(s[0], o); s[1] += __shfl_xor(s[1], o); }
#pragma unroll
            for (int q = 0; q < 2; ++q) { const float rstd = 1.0f / sqrtf(s[q] * (1.f / DM) + NORM_EPS);
                f16* h2 = (HHALO != nullptr && is_halo_row(row[q])) ? HHALO + (size_t)(2 * ((row[q] >> 8) + 1) + ((row[q] & 255) - 254)) * DM : nullptr;
#pragma unroll
                for (int j = 0; j < 2; ++j) { const int col = 512 * j + 8 * lane; const LAS float* tb = TB + bq[q] * DM + col; const LAS float* tc = TC + bq[q] * DM + col;
                    const f32x4 b0 = *(const LAS f32x4*)tb, b1 = *(const LAS f32x4*)(tb + 4), c0 = *(const LAS f32x4*)tc, c1 = *(const LAS f32x4*)(tc + 4);
                    float hv[8];
#pragma unroll
                    for (int e = 0; e < 4; ++e) { hv[e] = (xv[q][8 * j + e] * rstd) * b0[e] + c0[e]; hv[4 + e] = (xv[q][8 * j + 4 + e] * rstd) * b1[e] + c1[e]; }
                    u32x4 w; w.x = pk_f16(hv[0], hv[1]); w.y = pk_f16(hv[2], hv[3]); w.z = pk_f16(hv[4], hv[5]); w.w = pk_f16(hv[6], hv[7]);
                    *(u32x4*)(H + (size_t)row[q] * DM + col) = w;
                    if (h2 != nullptr) *(u32x4*)(h2 + col) = w; } }
        }
    }
}

__device__ __forceinline__ void naive_kmean(const f16* PROJ, float* KMEAN, int gt, int NGT) {
    for (int e = gt; e < BATCH * 16 * 512; e += NGT) { const int col = e & 511, blk = (e >> 9) & 15, b = e >> 13;
        const f16* p = PROJ + ((size_t)b * SEQ + blk * 256) * AB_IN + 512 + col; float s = 0.f;
        for (int r = 0; r < 256; ++r) s += (float)p[(size_t)r * AB_IN];
        KMEAN[e] = s * (1.f / 256.f); }
}
#define OS_UPDATE(s_, vv_) do { const float mn_ = fmaxf(m, (s_)), al_ = expf(m - mn_), pe_ = expf((s_) - mn_); l = l * al_ + pe_; \
    _Pragma("unroll") for (int i_ = 0; i_ < 16; ++i_) acc[i_] = acc[i_] * al_ + pe_ * (vv_)[i_]; m = mn_; } while (0)
__device__ __forceinline__ void naive_moba(const f16* PROJ, const float* KMEAN, const float* relb, f16* ATT, int gt, int NGT) {
    const int sub = gt & 3, ngr = NGT >> 2;
    for (int item = gt >> 2; item < BATCH * NH * SEQ; item += ngr) {
        const int t = item & (SEQ - 1), h = (item >> 12) & 7, b = item >> 15;
        const size_t row = (size_t)b * SEQ + t;
        float q[16]; load16(PROJ + row * AB_IN + h * 64 + sub * 16, q);
        const int own = t >> 8;
        unsigned selmask = 0u;
        {
            float g[16];
#pragma unroll
            for (int j = 0; j < 16; ++j) { float p = 0.f;
                if (j < own) { const float* km = KMEAN + ((size_t)(b * 16 + j) * 512) + h * 64 + sub * 16;
#pragma unroll
                    for (int i = 0; i < 16; ++i) p += q[i] * km[i]; }
                p = quad_sum(p); g[j] = (j < own) ? p : -INFINITY; }
#pragma unroll
            for (int r = 0; r < 3; ++r) { float best = -INFINITY; int bi = -1;
#pragma unroll
                for (int j = 0; j < 16; ++j) { const bool ok = !((selmask >> j) & 1u) && (j < own) && (g[j] > best); if (ok) { best = g[j]; bi = j; } }
                if (bi >= 0) selmask |= 1u << bi; }
        }
        float m = -INFINITY, l = 0.f, acc[16];
#pragma unroll
        for (int i = 0; i < 16; ++i) acc[i] = 0.f;
        const f16* Kb = PROJ + (size_t)b * SEQ * AB_IN + 512 + h * 64 + sub * 16;
        const float* rb = relb + h * 32;
        for (int pos = own * 256; pos <= t; ++pos) { float kk[16], vv[16]; load16(Kb + (size_t)pos * AB_IN, kk); load16(Kb + (size_t)pos * AB_IN + 512, vv); float p = 0.f;
#pragma unroll
            for (int i = 0; i < 16; ++i) p += q[i] * kk[i];
            const float s = quad_sum(p) * 0.125f + rb[t5_bucket(t - pos)]; OS_UPDATE(s, vv); }
        for (int j = 0; j < own; ++j) { if (!((selmask >> j) & 1u)) continue;
            for (int pos = j * 256; pos < j * 256 + 256; ++pos) { float kk[16], vv[16]; load16(Kb + (size_t)pos * AB_IN, kk); load16(Kb + (size_t)pos * AB_IN + 512, vv); float p = 0.f;
#pragma unroll
                for (int i = 0; i < 16; ++i) p += q[i] * kk[i];
                const float s = quad_sum(p) * 0.125f + rb[t5_bucket(t - pos)]; OS_UPDATE(s, vv); } }
        const float il = 1.f / l; u32x4 w0, w1;
        w0.x = pk_f16(acc[0] * il, acc[1] * il); w0.y = pk_f16(acc[2] * il, acc[3] * il); w0.z = pk_f16(acc[4] * il, acc[5] * il); w0.w = pk_f16(acc[6] * il, acc[7] * il);
        w1.x = pk_f16(acc[8] * il, acc[9] * il); w1.y = pk_f16(acc[10] * il, acc[11] * il); w1.z = pk_f16(acc[12] * il, acc[13] * il); w1.w = pk_f16(acc[14] * il, acc[15] * il);
        f16* o = ATT + row * DM + h * 64 + sub * 16; *(u32x4*)o = w0; *(u32x4*)(o + 8) = w1;
    }
}
__device__ __forceinline__ void naive_dilated(const f16* PROJ, const float* relb, f16* ATT, int gt, int NGT) {
    const int sub = gt & 3, ngr = NGT >> 2;
    for (int item = gt >> 2; item < BATCH * NH * SEQ; item += ngr) {
        const int t = item & (SEQ - 1), h = (item >> 12) & 7, b = item >> 15;
        const size_t row = (size_t)b * SEQ + t;
        float q[16]; load16(PROJ + row * AB_IN + 1536 + h * 64 + sub * 16, q);
        float m = -INFINITY, l = 0.f, acc[16];
#pragma unroll
        for (int i = 0; i < 16; ++i) acc[i] = 0.f;
        const f16* Kb = PROJ + (size_t)b * SEQ * AB_IN + 2048 + h * 64 + sub * 16;
        const float* rb = relb + (8 + h) * 32;
        for (int br = 0; br < 3; ++br) { const int dil = br == 0 ? 1 : (br == 1 ? 4 : 16);
            for (int mm = 0; mm <= 128; ++mm) { const int pos = t - dil * mm; if (pos < 0) break;
                float kk[16], vv[16]; load16(Kb + (size_t)pos * AB_IN, kk); load16(Kb + (size_t)pos * AB_IN + 512, vv); float p = 0.f;
#pragma unroll
                for (int i = 0; i < 16; ++i) p += q[i] * kk[i];
                const float s = quad_sum(p) * 0.125f + rb[t5_bucket(dil * mm)]; OS_UPDATE(s, vv); } }
        const float il = 1.f / l; u32x4 w0, w1;
        w0.x = pk_f16(acc[0] * il, acc[1] * il); w0.y = pk_f16(acc[2] * il, acc[3] * il); w0.z = pk_f16(acc[4] * il, acc[5] * il); w0.w = pk_f16(acc[6] * il, acc[7] * il);
        w1.x = pk_f16(acc[8] * il, acc[9] * il); w1.y = pk_f16(acc[10] * il, acc[11] * il); w1.z = pk_f16(acc[12] * il, acc[13] * il); w1.w = pk_f16(acc[14] * il, acc[15] * il);
        f16* o = ATT + row * DM + 512 + h * 64 + sub * 16; *(u32x4*)o = w0; *(u32x4*)(o + 8) = w1;
    }
}
__device__ __forceinline__ void mla_norm_phase(f16* PROJ, f16* KPE, const float* rc, const float* rs, int tid, int bid, int G) {
    const int wave = tid >> 6, lane = tid & 63;
    const int gw = bid * NWAVES + wave, NGW = G * NWAVES;
    for (int row = gw; row < M; row += NGW) {
        f16* p = PROJ + (size_t)row * CD_INP;
        const int t = row & (SEQ - 1);
#pragma unroll
        for (int part = 0; part < 2; ++part) {
            f16x4 v = *(const f16x4*)(p + part * 256 + 4 * lane);
            float f[4] = {(float)v[0], (float)v[1], (float)v[2], (float)v[3]};
            const float s = wave_sum((f[0] * f[0] + f[1] * f[1]) + (f[2] * f[2] + f[3] * f[3]));
            const float rstd = 1.0f / sqrtf(s * (1.f / 256.f) + NORM_EPS);
            u32x2 w; w.x = pk_f16(f[0] * rstd, f[1] * rstd); w.y = pk_f16(f[2] * rstd, f[3] * rstd);
            *(u32x2*)(p + part * 256 + 4 * lane) = w;
        }
        if (lane < 16) { const float x1 = (float)p[512 + lane], x2 = (float)p[528 + lane]; const float c = rc[t * 16 + lane], s = rs[t * 16 + lane];
            KPE[(size_t)row * 32 + lane] = (f16)(x1 * c - x2 * s); KPE[(size_t)row * 32 + 16 + lane] = (f16)(x1 * s + x2 * c); }
    }
}
__device__ __forceinline__ void naive_mla(const f16* Q, const f16* KV, const f16* KPE, const float* rc, const float* rs, f16* ATT, int gt, int NGT) {
    const int sub = gt & 3, ngr = NGT >> 2;
    const float scale = 0.10206207261596575f;
    for (int item = gt >> 2; item < BATCH * NH * SEQ; item += ngr) {
        const int t = item & (SEQ - 1), h = (item >> 12) & 7, b = item >> 15;
        const size_t row = (size_t)b * SEQ + t;
        const f16* qp = Q + row * QW + h * 96;
        float q[16], qr[8]; load16(qp + sub * 16, q);
#pragma unroll
        for (int i = 0; i < 8; ++i) { const int d = 8 * sub + i, dd = d & 15; const float x1 = (float)qp[64 + dd], x2 = (float)qp[80 + dd]; const float c = rc[t * 16 + dd], s = rs[t * 16 + dd];
            qr[i] = (d < 16) ? (x1 * c - x2 * s) : (x1 * s + x2 * c); }
        float m = -INFINITY, l = 0.f, acc[16];
#pragma unroll
        for (int i = 0; i < 16; ++i) acc[i] = 0.f;
        const f16* Kb = KV + (size_t)b * SEQ * KVW + h * 128 + sub * 16;
        const f16* Pb = KPE + (size_t)b * SEQ * 32 + sub * 8;
        for (int pos = 0; pos <= t; ++pos) { float kk[16], kr[8], vv[16]; load16(Kb + (size_t)pos * KVW, kk); load8(Pb + (size_t)pos * 32, kr); load16(Kb + (size_t)pos * KVW + 64, vv); float p = 0.f;
#pragma unroll
            for (int i = 0; i < 16; ++i) p += q[i] * kk[i];
#pragma unroll
            for (int i = 0; i < 8; ++i) p += qr[i] * kr[i];
            const float s = quad_sum(p) * scale; OS_UPDATE(s, vv); }
        const float il = 1.f / l; u32x4 w0, w1;
        w0.x = pk_f16(acc[0] * il, acc[1] * il); w0.y = pk_f16(acc[2] * il, acc[3] * il); w0.z = pk_f16(acc[4] * il, acc[5] * il); w0.w = pk_f16(acc[6] * il, acc[7] * il);
        w1.x = pk_f16(acc[8] * il, acc[9] * il); w1.y = pk_f16(acc[10] * il, acc[11] * il); w1.z = pk_f16(acc[12] * il, acc[13] * il); w1.w = pk_f16(acc[14] * il, acc[15] * il);
        f16* o = ATT + row * DM + h * 64 + sub * 16; *(u32x4*)o = w0; *(u32x4*)(o + 8) = w1;
    }
}
__device__ __forceinline__ float softplusf(float x) { return fmaxf(x, 0.f) + log1pf(expf(-fabsf(x))); }
__device__ __forceinline__ void naive_sb(const f16* PROJ, f16* ATT, int gt, int NGT) {
    const int sub = gt & 3, ngr = NGT >> 2;
    for (int item = gt >> 2; item < BATCH * NH * SEQ; item += ngr) {
        const int t = item & (SEQ - 1), h = (item >> 12) & 7, b = item >> 15;
        const size_t row = (size_t)b * SEQ + t;
        float q[16]; load16(PROJ + row * CD_INP + 544 + h * 64 + sub * 16, q);
        float R = 0.f, acc[16];
#pragma unroll
        for (int i = 0; i < 16; ++i) acc[i] = 0.f;
        const f16* Kb = PROJ + (size_t)b * SEQ * CD_INP + 1056 + h * 64 + sub * 16;
        for (int pos = t - 1; pos >= 0; --pos) { float kk[16], vv[16]; load16(Kb + (size_t)pos * CD_INP, kk); load16(Kb + (size_t)pos * CD_INP + 512, vv); float p = 0.f;
#pragma unroll
            for (int i = 0; i < 16; ++i) p += q[i] * kk[i];
            const float z = quad_sum(p) * 0.125f;
            const float aw = expf(R - softplusf(-z));
#pragma unroll
            for (int i = 0; i < 16; ++i) acc[i] += aw * vv[i];
            R -= softplusf(z); }
        u32x4 w0, w1;
        w0.x = pk_f16(acc[0], acc[1]); w0.y = pk_f16(acc[2], acc[3]); w0.z = pk_f16(acc[4], acc[5]); w0.w = pk_f16(acc[6], acc[7]);
        w1.x = pk_f16(acc[8], acc[9]); w1.y = pk_f16(acc[10], acc[11]); w1.z = pk_f16(acc[12], acc[13]); w1.w = pk_f16(acc[14], acc[15]);
        f16* o = ATT + row * DM + 512 + h * 64 + sub * 16; *(u32x4*)o = w0; *(u32x4*)(o + 8) = w1;
    }
}
__device__ __forceinline__ float gelu_tanh(float g) { return 0.5f * g * (1.f + tanhf(0.7978845608028654f * (g + 0.044715f * g * g * g))); }
__device__ __forceinline__ void naive_convact(const f16* U, int half, const float* cw, const float* cb, f16* ACT, int gt, int NGT) {
    for (int e = gt; e < (M / 2) * DFF; e += NGT) { const int rl = e / DFF, j = e % DFF; const int row = half * (M / 2) + rl, t = row & (SEQ - 1);
        const int ucol = (j >> 7) * 256 + (j & 127);
        float g = cb[j], v = cb[DFF + j];
#pragma unroll
        for (int tap = 0; tap < 3; ++tap) { const int dt = 2 - tap; if (t - dt < 0) continue;
            const f16* up = U + (size_t)(rl - dt) * DFF2 + ucol;
            g += cw[tap * DFF2 + j] * (float)up[0]; v += cw[tap * DFF2 + DFF + j] * (float)up[128]; }
        ACT[(size_t)row * DFF + j] = (f16)(gelu_tanh(g) * v); }
}
namespace att {
typedef float f32x16 __attribute__((ext_vector_type(16)));
typedef short s16x4 __attribute__((ext_vector_type(4)));
__device__ __forceinline__ f16x4 tr_read(const LAS f16* p) { return __builtin_bit_cast(f16x4, __builtin_amdgcn_ds_read_tr16_b64_v4i16((LAS s16x4*)p)); }
constexpr int VP = 96;
constexpr int OFF_K = 0, KBUF = 128 * 104 * 2;
constexpr int OFF_V = 2 * KBUF, VBUF = 128 * VP * 2;
constexpr int OFF_BIAS = OFF_V + 2 * VBUF;
constexpr int OFF_KMEAN = OFF_BIAS + 16384;
constexpr int OFF_FLAG = OFF_KMEAN + 4096;
constexpr int ATT_LDS = OFF_FLAG + 64;
constexpr float LOG2E = 1.4426950408889634f, LN2 = 0.6931471805599453f;

struct Src {
    const f16* q; int qp;
    const f16* k; int kp;
    const f16* k2;
    const f16* v; int vp;
    f16* o;
};

template <int KIND  , int PM = 0  >
__device__ __forceinline__ void attn_unit(LAS unsigned char* lds, const Src& T, int b, int h, int qb, const float* rc, const float* rs, const float* KMEAN, const float* relb, int tid) {
    constexpr int DQ = (KIND == 0) ? 96 : 64, NS = DQ / 16, KP = DQ + 8;
    const int lane = tid & 63, r32 = lane & 31, hi = lane >> 5; const int wid = __builtin_amdgcn_readfirstlane(tid >> 6);
    const size_t rowbase = (size_t)b * SEQ;
    const int q0w = qb * 256 + wid * 32;
    const int t = q0w + r32;
    f16x8 qf[NS];
    {
        const f16* qrow = T.q + (rowbase + t) * T.qp;
#pragma unroll
        for (int s = 0; s < 4; ++s) qf[s] = *(const f16x8*)(qrow + 16 * s + 8 * hi);
        if constexpr (KIND == 0) {
            const f16x8 xa = *(const f16x8*)(qrow + 64 + 8 * hi), xb = *(const f16x8*)(qrow + 80 + 8 * hi);
            const f32x4 c0 = *(const f32x4*)(rc + t * 16 + 8 * hi), c1 = *(const f32x4*)(rc + t * 16 + 8 * hi + 4), s0 = *(const f32x4*)(rs + t * 16 + 8 * hi), s1 = *(const f32x4*)(rs + t * 16 + 8 * hi + 4);
#pragma unroll
            for (int j = 0; j < 8; ++j) { const float a = (float)xa[j], bb = (float)xb[j], c = j < 4 ? c0[j & 3] : c1[j & 3], s = j < 4 ? s0[j & 3] : s1[j & 3];
                qf[4][j] = (f16)(a * c - bb * s); qf[5][j] = (f16)(a * s + bb * c); }
        }
    }
    unsigned selmask = 0u;
    LAS float* biasl = (LAS float*)(lds + OFF_BIAS);
    if constexpr (KIND == 1) {
        LAS float* kml = (LAS float*)(lds + OFF_KMEAN);
        for (int d = tid; d < SEQ; d += NTHR) biasl[d] = relb[h * 32 + t5_bucket(d)] * LOG2E;
        for (int e = tid; e < 16 * 64; e += NTHR) kml[e] = KMEAN[((size_t)(b * 16 + (e >> 6)) * 512) + h * 64 + (e & 63)] * (1.f / 256.f);
        __syncthreads();
        float g[16];
#pragma unroll
        for (int j = 0; j < 16; ++j) { float p = 0.f;
            if (j < qb) {
#pragma unroll
                for (int s = 0; s < 4; ++s)
#pragma unroll
                    for (int i = 0; i < 8; ++i) p += (float)qf[s][i] * kml[j * 64 + 16 * s + 8 * hi + i]; }
            p += __shfl_xor(p, 32); g[j] = (j < qb) ? p : -INFINITY; }
#pragma unroll
        for (int r = 0; r < 3; ++r) { float best = -INFINITY; int bi = -1;
#pragma unroll
            for (int j = 0; j < 16; ++j) { const bool ok = !((selmask >> j) & 1u) && (j < qb) && (g[j] > best); if (ok) { best = g[j]; bi = j; } }
            if (bi >= 0) selmask |= 1u << bi; }
    }
    const int NT = 4 * qb + 4;
    auto tile_start = [&](int i) -> int {
        if constexpr (KIND == 0) return 64 * i;
        else if constexpr (KIND == 1) return i < 4 ? 256 * qb + 64 * i : 64 * (i - 4);
        else return 64 * (NT - 1 - i);
    };
    const int kr = tid >> 3, kc = tid & 7;
    const int k2r = tid >> 2, k2c = tid & 3;
    f16x8 kr0, vr0, k2r0, kr1, vr1, k2r1;
    auto gload = [&](int d) {
        const int ts0 = tile_start(2 * d), ts1 = tile_start(2 * d + 1);
        kr0 = *(const f16x8*)(T.k + (rowbase + ts0 + kr) * T.kp + 8 * kc); vr0 = *(const f16x8*)(T.v + (rowbase + ts0 + kr) * T.vp + 8 * kc);
        kr1 = *(const f16x8*)(T.k + (rowbase + ts1 + kr) * T.kp + 8 * kc); vr1 = *(const f16x8*)(T.v + (rowbase + ts1 + kr) * T.vp + 8 * kc);
        if constexpr (KIND == 0) { if (tid < 256) { k2r0 = *(const f16x8*)(T.k2 + (rowbase + ts0 + k2r) * 32 + 8 * k2c); k2r1 = *(const f16x8*)(T.k2 + (rowbase + ts1 + k2r) * 32 + 8 * k2c); } }
    };
    auto lstore = [&](int buf) {
        LAS f16* Kb = (LAS f16*)(lds + OFF_K + buf * KBUF); LAS f16* Vb = (LAS f16*)(lds + OFF_V + buf * VBUF);
        *(LAS f16x8*)(Kb + kr * KP + 8 * kc) = kr0; *(LAS f16x8*)(Kb + (64 + kr) * KP + 8 * kc) = kr1;
        if constexpr (KIND == 0) { if (tid < 256) { *(LAS f16x8*)(Kb + k2r * KP + 64 + 8 * k2c) = k2r0; *(LAS f16x8*)(Kb + (64 + k2r) * KP + 64 + 8 * k2c) = k2r1; } }
        *(LAS f16x8*)(Vb + kr * VP + 8 * kc) = vr0; *(LAS f16x8*)(Vb + (64 + kr) * VP + 8 * kc) = vr1;
    };
    f32x16 o0, o1;
#pragma unroll
    for (int r = 0; r < 16; ++r) { o0[r] = 0.f; o1[r] = 0.f; }
    float m = -1e30f, l = 0.f, R = 0.f;
    const float csc = (KIND == 0 ? 0.10206207261596575f : 0.125f) * (KIND == 2 ? 1.0f : LOG2E);
    LAS unsigned* flags = (LAS unsigned*)(lds + OFF_FLAG);

    const int ND = NT / 2;
    gload(0); lstore(0); gload(1);
    __syncthreads();
    auto tile = [&](int i, int buf, int sub) {
        const int ts = tile_start(i);
        bool active, need_mask;
        if constexpr (KIND == 2) { active = ts < q0w + 31; need_mask = ts + 63 >= q0w; }
        else if constexpr (KIND == 1) { if (i < 4) { active = ts <= q0w + 31; need_mask = ts + 63 > q0w; } else { active = true; need_mask = false; } }
        else { active = ts <= q0w + 31; need_mask = ts + 63 > q0w; }
        bool wave_done = false;
        if constexpr (KIND == 2) { wave_done = __all(R < -152.0f) != 0; if (wave_done) active = false; }
        if (active && PM != 1) {
            const LAS f16* Kb = (const LAS f16*)(lds + OFF_K + buf * KBUF) + sub * 64 * KP; const LAS f16* Vb = (const LAS f16*)(lds + OFF_V + buf * VBUF) + sub * 64 * VP;
            f32x16 p0, p1;
#pragma unroll
            for (int r = 0; r < 16; ++r) { p0[r] = 0.f; p1[r] = 0.f; }
            {
                f16x8 kf[2 * NS];
#pragma unroll
                for (int s = 0; s < NS; ++s) { kf[2 * s] = *(const LAS f16x8*)(Kb + r32 * KP + 16 * s + 8 * hi); kf[2 * s + 1] = *(const LAS f16x8*)(Kb + (32 + r32) * KP + 16 * s + 8 * hi); }
                __builtin_amdgcn_sched_barrier(0);
#pragma unroll
                for (int s = 0; s < NS; ++s) { p0 = __builtin_amdgcn_mfma_f32_32x32x16_f16(kf[2 * s], qf[s], p0, 0, 0, 0); p1 = __builtin_amdgcn_mfma_f32_32x32x16_f16(kf[2 * s + 1], qf[s], p1, 0, 0, 0); }
            }
            f16x4 vlo[8], vhh[8];
            auto vfrag_load = [&]() {
#pragma unroll
            for (int kb = 0; kb < 2; ++kb)
#pragma unroll
                for (int s2 = 0; s2 < 2; ++s2)
#pragma unroll
                    for (int db = 0; db < 2; ++db) {
                        const LAS f16* vp = Vb + (32 * kb + 16 * s2 + 4 * hi + ((lane & 15) >> 2)) * VP + 32 * db + (r32 & 16) + 4 * (lane & 3);
                        vlo[(kb * 2 + s2) * 2 + db] = tr_read(vp); vhh[(kb * 2 + s2) * 2 + db] = tr_read(vp + 8 * VP); }
            };
            if constexpr (PM < 2 && KIND != 2) vfrag_load();
            __builtin_amdgcn_sched_barrier(0);
            const int lim = t - ts - 4 * hi;
            if constexpr (PM == 3) { asm volatile("" :: "v"(p0), "v"(p1)); }
            else if constexpr (KIND != 2) {
                if constexpr (KIND == 1) {
                    const int dbase = lim;
                    float b0[16], b1[16];
                    if (i < 4) {
#pragma unroll
                        for (int r = 0; r < 16; ++r) { const int c = (r & 3) + 8 * (r >> 2); int d0 = dbase - c, d1 = dbase - 32 - c; d0 = d0 < 0 ? 0 : d0; d1 = d1 < 0 ? 0 : d1; b0[r] = biasl[d0]; b1[r] = biasl[d1]; }
                    } else {
#pragma unroll
                        for (int r = 0; r < 16; ++r) { const int c = (r & 3) + 8 * (r >> 2); b0[r] = biasl[dbase - c]; b1[r] = biasl[dbase - 32 - c]; }
                    }
                    __builtin_amdgcn_sched_barrier(0);
#pragma unroll
                    for (int r = 0; r < 16; r += 2) { const f32x2 q0 = (f32x2){p0[r], p0[r + 1]} * csc + (f32x2){b0[r], b0[r + 1]}, q1 = (f32x2){p1[r], p1[r + 1]} * csc + (f32x2){b1[r], b1[r + 1]};
                        p0[r] = q0.x; p0[r + 1] = q0.y; p1[r] = q1.x; p1[r + 1] = q1.y; }
                    if (i >= 4) { const bool sel = (selmask >> (ts >> 8)) & 1u;
                        if (!sel) {
#pragma unroll
                            for (int r = 0; r < 16; ++r) { p0[r] = -INFINITY; p1[r] = -INFINITY; } } }
                }
                if (need_mask) {
#pragma unroll
                    for (int r = 0; r < 16; ++r) { const int c = (r & 3) + 8 * (r >> 2); if (c > lim) p0[r] = -INFINITY; if (c + 32 > lim) p1[r] = -INFINITY; }
                }
                const float esc = (KIND == 1) ? 1.0f : csc;
                float mx = fmaxf(p0[0], p1[0]);
#pragma unroll
                for (int r = 1; r < 16; ++r) mx = fmaxf(mx, fmaxf(p0[r], p1[r]));
                mx = fmaxf(mx, __shfl_xor(mx, 32)) * esc;
                if (__any(mx > m + 8.0f)) {
                    const float mn = fmaxf(m, mx), alpha = __builtin_amdgcn_exp2f(m - mn);
                    m = mn; l *= alpha;
#pragma unroll
                    for (int r = 0; r < 16; ++r) { o0[r] *= alpha; o1[r] *= alpha; }
                }
                f32x2 sum2 = {0.f, 0.f};
#pragma unroll
                for (int r = 0; r < 16; r += 2) {
                    const f32x2 t0 = (f32x2){p0[r], p0[r + 1]} * esc - m, t1 = (f32x2){p1[r], p1[r + 1]} * esc - m;
                    f32x2 e0, e1; e0.x = __builtin_amdgcn_exp2f(t0.x); e0.y = __builtin_amdgcn_exp2f(t0.y); e1.x = __builtin_amdgcn_exp2f(t1.x); e1.y = __builtin_amdgcn_exp2f(t1.y);
                    p0[r] = e0.x; p0[r + 1] = e0.y; p1[r] = e1.x; p1[r + 1] = e1.y; sum2 += e0 + e1; }
                l += sum2.x + sum2.y;
            } else {
                float lk0[16], lk1[16];
#pragma unroll
                for (int r = 0; r < 16; ++r) { const int c = (r & 3) + 8 * (r >> 2);
                    const float z0 = p0[r] * (csc * LOG2E), z1 = p1[r] * (csc * LOG2E);
                    const float e0 = __builtin_amdgcn_exp2f(z0), e1 = __builtin_amdgcn_exp2f(z1);
                    const float g0 = __builtin_amdgcn_logf(1.f + e0), g1 = __builtin_amdgcn_logf(1.f + e1);
                    const float a0 = -(z0 > 64.f ? z0 : g0), a1 = -(z1 > 64.f ? z1 : g1);
                    const bool v0 = !need_mask || (c < lim), v1 = !need_mask || (c + 32 < lim);
                    lk0[r] = v0 ? a0 : 0.f; lk1[r] = v1 ? a1 : 0.f;
                    p0[r] = v0 ? z0 + a0 : -INFINITY; p1[r] = v1 ? z1 + a1 : -INFINITY; }
                float gs[8], gp[8];
#pragma unroll
                for (int g = 0; g < 4; ++g) { gs[g] = (lk0[4 * g] + lk0[4 * g + 1]) + (lk0[4 * g + 2] + lk0[4 * g + 3]); gs[4 + g] = (lk1[4 * g] + lk1[4 * g + 1]) + (lk1[4 * g + 2] + lk1[4 * g + 3]); }
#pragma unroll
                for (int c4 = 0; c4 < 8; ++c4) gp[c4] = __shfl_xor(gs[c4], 32);
                float suf = R;
#pragma unroll
                for (int c4 = 7; c4 >= 0; --c4) {
                    const float ev = hi ? gp[c4] : gs[c4], od = hi ? gs[c4] : gp[c4];
                    const float base = hi ? suf : suf + od;
                    if (c4 < 4) { const int g = c4; float acc = base;
                        p0[4 * g + 3] += acc; acc += lk0[4 * g + 3]; p0[4 * g + 2] += acc; acc += lk0[4 * g + 2]; p0[4 * g + 1] += acc; acc += lk0[4 * g + 1]; p0[4 * g] += acc; }
                    else { const int g = c4 - 4; float acc = base;
                        p1[4 * g + 3] += acc; acc += lk1[4 * g + 3]; p1[4 * g + 2] += acc; acc += lk1[4 * g + 2]; p1[4 * g + 1] += acc; acc += lk1[4 * g + 1]; p1[4 * g] += acc; }
                    suf += ev + od;
                }
                R = suf;
#pragma unroll
                for (int r = 0; r < 16; ++r) { p0[r] = __builtin_amdgcn_exp2f(p0[r]); p1[r] = __builtin_amdgcn_exp2f(p1[r]); }
            }
            if constexpr (PM < 2 && KIND == 2) { vfrag_load(); __builtin_amdgcn_sched_barrier(0); }
            if constexpr (PM >= 2) { asm volatile("" :: "v"(p0), "v"(p1)); }
            else
#pragma unroll
            for (int kb = 0; kb < 2; ++kb)
#pragma unroll
                for (int s2 = 0; s2 < 2; ++s2) {
                    f16x8 bf;
#pragma unroll
                    for (int j = 0; j < 8; ++j) bf[j] = (f16)(kb ? p1[8 * s2 + j] : p0[8 * s2 + j]);
#pragma unroll
                    for (int db = 0; db < 2; ++db) {
                        const f16x4 lo = vlo[(kb * 2 + s2) * 2 + db], hh = vhh[(kb * 2 + s2) * 2 + db];
                        const f16x8 af = {lo[0], lo[1], lo[2], lo[3], hh[0], hh[1], hh[2], hh[3]};
                        if (db == 0) o0 = __builtin_amdgcn_mfma_f32_32x32x16_f16(af, bf, o0, 0, 0, 0); else o1 = __builtin_amdgcn_mfma_f32_32x32x16_f16(af, bf, o1, 0, 0, 0);
                    }
                }
        }
    };
    for (int d = 0; d < ND; ++d) {
        const int buf = d & 1;
        tile(2 * d, buf, 0);
        tile(2 * d + 1, buf, 1);
        if constexpr (KIND == 2) { if (lane == 0) flags[buf * 8 + wid] = (__all(R < -152.0f) != 0) ? 1u : 0u; }
        if (d + 1 < ND) lstore(buf ^ 1);
        if (d + 2 < ND) gload(d + 2);
        __syncthreads();
        if constexpr (KIND == 2) {
            unsigned alld = 1u;
#pragma unroll
            for (int w = 0; w < 8; ++w) alld &= flags[buf * 8 + w];
            if (alld) break;
        }
    }
    float inv = 1.f;
    if constexpr (KIND != 2) { l += __shfl_xor(l, 32); inv = 1.f / l; }
    f16* orow = T.o + (rowbase + t) * DM;
    if constexpr (PM == 0)
#pragma unroll
    for (int g = 0; g < 4; ++g) {
        u32x2 w0, w1;
        w0.x = pk_f16(o0[4 * g] * inv, o0[4 * g + 1] * inv); w0.y = pk_f16(o0[4 * g + 2] * inv, o0[4 * g + 3] * inv);
        w1.x = pk_f16(o1[4 * g] * inv, o1[4 * g + 1] * inv); w1.y = pk_f16(o1[4 * g + 2] * inv, o1[4 * g + 3] * inv);
        *(u32x2*)(orow + 8 * g + 4 * hi) = w0; *(u32x2*)(orow + 32 + 8 * g + 4 * hi) = w1;
    }
    __syncthreads();
}
}
namespace dil {
typedef float f32x16 __attribute__((ext_vector_type(16)));
constexpr int KPW = 72, VPW = 96;
constexpr int WAVE_LDS = 32 * KPW * 2 + 32 * VPW * 2;
constexpr int OFF_BIASD = 8 * WAVE_LDS;
constexpr float LOG2E = 1.4426950408889634f;

__device__ __forceinline__ void dilated_unit(LAS unsigned char* lds, const f16* PROJ, const float* relb, f16* ATT, float* stAo, float* stAml, float* stBo, float* stBml, int b, int h, int sp, int tid) {
    const int lane = tid & 63, r32 = lane & 31, hi = lane >> 5; const int wid = __builtin_amdgcn_readfirstlane(tid >> 6);
    LAS float* biasd = (LAS float*)(lds + OFF_BIASD);
    for (int e = tid; e < 3 * 129; e += NTHR) { const int br = e / 129, mm = e % 129; const int dl = br == 0 ? 16 : (br == 1 ? 4 : 1); biasd[br * 132 + mm] = relb[(8 + h) * 32 + t5_bucket(dl * mm)] * LOG2E; }
    __syncthreads();
    LAS f16* Kb = (LAS f16*)(lds + wid * WAVE_LDS); LAS f16* Vb = Kb + 32 * KPW;
    const size_t rowbase = (size_t)b * SEQ; const int T0 = sp * 512;
    const f16* Kg = PROJ + 2048 + h * 64; const f16* Vg = PROJ + 2560 + h * 64;
    const size_t gtok0 = ((size_t)(b * NH + h)) * SEQ;
    const float csc = 0.125f * LOG2E;
#pragma unroll 1
    for (int pass = 0; pass < 3; ++pass) {
        const int dl = pass == 0 ? 16 : (pass == 1 ? 4 : 1);
        const float* ldo = pass == 1 ? stAo : stBo; const float* ldml = pass == 1 ? stAml : stBml;
        float* sto = pass == 0 ? stAo : stBo; float* stml = pass == 0 ? stAml : stBml;
        const LAS float* bt = biasd + pass * 132;
#pragma unroll 1
        for (int jj = 0; jj < 2; ++jj) {
            const int j = wid + 8 * jj;
            const int tq0 = pass == 0 ? T0 + j : (pass == 1 ? T0 + (j >> 2) + 128 * (j & 3) : T0 + 32 * j);
            const int t = tq0 + dl * r32;
            f16x8 qf[4];
            { const f16* qrow = PROJ + (rowbase + t) * AB_IN + 1536 + h * 64;
#pragma unroll
              for (int s = 0; s < 4; ++s) qf[s] = *(const f16x8*)(qrow + 16 * s + 8 * hi); }
            f32x16 o0, o1; float m, l;
            const size_t sidx = (gtok0 + t) * 2 + hi;
            if (pass == 0) {
#pragma unroll
                for (int r = 0; r < 16; ++r) { o0[r] = 0.f; o1[r] = 0.f; }
                m = -1e30f; l = 0.f;
            } else {
                const f32x4* po = (const f32x4*)(ldo + sidx * 32);
#pragma unroll
                for (int g = 0; g < 4; ++g) { const f32x4 a = po[g], c = po[4 + g];
                    o0[4 * g] = a[0]; o0[4 * g + 1] = a[1]; o0[4 * g + 2] = a[2]; o0[4 * g + 3] = a[3]; o1[4 * g] = c[0]; o1[4 * g + 1] = c[1]; o1[4 * g + 2] = c[2]; o1[4 * g + 3] = c[3]; }
                const f32x2 ml = *(const f32x2*)(ldml + sidx * 2); m = ml[0]; l = ml[1];
            }
            f16x8 kA[4], vA[4], kB[4], vB[4];
            auto gload = [&](int kbk, f16x8 (&kreg)[4], f16x8 (&vreg)[4]) {
#pragma unroll
                for (int i = 0; i < 4; ++i) { const int id = lane + 64 * i, c = id >> 3, ch = id & 7; int pos = tq0 + dl * (-128 + 32 * kbk + c); pos = pos < 0 ? 0 : pos;
                    kreg[i] = *(const f16x8*)(Kg + (rowbase + pos) * AB_IN + 8 * ch); vreg[i] = *(const f16x8*)(Vg + (rowbase + pos) * AB_IN + 8 * ch); }
            };
            auto lstore = [&](const f16x8 (&kreg)[4], const f16x8 (&vreg)[4]) {
#pragma unroll
                for (int i = 0; i < 4; ++i) { const int id = lane + 64 * i, c = id >> 3, ch = id & 7;
                    *(LAS f16x8*)(Kb + c * KPW + 8 * ch) = kreg[i];
                    *(LAS f16x8*)(Vb + c * VPW + 8 * ch) = vreg[i]; }
            };
            int kb0 = 0;
            while (kb0 < 4 && tq0 + dl * (-128 + 32 * kb0 + 31) < 0) ++kb0;
            gload(kb0, kA, vA); if (kb0 + 1 < 5) gload(kb0 + 1, kB, vB);
            auto step = [&](int kbk, f16x8 (&kreg)[4], f16x8 (&vreg)[4]) {
                asm volatile("s_waitcnt lgkmcnt(0)" ::: "memory");
                lstore(kreg, vreg);
                if (kbk + 2 < 5) gload(kbk + 2, kreg, vreg);
                asm volatile("s_waitcnt lgkmcnt(0)" ::: "memory");
                f32x16 p;
#pragma unroll
                for (int r = 0; r < 16; ++r) p[r] = 0.f;
                f16x4 vlo[4], vhh[4];
                {
                    f16x8 kf[4];
#pragma unroll
                    for (int s = 0; s < 4; ++s) kf[s] = *(const LAS f16x8*)(Kb + r32 * KPW + 16 * s + 8 * hi);
#pragma unroll
                    for (int s2 = 0; s2 < 2; ++s2)
#pragma unroll
                        for (int db = 0; db < 2; ++db) { const LAS f16* vp = Vb + (16 * s2 + 4 * hi + ((lane & 15) >> 2)) * VPW + 32 * db + (r32 & 16) + 4 * (lane & 3); vlo[s2 * 2 + db] = att::tr_read(vp); vhh[s2 * 2 + db] = att::tr_read(vp + 8 * VPW); }
                    __builtin_amdgcn_sched_barrier(0);
#pragma unroll
                    for (int s = 0; s < 4; ++s) p = __builtin_amdgcn_mfma_f32_32x32x16_f16(kf[s], qf[s], p, 0, 0, 0);
                }
                const int basepos = tq0 + dl * (-128 + 32 * kbk);
                const int bmm = r32 + 128 - 32 * kbk - 4 * hi;
                const int bpos = basepos + dl * 4 * hi;
                const bool edge = (kbk == 0) || (kbk == 4) || (basepos < 0);
                if (edge) {
#pragma unroll
                    for (int r = 0; r < 16; ++r) { const int c = (r & 3) + 8 * (r >> 2); const int mm = bmm - c; const bool ok = (mm >= 0) && (mm <= 128) && (bpos + dl * c >= 0);
                        const int mc = mm < 0 ? 0 : (mm > 128 ? 128 : mm);
                        p[r] = ok ? p[r] * csc + bt[mc] : -INFINITY; }
                } else {
                    float bb[16];
#pragma unroll
                    for (int r = 0; r < 16; ++r) { const int c = (r & 3) + 8 * (r >> 2); bb[r] = bt[bmm - c]; }
                    __builtin_amdgcn_sched_barrier(0);
#pragma unroll
                    for (int r = 0; r < 16; ++r) p[r] = p[r] * csc + bb[r];
                }
                float mx = p[0];
#pragma unroll
                for (int r = 1; r < 16; ++r) mx = fmaxf(mx, p[r]);
                mx = fmaxf(mx, __shfl_xor(mx, 32));
                if (__any(mx > m + 8.0f)) {
                    const float mn = fmaxf(m, mx), alpha = __builtin_amdgcn_exp2f(m - mn);
                    m = mn; l *= alpha;
#pragma unroll
                    for (int r = 0; r < 16; ++r) { o0[r] *= alpha; o1[r] *= alpha; }
                }
                float sum = 0.f;
#pragma unroll
                for (int r = 0; r < 16; ++r) { p[r] = __builtin_amdgcn_exp2f(p[r] - m); sum += p[r]; }
                l += sum;
#pragma unroll
                for (int s2 = 0; s2 < 2; ++s2) {
                    f16x8 bf;
#pragma unroll
                    for (int e = 0; e < 8; ++e) bf[e] = (f16)p[8 * s2 + e];
#pragma unroll
                    for (int db = 0; db < 2; ++db) {
                        const f16x4 lo = vlo[s2 * 2 + db], hh = vhh[s2 * 2 + db];
                        const f16x8 af = {lo[0], lo[1], lo[2], lo[3], hh[0], hh[1], hh[2], hh[3]};
                        if (db == 0) o0 = __builtin_amdgcn_mfma_f32_32x32x16_f16(af, bf, o0, 0, 0, 0); else o1 = __builtin_amdgcn_mfma_f32_32x32x16_f16(af, bf, o1, 0, 0, 0);
                    }
                }
            };
#pragma unroll 1
            for (int kbk = kb0; kbk < 5; kbk += 2) { step(kbk, kA, vA); if (kbk + 1 < 5) step(kbk + 1, kB, vB); }
            if (pass < 2) {
                f32x4* po = (f32x4*)(sto + sidx * 32);
#pragma unroll
                for (int g = 0; g < 4; ++g) { po[g] = (f32x4){o0[4 * g], o0[4 * g + 1], o0[4 * g + 2], o0[4 * g + 3]}; po[4 + g] = (f32x4){o1[4 * g], o1[4 * g + 1], o1[4 * g + 2], o1[4 * g + 3]}; }
                *(f32x2*)(stml + sidx * 2) = (f32x2){m, l};
            } else {
                l += __shfl_xor(l, 32); const float inv = 1.f / l;
                f16* orow = ATT + (rowbase + t) * DM + 512 + h * 64;
#pragma unroll
                for (int g = 0; g < 4; ++g) {
                    u32x2 w0, w1;
                    w0.x = pk_f16(o0[4 * g] * inv, o0[4 * g + 1] * inv); w0.y = pk_f16(o0[4 * g + 2] * inv, o0[4 * g + 3] * inv);
                    w1.x = pk_f16(o1[4 * g] * inv, o1[4 * g + 1] * inv); w1.y = pk_f16(o1[4 * g + 2] * inv, o1[4 * g + 3] * inv);
                    *(u32x2*)(orow + 8 * g + 4 * hi) = w0; *(u32x2*)(orow + 32 + 8 * g + 4 * hi) = w1;
                }
            }
        }
        asm volatile("s_waitcnt vmcnt(0) lgkmcnt(0)" ::: "memory");
        __syncthreads();
    }
}
}
#ifndef USE_MFMA_MOBA
#define USE_MFMA_MOBA 1
#endif
#ifndef USE_MFMA_MLA
#define USE_MFMA_MLA 1
#endif
#ifndef USE_MFMA_SB
#define USE_MFMA_SB 1
#endif
#ifndef USE_MFMA_DIL
#define USE_MFMA_DIL 1
#endif
#ifndef REP_MOBA
#define REP_MOBA 1
#endif
#ifndef REP_DIL
#define REP_DIL 1
#endif
#ifndef REP_MLA
#define REP_MLA 1
#endif
#ifndef REP_SB
#define REP_SB 1
#endif
#ifndef REP_P0
#define REP_P0 1
#endif
#ifndef REP_THIN
#define REP_THIN 1
#endif
#ifndef REP_INPROJ
#define REP_INPROJ 1
#endif
#ifndef REP_OUTPROJ
#define REP_OUTPROJ 1
#endif
#ifndef REP_FUP
#define REP_FUP 1
#endif
#ifndef REP_FDN
#define REP_FDN 1
#endif
#ifndef PROBE_XBAR
#define PROBE_XBAR 0
#endif
#ifndef HALO_IN_THIN1
#define HALO_IN_THIN1 0
#endif
#ifndef HALO_IN_FUP
#define HALO_IN_FUP 1
#endif
#ifndef PROBE_PM
#define PROBE_PM 0
#endif
#ifndef DEFER_W
#ifndef P0_SPLIT
#define P0_SPLIT 1
#endif
#define DEFER_W 1
#endif
#ifndef PROBE_STAMP
#define PROBE_STAMP (-1)
#endif
#ifndef PROBE_BLK
#define PROBE_BLK 0
#endif
#ifndef PROBE_FUP
#define PROBE_FUP 0
#endif
#ifndef SEAM_FUSE
#define SEAM_FUSE 2
#endif
#ifndef MK_SPLIT
#define MK_SPLIT 0
#endif
constexpr int N_PHASES = 2 + DEPTH * 12;

__device__ __forceinline__ void panel_wait(unsigned* cnt, unsigned want, int tid) {
    if (tid < 64) { unsigned spins = 0;
        while ((unsigned)__builtin_amdgcn_readfirstlane(__hip_atomic_load(cnt, __ATOMIC_RELAXED, __HIP_MEMORY_SCOPE_AGENT)) < want) { __builtin_amdgcn_s_sleep(2); if (++spins > (1u << 16)) break; }
        __builtin_amdgcn_fence(__ATOMIC_ACQUIRE, "agent");
        asm volatile("s_waitcnt vmcnt(0)" ::: "memory"); }
    __syncthreads();
}
__device__ __forceinline__ int lane_now() { int l; asm volatile("v_mbcnt_lo_u32_b32 %0, -1, 0\n\tv_mbcnt_hi_u32_b32 %0, -1, %0" : "=v"(l)); return l; }
__global__ void __launch_bounds__(NTHR, 2) fwd_kernel(Args a) {
    extern __shared__ __attribute__((aligned(16))) unsigned char lds_raw[];
    LAS unsigned char* lds = (LAS unsigned char*)lds_raw;
    const int wave0 = __builtin_amdgcn_readfirstlane((int)threadIdx.x >> 6);
#define TID_NOW (wave0 * 64 + lane_now())
    const int bid = blockIdx.x, G = gridDim.x; const int NGT = G * NTHR;
    for (int u = TID_NOW; u < (LDS_BYTES - LDSCTL_OFF) / 4; u += NTHR) ((LAS unsigned*)(lds + LDSCTL_OFF))[u] = 0u;
    __syncthreads();
    volatile LAS unsigned* MISC = (volatile LAS unsigned*)(lds + MISC_OFF);
    XcdBarrier bar = xcd_barrier_post((unsigned*)(a.ws + WS_CTL) + CW_BAR, MISC + 8, TID_NOW);
    const int lo = a.ph_lo, hi = a.ph_hi; const bool seams = (hi - lo) > 1;
    int ph = 0;
    unsigned long long pacc = 0ull; int pkind = 0; (void)pkind;
    unsigned char* const ws0 = a.ws;
#define X16B ((f16*)(ws + WS_R2 + 32 * MiB))
#define X16 ((f16*)xout0)
#define MOD ((float*)(ws + WS_MOD))
#define H ((f16*)(ws + WS_H))
#define ATT ((f16*)(ws + WS_ATT))
#define HHALO ((f16*)(ws + WS_HHALO))
#define PROJ ((f16*)(ws + WS_R1))
#define Qb ((f16*)(ws + WS_R2))
#define KVb ((f16*)(ws + WS_R2 + 24 * MiB))
#define KPE ((f16*)(ws + WS_R2 + 56 * MiB))
#define rc ((const float*)(ws + WS_ROPE))
#define rs (((const float*)(ws + WS_ROPE)) + SEQ * 16)
#define ctl ((unsigned*)(ws + WS_CTL))
#define Y1 ((f16*)(ws + WS_R2))
#define Y2 ((f16*)(ws + WS_R2))
#define ACT ((f16*)(ws + WS_R1))
    float* const xout0 = a.out;
#define PH_ON (lo <= ph && ph < hi)
#define PH_LOC int tid = TID_NOW; asm volatile("" : "+v"(tid)); const int gt = bid * NTHR + tid; (void)gt; unsigned char* ws = ws0; asm volatile("" : "+s"(ws)); const unsigned long long t_ph0 = (PROBE_STAMP >= 0) ? rt() : 0ull; (void)t_ph0
#define PH_END do { const unsigned long long t1_ = (PROBE_STAMP >= 0) ? rt() : 0ull; if (seams) xcd_barrier(bar, TID_NOW); if (PROBE_STAMP >= 0) { const unsigned long long t2_ = rt(); if (PROBE_STAMP == 0) pacc += t2_ - t1_; else if (PROBE_STAMP == 20) pacc += t2_ - t_ph0; else if (PROBE_STAMP >= 100) { if (pkind == PROBE_STAMP - 100) pacc += t2_ - t1_; } else if (pkind == PROBE_STAMP) pacc += t1_ - t_ph0; } } while (0)

    pkind = 1;
    const int nmodw = (P0_SPLIT && DEFER_W && G >= 192) ? 96 : 0;
    if (PH_ON) { PH_LOC;
        if (nmodw == 0) { for (int ll = 0; ll < (DEFER_W ? 1 : DEPTH); ++ll) layer_mod(a, lds, tid, bid, G, ll); }
        else if (bid < nmodw) layer_mod(a, lds, tid, bid, nmodw, 0);
        else { layer_weights(a, lds, tid, bid - nmodw, G - nmodw, 0, 1); p0_misc(a, tid, bid - nmodw, G - nmodw); }
        PH_END; } ++ph;
    pkind = 2;
    if (PH_ON) { PH_LOC; if (gt < BATCH * 16 * 512) ((float*)(ws + WS_KMEAN))[gt] = 0.f;
        if (nmodw == 0) { for (int ll = 0; ll < (DEFER_W ? 1 : DEPTH); ++ll) { layer_weights(a, lds, tid, bid, G, ll, 3); __syncthreads(); } p0_misc(a, tid, bid, G); }
        else layer_weights(a, lds, tid, bid, G, 0, 2);
        __syncthreads();
        thin_phase<true, false, false, true>(a.in[I_X], nullptr, X16, nullptr, nullptr, nullptr, nullptr, a.in[I_MIXPRE], MOD, H, nullptr, lds, tid, bid * NWAVES + (tid >> 6), G * NWAVES); PH_END; } ++ph;

    for (int l = 0; l < DEPTH; ++l) {
        const int li = l >> 1; const bool odd = (l & 1) != 0;
#define modl (MOD + (size_t)l * BATCH * 6144)
        for (int xb = 0; xb < PROBE_XBAR; ++xb) if (seams) xcd_barrier(bar, TID_NOW);
        pkind = 3;
        if (PH_ON) { PH_LOC;
            const int N = odd ? CD_INP : AB_IN;
            const f16* Bt = odd ? (const f16*)(ws + WS_W_INCD) + (size_t)li * CD_INP * DM : (const f16*)(ws + WS_W_INAB) + (size_t)li * AB_IN * DM;
            pg8::Gemm g{H, Bt, M, N, DM, DM}; pg8::StaticOrder S; S.init(M, N, G, bid);
            pg8::EpiF16 E{PROJ, N, 0, nullptr, 0, odd ? nullptr : (float*)(ws + WS_KMEAN), 512, 1024, odd ? (PG8_LAS float*)(lds + XCH_OFF) : (PG8_LAS float*)nullptr, KPE, rc, rs, nullptr};
            for (int rep = 0; rep < REP_INPROJ; ++rep) pg8::gemm_phase<pg8::EpiF16, pg8::StaticOrder, true, true>(lds, g, S, E, tid);
            if (DEFER_W && odd) {
                const int total = (M / 256) * (N / 256), rounds = (total + G - 1) / G; int first_short = total - (rounds - 1) * G; if (first_short >= G) first_short = 0;
                if (bid >= first_short) { const int tid2 = TID_NOW; layer_weights(a, lds, tid2, bid - first_short, G - first_short, l, 2); if (l == 1) layer_weights(a, lds, tid2, bid - first_short, G - first_short, 2, 2); }
            }
            PH_END; } ++ph;
        pkind = 4;
        if (PH_ON) { PH_LOC;
            (void)tid; } ++ph;
        if (PH_ON) { PH_LOC;
            if (odd) {
                pg8::Gemm g{PROJ, (const f16*)(ws + WS_W_UP2) + (size_t)li * UP_N * UP_K, M, UP_N, UP_K, CD_INP}; pg8::UpOrder S; S.init(M, UP_N, G, bid, QW / 256);
                pg8::EpiF16 E{Qb, QW, QW, KVb, KVW, nullptr, 0, 0, nullptr, nullptr, nullptr, nullptr, nullptr};
                pg8::gemm_phase<pg8::EpiF16, pg8::UpOrder, true, true>(lds, g, S, E, tid);
                PH_END; }
        } ++ph;
        pkind = odd ? 6 : 5;
        if (PH_ON) { PH_LOC;
            const int vcu = (G % 8 == 0) ? (bid % 8) * (G / 8) + bid / 8 : bid;
            if (!odd) {
#pragma unroll 1
                for (int step = 0; step < 2; ++step) {
                    if ((step == 0) == ((vcu & 1) != 0)) {
                        for (int u = vcu; u < 256; u += G) { const int bh = u >> 3, sp = u & 7;
                            dil::dilated_unit(lds, PROJ, a.in[I_RELB], ATT, (float*)(ws + WS_R2), (float*)(ws + WS_R2 + 32 * MiB), (float*)(ws + WS_H), (float*)(ws + WS_R2 + 34 * MiB), bh >> 3, bh & 7, sp, tid); }
                    } else {
                        for (int p = vcu; p < 256; p += G) { const int bh = p >> 3, s = p & 7, b = bh >> 3, h = bh & 7;
                            att::Src T{PROJ + h * 64, AB_IN, PROJ + 512 + h * 64, AB_IN, nullptr, PROJ + 1024 + h * 64, AB_IN, ATT + h * 64};
                            att::attn_unit<1>(lds, T, b, h, s, rc, rs, (const float*)(ws + WS_KMEAN), a.in[I_RELB], tid);
                            att::attn_unit<1>(lds, T, b, h, 15 - s, rc, rs, (const float*)(ws + WS_KMEAN), a.in[I_RELB], tid); }
                    }
                }
            } else {
#if USE_MFMA_MLA
                for (int rep = 1; rep < REP_MLA; ++rep)
                for (int p = vcu; p < 256; p += G) { const int bh = p >> 3, s = p & 7, b = bh >> 3, h = bh & 7;
                    att::Src T{Qb + h * 96, QW, KVb + h * 128, KVW, KPE, KVb + h * 128 + 64, KVW, ATT + h * 64};
                    att::attn_unit<0, PROBE_PM>(lds, T, b, h, s, rc, rs, nullptr, nullptr, tid);
                    att::attn_unit<0, PROBE_PM>(lds, T, b, h, 15 - s, rc, rs, nullptr, nullptr, tid); }
                for (int p = vcu; p < 256; p += G) { const int bh = p >> 3, s = p & 7, b = bh >> 3, h = bh & 7;
                    att::Src T{Qb + h * 96, QW, KVb + h * 128, KVW, KPE, KVb + h * 128 + 64, KVW, ATT + h * 64};
                    att::attn_unit<0>(lds, T, b, h, s, rc, rs, nullptr, nullptr, tid);
                    att::attn_unit<0>(lds, T, b, h, 15 - s, rc, rs, nullptr, nullptr, tid); }
#else
                naive_mla(Qb, KVb, KPE, rc, rs, ATT, gt, NGT);
#endif
#if USE_MFMA_SB
                for (int rep = 0; rep < REP_SB; ++rep)
                for (int p = vcu; p < 256; p += G) { const int bh = p >> 3, s = p & 7, b = bh >> 3, h = bh & 7;
                    att::Src T{PROJ + 544 + h * 64, CD_INP, PROJ + 1056 + h * 64, CD_INP, nullptr, PROJ + 1568 + h * 64, CD_INP, ATT + 512 + h * 64};
                    att::attn_unit<2>(lds, T, b, h, s, rc, rs, nullptr, nullptr, tid);
                    att::attn_unit<2>(lds, T, b, h, 15 - s, rc, rs, nullptr, nullptr, tid); }
#else
                naive_sb(PROJ, ATT, gt, NGT);
#endif
            }
            PH_END; } ++ph;
        pkind = 7;
        if (PH_ON) { PH_LOC;
            const f16* Bt = odd ? (const f16*)(ws + WS_W_OUTCD) + (size_t)li * DM * DM : (const f16*)(ws + WS_W_OUTAB) + (size_t)li * DM * DM;
            pg8::Gemm g{ATT, Bt, M, DM, DM, DM}; pg8::StaticOrder S; S.init(M, DM, G, bid);
#if SEAM_FUSE == 2
            if (G == 256) {
                pg8::EpiRow ER{X16, (l + 1 == DEPTH) ? X16B : X16, nullptr, modl + 2 * DM, a.in[I_MIXPOST] + l * DM, a.in[I_FFNPRE] + l * DM, modl + 3 * DM, H, HHALO,
                               (float*)(ws + WS_XB), (float*)(ws + WS_XB + 256 * 1024), ctl + CW_PANEL + 64 * (((2 * l + 0) * 2 + 0) * 64), ctl + CW_PANEL + 64 * (((2 * l + 0) * 2 + 1) * 64)};
                pg8::gemm_phase<pg8::EpiRow, pg8::StaticOrder, false, true>(lds, g, S, ER, tid);
            } else
#endif
            {
            const bool fuse = SEAM_FUSE == 1 && G == 256;
            unsigned* pc = ctl + CW_PANEL + 64 * ((2 * l + 0) * 64);
            pg8::EpiF16 E{Y1, DM, 0, nullptr, 0, nullptr, 0, 0, nullptr, nullptr, nullptr, nullptr, fuse ? pc : nullptr};
            pg8::gemm_phase<pg8::EpiF16, pg8::StaticOrder, true, true>(lds, g, S, E, tid);
            if (fuse) { pg8::Unit u; S.next(0, u);
                panel_wait(pc + 64 * u.pm, 32u, tid);
                thin_phase<false, true, false, true>(nullptr, X16, (l + 1 == DEPTH) ? X16B : X16, nullptr, Y1, modl + 2 * DM, a.in[I_MIXPOST] + l * DM, a.in[I_FFNPRE] + l * DM, modl + 3 * DM, H, HHALO, lds, tid,
                                                     u.pm * 256 + u.pn * 64 + (tid >> 6), NWAVES, u.pm * 256 + u.pn * 64 + 64); }
            }
            PH_END; } ++ph;
        pkind = 2;
        if (PH_ON) { PH_LOC;
            if (!(SEAM_FUSE != 0 && G == 256)) {
            const float* gpost = a.in[I_MIXPOST] + l * DM; const float* gpre = a.in[I_FFNPRE] + l * DM;
            thin_phase<false, true, false, true>(nullptr, X16, (l + 1 == DEPTH) ? X16B : X16, nullptr, Y1, modl + 2 * DM, gpost, gpre, modl + 3 * DM, H, HHALO, lds, tid, bid * NWAVES + (tid >> 6), G * NWAVES);
            PH_END; } } ++ph;
#if !HALO_IN_FUP
        if (PH_ON) { PH_LOC;
            pg8::Gemm g{HHALO, (const f16*)(ws + WS_W_FUP) + (size_t)l * DFF2 * DM, 256, DFF2, DM, DM}; pg8::StaticOrder S; S.init(256, DFF2, G, bid);
            pg8::EpiF32 E{(float*)(ws + WS_UHALO), DFF2, 128};
            pg8::gemm_phase<pg8::EpiF32, pg8::StaticOrder, true, true>(lds, g, S, E, tid);
            PH_END; }
#endif
        ++ph;
        pkind = 8;
        if (PH_ON) { PH_LOC;
            pg8::Gemm g{H, (const f16*)(ws + WS_W_FUP) + (size_t)l * DFF2 * DM, M, DFF2, DM, DM};
#if HALO_IN_FUP
            pg8::FfnUpOrder S; S.init(M, DFF2, G, bid);
            pg8::EpiConv E{ACT, (float*)(ws + WS_UHALO), a.in[I_CONVW] + (size_t)l * 3 * DFF2, a.in[I_CONVB] + (size_t)l * DFF2, (PG8_LAS float*)(lds + XCH_OFF), (PG8_LAS float*)(lds + XCH_OFF + 8192), ctl + CW_HALO + 64 * 22 * l, M / 256};
            pg8::gemm_phase<pg8::EpiConv, pg8::FfnUpOrder, true, true>(lds, g, S, E, tid);
#if PROBE_FUP == 1
            pg8::gemm_phase<pg8::EpiConv, pg8::FfnUpOrder, true, true>(lds, g, S, E, tid);
#elif PROBE_FUP == 3
            { pg8::StaticOrder S2; S2.init(M, DFF2, G, bid); pg8::EpiNull E2{}; pg8::gemm_phase<pg8::EpiNull, pg8::StaticOrder, true, true>(lds, g, S2, E2, tid); }
#elif PROBE_FUP == 2
            { pg8::StaticOrder S2; S2.init(M, DFF2, G, bid); pg8::EpiF16 E2{(f16*)(ws + WS_R2), 1024, 0, nullptr, 0, nullptr, 0, 0, nullptr, nullptr, nullptr, nullptr, nullptr};
              pg8::gemm_phase<pg8::EpiF16, pg8::StaticOrder, true, true>(lds, g, S2, E2, tid); }
#endif
            if (DEFER_W && l + 1 < DEPTH) {
                const int total = (M / 256) * (DFF2 / 256) + DFF2 / 256, rounds = (total + G - 1) / G; int first_short = total - (rounds - 1) * G; if (first_short >= G) first_short = 0;
                if (bid >= first_short) { const int tid2 = TID_NOW;
                    layer_mod(a, lds, tid2, bid - first_short, G - first_short, l + 1); layer_weights(a, lds, tid2, bid - first_short, G - first_short, l + 1, 1); }
            }
#else
            pg8::StaticOrder S; S.init(M, DFF2, G, bid);
            pg8::EpiConv E{ACT, (float*)(ws + WS_UHALO), a.in[I_CONVW] + (size_t)l * 3 * DFF2, a.in[I_CONVB] + (size_t)l * DFF2, (PG8_LAS float*)(lds + XCH_OFF), (PG8_LAS float*)(lds + XCH_OFF + 8192), ctl + CW_HALO, -1};
            for (int rep = 0; rep < REP_FUP; ++rep) pg8::gemm_phase<pg8::EpiConv, pg8::StaticOrder, true, true>(lds, g, S, E, tid);
#endif
            PH_END; } ++ph;
        ++ph; ++ph;
        pkind = 9;
        if (PH_ON) { PH_LOC;
            pg8::Gemm g{ACT, (const f16*)(ws + WS_W_FDN) + (size_t)l * DM * DFF, M, DM, DFF, DFF}; pg8::StaticOrder S; S.init(M, DM, G, bid);
#if SEAM_FUSE == 2
            if (G == 256) {
                const int ln2 = (l + 1 < DEPTH) ? l + 1 : l; const bool last = l + 1 == DEPTH;
                pg8::EpiRow ER{last ? X16B : X16, last ? (f16*)nullptr : X16, last ? xout0 : (float*)nullptr, modl + 5 * DM, a.in[I_FFNPOST] + l * DM, a.in[I_MIXPRE] + ln2 * DM, MOD + (size_t)ln2 * BATCH * 6144, H, nullptr,
                               (float*)(ws + WS_XB), (float*)(ws + WS_XB + 256 * 1024), ctl + CW_PANEL + 64 * (((2 * l + 1) * 2 + 0) * 64), ctl + CW_PANEL + 64 * (((2 * l + 1) * 2 + 1) * 64)};
                pg8::gemm_phase<pg8::EpiRow, pg8::StaticOrder, false, true>(lds, g, S, ER, tid);
                if (gt < BATCH * 16 * 512) ((float*)(ws + WS_KMEAN))[gt] = 0.f;
            } else
#endif
            {
            const bool fuse = SEAM_FUSE == 1 && G == 256;
            unsigned* pc = ctl + CW_PANEL + 64 * ((2 * l + 1) * 64);
            pg8::EpiF16 E{Y2, DM, 0, nullptr, 0, nullptr, 0, 0, nullptr, nullptr, nullptr, nullptr, fuse ? pc : nullptr};
            pg8::gemm_phase<pg8::EpiF16, pg8::StaticOrder, true, true>(lds, g, S, E, tid);
            if (fuse) { pg8::Unit u; S.next(0, u);
                panel_wait(pc + 64 * u.pm, 32u, tid);
                const int ln = (l + 1 < DEPTH) ? l + 1 : l; const int r0 = u.pm * 256 + u.pn * 64;
                if (l + 1 < DEPTH) thin_phase<false, true, false, true>(nullptr, X16, X16, nullptr, Y2, modl + 5 * DM, a.in[I_FFNPOST] + l * DM, a.in[I_MIXPRE] + ln * DM, MOD + (size_t)ln * BATCH * 6144, H, nullptr, lds, tid, r0 + (tid >> 6), NWAVES, r0 + 64);
                else thin_phase<false, true, true, false>(nullptr, X16B, nullptr, xout0, Y2, modl + 5 * DM, a.in[I_FFNPOST] + l * DM, nullptr, nullptr, nullptr, nullptr, lds, tid, r0 + (tid >> 6), NWAVES, r0 + 64);
                if (gt < BATCH * 16 * 512) ((float*)(ws + WS_KMEAN))[gt] = 0.f; }
            }
            PH_END; } ++ph;
        pkind = 2;
        if (PH_ON) { PH_LOC;
            if (!(SEAM_FUSE != 0 && G == 256)) {
            const int ln = (l + 1 < DEPTH) ? l + 1 : l;
            if (gt < BATCH * 16 * 512) ((float*)(ws + WS_KMEAN))[gt] = 0.f;
            if (l + 1 < DEPTH) thin_phase<false, true, false, true>(nullptr, X16, X16, nullptr, Y2, modl + 5 * DM, a.in[I_FFNPOST] + l * DM, a.in[I_MIXPRE] + ln * DM, MOD + (size_t)ln * BATCH * 6144, H, nullptr, lds, tid, bid * NWAVES + (tid >> 6), G * NWAVES);
            else thin_phase<false, true, true, false>(nullptr, X16B, nullptr, xout0, Y2, modl + 5 * DM, a.in[I_FFNPOST] + l * DM, nullptr, nullptr, nullptr, nullptr, lds, tid, bid * NWAVES + (tid >> 6), G * NWAVES);
            PH_END; } } ++ph;
    }
    if (PROBE_STAMP >= 0 && bid == PROBE_BLK) { const unsigned long long t0_ = rt(); while (rt() - t0_ < pacc) __builtin_amdgcn_s_sleep(10); }
#undef PH_ON
#undef PH_END
#undef X16
#undef X16B
#undef MOD
#undef H
#undef ATT
#undef HHALO
#undef PROJ
#undef Qb
#undef KVb
#undef KPE
#undef rc
#undef rs
#undef ctl
#undef Y1
#undef Y2
#undef ACT
#undef modl
}

extern "C" void kernel_launch(void* const* d_in, const int* in_sizes, int n_in, void* d_out, int out_size, void* d_ws, size_t ws_size, hipStream_t stream) {
    static int grid = 0;
    if (grid == 0) {
        if (n_in != 21 || in_sizes[0] != M * DM || out_size != M * DM || ws_size < WS_END) { fprintf(stderr, "kernel_launch: unexpected shapes (n_in %d, ws %zu); nothing launched\n", n_in, ws_size); grid = -1; return; }
        int dev = 0, cus = 0, per_cu = 0;
        if (hipGetDevice(&dev) != hipSuccess || hipDeviceGetAttribute(&cus, hipDeviceAttributeMultiprocessorCount, dev) != hipSuccess) { grid = -1; return; }
        if (hipFuncSetAttribute((const void*)fwd_kernel, hipFuncAttributeMaxDynamicSharedMemorySize, LDS_BYTES) != hipSuccess) { fprintf(stderr, "kernel_launch: hipFuncSetAttribute failed\n"); grid = -1; return; }
        if (hipOccupancyMaxActiveBlocksPerMultiprocessor(&per_cu, (const void*)fwd_kernel, NTHR, LDS_BYTES) != hipSuccess || per_cu < 1) { fprintf(stderr, "kernel_launch: occupancy query reports %d\n", per_cu); }
        (void)hipGetLastError();
        grid = cus;
        if (grid < 64) { fprintf(stderr, "kernel_launch: %d CUs: too few\n", cus); grid = -1; return; }
    }
    if (grid < 0) return;
    (void)hipMemsetAsync((char*)d_ws + WS_CTL, 0, CTL_ZERO_BYTES, stream);
    Args a{};
    for (int i = 0; i < 21; ++i) a.in[i] = (const float*)d_in[i];
    a.out = (float*)d_out; a.ws = (unsigned char*)d_ws;
#if MK_SPLIT
    for (int p = 0; p < N_PHASES; ++p) { a.ph_lo = p; a.ph_hi = p + 1; hipLaunchKernelGGL(fwd_kernel, dim3(grid), dim3(NTHR), LDS_BYTES, stream, a); }
#else
    a.ph_lo = 0; a.ph_hi = N_PHASES;
    hipLaunchKernelGGL(fwd_kernel, dim3(grid), dim3(NTHR), LDS_BYTES, stream, a);
#endif
}
```

```cpp
#include <hip/hip_runtime.h>
#include <cstdio>
#include <cstdint>

constexpr int BATCH = 4, SEQ = 4096, DM = 1024, M = BATCH * SEQ, DEPTH = 4;
constexpr int NH = 8, HD = 64;
constexpr int AB_IN = 3072, CD_IN = 2080, CD_INP = 2304;
constexpr int DFF = 2816, DFF2 = 5632;
constexpr int UP_N = 1792, UP_K = 256;
constexpr int QW = 768, KVW = 1024;
constexpr float NORM_EPS = 1e-6f;

typedef _Float16 f16;
typedef _Float16 f16x2 __attribute__((ext_vector_type(2)));
typedef _Float16 f16x4 __attribute__((ext_vector_type(4)));
typedef _Float16 f16x8 __attribute__((ext_vector_type(8)));
typedef float f32x2 __attribute__((ext_vector_type(2)));
typedef float f32x4 __attribute__((ext_vector_type(4)));
typedef unsigned u32x2 __attribute__((ext_vector_type(2)));
typedef unsigned u32x4 __attribute__((ext_vector_type(4)));

__device__ __forceinline__ unsigned pk_f16(float lo, float hi) { f32x2 v = {lo, hi}; f16x2 h = __builtin_convertvector(v, f16x2); return __builtin_bit_cast(unsigned, h); }

constexpr size_t MiB = 1u << 20;
constexpr size_t WS_CTL = 0, CTL_ZERO_BYTES = 1 * MiB;
constexpr size_t WS_MOD = 1 * MiB;
constexpr size_t WS_KMEAN = 1 * MiB + 512 * 1024;
constexpr size_t WS_ROPE = 2 * MiB;
constexpr size_t WS_UHALO = 3 * MiB;
constexpr size_t WS_HHALO = 140 * MiB;
constexpr size_t WS_XB = 6 * MiB;
constexpr size_t WS_W_INAB = 8 * MiB;
constexpr size_t WS_W_OUTAB = 20 * MiB;
constexpr size_t WS_W_INCD = 24 * MiB;
constexpr size_t WS_W_UP2 = 33 * MiB;
constexpr size_t WS_W_OUTCD = 37 * MiB;
constexpr size_t WS_W_FUP = 41 * MiB;
constexpr size_t WS_W_FDN = 85 * MiB;
constexpr size_t WS_H = 108 * MiB;
constexpr size_t WS_ATT = 140 * MiB;
constexpr size_t WS_R2 = 172 * MiB;
constexpr size_t WS_R1 = 236 * MiB;
constexpr size_t WS_END = 332 * MiB;
constexpr int CW_BAR = 4096;
constexpr int CW_PANEL = 32768;
constexpr int CW_HALO = 16384;
namespace pg8 {
__device__ __forceinline__ int lane_hw() { int l; asm volatile("v_mbcnt_lo_u32_b32 %0, -1, 0\n\tv_mbcnt_hi_u32_b32 %0, -1, %0" : "=v"(l)); return l; }
#define PG8_LAS __attribute__((address_space(3)))
constexpr int BM = 256, BK = 64, HALF = 128, HTB = HALF * BK * 2  , STAGE_BYTES = 8 * HTB, NXCD = 8, WGM = 8;

__host__ __device__ __forceinline__ int lds_byte(int r, int c) { const int st = (r >> 4) * 2 + (c >> 5), rr = r & 15, cc = c & 31, ob = rr * 64 + cc * 2; return st * 1024 + (ob ^ (((ob >> 9) & 1) << 5)); }
__host__ __device__ __forceinline__ void stage_rc(int b, int& R, int& C) { const int st = b / 1024, sb = b % 1024, swz = sb ^ (((sb >> 9) & 1) << 5); R = (st >> 1) * 16 + swz / 64; C = (st & 1) * 32 + (swz % 64) / 2; }
__host__ __device__ __forceinline__ int perm32(int rho) { const int n = rho >> 4, i = rho & 15; return 8 * (i >> 2) + 4 * n + (i & 3); }

struct Unit { int pm, pn; };
struct Gemm { const f16* A; const f16* Bt; int M, N, K, lda; };

struct StaticOrder {
    int nM, nN, nwg, G, c;
    __host__ __device__ __forceinline__ void init(int M_, int N_, int G_, int c_) { nM = M_ / BM; nN = N_ / BM; nwg = nM * nN; G = G_; c = c_; }
    __host__ __device__ __forceinline__ void map(int wgid, Unit& u) const {
        { const int q = nwg / NXCD, r = nwg % NXCD, xcd = wgid % NXCD, off = wgid / NXCD; wgid = (xcd < r ? xcd * (q + 1) : r * (q + 1) + (xcd - r) * q) + off; }
        const int nig = WGM * nN, gid = wgid / nig, fm = gid * WGM, gsz = (nM - fm) < WGM ? (nM - fm) : WGM;
        u.pm = fm + ((wgid % nig) % gsz); u.pn = (wgid % nig) / gsz;
    }
    __host__ __device__ __forceinline__ bool next(int i, Unit& u) const { const long L = (long)i * G + c; if (L >= nwg) return false; map((int)L, u); return true; }
    __device__ __forceinline__ void a_ready(const Unit&) const {}
    __device__ __forceinline__ void done(const Unit&) const {}
    __device__ __forceinline__ size_t a_off(const Unit&) const { return 0; }
};

struct FfnUpOrder {
    StaticOrder S; int nh;
    __host__ __device__ __forceinline__ void init(int M_, int N_, int G_, int c_) { S.init(M_, N_, G_, c_); nh = N_ / BM; }
    __host__ __device__ __forceinline__ bool next(int i, Unit& u) const { const long L = (long)i * S.G + S.c; if (L >= S.nwg + nh) return false; if (L < nh) { u.pm = S.nM; u.pn = (int)L; return true; } S.map((int)L - nh, u); return true; }
    __device__ __forceinline__ void a_ready(const Unit&) const {}
    __device__ __forceinline__ void done(const Unit&) const {}
    __device__ __forceinline__ size_t a_off(const Unit&) const { return 0; }
};

struct UpOrder {
    StaticOrder S; int split_pn;
    __host__ __device__ __forceinline__ void init(int M_, int N_, int G_, int c_, int sp) { S.init(M_, N_, G_, c_); split_pn = sp; }
    __host__ __device__ __forceinline__ bool next(int i, Unit& u) const { return S.next(i, u); }
    __device__ __forceinline__ void a_ready(const Unit&) const {}
    __device__ __forceinline__ void done(const Unit&) const {}
    __device__ __forceinline__ size_t a_off(const Unit& u) const { return u.pn >= split_pn ? 512 : 0; }
};

struct NoPre { __device__ __forceinline__ void pin() {} };
struct EpiNull {
    static constexpr bool PERM = true, AFTER_DRAIN = false;
    typedef NoPre Pre; __device__ __forceinline__ void prefetch(Pre&, const Unit&, int) const {}
    __device__ __forceinline__ void operator()(const f32x4 (&acc)[2][2][4][2], const Unit&, int, int, int, int, const Pre&) const {
#pragma unroll
        for (int a = 0; a < 2; ++a)
#pragma unroll
            for (int b = 0; b < 2; ++b)
#pragma unroll
                for (int m = 0; m < 4; ++m) asm volatile("" :: "v"(acc[a][b][m][0]), "v"(acc[a][b][m][1]));
    }
};
struct EpiF32 {
    static constexpr bool PERM = false, AFTER_DRAIN = false;
    float* C; int ldc; int row_limit;
    typedef NoPre Pre; __device__ __forceinline__ void prefetch(Pre&, const Unit&, int) const {}
    __device__ __forceinline__ void operator()(const f32x4 (&acc)[2][2][4][2], const Unit& u, int wr, int wc, int fr_in, int fq_in, const Pre&) const {
        int fr = fr_in, fq = fq_in; asm volatile("" : "+v"(fr), "+v"(fq));
        const int row0 = u.pm * BM + wr * 64 + fr, col0 = u.pn * BM + wc * 32 + 4 * fq;
#pragma unroll
        for (int ai = 0; ai < 2; ++ai)
#pragma unroll
            for (int m = 0; m < 4; ++m) { const int row = row0 + ai * HALF + m * 16; if (row >= row_limit) continue; float* rowp = C + (size_t)row * ldc + col0;
#pragma unroll
                for (int bj = 0; bj < 2; ++bj)
#pragma unroll
                    for (int n = 0; n < 2; ++n) *(f32x4*)(rowp + bj * HALF + n * 16) = acc[ai][bj][m][n]; }
    }
};
struct EpiF16 {
    static constexpr bool PERM = true, AFTER_DRAIN = false;
    f16* O; int ldc; int split_col; f16* O2; int ldc2;
    float* ksum; int ks_lo, ks_hi;
    PG8_LAS float* XR; f16* KPE; const float* rc; const float* rs;
    unsigned* pcnt;
    typedef NoPre Pre; __device__ __forceinline__ void prefetch(Pre&, const Unit&, int) const {}
    __device__ __forceinline__ void operator()(const f32x4 (&acc)[2][2][4][2], const Unit& u, int wr, int wc, int fr_in, int fq_in, const Pre&) const {
        int fr = fr_in, fq = fq_in; asm volatile("" : "+v"(fr), "+v"(fq));
        float rsc[2][4];
#pragma unroll
        for (int ai = 0; ai < 2; ++ai)
#pragma unroll
            for (int m = 0; m < 4; ++m) rsc[ai][m] = 1.0f;
        if (XR != nullptr) {
            const bool nt = u.pn < 2;
            if (nt) {
#pragma unroll
                for (int ai = 0; ai < 2; ++ai)
#pragma unroll
                    for (int m = 0; m < 4; ++m) { float q = 0.f;
#pragma unroll
                        for (int bj = 0; bj < 2; ++bj)
#pragma unroll
                            for (int n = 0; n < 2; ++n) { const f32x4 x = acc[ai][bj][m][n]; q += (x[0] * x[0] + x[1] * x[1]) + (x[2] * x[2] + x[3] * x[3]); }
                        q += __shfl_xor(q, 16); q += __shfl_xor(q, 32);
                        if (fq == 0) XR[(ai * HALF + wr * 64 + m * 16 + fr) * 4 + wc] = q; }
            }
            asm volatile("s_waitcnt lgkmcnt(0)" ::: "memory"); __builtin_amdgcn_s_barrier(); asm volatile("" ::: "memory");
            if (nt) {
#pragma unroll
                for (int ai = 0; ai < 2; ++ai)
#pragma unroll
                    for (int m = 0; m < 4; ++m) { const f32x4 q = *(const PG8_LAS f32x4*)(XR + (ai * HALF + wr * 64 + m * 16 + fr) * 4); rsc[ai][m] = 1.0f / sqrtf(((q[0] + q[1]) + (q[2] + q[3])) * (1.0f / 256.0f) + NORM_EPS); }
            }
            if (u.pn == 2 && wc == 0) {
                const int half = fq >> 1, dd0 = 8 * (fq & 1);
#pragma unroll
                for (int ai = 0; ai < 2; ++ai)
#pragma unroll
                    for (int m = 0; m < 4; ++m) { const int row = u.pm * BM + ai * HALF + wr * 64 + m * 16 + fr, t = row & (SEQ - 1);
#pragma unroll
                        for (int n = 0; n < 2; ++n) { const f32x4 own = acc[ai][0][m][n]; f32x4 par;
#pragma unroll
                            for (int e = 0; e < 4; ++e) par[e] = __shfl_xor(own[e], 32);
                            const f32x4 cs = *(const f32x4*)(rc + t * 16 + dd0 + 4 * n), sn = *(const f32x4*)(rs + t * 16 + dd0 + 4 * n);
                            const f32x4 o = half ? (par * sn + own * cs) : (own * cs - par * sn);
                            u32x2 w; w.x = pk_f16(o[0], o[1]); w.y = pk_f16(o[2], o[3]);
                            *(u32x2*)(KPE + (size_t)row * 32 + 16 * half + dd0 + 4 * n) = w; } }
            }
        }
        if (ksum != nullptr && u.pn * BM >= ks_lo && u.pn * BM < ks_hi) {
#pragma unroll
            for (int bj = 0; bj < 2; ++bj)
#pragma unroll
                for (int n = 0; n < 2; ++n) { f32x4 cs = (acc[0][bj][0][n] + acc[0][bj][1][n]) + (acc[0][bj][2][n] + acc[0][bj][3][n]); cs = cs + ((acc[1][bj][0][n] + acc[1][bj][1][n]) + (acc[1][bj][2][n] + acc[1][bj][3][n]));
#pragma unroll
                    for (int e = 0; e < 4; ++e) { float v = cs[e]; v += __shfl_xor(v, 1); v += __shfl_xor(v, 2); v += __shfl_xor(v, 4); v += __shfl_xor(v, 8);
                        if (fr == 0) atomicAdd(ksum + (size_t)u.pm * (ks_hi - ks_lo) + (u.pn * BM - ks_lo) + bj * HALF + wc * 32 + 8 * fq + 4 * n + e, v); } }
        }
        const int row0 = u.pm * BM + wr * 64 + fr; int colt = u.pn * BM; f16* base = O; int ld = ldc;
        if (split_col && colt >= split_col) { base = O2; ld = ldc2; colt -= split_col; }
        const int col0 = colt + wc * 32 + 8 * fq;
        if (pcnt == nullptr) {
#pragma unroll
            for (int ai = 0; ai < 2; ++ai)
#pragma unroll
                for (int m = 0; m < 4; ++m) { f16* rowp = base + (size_t)(row0 + ai * HALF + m * 16) * ld + col0;
#pragma unroll
                    for (int bj = 0; bj < 2; ++bj) { const f32x4 v0 = acc[ai][bj][m][0] * rsc[ai][m], v1 = acc[ai][bj][m][1] * rsc[ai][m];
                        u32x4 w; w.x = pk_f16(v0[0], v0[1]); w.y = pk_f16(v0[2], v0[3]); w.z = pk_f16(v1[0], v1[1]); w.w = pk_f16(v1[2], v1[3]);
                        *(u32x4*)(rowp + bj * HALF) = w; } }
        } else {
            const __amdgpu_buffer_rsrc_t rsrc = __builtin_amdgcn_make_buffer_rsrc((void*)base, 0, 0x7fffffff, 0x00020000);
#pragma unroll
            for (int ai = 0; ai < 2; ++ai)
#pragma unroll
                for (int m = 0; m < 4; ++m) { const unsigned boff = (unsigned)(((size_t)(row0 + ai * HALF + m * 16) * ld + col0) * 2);
#pragma unroll
                    for (int bj = 0; bj < 2; ++bj) { const f32x4 v0 = acc[ai][bj][m][0] * rsc[ai][m], v1 = acc[ai][bj][m][1] * rsc[ai][m];
                        u32x4 w; w.x = pk_f16(v0[0], v0[1]); w.y = pk_f16(v0[2], v0[3]); w.z = pk_f16(v1[0], v1[1]); w.w = pk_f16(v1[2], v1[3]);
                        __builtin_amdgcn_raw_buffer_store_b128(w, rsrc, boff + bj * HALF * 2, 0, 16); } }
            asm volatile("s_waitcnt vmcnt(0)" ::: "memory");
            if (fr == 0 && fq == 0) __hip_atomic_fetch_add(pcnt + 64 * u.pm, 1u, __ATOMIC_RELAXED, __HIP_MEMORY_SCOPE_AGENT);
        }
    }
};

struct EpiRow {
    static constexpr bool PERM = true, AFTER_DRAIN = true;
    typedef NoPre Pre; __device__ __forceinline__ void prefetch(Pre&, const Unit&, int) const {}
    const f16* xin; f16* xout; float* out32;
    const float* gate_l; const float* gpost;
    const float* gpre; const float* ss_l;
    f16* H; f16* HHALO;
    float* xb1; float* xb2; unsigned* c1; unsigned* c2;
    __device__ __forceinline__ void exchange(float (&q)[2][4], float* xb, unsigned* cnt, const Unit& u, int wr, int wc, int fr, int fq, PG8_LAS unsigned char* lds, int wid, int lane) const {
        PG8_LAS float* P = (PG8_LAS float*)lds;
        PG8_LAS float* S = (PG8_LAS float*)(lds + 8192);
#pragma unroll
        for (int ai = 0; ai < 2; ++ai)
#pragma unroll
            for (int m = 0; m < 4; ++m) { float v = q[ai][m]; v += __shfl_xor(v, 16); v += __shfl_xor(v, 32);
                if (fq == 0) P[(ai * HALF + wr * 64 + m * 16 + fr) * 4 + wc] = v; }
        asm volatile("s_waitcnt lgkmcnt(0)" ::: "memory"); __builtin_amdgcn_s_barrier(); asm volatile("" ::: "memory");
        const int row = wid * 32 + (lane & 31);
        if (lane < 32) { const f32x4 p = *(const PG8_LAS f32x4*)(P + row * 4);
            __hip_atomic_store((unsigned*)(xb + ((size_t)(u.pm * BM + row)) * 4 + u.pn), __builtin_bit_cast(unsigned, (p[0] + p[1]) + (p[2] + p[3])), __ATOMIC_RELAXED, __HIP_MEMORY_SCOPE_AGENT); }
        asm volatile("s_waitcnt vmcnt(0)" ::: "memory");
        if (lane == 0) __hip_atomic_fetch_add(cnt + 64 * u.pm, 1u, __ATOMIC_RELAXED, __HIP_MEMORY_SCOPE_AGENT);
        if (wid == 0) { unsigned spins = 0;
            while ((unsigned)__builtin_amdgcn_readfirstlane(__hip_atomic_load(cnt + 64 * u.pm, __ATOMIC_RELAXED, __HIP_MEMORY_SCOPE_AGENT)) < 32u) { __builtin_amdgcn_s_sleep(1); if (++spins > (1u << 16)) break; }
            __builtin_amdgcn_fence(__ATOMIC_ACQUIRE, "agent"); }
        asm volatile("s_waitcnt vmcnt(0) lgkmcnt(0)" ::: "memory"); __builtin_amdgcn_s_barrier(); asm volatile("" ::: "memory");
        if (lane < 32) { const unsigned* sl = (const unsigned*)(xb + ((size_t)(u.pm * BM + row)) * 4); float t = 0.f;
#pragma unroll
            for (int k = 0; k < 4; ++k) t += __builtin_bit_cast(float, __hip_atomic_load(sl + k, __ATOMIC_RELAXED, __HIP_MEMORY_SCOPE_AGENT));
            S[row] = t; }
        asm volatile("s_waitcnt lgkmcnt(0)" ::: "memory"); __builtin_amdgcn_s_barrier(); asm volatile("" ::: "memory");
#pragma unroll
        for (int ai = 0; ai < 2; ++ai)
#pragma unroll
            for (int m = 0; m < 4; ++m) q[ai][m] = S[ai * HALF + wr * 64 + m * 16 + fr];
        asm volatile("s_waitcnt lgkmcnt(0)" ::: "memory"); __builtin_amdgcn_s_barrier(); asm volatile("" ::: "memory");
    }
    __device__ __forceinline__ void fused(f32x4 (&acc)[2][2][4][2], const Unit& u, int wr, int wc, int fr, int fq, PG8_LAS unsigned char* lds, int wid, int lane) const {
        const int b = (u.pm * BM) / SEQ;
        const int row0 = u.pm * BM + wr * 64 + fr, col0 = u.pn * BM + wc * 32 + 8 * fq;
        float q[2][4];
#pragma unroll
        for (int ai = 0; ai < 2; ++ai)
#pragma unroll
            for (int m = 0; m < 4; ++m) { float v = 0.f;
#pragma unroll
                for (int bj = 0; bj < 2; ++bj)
#pragma unroll
                    for (int n = 0; n < 2; ++n) { const f32x4 x = acc[ai][bj][m][n]; v += (x[0] * x[0] + x[1] * x[1]) + (x[2] * x[2] + x[3] * x[3]); }
                q[ai][m] = v; }
        exchange(q, xb1, c1, u, wr, wc, fr, fq, lds, wid, lane);
#pragma unroll
        for (int ai = 0; ai < 2; ++ai)
#pragma unroll
            for (int m = 0; m < 4; ++m) q[ai][m] = 1.0f / sqrtf(q[ai][m] * (1.0f / 1024.0f) + NORM_EPS);
#pragma unroll
        for (int bj = 0; bj < 2; ++bj) {
            const int col = col0 + bj * HALF;
            const f32x4 ta0 = *(const f32x4*)(gate_l + (size_t)b * 6144 + col) * *(const f32x4*)(gpost + col), ta1 = *(const f32x4*)(gate_l + (size_t)b * 6144 + col + 4) * *(const f32x4*)(gpost + col + 4);
#pragma unroll
            for (int ai = 0; ai < 2; ++ai)
#pragma unroll
                for (int m = 0; m < 4; ++m) { const size_t off = (size_t)(row0 + ai * HALF + m * 16) * 1024 + col;
                    const f16x8 xh = *(const f16x8*)(xin + off);
                    f32x4 x0 = {(float)xh[0], (float)xh[1], (float)xh[2], (float)xh[3]}, x1 = {(float)xh[4], (float)xh[5], (float)xh[6], (float)xh[7]};
                    x0 = x0 + ta0 * (acc[ai][bj][m][0] * q[ai][m]); x1 = x1 + ta1 * (acc[ai][bj][m][1] * q[ai][m]);
                    if (out32 != nullptr) { *(f32x4*)(out32 + off) = x0; *(f32x4*)(out32 + off + 4) = x1; }
                    else { u32x4 w; w.x = pk_f16(x0[0], x0[1]); w.y = pk_f16(x0[2], x0[3]); w.z = pk_f16(x1[0], x1[1]); w.w = pk_f16(x1[2], x1[3]);
                        *(u32x4*)(xout + off) = w;
                        const f16x8 r = __builtin_bit_cast(f16x8, w);
                        x0 = (f32x4){(float)r[0], (float)r[1], (float)r[2], (float)r[3]}; x1 = (f32x4){(float)r[4], (float)r[5], (float)r[6], (float)r[7]}; }
                    acc[ai][bj][m][0] = x0; acc[ai][bj][m][1] = x1; }
            asm volatile("" ::: "memory");
        }
        if (out32 != nullptr) return;
#pragma unroll
        for (int ai = 0; ai < 2; ++ai)
#pragma unroll
            for (int m = 0; m < 4; ++m) { float v = 0.f;
#pragma unroll
                for (int bj = 0; bj < 2; ++bj)
#pragma unroll
                    for (int n = 0; n < 2; ++n) { const f32x4 x = acc[ai][bj][m][n]; v += (x[0] * x[0] + x[1] * x[1]) + (x[2] * x[2] + x[3] * x[3]); }
                q[ai][m] = v; }
        exchange(q, xb2, c2, u, wr, wc, fr, fq, lds, wid, lane);
#pragma unroll
        for (int ai = 0; ai < 2; ++ai)
#pragma unroll
            for (int m = 0; m < 4; ++m) q[ai][m] = 1.0f / sqrtf(q[ai][m] * (1.0f / 1024.0f) + NORM_EPS);
#pragma unroll
        for (int bj = 0; bj < 2; ++bj) {
            const int col = col0 + bj * HALF; const float* sp = ss_l + (size_t)b * 6144 + col;
            const f32x4 tb0 = *(const f32x4*)(gpre + col) * (*(const f32x4*)(sp + 1024) + 1.0f), tb1 = *(const f32x4*)(gpre + col + 4) * (*(const f32x4*)(sp + 1024 + 4) + 1.0f);
            const f32x4 tc0 = *(const f32x4*)sp, tc1 = *(const f32x4*)(sp + 4);
#pragma unroll
            for (int ai = 0; ai < 2; ++ai)
#pragma unroll
                for (int m = 0; m < 4; ++m) { const int row = row0 + ai * HALF + m * 16;
                    const f32x4 h0 = (acc[ai][bj][m][0] * q[ai][m]) * tb0 + tc0, h1 = (acc[ai][bj][m][1] * q[ai][m]) * tb1 + tc1;
                    u32x4 w; w.x = pk_f16(h0[0], h0[1]); w.y = pk_f16(h0[2], h0[3]); w.z = pk_f16(h1[0], h1[1]); w.w = pk_f16(h1[2], h1[3]);
                    *(u32x4*)(H + (size_t)row * 1024 + col) = w;
                    if (HHALO != nullptr && (row & 255) >= 254 && (((row >> 8) + 1) & 15) != 0) *(u32x4*)(HHALO + (size_t)(2 * ((row >> 8) + 1) + ((row & 255) - 254)) * 1024 + col) = w; }
            asm volatile("" ::: "memory");
        }
    }
};

__device__ __forceinline__ float gelu_tanh_f(float g) { const float u = 0.7978845608028654f * (g + 0.044715f * g * g * g); const float e = __builtin_amdgcn_exp2f(u * 2.885390081777927f); return g * (1.0f - __builtin_amdgcn_rcpf(e + 1.0f)); }
__device__ __forceinline__ f32x2 gelu_mul_pk(f32x2 g, f32x2 v) {
    const f32x2 g2 = g * g, t = g2 * (0.044715f * 2.302208198f) + 2.302208198f, u2 = t * g;
    f32x2 e; e.x = __builtin_amdgcn_exp2f(u2.x); e.y = __builtin_amdgcn_exp2f(u2.y);
    const f32x2 d = e + 1.0f; f32x2 r; r.x = __builtin_amdgcn_rcpf(d.x); r.y = __builtin_amdgcn_rcpf(d.y);
    const f32x2 gv = g * v; return gv - gv * r;
}
template <int N> __device__ __forceinline__ float ror16(float v) { return __builtin_bit_cast(float, __builtin_amdgcn_update_dpp(0, __builtin_bit_cast(int, v), 0x120 + N, 0xf, 0xf, false)); }
__device__ __forceinline__ f32x4 ld_agent_f32x4(const float* p) { typedef unsigned long long u64; const u64 a = __hip_atomic_load((u64*)p, __ATOMIC_RELAXED, __HIP_MEMORY_SCOPE_AGENT), b = __hip_atomic_load((u64*)p + 1, __ATOMIC_RELAXED, __HIP_MEMORY_SCOPE_AGENT);
    return (f32x4){__builtin_bit_cast(float, (unsigned)a), __builtin_bit_cast(float, (unsigned)(a >> 32)), __builtin_bit_cast(float, (unsigned)b), __builtin_bit_cast(float, (unsigned)(b >> 32))}; }
struct EpiConv {
    static constexpr bool PERM = true, AFTER_DRAIN = false;
    f16* ACT; float* UHALO; const float* cw; const float* cb; PG8_LAS float* X;
    PG8_LAS float* WL;
    unsigned* hcnt; int halo_pm;
    struct Pre { float w[2]; unsigned hc; __device__ __forceinline__ void pin() { asm volatile("" : "+v"(w[0]), "+v"(w[1]), "+v"(hc)); } };
    __device__ __forceinline__ void prefetch(Pre& p, const Unit& u, int tid) const {
        if (u.pm == halo_pm) return;
        p.hc = ((u.pm & 15) != 0) ? __hip_atomic_load(hcnt + 64 * u.pn, __ATOMIC_RELAXED, __HIP_MEMORY_SCOPE_AGENT) : 8u;
        asm volatile("" : "+v"(tid));
#pragma unroll
        for (int k = 0; k < 2; ++k) { const int idx = tid + 512 * k, q = idx >> 8, bjw = (idx >> 7) & 1, col = idx & 127; const int oc = bjw * 2816 + u.pn * 128 + col;
            p.w[k] = (q < 3) ? cw[q * 5632 + oc] : cb[oc]; }
    }
    __device__ __forceinline__ void operator()(f32x4 (&acc)[2][2][4][2], const Unit& u, int wr, int wc, int fr_in, int fq_in, const Pre& pre) const {
        int fr = fr_in, fq = fq_in; asm volatile("" : "+v"(fr), "+v"(fq));
        const int lane = fr + 16 * fq;
        const int lc = wc * 32 + 8 * fq;
        if (u.pm == halo_pm) {
#pragma unroll
            for (int m = 0; m < 4; ++m)
#pragma unroll
                for (int bj = 0; bj < 2; ++bj)
#pragma unroll
                    for (int n = 0; n < 2; ++n) *(f32x4*)(UHALO + (size_t)(wr * 64 + m * 16 + fr) * 5632 + u.pn * 256 + bj * 128 + lc + 4 * n) = acc[0][bj][m][n];
            __builtin_amdgcn_fence(__ATOMIC_RELEASE, "agent");
            asm volatile("s_waitcnt vmcnt(0)" ::: "memory");
            if (lane == 0) __hip_atomic_fetch_add(hcnt + 64 * u.pn, 1u, __ATOMIC_RELAXED, __HIP_MEMORY_SCOPE_AGENT);
            return;
        }
        if (wr == 0 && (u.pm & 15) != 0) {
            unsigned c = pre.hc, spins = 0;
            while ((unsigned)__builtin_amdgcn_readfirstlane(c) < 8u) { __builtin_amdgcn_s_sleep(2); c = __hip_atomic_load(hcnt + 64 * u.pn, __ATOMIC_RELAXED, __HIP_MEMORY_SCOPE_AGENT); if (++spins > (1u << 14)) break; }
        }
        {
            const int t512 = (wr * 4 + wc) * 64 + lane;
            WL[t512] = pre.w[0]; WL[t512 + 512] = pre.w[1];
        }
        if (fr >= 14) {
#pragma unroll
            for (int ai = 0; ai < 2; ++ai)
#pragma unroll
                for (int bj = 0; bj < 2; ++bj)
#pragma unroll
                    for (int n = 0; n < 2; ++n) *(PG8_LAS f32x4*)(X + (((2 * ai + wr) * 2 + (fr - 14)) * 2 + bj) * 128 + lc + 4 * n) = acc[ai][bj][3][n];
        }
        asm volatile("s_waitcnt lgkmcnt(0)" ::: "memory"); __builtin_amdgcn_s_barrier(); asm volatile("" ::: "memory");
        const bool batch_start = (u.pm & 15) == 0;
#pragma unroll
        for (int bj = 0; bj < 2; ++bj)
#pragma unroll
            for (int n = 0; n < 2; ++n) {
                asm volatile("" ::: "memory");
                const int cl = bj * 128 + lc + 4 * n;
                const f32x4 w0v = *(const PG8_LAS f32x4*)(WL + 0 * 256 + cl), w1v = *(const PG8_LAS f32x4*)(WL + 1 * 256 + cl), w2v = *(const PG8_LAS f32x4*)(WL + 2 * 256 + cl), bbv = *(const PG8_LAS f32x4*)(WL + 3 * 256 + cl);
                f32x4 hq0[2], hq1[2];
#pragma unroll
                for (int ai = 0; ai < 2; ++ai) { const int g = 2 * ai + wr;
                    if (g > 0) { hq0[ai] = *(const PG8_LAS f32x4*)(X + (((g - 1) * 2 + 0) * 2 + bj) * 128 + lc + 4 * n); hq1[ai] = *(const PG8_LAS f32x4*)(X + (((g - 1) * 2 + 1) * 2 + bj) * 128 + lc + 4 * n); }
                    else if (!batch_start) { const float* hp = UHALO + (size_t)(2 * u.pm) * 5632 + u.pn * 256 + bj * 128 + lc + 4 * n; hq0[ai] = ld_agent_f32x4(hp); hq1[ai] = ld_agent_f32x4(hp + 5632); }
                    else { hq0[ai] = (f32x4){0.f, 0.f, 0.f, 0.f}; hq1[ai] = hq0[ai]; } }
#pragma unroll
                for (int ai = 1; ai >= 0; --ai) {
                    const f32x4 h0v = hq0[ai], h1v = hq1[ai];
#pragma unroll
                    for (int e = 0; e < 4; e += 2) {
                        const f32x2 w0 = {w0v[e], w0v[e + 1]}, w1 = {w1v[e], w1v[e + 1]}, w2 = {w2v[e], w2v[e + 1]}, bb = {bbv[e], bbv[e + 1]}, h0 = {h0v[e], h0v[e + 1]}, h1 = {h1v[e], h1v[e + 1]};
                        f32x2 c1 = {ror16<1>(acc[ai][bj][3][n][e]), ror16<1>(acc[ai][bj][3][n][e + 1])}, c2 = {ror16<2>(acc[ai][bj][3][n][e]), ror16<2>(acc[ai][bj][3][n][e + 1])};
#pragma unroll
                        for (int m = 3; m >= 0; --m) {
                            f32x2 p1, p2;
                            if (m > 0) { p1 = (f32x2){ror16<1>(acc[ai][bj][m - 1][n][e]), ror16<1>(acc[ai][bj][m - 1][n][e + 1])}; p2 = (f32x2){ror16<2>(acc[ai][bj][m - 1][n][e]), ror16<2>(acc[ai][bj][m - 1][n][e + 1])}; }
                            else { p1 = h1; p2 = (fr == 0) ? h0 : h1; }
                            const f32x2 r1 = (fr >= 1) ? c1 : p1, r2 = (fr >= 2) ? c2 : p2;
                            const f32x2 cur = {acc[ai][bj][m][n][e], acc[ai][bj][m][n][e + 1]};
                            const f32x2 o = w0 * r2 + (w1 * r1 + (w2 * cur + bb));
                            acc[ai][bj][m][n][e] = o[0]; acc[ai][bj][m][n][e + 1] = o[1];
                            asm volatile("" : "+v"(acc[ai][bj][m][n]));
                            c1 = p1; c2 = p2;
                        }
                    }
                }
            }
        asm volatile("" ::: "memory");
        const int row0 = u.pm * BM + wr * 64 + fr;
#pragma unroll
        for (int ai = 0; ai < 2; ++ai)
#pragma unroll
            for (int m = 0; m < 4; ++m) {
                const f32x4 g0 = acc[ai][0][m][0], g1 = acc[ai][0][m][1], v0 = acc[ai][1][m][0], v1 = acc[ai][1][m][1];
                const f32x2 a0 = gelu_mul_pk((f32x2){g0[0], g0[1]}, (f32x2){v0[0], v0[1]}), a1 = gelu_mul_pk((f32x2){g0[2], g0[3]}, (f32x2){v0[2], v0[3]});
                const f32x2 a2 = gelu_mul_pk((f32x2){g1[0], g1[1]}, (f32x2){v1[0], v1[1]}), a3 = gelu_mul_pk((f32x2){g1[2], g1[3]}, (f32x2){v1[2], v1[3]});
                u32x4 w; w.x = pk_f16(a0.x, a0.y); w.y = pk_f16(a1.x, a1.y); w.z = pk_f16(a2.x, a2.y); w.w = pk_f16(a3.x, a3.y);
                *(u32x4*)(ACT + (size_t)(row0 + ai * HALF + m * 16) * 2816 + u.pn * 128 + lc) = w;
                asm volatile("" ::: "memory");
            }
    }
};

template <class Epi, class Sched, bool ALIGN_EPI = false, bool SP2 = false>
__device__ __forceinline__ void gemm_phase(PG8_LAS unsigned char* lds, const Gemm g, const Sched& S, const Epi& E, int tid_in) {
    const int wid = __builtin_amdgcn_readfirstlane(tid_in >> 6), wr = wid >> 2, wc = wid & 3;
    const int K = g.K, nt = K / BK;
    unsigned voffA[2], voffB[2]; int aoff, boff;
    auto lane_consts = [&]() {
        const int lane = lane_hw(), tid = wid * 64 + lane, fr = lane & 15, fq = lane >> 4;
#pragma unroll
        for (int i = 0; i < 2; ++i) { int R, C; stage_rc(tid * 16 + i * 8192, R, C); const int Rb = Epi::PERM ? ((R & ~31) + perm32(R & 31)) : R;
            voffA[i] = (unsigned)(R * g.lda + C) * 2u; voffB[i] = (unsigned)(Rb * K + C) * 2u; }
        aoff = lds_byte(wr * 64 + fr, fq * 8); boff = lds_byte(wc * 32 + fr, fq * 8);
    };
    lane_consts();
    const size_t kstep = (size_t)(BK * 2);
    const size_t hstep = (size_t)HALF * K * 2;
    const size_t tstep = 2 * hstep;
    const size_t hstepA = (size_t)HALF * g.lda * 2, tstepA = 2 * hstepA;
    const unsigned ldsw = (unsigned)wid * 1024u;
#define PG8_SA(b, h) (((b) * 2 + (h)) * HTB)
#define PG8_SB(b, h) ((4 + (b) * 2 + (h)) * HTB)
#define PG8_STAGE(bufoff, gbase, voff) do { _Pragma("unroll") for (int _i = 0; _i < 2; ++_i) \
        __builtin_amdgcn_global_load_lds((const unsigned*)((const char*)(gbase) + (voff)[_i]), (PG8_LAS unsigned*)(lds + (bufoff) + ldsw + _i * 8192), 16, 0, 0); } while (0)
#define PG8_LDA(dst, b, h) do { _Pragma("unroll") for (int m = 0; m < 4; ++m) _Pragma("unroll") for (int k = 0; k < 2; ++k) dst[m][k] = *(const PG8_LAS f16x8*)(lds + PG8_SA(b, h) + aoff + m * 2048 + k * 1024); } while (0)
#define PG8_LDB(dst, b, h) do { _Pragma("unroll") for (int n = 0; n < 2; ++n) _Pragma("unroll") for (int k = 0; k < 2; ++k) dst[n][k] = *(const PG8_LAS f16x8*)(lds + PG8_SB(b, h) + boff + n * 2048 + k * 1024); } while (0)
#define PG8_MMA(ai, bj, At, Bt) do { __builtin_amdgcn_s_setprio(1); _Pragma("unroll") for (int m = 0; m < 4; ++m) _Pragma("unroll") for (int n = 0; n < 2; ++n) _Pragma("unroll") for (int k = 0; k < 2; ++k) \
        acc[ai][bj][m][n] = __builtin_amdgcn_mfma_f32_16x16x32_f16(Bt[n][k], At[m][k], acc[ai][bj][m][n], 0, 0, 0); __builtin_amdgcn_s_setprio(0); } while (0)
#define PG8_WAIT_V(n) asm volatile("s_waitcnt vmcnt(" #n ")" ::: "memory")
#define PG8_WAIT_L(n) asm volatile("s_waitcnt lgkmcnt(" #n ")" ::: "memory")
#define PG8_BAR __builtin_amdgcn_s_barrier()
#define PG8_SCHED __builtin_amdgcn_sched_barrier(0)
    Unit cur, nxt; int ui = 0;
    if (!S.next(0, cur)) return;
    typename Epi::Pre pre; E.prefetch(pre, cur, wid * 64 + lane_hw());
    f32x4 acc[2][2][4][2];
#pragma unroll
    for (int a = 0; a < 2; ++a)
#pragma unroll
        for (int b = 0; b < 2; ++b)
#pragma unroll
            for (int m = 0; m < 4; ++m)
#pragma unroll
                for (int n = 0; n < 2; ++n) acc[a][b][m][n] = (f32x4){0.f, 0.f, 0.f, 0.f};
    f16x8 At[4][2], B0[2][2], B1[2][2];
    const char* cA = (const char*)g.A + (size_t)cur.pm * tstepA + S.a_off(cur); const char* cB = (const char*)g.Bt + (size_t)cur.pn * tstep;
    S.a_ready(cur);
    if constexpr (SP2) {
        PG8_STAGE(PG8_SB(0, 0), cB, voffB); PG8_STAGE(PG8_SB(0, 1), cB + hstep, voffB); PG8_STAGE(PG8_SA(0, 0), cA, voffA); PG8_STAGE(PG8_SA(0, 1), cA + hstepA, voffA);
        if (wr == 1) PG8_BAR;
        PG8_WAIT_V(2); PG8_BAR;
        PG8_STAGE(PG8_SB(1, 0), cB + kstep, voffB); PG8_STAGE(PG8_SA(1, 0), cA + kstep, voffA); PG8_STAGE(PG8_SB(1, 1), cB + hstep + kstep, voffB);
        PG8_WAIT_V(6); PG8_BAR;
    } else {
        PG8_STAGE(PG8_SB(0, 0), cB, voffB); PG8_STAGE(PG8_SA(0, 0), cA, voffA); PG8_STAGE(PG8_SB(0, 1), cB + hstep, voffB); PG8_STAGE(PG8_SA(0, 1), cA + hstepA, voffA);
        if (wr == 1) PG8_BAR;
        PG8_WAIT_V(4); PG8_BAR;
        PG8_STAGE(PG8_SB(1, 0), cB + kstep, voffB); PG8_STAGE(PG8_SA(1, 0), cA + kstep, voffA); PG8_STAGE(PG8_SB(1, 1), cB + hstep + kstep, voffB);
        PG8_WAIT_V(6); PG8_BAR;
    }
    for (;;) {
        const bool has_next = S.next(ui + 1, nxt);
        const char* nA = has_next ? (const char*)g.A + (size_t)nxt.pm * tstepA + S.a_off(nxt) : cA; const char* nB = has_next ? (const char*)g.Bt + (size_t)nxt.pn * tstep : cB;
#pragma unroll 1
        for (int t = 0; t < nt; t += 2) {
            const bool last = (t == nt - 2);
            const char* a1 = cA + (size_t)(t + 1) * kstep;
            const char* a2 = last ? nA : cA + (size_t)(t + 2) * kstep; const char* b2 = last ? nB : cB + (size_t)(t + 2) * kstep;
            const char* a3 = a2 + kstep; const char* b3 = b2 + kstep;
            if (last && has_next) S.a_ready(nxt);
            if constexpr (SP2) {
            PG8_LDB(B0, 0, 0); PG8_LDB(B1, 0, 1); PG8_SCHED; PG8_LDA(At, 0, 0); PG8_STAGE(PG8_SA(1, 1), a1 + hstepA, voffA);
            PG8_WAIT_V(8); PG8_WAIT_L(0); PG8_BAR; PG8_MMA(0, 0, At, B0); PG8_MMA(0, 1, At, B1); PG8_BAR; PG8_SCHED;
            PG8_LDA(At, 0, 1); PG8_STAGE(PG8_SB(0, 0), b2, voffB); PG8_STAGE(PG8_SB(0, 1), b2 + hstep, voffB); PG8_STAGE(PG8_SA(0, 0), a2, voffA);
            PG8_WAIT_V(8); PG8_WAIT_L(0); PG8_BAR; PG8_MMA(1, 0, At, B0); PG8_MMA(1, 1, At, B1); PG8_BAR; PG8_SCHED;
            PG8_LDB(B0, 1, 0); PG8_LDB(B1, 1, 1); PG8_SCHED; PG8_LDA(At, 1, 0); PG8_STAGE(PG8_SA(0, 1), a2 + hstepA, voffA);
            PG8_WAIT_V(8); PG8_WAIT_L(0); PG8_BAR; PG8_MMA(0, 0, At, B0); PG8_MMA(0, 1, At, B1); PG8_BAR; PG8_SCHED;
            PG8_LDA(At, 1, 1); PG8_STAGE(PG8_SB(1, 0), b3, voffB); PG8_STAGE(PG8_SB(1, 1), b3 + hstep, voffB); PG8_STAGE(PG8_SA(1, 0), a3, voffA);
            PG8_WAIT_V(8); PG8_WAIT_L(0); PG8_BAR; PG8_MMA(1, 0, At, B0); PG8_MMA(1, 1, At, B1); PG8_BAR; PG8_SCHED;
            } else {
            PG8_LDB(B0, 0, 0); PG8_SCHED; PG8_LDA(At, 0, 0); PG8_STAGE(PG8_SA(1, 1), a1 + hstepA, voffA);
            PG8_WAIT_L(8); PG8_BAR; PG8_WAIT_L(0); PG8_MMA(0, 0, At, B0); PG8_BAR; PG8_SCHED;
            PG8_LDB(B1, 0, 1); PG8_STAGE(PG8_SB(0, 0), b2, voffB);
            PG8_BAR; PG8_WAIT_L(0); PG8_MMA(0, 1, At, B1); PG8_BAR;
            PG8_LDA(At, 0, 1); PG8_STAGE(PG8_SA(0, 0), a2, voffA);
            PG8_BAR; PG8_WAIT_L(0); PG8_MMA(1, 0, At, B0); PG8_BAR; PG8_SCHED;
            PG8_STAGE(PG8_SB(0, 1), b2 + hstep, voffB);
            PG8_WAIT_V(6); PG8_BAR; PG8_MMA(1, 1, At, B1); PG8_BAR;
            PG8_LDB(B0, 1, 0); PG8_SCHED; PG8_LDA(At, 1, 0); PG8_STAGE(PG8_SA(0, 1), a2 + hstepA, voffA);
            PG8_WAIT_L(8); PG8_BAR; PG8_WAIT_L(0); PG8_MMA(0, 0, At, B0); PG8_BAR; PG8_SCHED;
            PG8_LDB(B1, 1, 1); PG8_STAGE(PG8_SB(1, 0), b3, voffB);
            PG8_BAR; PG8_WAIT_L(0); PG8_MMA(0, 1, At, B1); PG8_BAR;
            PG8_LDA(At, 1, 1); PG8_STAGE(PG8_SA(1, 0), a3, voffA);
            PG8_BAR; PG8_WAIT_L(0); PG8_MMA(1, 0, At, B0); PG8_BAR; PG8_SCHED;
            PG8_STAGE(PG8_SB(1, 1), b3 + hstep, voffB);
            PG8_WAIT_V(6); PG8_BAR; PG8_MMA(1, 1, At, B1); PG8_BAR;
            }
        }
        if constexpr (ALIGN_EPI) { if (wr == 0) PG8_BAR; }
        pre.pin();
        if constexpr (!Epi::AFTER_DRAIN) { const int le = lane_hw(); E(acc, cur, wr, wc, le & 15, le >> 4, pre); S.done(cur); }
        if (!has_next) break;
#pragma unroll
        for (int a = 0; a < 2; ++a)
#pragma unroll
            for (int b = 0; b < 2; ++b)
#pragma unroll
                for (int m = 0; m < 4; ++m)
#pragma unroll
                    for (int n = 0; n < 2; ++n) acc[a][b][m][n] = (f32x4){0.f, 0.f, 0.f, 0.f};
        cur = nxt; cA = nA; cB = nB; ++ui; E.prefetch(pre, cur, wid * 64 + lane_hw()); lane_consts();
        if constexpr (ALIGN_EPI) { if (wr == 1) PG8_BAR; }
    }
    PG8_WAIT_V(0);
    if constexpr (!ALIGN_EPI) { if (wr == 0) PG8_BAR; }
    PG8_BAR;
    if constexpr (Epi::AFTER_DRAIN) { const int le = lane_hw(); E.fused(acc, cur, wr, wc, le & 15, le >> 4, lds, wid, le); S.done(cur); }
#undef PG8_SA
#undef PG8_SB
#undef PG8_STAGE
#undef PG8_LDA
#undef PG8_LDB
#undef PG8_MMA
#undef PG8_WAIT_V
#undef PG8_WAIT_L
#undef PG8_BAR
#undef PG8_SCHED
}
}
#define GAS __attribute__((address_space(1)))
#define LAS __attribute__((address_space(3)))
typedef GAS unsigned gu32;
typedef GAS unsigned long long gu64;
#define RLX_AGENT __ATOMIC_RELAXED, __HIP_MEMORY_SCOPE_AGENT
#define LDS_WAIT() asm volatile("s_waitcnt lgkmcnt(0)" ::: "memory")
#define VM_WAIT() asm volatile("s_waitcnt vmcnt(0)" ::: "memory")
__device__ __forceinline__ unsigned long long rt() { return __builtin_amdgcn_s_memrealtime(); }
#define XB_TMO      128
#define XB_XCNT(j)  (256  + 64 * (j))
#define XB_XSUB(j)  (1280 + 64 * (j))
#define XB_XGEN(j)  (2304 + 64 * (j))
#define XB_TOP      3328
#define XB_TOPGEN   3392
#define XCD_BAR_WORDS 3456
#define XB_SPIN_CAP (1u << 18)

__device__ __forceinline__ unsigned xb_ld(unsigned* p)              { return __hip_atomic_load(p, __ATOMIC_RELAXED, __HIP_MEMORY_SCOPE_AGENT); }
__device__ __forceinline__ unsigned xb_add(unsigned* p, unsigned v) { return __hip_atomic_fetch_add(p, v, __ATOMIC_RELAXED, __HIP_MEMORY_SCOPE_AGENT); }
__device__ __forceinline__ unsigned xb_xcc_id() { return (unsigned)__builtin_amdgcn_s_getreg((3 << 11) | 20) & 0xFu; }
#define XB_SPIN(cond, bar) do { unsigned _sp = 0; while (cond) { __builtin_amdgcn_s_sleep(1); \
    if ((++_sp & 255u) == 0u) { if (xb_ld(&(bar)[XB_TMO])) break; if (_sp > XB_SPIN_CAP) { atomicAdd(&(bar)[XB_TMO], 1u); break; } } } } while (0)

struct XcdBarrier {
    unsigned* bar; unsigned x;
    volatile LAS unsigned* st;
};

__device__ __forceinline__ XcdBarrier xcd_barrier_post(unsigned* bar, volatile LAS unsigned* st, int tid) {
    XcdBarrier b; b.bar = bar; b.x = xb_xcc_id(); b.st = st;
    if (tid == 0) (void)xb_add(&bar[XB_XCNT(b.x)], 1u);
    return b;
}
__device__ __forceinline__ void xcd_barrier_complete(unsigned* bar, unsigned x, unsigned& nloc, unsigned& nx) {
    const unsigned G = gridDim.x * gridDim.y * gridDim.z;
    unsigned sum, cnt, mine, sp = 0u;
    for (;;) {
        sum = 0u; cnt = 0u; mine = 0u;
#pragma unroll
        for (unsigned j = 0; j < 16; ++j) { const unsigned c = xb_ld(&bar[XB_XCNT(j)]); sum += c; cnt += (c > 0u) ? 1u : 0u; mine = (j == x) ? c : mine; }
        if (sum == G) break;
        __builtin_amdgcn_s_sleep(1);
        if ((++sp & 255u) == 0u) { if (xb_ld(&bar[XB_TMO])) break; if (sp > XB_SPIN_CAP) { atomicAdd(&bar[XB_TMO], 1u); break; } }
    }
    nloc = mine > 0u ? mine : 1u; nx = cnt > 0u ? cnt : 1u;
}

__device__ __forceinline__ void xcd_barrier(const XcdBarrier& b, int tid) {
    asm volatile("s_waitcnt vmcnt(0)" ::: "memory");
    __syncthreads();
    if (tid == 0) {
        unsigned* bar = b.bar;
        __builtin_amdgcn_s_waitcnt(0);
        unsigned nloc = b.st[0], nx = b.st[1];
        if (nloc == 0u) { xcd_barrier_complete(bar, b.x, nloc, nx); b.st[0] = nloc; b.st[1] = nx; }
        const unsigned old = xb_add(&bar[XB_XSUB(b.x)], 1u);
        const unsigned gen = old / nloc;
        if (old + 1u == (gen + 1u) * nloc) {
            __builtin_amdgcn_fence(__ATOMIC_RELEASE, "agent");
            asm volatile("s_waitcnt vmcnt(0)" ::: "memory");
            const unsigned og = xb_add(&bar[XB_TOP], 1u);
            const unsigned tg = og / nx;
            if (og + 1u == (tg + 1u) * nx) xb_add(&bar[XB_TOPGEN], 1u);
            else XB_SPIN(xb_ld(&bar[XB_TOPGEN]) == tg, bar);
            __builtin_amdgcn_fence(__ATOMIC_ACQUIRE, "agent");
            xb_add(&bar[XB_XGEN(b.x)], 1u);
            asm volatile("s_waitcnt vmcnt(0)" ::: "memory");
        } else {
            XB_SPIN(xb_ld(&bar[XB_XGEN(b.x)]) == gen, bar);
            __builtin_amdgcn_fence(__ATOMIC_ACQUIRE, "agent");
            asm volatile("s_waitcnt vmcnt(0)" ::: "memory");
        }
    }
    __syncthreads();
}
constexpr int NWAVES = 8, NTHR = NWAVES * 64;
constexpr int RING_BYTES = 131072;
constexpr int LDSCTL_OFF = RING_BYTES, MISC_OFF = LDSCTL_OFF + 320;
constexpr int XCH_OFF = RING_BYTES + 1024;
constexpr int LDS_BYTES = 163840;

struct Args { const float* in[21]; float* out; unsigned char* ws; int ph_lo, ph_hi; };

enum { I_X = 0, I_C, I_RELB, I_ADAW, I_ADAB, I_MIXPRE, I_MIXPOST, I_FFNPRE, I_FFNPOST, I_ABWIN, I_ABWOUT, I_CDWIN, I_QNG, I_KVNG, I_WUQ, I_WUKV, I_CDWOUT, I_WUP, I_CONVW, I_CONVB, I_WDN };

__device__ __forceinline__ float wave_sum(float v) {
#pragma unroll
    for (int o = 1; o < 64; o <<= 1) v += __shfl_xor(v, o);
    return v;
}
__device__ __forceinline__ float quad_sum(float v) { v += __shfl_xor(v, 1); v += __shfl_xor(v, 2); return v; }
__device__ __forceinline__ void load16(const f16* p, float (&o)[16]) {
    const f16x8 a = *(const f16x8*)p, b = *(const f16x8*)(p + 8);
#pragma unroll
    for (int i = 0; i < 8; ++i) { o[i] = (float)a[i]; o[8 + i] = (float)b[i]; }
}
__device__ __forceinline__ void load8(const f16* p, float (&o)[8]) {
    const f16x8 a = *(const f16x8*)p;
#pragma unroll
    for (int i = 0; i < 8; ++i) o[i] = (float)a[i];
}
__device__ __forceinline__ int t5_bucket(int d) {
    if (d < 16) return d;
    return 16 + (d >= 22) + (d >= 30) + (d >= 40) + (d >= 54) + (d >= 73) + (d >= 99) + (d >= 134) + (d >= 182) + (d >= 246) + (d >= 332) + (d >= 450) + (d >= 609) + (d >= 825) + (d >= 1117) + (d >= 1513);
}

__device__ __forceinline__ void layer_mod(const Args& a, LAS unsigned char* lds, int tid, int slot, int nslots, int l) {
    LAS float* sc = (LAS float*)lds; LAS float* red = (LAS float*)(lds + 16384);
    const float* c = a.in[I_C];
    for (int i = tid; i < BATCH * DM; i += NTHR) { const float v = c[i]; sc[i] = v / (1.f + expf(-v)); }
    __syncthreads();
    const int wave = tid >> 6, lane = tid & 63;
    float* MOD = (float*)(a.ws + WS_MOD);
    for (int cg = slot; cg < 96; cg += nslots) {
        const int n = cg * 64 + lane;
        const float* W = a.in[I_ADAW] + (size_t)l * DM * 6144 + n;
        float a0 = 0.f, a1 = 0.f, a2 = 0.f, a3 = 0.f;
        const int k0 = wave * 128;
#pragma unroll 1
        for (int kb = k0; kb < k0 + 128; kb += 64) {
            float wv[64];
#pragma unroll
            for (int j = 0; j < 64; ++j) wv[j] = W[(size_t)(kb + j) * 6144];
#pragma unroll
            for (int j = 0; j < 64; ++j) { const int k = kb + j; a0 += sc[k] * wv[j]; a1 += sc[DM + k] * wv[j]; a2 += sc[2 * DM + k] * wv[j]; a3 += sc[3 * DM + k] * wv[j]; }
        }
        red[(wave * 4 + 0) * 64 + lane] = a0; red[(wave * 4 + 1) * 64 + lane] = a1; red[(wave * 4 + 2) * 64 + lane] = a2; red[(wave * 4 + 3) * 64 + lane] = a3;
        __syncthreads();
        if (tid < 256) { const int b = tid >> 6; float s = 0.f;
#pragma unroll
            for (int w = 0; w < 8; ++w) s += red[(w * 4 + b) * 64 + lane];
            MOD[(size_t)(l * BATCH + b) * 6144 + n] = s + a.in[I_ADAB][l * 6144 + n]; }
        __syncthreads();
    }
}
struct TD { const float* W; int N; f16* dst; int pitch, coloff; const float* gk; int mode, nblk; };
__device__ __forceinline__ void transpose_item(const TD& d, LAS float* scr, int item, int lane) {
    const int kb = item / d.nblk, nb = item % d.nblk, k0 = 64 * kb, n0 = 32 * nb;
    float wv[32];
#pragma unroll
    for (int i = 0; i < 32; ++i) { const int kk = 2 * i + (lane >> 5); wv[i] = d.W[(size_t)(k0 + kk) * d.N + n0 + (lane & 31)]; }
#pragma unroll
    for (int i = 0; i < 32; ++i) { const int kk = 2 * i + (lane >> 5); scr[kk * 33 + (lane & 31)] = wv[i]; }
    LDS_WAIT(); asm volatile("" ::: "memory");
    const int c = lane & 7;
    float gs[8];
#pragma unroll
    for (int i = 0; i < 8; ++i) gs[i] = d.gk ? d.gk[k0 + 8 * c + i] : 1.f;
#pragma unroll
    for (int j = 0; j < 4; ++j) { const int n = (lane >> 3) + 8 * j; const LAS float* s = scr + (8 * c) * 33 + n;
        u32x4 o; o.x = pk_f16(s[0 * 33] * gs[0], s[1 * 33] * gs[1]); o.y = pk_f16(s[2 * 33] * gs[2], s[3 * 33] * gs[3]); o.z = pk_f16(s[4 * 33] * gs[4], s[5 * 33] * gs[5]); o.w = pk_f16(s[6 * 33] * gs[6], s[7 * 33] * gs[7]);
        const int col = n0 + n; int row = col;
        if (d.mode == 1) { const int half = col / DFF, jj = col % DFF; row = (jj >> 7) * 256 + half * 128 + (jj & 127); }
        *(GAS u32x4*)(d.dst + (size_t)row * d.pitch + d.coloff + k0 + 8 * c) = o; }
    LDS_WAIT(); asm volatile("" ::: "memory");
}
__device__ __forceinline__ void layer_weights(const Args& a, LAS unsigned char* lds, int tid, int slot, int nslots, int l, int part  ) {
    const int wave = tid >> 6, lane = tid & 63;
    LAS float* scr = (LAS float*)(lds + wave * 16384);
    const int gw = slot * NWAVES + wave, NGW = nslots * NWAVES;
    constexpr int C0 = 16 * 96, C1 = 16 * 32, C2 = 16 * 65, C3 = 4 * 24, C4 = 4 * 32, C5 = 16 * 32, C6 = 16 * 176, C7 = 44 * 32;
    const int i = l >> 1; const bool odd = (l & 1) != 0;
    const int nmix = odd ? (C2 + C3 + C4 + C5) : (C0 + C1);
    unsigned char* ws = a.ws;
    const int it_lo = (part & 1) ? 0 : nmix, it_hi = (part & 2) ? nmix + C6 + C7 : nmix;
    for (int it = it_lo + gw; it < it_hi; it += NGW) {
        int r = it; TD d; d.gk = nullptr; d.mode = 0; d.coloff = 0;
        if (r >= nmix) { r -= nmix;
            if (r < C6) { d.W = a.in[I_WUP] + (size_t)l * DM * DFF2; d.N = DFF2; d.dst = (f16*)(ws + WS_W_FUP) + (size_t)l * DFF2 * DM; d.pitch = DM; d.nblk = 176; d.mode = 1; }
            else { r -= C6; d.W = a.in[I_WDN] + (size_t)l * DFF * DM; d.N = DM; d.dst = (f16*)(ws + WS_W_FDN) + (size_t)l * DM * DFF; d.pitch = DFF; d.nblk = 32; } }
        else if (!odd) {
            if (r < C0) { d.W = a.in[I_ABWIN] + (size_t)i * DM * AB_IN; d.N = AB_IN; d.dst = (f16*)(ws + WS_W_INAB) + (size_t)i * AB_IN * DM; d.pitch = DM; d.nblk = 96; }
            else { r -= C0; d.W = a.in[I_ABWOUT] + (size_t)i * DM * DM; d.N = DM; d.dst = (f16*)(ws + WS_W_OUTAB) + (size_t)i * DM * DM; d.pitch = DM; d.nblk = 32; } }
        else {
            if (r < C2) { d.W = a.in[I_CDWIN] + (size_t)i * DM * CD_IN; d.N = CD_IN; d.dst = (f16*)(ws + WS_W_INCD) + (size_t)i * CD_INP * DM; d.pitch = DM; d.nblk = 65; }
            else if ((r -= C2) < C3) { d.W = a.in[I_WUQ] + (size_t)i * 256 * QW; d.N = QW; d.dst = (f16*)(ws + WS_W_UP2) + (size_t)i * UP_N * UP_K; d.pitch = UP_K; d.nblk = 24; d.gk = a.in[I_QNG] + i * 256; }
            else if ((r -= C3) < C4) { d.W = a.in[I_WUKV] + (size_t)i * 256 * KVW; d.N = KVW; d.dst = (f16*)(ws + WS_W_UP2) + (size_t)i * UP_N * UP_K + (size_t)QW * UP_K; d.pitch = UP_K; d.nblk = 32; d.gk = a.in[I_KVNG] + i * 256; }
            else { r -= C4; d.W = a.in[I_CDWOUT] + (size_t)i * DM * DM; d.N = DM; d.dst = (f16*)(ws + WS_W_OUTCD) + (size_t)i * DM * DM; d.pitch = DM; d.nblk = 32; } }
        transpose_item(d, scr, r, lane);
    }
}
__device__ __forceinline__ void p0_misc(const Args& a, int tid, int bid, int G) {
    unsigned char* ws = a.ws;
    const int gt = bid * NTHR + tid, NGT = G * NTHR;
    const u32x4 z = {0u, 0u, 0u, 0u};
    for (int i = 0; i < 2; ++i) {
        GAS u32x4* p = (GAS u32x4*)((f16*)(ws + WS_W_INCD) + (size_t)i * CD_INP * DM + (size_t)CD_IN * DM);
        for (int e = gt; e < (CD_INP - CD_IN) * DM / 8; e += NGT) p[e] = z;
    }
    float* rc = (float*)(ws + WS_ROPE); float* rs = rc + SEQ * 16;
    for (int e = gt; e < SEQ * 16; e += NGT) { const int t = e >> 4, i = e & 15; const float inv = (float)(1.0 / pow(10000.0, (double)i / 16.0)); const float ang = (float)t * inv;
        rc[e] = (float)cos((double)ang); rs[e] = (float)sin((double)ang); }
}

__device__ __forceinline__ void thin_row(int row, const float* xin32, const f16* xin16, f16* xout16, float* xout32, const f16* y, const float* gate_l  , const float* gpost,
                                         const float* gpre, const float* ss_l  , f16* Hrow, f16* H2row, bool has_y, int lane) {
    const int b = row / SEQ;
    f32x4 xv[4];
    if (xin32 != nullptr) {
#pragma unroll
        for (int j = 0; j < 4; ++j) xv[j] = *(const f32x4*)(xin32 + (size_t)row * DM + 4 * lane + 256 * j);
    } else {
#pragma unroll
        for (int j = 0; j < 4; ++j) { const f16x4 xh = *(const f16x4*)(xin16 + (size_t)row * DM + 4 * lane + 256 * j); xv[j] = (f32x4){(float)xh[0], (float)xh[1], (float)xh[2], (float)xh[3]}; }
    }
    if (has_y) {
        f32x4 yv[4]; float s = 0.f;
#pragma unroll
        for (int j = 0; j < 4; ++j) { const f16x4 yh = *(const f16x4*)(y + (size_t)row * DM + 4 * lane + 256 * j); yv[j] = (f32x4){(float)yh[0], (float)yh[1], (float)yh[2], (float)yh[3]}; s += (yv[j].x * yv[j].x + yv[j].y * yv[j].y) + (yv[j].z * yv[j].z + yv[j].w * yv[j].w); }
        const float rstd = 1.0f / sqrtf(wave_sum(s) * (1.f / DM) + NORM_EPS);
#pragma unroll
        for (int j = 0; j < 4; ++j) { const f32x4 g = *(const f32x4*)(gpost + 4 * lane + 256 * j); const f32x4 gt = *(const f32x4*)(gate_l + (size_t)b * 6144 + 4 * lane + 256 * j);
            xv[j] = xv[j] + gt * ((yv[j] * rstd) * g); }
    }
    if (xout16 != nullptr) {
#pragma unroll
        for (int j = 0; j < 4; ++j) { u32x2 w; w.x = pk_f16(xv[j].x, xv[j].y); w.y = pk_f16(xv[j].z, xv[j].w); *(u32x2*)(xout16 + (size_t)row * DM + 4 * lane + 256 * j) = w;
            if (Hrow != nullptr) { const f16x4 r = __builtin_bit_cast(f16x4, w); xv[j] = (f32x4){(float)r[0], (float)r[1], (float)r[2], (float)r[3]}; } }
    }
    if (xout32 != nullptr) {
#pragma unroll
        for (int j = 0; j < 4; ++j) *(f32x4*)(xout32 + (size_t)row * DM + 4 * lane + 256 * j) = xv[j];
    }
    if (Hrow != nullptr) {
        float s = 0.f;
#pragma unroll
        for (int j = 0; j < 4; ++j) s += (xv[j].x * xv[j].x + xv[j].y * xv[j].y) + (xv[j].z * xv[j].z + xv[j].w * xv[j].w);
        const float rstd = 1.0f / sqrtf(wave_sum(s) * (1.f / DM) + NORM_EPS);
#pragma unroll
        for (int j = 0; j < 4; ++j) { const int col = 4 * lane + 256 * j; const f32x4 g = *(const f32x4*)(gpre + col);
            const f32x4 sh = *(const f32x4*)(ss_l + (size_t)b * 6144 + col), sc = *(const f32x4*)(ss_l + (size_t)b * 6144 + DM + col);
            const f32x4 hv = ((xv[j] * rstd) * g) * (sc + 1.0f) + sh;
            u32x2 w; w.x = pk_f16(hv.x, hv.y); w.y = pk_f16(hv.z, hv.w);
            *(u32x2*)(Hrow + col) = w;
            if (H2row != nullptr) *(u32x2*)(H2row + col) = w; }
    }
}
__device__ __forceinline__ bool is_halo_row(int row) { return (row & 255) >= 254 && (((row >> 8) + 1) & 15) != 0; }
__device__ __forceinline__ int halo_row_of(int hidx) { const int pm = hidx >> 1; return (pm == 0 || (pm & 15) == 0) ? -1 : 256 * pm - 2 + (hidx & 1); }
template <bool X32IN, bool HAS_Y, bool OUT32, bool WH>
__device__ __forceinline__ void thin_phase(const float* xin32, const f16* X16in, f16* X16out, float* out32, const f16* y, const float* gate_l, const float* gpost, const float* gpre, const float* ss_l, f16* H, f16* HHALO  ,
                                           LAS unsigned char* lds, int tid, int gw0, int ngw, int row_end = M) {
    const int lane = tid & 63;
    LAS float* TA = (LAS float*)lds; LAS float* TB = TA + BATCH * DM; LAS float* TC = TB + BATCH * DM;
    for (int idx = tid; idx < BATCH * DM; idx += NTHR) { const int b = idx >> 10, col = idx & (DM - 1);
        if constexpr (HAS_Y) TA[idx] = gate_l[(size_t)b * 6144 + col] * gpost[col];
        if constexpr (WH) { TB[idx] = gpre[col] * (1.0f + ss_l[(size_t)b * 6144 + DM + col]); TC[idx] = ss_l[(size_t)b * 6144 + col]; } }
    __syncthreads();
    for (int row0 = gw0; row0 < row_end; row0 += 2 * ngw) {
        int row[2] = {row0, row0 + ngw}; if (row[1] >= row_end) row[1] = row0;
        const int bq[2] = {row[0] / SEQ, row[1] / SEQ};
        float xv[2][16], yv[2][16];
#pragma unroll
        for (int q = 0; q < 2; ++q)
#pragma unroll
            for (int j = 0; j < 2; ++j) { const size_t off = (size_t)row[q] * DM + 512 * j + 8 * lane;
                if constexpr (X32IN) { const f32x4 a0 = *(const f32x4*)(xin32 + off), a1 = *(const f32x4*)(xin32 + off + 4);
#pragma unroll
                    for (int e = 0; e < 4; ++e) { xv[q][8 * j + e] = a0[e]; xv[q][8 * j + 4 + e] = a1[e]; } }
                else { const f16x8 xh = *(const f16x8*)(X16in + off);
#pragma unroll
                    for (int e = 0; e < 8; ++e) xv[q][8 * j + e] = (float)xh[e]; }
                if constexpr (HAS_Y) { const f16x8 yh = *(const f16x8*)(y + off);
#pragma unroll
                    for (int e = 0; e < 8; ++e) yv[q][8 * j + e] = (float)yh[e]; }
            }
        if constexpr (HAS_Y) {
            float s[2] = {0.f, 0.f};
#pragma unroll
            for (int q = 0; q < 2; ++q)
#pragma unroll
                for (int e = 0; e < 16; ++e) s[q] += yv[q][e] * yv[q][e];
#pragma unroll
            for (int o = 1; o < 64; o <<= 1) { s[0] += __shfl_xor(s[0], o); s[1] += __shfl_xor(s[1], o); }
#pragma unroll
            for (int q = 0; q < 2; ++q) { const float rstd = 1.0f / sqrtf(s[q] * (1.f / DM) + NORM_EPS);
#pragma unroll
                for (int j = 0; j < 2; ++j) { const LAS float* ta = TA + bq[q] * DM + 512 * j + 8 * lane; const f32x4 t0 = *(const LAS f32x4*)ta, t1 = *(const LAS f32x4*)(ta + 4);
#pragma unroll
                    for (int e = 0; e < 4; ++e) { xv[q][8 * j + e] += t0[e] * (yv[q][8 * j + e] * rstd); xv[q][8 * j + 4 + e] += t1[e] * (yv[q][8 * j + 4 + e] * rstd); } } }
        }
#pragma unroll
        for (int q = 0; q < 2; ++q)
#pragma unroll
            for (int j = 0; j < 2; ++j) { const size_t off = (size_t)row[q] * DM + 512 * j + 8 * lane;
                if constexpr (OUT32) { float* o32 = out32;
                    *(f32x4*)(o32 + off) = (f32x4){xv[q][8 * j], xv[q][8 * j + 1], xv[q][8 * j + 2], xv[q][8 * j + 3]}; *(f32x4*)(o32 + off + 4) = (f32x4){xv[q][8 * j + 4], xv[q][8 * j + 5], xv[q][8 * j + 6], xv[q][8 * j + 7]}; }
                else { u32x4 w; w.x = pk_f16(xv[q][8 * j], xv[q][8 * j + 1]); w.y = pk_f16(xv[q][8 * j + 2], xv[q][8 * j + 3]); w.z = pk_f16(xv[q][8 * j + 4], xv[q][8 * j + 5]); w.w = pk_f16(xv[q][8 * j + 6], xv[q][8 * j + 7]);
                    *(u32x4*)(X16out + off) = w;
                    const f16x8 r = __builtin_bit_cast(f16x8, w);
#pragma unroll
                    for (int e = 0; e < 8; ++e) xv[q][8 * j + e] = (float)r[e]; }
            }
        if constexpr (WH) {
            float s[2] = {0.f, 0.f};
#pragma unroll
            for (int q = 0; q < 2; ++q)
#pragma unroll
                for (int e = 0; e < 16; ++e) s[q] += xv[q][e] * xv[q][e];
#pragma unroll
            for (int o = 1; o < 64; o <<= 1) { s[0] += __shfl_xor(s[0], o); s[1] += __shfl_xor(s[1], o); }
#pragma unroll
            for (int q = 0; q < 2; ++q) { const float rstd = 1.0f / sqrtf(s[q] * (1.f / DM) + NORM_EPS);
                f16* h2 = (HHALO != nullptr && is_halo_row(row[q])) ? HHALO + (size_t)(2 * ((row[q] >> 8) + 1) + ((row[q] & 255) - 254)) * DM : nullptr;
#pragma unroll
                for (int j = 0; j < 2; ++j) { const int col = 512 * j + 8 * lane; const LAS float* tb = TB + bq[q] * DM + col; const LAS float* tc = TC + bq[q] * DM + col;
                    const f32x4 b0 = *(const LAS f32x4*)tb, b1 = *(const LAS f32x4*)(tb + 4), c0 = *(const LAS f32x4*)tc, c1 = *(const LAS f32x4*)(tc + 4);
                    float hv[8];
#pragma unroll
                    for (int e = 0; e < 4; ++e) { hv[e] = (xv[q][8 * j + e] * rstd) * b0[e] + c0[e]; hv[4 + e] = (xv[q][8 * j + 4 + e] * rstd) * b1[e] + c1[e]; }
                    u32x4 w; w.x = pk_f16(hv[0], hv[1]); w.y = pk_f16(hv[2], hv[3]); w.z = pk_f16(hv[4], hv[5]); w.w = pk_f16(hv[6], hv[7]);
                    *(u32x4*)(H + (size_t)row[q] * DM + col) = w;
                    if (h2 != nullptr) *(u32x4*)(h2 + col) = w; } }
        }
    }
}

__device__ __forceinline__ void naive_kmean(const f16* PROJ, float* KMEAN, int gt, int NGT) {
    for (int e = gt; e < BATCH * 16 * 512; e += NGT) { const int col = e & 511, blk = (e >> 9) & 15, b = e >> 13;
        const f16* p = PROJ + ((size_t)b * SEQ + blk * 256) * AB_IN + 512 + col; float s = 0.f;
        for (int r = 0; r < 256; ++r) s += (float)p[(size_t)r * AB_IN];
        KMEAN[e] = s * (1.f / 256.f); }
}
#define OS_UPDATE(s_, vv_) do { const float mn_ = fmaxf(m, (s_)), al_ = expf(m - mn_), pe_ = expf((s_) - mn_); l = l * al_ + pe_; \
    _Pragma("unroll") for (int i_ = 0; i_ < 16; ++i_) acc[i_] = acc[i_] * al_ + pe_ * (vv_)[i_]; m = mn_; } while (0)
__device__ __forceinline__ void naive_moba(const f16* PROJ, const float* KMEAN, const float* relb, f16* ATT, int gt, int NGT) {
    const int sub = gt & 3, ngr = NGT >> 2;
    for (int item = gt >> 2; item < BATCH * NH * SEQ; item += ngr) {
        const int t = item & (SEQ - 1), h = (item >> 12) & 7, b = item >> 15;
        const size_t row = (size_t)b * SEQ + t;
        float q[16]; load16(PROJ + row * AB_IN + h * 64 + sub * 16, q);
        const int own = t >> 8;
        unsigned selmask = 0u;
        {
            float g[16];
#pragma unroll
            for (int j = 0; j < 16; ++j) { float p = 0.f;
                if (j < own) { const float* km = KMEAN + ((size_t)(b * 16 + j) * 512) + h * 64 + sub * 16;
#pragma unroll
                    for (int i = 0; i < 16; ++i) p += q[i] * km[i]; }
                p = quad_sum(p); g[j] = (j < own) ? p : -INFINITY; }
#pragma unroll
            for (int r = 0; r < 3; ++r) { float best = -INFINITY; int bi = -1;
#pragma unroll
                for (int j = 0; j < 16; ++j) { const bool ok = !((selmask >> j) & 1u) && (j < own) && (g[j] > best); if (ok) { best = g[j]; bi = j; } }
                if (bi >= 0) selmask |= 1u << bi; }
        }
        float m = -INFINITY, l = 0.f, acc[16];
#pragma unroll
        for (int i = 0; i < 16; ++i) acc[i] = 0.f;
        const f16* Kb = PROJ + (size_t)b * SEQ * AB_IN + 512 + h * 64 + sub * 16;
        const float* rb = relb + h * 32;
        for (int pos = own * 256; pos <= t; ++pos) { float kk[16], vv[16]; load16(Kb + (size_t)pos * AB_IN, kk); load16(Kb + (size_t)pos * AB_IN + 512, vv); float p = 0.f;
#pragma unroll
            for (int i = 0; i < 16; ++i) p += q[i] * kk[i];
            const float s = quad_sum(p) * 0.125f + rb[t5_bucket(t - pos)]; OS_UPDATE(s, vv); }
        for (int j = 0; j < own; ++j) { if (!((selmask >> j) & 1u)) continue;
            for (int pos = j * 256; pos < j * 256 + 256; ++pos) { float kk[16], vv[16]; load16(Kb + (size_t)pos * AB_IN, kk); load16(Kb + (size_t)pos * AB_IN + 512, vv); float p = 0.f;
#pragma unroll
                for (int i = 0; i < 16; ++i) p += q[i] * kk[i];
                const float s = quad_sum(p) * 0.125f + rb[t5_bucket(t - pos)]; OS_UPDATE(s, vv); } }
        const float il = 1.f / l; u32x4 w0, w1;
        w0.x = pk_f16(acc[0] * il, acc[1] * il); w0.y = pk_f16(acc[2] * il, acc[3] * il); w0.z = pk_f16(acc[4] * il, acc[5] * il); w0.w = pk_f16(acc[6] * il, acc[7] * il);
        w1.x = pk_f16(acc[8] * il, acc[9] * il); w1.y = pk_f16(acc[10] * il, acc[11] * il); w1.z = pk_f16(acc[12] * il, acc[13] * il); w1.w = pk_f16(acc[14] * il, acc[15] * il);
        f16* o = ATT + row * DM + h * 64 + sub * 16; *(u32x4*)o = w0; *(u32x4*)(o + 8) = w1;
    }
}
__device__ __forceinline__ void naive_dilated(const f16* PROJ, const float* relb, f16* ATT, int gt, int NGT) {
    const int sub = gt & 3, ngr = NGT >> 2;
    for (int item = gt >> 2; item < BATCH * NH * SEQ; item += ngr) {
        const int t = item & (SEQ - 1), h = (item >> 12) & 7, b = item >> 15;
        const size_t row = (size_t)b * SEQ + t;
        float q[16]; load16(PROJ + row * AB_IN + 1536 + h * 64 + sub * 16, q);
        float m = -INFINITY, l = 0.f, acc[16];
#pragma unroll
        for (int i = 0; i < 16; ++i) acc[i] = 0.f;
        const f16* Kb = PROJ + (size_t)b * SEQ * AB_IN + 2048 + h * 64 + sub * 16;
        const float* rb = relb + (8 + h) * 32;
        for (int br = 0; br < 3; ++br) { const int dil = br == 0 ? 1 : (br == 1 ? 4 : 16);
            for (int mm = 0; mm <= 128; ++mm) { const int pos = t - dil * mm; if (pos < 0) break;
                float kk[16], vv[16]; load16(Kb + (size_t)pos * AB_IN, kk); load16(Kb + (size_t)pos * AB_IN + 512, vv); float p = 0.f;
#pragma unroll
                for (int i = 0; i < 16; ++i) p += q[i] * kk[i];
                const float s = quad_sum(p) * 0.125f + rb[t5_bucket(dil * mm)]; OS_UPDATE(s, vv); } }
        const float il = 1.f / l; u32x4 w0, w1;
        w0.x = pk_f16(acc[0] * il, acc[1] * il); w0.y = pk_f16(acc[2] * il, acc[3] * il); w0.z = pk_f16(acc[4] * il, acc[5] * il); w0.w = pk_f16(acc[6] * il, acc[7] * il);
        w1.x = pk_f16(acc[8] * il, acc[9] * il); w1.y = pk_f16(acc[10] * il, acc[11] * il); w1.z = pk_f16(acc[12] * il, acc[13] * il); w1.w = pk_f16(acc[14] * il, acc[15] * il);
        f16* o = ATT + row * DM + 512 + h * 64 + sub * 16; *(u32x4*)o = w0; *(u32x4*)(o + 8) = w1;
    }
}
__device__ __forceinline__ void mla_norm_phase(f16* PROJ, f16* KPE, const float* rc, const float* rs, int tid, int bid, int G) {
    const int wave = tid >> 6, lane = tid & 63;
    const int gw = bid * NWAVES + wave, NGW = G * NWAVES;
    for (int row = gw; row < M; row += NGW) {
        f16* p = PROJ + (size_t)row * CD_INP;
        const int t = row & (SEQ - 1);
#pragma unroll
        for (int part = 0; part < 2; ++part) {
            f16x4 v = *(const f16x4*)(p + part * 256 + 4 * lane);
            float f[4] = {(float)v[0], (float)v[1], (float)v[2], (float)v[3]};
            const float s = wave_sum((f[0] * f[0] + f[1] * f[1]) + (f[2] * f[2] + f[3] * f[3]));
            const float rstd = 1.0f / sqrtf(s * (1.f / 256.f) + NORM_EPS);
            u32x2 w; w.x = pk_f16(f[0] * rstd, f[1] * rstd); w.y = pk_f16(f[2] * rstd, f[3] * rstd);
            *(u32x2*)(p + part * 256 + 4 * lane) = w;
        }
        if (lane < 16) { const float x1 = (float)p[512 + lane], x2 = (float)p[528 + lane]; const float c = rc[t * 16 + lane], s = rs[t * 16 + lane];
            KPE[(size_t)row * 32 + lane] = (f16)(x1 * c - x2 * s); KPE[(size_t)row * 32 + 16 + lane] = (f16)(x1 * s + x2 * c); }
    }
}
__device__ __forceinline__ void naive_mla(const f16* Q, const f16* KV, const f16* KPE, const float* rc, const float* rs, f16* ATT, int gt, int NGT) {
    const int sub = gt & 3, ngr = NGT >> 2;
    const float scale = 0.10206207261596575f;
    for (int item = gt >> 2; item < BATCH * NH * SEQ; item += ngr) {
        const int t = item & (SEQ - 1), h = (item >> 12) & 7, b = item >> 15;
        const size_t row = (size_t)b * SEQ + t;
        const f16* qp = Q + row * QW + h * 96;
        float q[16], qr[8]; load16(qp + sub * 16, q);
#pragma unroll
        for (int i = 0; i < 8; ++i) { const int d = 8 * sub + i, dd = d & 15; const float x1 = (float)qp[64 + dd], x2 = (float)qp[80 + dd]; const float c = rc[t * 16 + dd], s = rs[t * 16 + dd];
            qr[i] = (d < 16) ? (x1 * c - x2 * s) : (x1 * s + x2 * c); }
        float m = -INFINITY, l = 0.f, acc[16];
#pragma unroll
        for (int i = 0; i < 16; ++i) acc[i] = 0.f;
        const f16* Kb = KV + (size_t)b * SEQ * KVW + h * 128 + sub * 16;
        const f16* Pb = KPE + (size_t)b * SEQ * 32 + sub * 8;
        for (int pos = 0; pos <= t; ++pos) { float kk[16], kr[8], vv[16]; load16(Kb + (size_t)pos * KVW, kk); load8(Pb + (size_t)pos * 32, kr); load16(Kb + (size_t)pos * KVW + 64, vv); float p = 0.f;
#pragma unroll
            for (int i = 0; i < 16; ++i) p += q[i] * kk[i];
#pragma unroll
            for (int i = 0; i < 8; ++i) p += qr[i] * kr[i];
            const float s = quad_sum(p) * scale; OS_UPDATE(s, vv); }
        const float il = 1.f / l; u32x4 w0, w1;
        w0.x = pk_f16(acc[0] * il, acc[1] * il); w0.y = pk_f16(acc[2] * il, acc[3] * il); w0.z = pk_f16(acc[4] * il, acc[5] * il); w0.w = pk_f16(acc[6] * il, acc[7] * il);
        w1.x = pk_f16(acc[8] * il, acc[9] * il); w1.y = pk_f16(acc[10] * il, acc[11] * il); w1.z = pk_f16(acc[12] * il, acc[13] * il); w1.w = pk_f16(acc[14] * il, acc[15] * il);
        f16* o = ATT + row * DM + h * 64 + sub * 16; *(u32x4*)o = w0; *(u32x4*)(o + 8) = w1;
    }
}
__device__ __forceinline__ float softplusf(float x) { return fmaxf(x, 0.f) + log1pf(expf(-fabsf(x))); }
__device__ __forceinline__ void naive_sb(const f16* PROJ, f16* ATT, int gt, int NGT) {
    const int sub = gt & 3, ngr = NGT >> 2;
    for (int item = gt >> 2; item < BATCH * NH * SEQ; item += ngr) {
        const int t = item & (SEQ - 1), h = (item >> 12) & 7, b = item >> 15;
        const size_t row = (size_t)b * SEQ + t;
        float q[16]; load16(PROJ + row * CD_INP + 544 + h * 64 + sub * 16, q);
        float R = 0.f, acc[16];
#pragma unroll
        for (int i = 0; i < 16; ++i) acc[i] = 0.f;
        const f16* Kb = PROJ + (size_t)b * SEQ * CD_INP + 1056 + h * 64 + sub * 16;
        for (int pos = t - 1; pos >= 0; --pos) { float kk[16], vv[16]; load16(Kb + (size_t)pos * CD_INP, kk); load16(Kb + (size_t)pos * CD_INP + 512, vv); float p = 0.f;
#pragma unroll
            for (int i = 0; i < 16; ++i) p += q[i] * kk[i];
            const float z = quad_sum(p) * 0.125f;
            const float aw = expf(R - softplusf(-z));
#pragma unroll
            for (int i = 0; i < 16; ++i) acc[i] += aw * vv[i];
            R -= softplusf(z); }
        u32x4 w0, w1;
        w0.x = pk_f16(acc[0], acc[1]); w0.y = pk_f16(acc[2], acc[3]); w0.z = pk_f16(acc[4], acc[5]); w0.w = pk_f16(acc[6], acc[7]);
        w1.x = pk_f16(acc[8], acc[9]); w1.y = pk_f16(acc[10], acc[11]); w1.z = pk_f16(acc[12], acc[13]); w1.w = pk_f16(acc[14], acc[15]);
        f16* o = ATT + row * DM + 512 + h * 64 + sub * 16; *(u32x4*)o = w0; *(u32x4*)(o + 8) = w1;
    }
}
__device__ __forceinline__ float gelu_tanh(float g) { return 0.5f * g * (1.f + tanhf(0.7978845608028654f * (g + 0.044715f * g * g * g))); }
__device__ __forceinline__ void naive_convact(const f16* U, int half, const float* cw, const float* cb, f16* ACT, int gt, int NGT) {
    for (int e = gt; e < (M / 2) * DFF; e += NGT) { const int rl = e / DFF, j = e % DFF; const int row = half * (M / 2) + rl, t = row & (SEQ - 1);
        const int ucol = (j >> 7) * 256 + (j & 127);
        float g = cb[j], v = cb[DFF + j];
#pragma unroll
        for (int tap = 0; tap < 3; ++tap) { const int dt = 2 - tap; if (t - dt < 0) continue;
            const f16* up = U + (size_t)(rl - dt) * DFF2 + ucol;
            g += cw[tap * DFF2 + j] * (float)up[0]; v += cw[tap * DFF2 + DFF + j] * (float)up[128]; }
        ACT[(size_t)row * DFF + j] = (f16)(gelu_tanh(g) * v); }
}
namespace att {
typedef float f32x16 __attribute__((ext_vector_type(16)));
typedef short s16x4 __attribute__((ext_vector_type(4)));
__device__ __forceinline__ f16x4 tr_read(const LAS f16* p) { return __builtin_bit_cast(f16x4, __builtin_amdgcn_ds_read_tr16_b64_v4i16((LAS s16x4*)p)); }
constexpr int VP = 96;
constexpr int OFF_K = 0, KBUF = 128 * 104 * 2;
constexpr int OFF_V = 2 * KBUF, VBUF = 128 * VP * 2;
constexpr int OFF_BIAS = OFF_V + 2 * VBUF;
constexpr int OFF_KMEAN = OFF_BIAS + 16384;
constexpr int OFF_FLAG = OFF_KMEAN + 4096;
constexpr int ATT_LDS = OFF_FLAG + 64;
constexpr float LOG2E = 1.4426950408889634f, LN2 = 0.6931471805599453f;

struct Src {
    const f16* q; int qp;
    const f16* k; int kp;
    const f16* k2;
    const f16* v; int vp;
    f16* o;
};

template <int KIND  , int PM = 0  >
__device__ __forceinline__ void attn_unit(LAS unsigned char* lds, const Src& T, int b, int h, int qb, const float* rc, const float* rs, const float* KMEAN, const float* relb, int tid) {
    constexpr int DQ = (KIND == 0) ? 96 : 64, NS = DQ / 16, KP = DQ + 8;
    const int lane = tid & 63, r32 = lane & 31, hi = lane >> 5; const int wid = __builtin_amdgcn_readfirstlane(tid >> 6);
    const size_t rowbase = (size_t)b * SEQ;
    const int q0w = qb * 256 + wid * 32;
    const int t = q0w + r32;
    f16x8 qf[NS];
    {
        const f16* qrow = T.q + (rowbase + t) * T.qp;
#pragma unroll
        for (int s = 0; s < 4; ++s) qf[s] = *(const f16x8*)(qrow + 16 * s + 8 * hi);
        if constexpr (KIND == 0) {
            const f16x8 xa = *(const f16x8*)(qrow + 64 + 8 * hi), xb = *(const f16x8*)(qrow + 80 + 8 * hi);
            const f32x4 c0 = *(const f32x4*)(rc + t * 16 + 8 * hi), c1 = *(const f32x4*)(rc + t * 16 + 8 * hi + 4), s0 = *(const f32x4*)(rs + t * 16 + 8 * hi), s1 = *(const f32x4*)(rs + t * 16 + 8 * hi + 4);
#pragma unroll
            for (int j = 0; j < 8; ++j) { const float a = (float)xa[j], bb = (float)xb[j], c = j < 4 ? c0[j & 3] : c1[j & 3], s = j < 4 ? s0[j & 3] : s1[j & 3];
                qf[4][j] = (f16)(a * c - bb * s); qf[5][j] = (f16)(a * s + bb * c); }
        }
    }
    unsigned selmask = 0u;
    LAS float* biasl = (LAS float*)(lds + OFF_BIAS);
    if constexpr (KIND == 1) {
        LAS float* kml = (LAS float*)(lds + OFF_KMEAN);
        for (int d = tid; d < SEQ; d += NTHR) biasl[d] = relb[h * 32 + t5_bucket(d)] * LOG2E;
        for (int e = tid; e < 16 * 64; e += NTHR) kml[e] = KMEAN[((size_t)(b * 16 + (e >> 6)) * 512) + h * 64 + (e & 63)] * (1.f / 256.f);
        __syncthreads();
        float g[16];
#pragma unroll
        for (int j = 0; j < 16; ++j) { float p = 0.f;
            if (j < qb) {
#pragma unroll
                for (int s = 0; s < 4; ++s)
#pragma unroll
                    for (int i = 0; i < 8; ++i) p += (float)qf[s][i] * kml[j * 64 + 16 * s + 8 * hi + i]; }
            p += __shfl_xor(p, 32); g[j] = (j < qb) ? p : -INFINITY; }
#pragma unroll
        for (int r = 0; r < 3; ++r) { float best = -INFINITY; int bi = -1;
#pragma unroll
            for (int j = 0; j < 16; ++j) { const bool ok = !((selmask >> j) & 1u) && (j < qb) && (g[j] > best); if (ok) { best = g[j]; bi = j; } }
            if (bi >= 0) selmask |= 1u << bi; }
    }
    const int NT = 4 * qb + 4;
    auto tile_start = [&](int i) -> int {
        if constexpr (KIND == 0) return 64 * i;
        else if constexpr (KIND == 1) return i < 4 ? 256 * qb + 64 * i : 64 * (i - 4);
        else return 64 * (NT - 1 - i);
    };
    const int kr = tid >> 3, kc = tid & 7;
    const int k2r = tid >> 2, k2c = tid & 3;
    f16x8 kr0, vr0, k2r0, kr1, vr1, k2r1;
    auto gload = [&](int d) {
        const int ts0 = tile_start(2 * d), ts1 = tile_start(2 * d + 1);
        kr0 = *(const f16x8*)(T.k + (rowbase + ts0 + kr) * T.kp + 8 * kc); vr0 = *(const f16x8*)(T.v + (rowbase + ts0 + kr) * T.vp + 8 * kc);
        kr1 = *(const f16x8*)(T.k + (rowbase + ts1 + kr) * T.kp + 8 * kc); vr1 = *(const f16x8*)(T.v + (rowbase + ts1 + kr) * T.vp + 8 * kc);
        if constexpr (KIND == 0) { if (tid < 256) { k2r0 = *(const f16x8*)(T.k2 + (rowbase + ts0 + k2r) * 32 + 8 * k2c); k2r1 = *(const f16x8*)(T.k2 + (rowbase + ts1 + k2r) * 32 + 8 * k2c); } }
    };
    auto lstore = [&](int buf) {
        LAS f16* Kb = (LAS f16*)(lds + OFF_K + buf * KBUF); LAS f16* Vb = (LAS f16*)(lds + OFF_V + buf * VBUF);
        *(LAS f16x8*)(Kb + kr * KP + 8 * kc) = kr0; *(LAS f16x8*)(Kb + (64 + kr) * KP + 8 * kc) = kr1;
        if constexpr (KIND == 0) { if (tid < 256) { *(LAS f16x8*)(Kb + k2r * KP + 64 + 8 * k2c) = k2r0; *(LAS f16x8*)(Kb + (64 + k2r) * KP + 64 + 8 * k2c) = k2r1; } }
        *(LAS f16x8*)(Vb + kr * VP + 8 * kc) = vr0; *(LAS f16x8*)(Vb + (64 + kr) * VP + 8 * kc) = vr1;
    };
    f32x16 o0, o1;
#pragma unroll
    for (int r = 0; r < 16; ++r) { o0[r] = 0.f; o1[r] = 0.f; }
    float m = -1e30f, l = 0.f, R = 0.f;
    const float csc = (KIND == 0 ? 0.10206207261596575f : 0.125f) * (KIND == 2 ? 1.0f : LOG2E);
    LAS unsigned* flags = (LAS unsigned*)(lds + OFF_FLAG);

    const int ND = NT / 2;
    gload(0); lstore(0); gload(1);
    __syncthreads();
    auto tile = [&](int i, int buf, int sub) {
        const int ts = tile_start(i);
        bool active, need_mask;
        if constexpr (KIND == 2) { active = ts < q0w + 31; need_mask = ts + 63 >= q0w; }
        else if constexpr (KIND == 1) { if (i < 4) { active = ts <= q0w + 31; need_mask = ts + 63 > q0w; } else { active = true; need_mask = false; } }
        else { active = ts <= q0w + 31; need_mask = ts + 63 > q0w; }
        bool wave_done = false;
        if constexpr (KIND == 2) { wave_done = __all(R < -152.0f) != 0; if (wave_done) active = false; }
        if (active && PM != 1) {
            const LAS f16* Kb = (const LAS f16*)(lds + OFF_K + buf * KBUF) + sub * 64 * KP; const LAS f16* Vb = (const LAS f16*)(lds + OFF_V + buf * VBUF) + sub * 64 * VP;
            f32x16 p0, p1;
#pragma unroll
            for (int r = 0; r < 16; ++r) { p0[r] = 0.f; p1[r] = 0.f; }
            {
                f16x8 kf[2 * NS];
#pragma unroll
                for (int s = 0; s < NS; ++s) { kf[2 * s] = *(const LAS f16x8*)(Kb + r32 * KP + 16 * s + 8 * hi); kf[2 * s + 1] = *(const LAS f16x8*)(Kb + (32 + r32) * KP + 16 * s + 8 * hi); }
                __builtin_amdgcn_sched_barrier(0);
#pragma unroll
                for (int s = 0; s < NS; ++s) { p0 = __builtin_amdgcn_mfma_f32_32x32x16_f16(kf[2 * s], qf[s], p0, 0, 0, 0); p1 = __builtin_amdgcn_mfma_f32_32x32x16_f16(kf[2 * s + 1], qf[s], p1, 0, 0, 0); }
            }
            f16x4 vlo[8], vhh[8];
            auto vfrag_load = [&]() {
#pragma unroll
            for (int kb = 0; kb < 2; ++kb)
#pragma unroll
                for (int s2 = 0; s2 < 2; ++s2)
#pragma unroll
                    for (int db = 0; db < 2; ++db) {
                        const LAS f16* vp = Vb + (32 * kb + 16 * s2 + 4 * hi + ((lane & 15) >> 2)) * VP + 32 * db + (r32 & 16) + 4 * (lane & 3);
                        vlo[(kb * 2 + s2) * 2 + db] = tr_read(vp); vhh[(kb * 2 + s2) * 2 + db] = tr_read(vp + 8 * VP); }
            };
            if constexpr (PM < 2 && KIND != 2) vfrag_load();
            __builtin_amdgcn_sched_barrier(0);
            const int lim = t - ts - 4 * hi;
            if constexpr (PM == 3) { asm volatile("" :: "v"(p0), "v"(p1)); }
            else if constexpr (KIND != 2) {
                if constexpr (KIND == 1) {
                    const int dbase = lim;
                    float b0[16], b1[16];
                    if (i < 4) {
#pragma unroll
                        for (int r = 0; r < 16; ++r) { const int c = (r & 3) + 8 * (r >> 2); int d0 = dbase - c, d1 = dbase - 32 - c; d0 = d0 < 0 ? 0 : d0; d1 = d1 < 0 ? 0 : d1; b0[r] = biasl[d0]; b1[r] = biasl[d1]; }
                    } else {
#pragma unroll
                        for (int r = 0; r < 16; ++r) { const int c = (r & 3) + 8 * (r >> 2); b0[r] = biasl[dbase - c]; b1[r] = biasl[dbase - 32 - c]; }
                    }
                    __builtin_amdgcn_sched_barrier(0);
#pragma unroll
                    for (int r = 0; r < 16; r += 2) { const f32x2 q0 = (f32x2){p0[r], p0[r + 1]} * csc + (f32x2){b0[r], b0[r + 1]}, q1 = (f32x2){p1[r], p1[r + 1]} * csc + (f32x2){b1[r], b1[r + 1]};
                        p0[r] = q0.x; p0[r + 1] = q0.y; p1[r] = q1.x; p1[r + 1] = q1.y; }
                    if (i >= 4) { const bool sel = (selmask >> (ts >> 8)) & 1u;
                        if (!sel) {
#pragma unroll
                            for (int r = 0; r < 16; ++r) { p0[r] = -INFINITY; p1[r] = -INFINITY; } } }
                }
                if (need_mask) {
#pragma unroll
                    for (int r = 0; r < 16; ++r) { const int c = (r & 3) + 8 * (r >> 2); if (c > lim) p0[r] = -INFINITY; if (c + 32 > lim) p1[r] = -INFINITY; }
                }
                const float esc = (KIND == 1) ? 1.0f : csc;
                float mx = fmaxf(p0[0], p1[0]);
#pragma unroll
                for (int r = 1; r < 16; ++r) mx = fmaxf(mx, fmaxf(p0[r], p1[r]));
                mx = fmaxf(mx, __shfl_xor(mx, 32)) * esc;
                if (__any(mx > m + 8.0f)) {
                    const float mn = fmaxf(m, mx), alpha = __builtin_amdgcn_exp2f(m - mn);
                    m = mn; l *= alpha;
#pragma unroll
                    for (int r = 0; r < 16; ++r) { o0[r] *= alpha; o1[r] *= alpha; }
                }
                f32x2 sum2 = {0.f, 0.f};
#pragma unroll
                for (int r = 0; r < 16; r += 2) {
                    const f32x2 t0 = (f32x2){p0[r], p0[r + 1]} * esc - m, t1 = (f32x2){p1[r], p1[r + 1]} * esc - m;
                    f32x2 e0, e1; e0.x = __builtin_amdgcn_exp2f(t0.x); e0.y = __builtin_amdgcn_exp2f(t0.y); e1.x = __builtin_amdgcn_exp2f(t1.x); e1.y = __builtin_amdgcn_exp2f(t1.y);
                    p0[r] = e0.x; p0[r + 1] = e0.y; p1[r] = e1.x; p1[r + 1] = e1.y; sum2 += e0 + e1; }
                l += sum2.x + sum2.y;
            } else {
                float lk0[16], lk1[16];
#pragma unroll
                for (int r = 0; r < 16; ++r) { const int c = (r & 3) + 8 * (r >> 2);
                    const float z0 = p0[r] * (csc * LOG2E), z1 = p1[r] * (csc * LOG2E);
                    const float e0 = __builtin_amdgcn_exp2f(z0), e1 = __builtin_amdgcn_exp2f(z1);
                    const float g0 = __builtin_amdgcn_logf(1.f + e0), g1 = __builtin_amdgcn_logf(1.f + e1);
                    const float a0 = -(z0 > 64.f ? z0 : g0), a1 = -(z1 > 64.f ? z1 : g1);
                    const bool v0 = !need_mask || (c < lim), v1 = !need_mask || (c + 32 < lim);
                    lk0[r] = v0 ? a0 : 0.f; lk1[r] = v1 ? a1 : 0.f;
                    p0[r] = v0 ? z0 + a0 : -INFINITY; p1[r] = v1 ? z1 + a1 : -INFINITY; }
                float gs[8], gp[8];
#pragma unroll
                for (int g = 0; g < 4; ++g) { gs[g] = (lk0[4 * g] + lk0[4 * g + 1]) + (lk0[4 * g + 2] + lk0[4 * g + 3]); gs[4 + g] = (lk1[4 * g] + lk1[4 * g + 1]) + (lk1[4 * g + 2] + lk1[4 * g + 3]); }
#pragma unroll
                for (int c4 = 0; c4 < 8; ++c4) gp[c4] = __shfl_xor(gs[c4], 32);
                float suf = R;
#pragma unroll
                for (int c4 = 7; c4 >= 0; --c4) {
                    const float ev = hi ? gp[c4] : gs[c4], od = hi ? gs[c4] : gp[c4];
                    const float base = hi ? suf : suf + od;
                    if (c4 < 4) { const int g = c4; float acc = base;
                        p0[4 * g + 3] += acc; acc += lk0[4 * g + 3]; p0[4 * g + 2] += acc; acc += lk0[4 * g + 2]; p0[4 * g + 1] += acc; acc += lk0[4 * g + 1]; p0[4 * g] += acc; }
                    else { const int g = c4 - 4; float acc = base;
                        p1[4 * g + 3] += acc; acc += lk1[4 * g + 3]; p1[4 * g + 2] += acc; acc += lk1[4 * g + 2]; p1[4 * g + 1] += acc; acc += lk1[4 * g + 1]; p1[4 * g] += acc; }
                    suf += ev + od;
                }
                R = suf;
#pragma unroll
                for (int r = 0; r < 16; ++r) { p0[r] = __builtin_amdgcn_exp2f(p0[r]); p1[r] = __builtin_amdgcn_exp2f(p1[r]); }
            }
            if constexpr (PM < 2 && KIND == 2) { vfrag_load(); __builtin_amdgcn_sched_barrier(0); }
            if constexpr (PM >= 2) { asm volatile("" :: "v"(p0), "v"(p1)); }
            else
#pragma unroll
            for (int kb = 0; kb < 2; ++kb)
#pragma unroll
                for (int s2 = 0; s2 < 2; ++s2) {
                    f16x8 bf;
#pragma unroll
                    for (int j = 0; j < 8; ++j) bf[j] = (f16)(kb ? p1[8 * s2 + j] : p0[8 * s2 + j]);
#pragma unroll
                    for (int db = 0; db < 2; ++db) {
                        const f16x4 lo = vlo[(kb * 2 + s2) * 2 + db], hh = vhh[(kb * 2 + s2) * 2 + db];
                        const f16x8 af = {lo[0], lo[1], lo[2], lo[3], hh[0], hh[1], hh[2], hh[3]};
                        if (db == 0) o0 = __builtin_amdgcn_mfma_f32_32x32x16_f16(af, bf, o0, 0, 0, 0); else o1 = __builtin_amdgcn_mfma_f32_32x32x16_f16(af, bf, o1, 0, 0, 0);
                    }
                }
        }
    };
    for (int d = 0; d < ND; ++d) {
        const int buf = d & 1;
        tile(2 * d, buf, 0);
        tile(2 * d + 1, buf, 1);
        if constexpr (KIND == 2) { if (lane == 0) flags[buf * 8 + wid] = (__all(R < -152.0f) != 0) ? 1u : 0u; }
        if (d + 1 < ND) lstore(buf ^ 1);
        if (d + 2 < ND) gload(d + 2);
        __syncthreads();
        if constexpr (KIND == 2) {
            unsigned alld = 1u;
#pragma unroll
            for (int w = 0; w < 8; ++w) alld &= flags[buf * 8 + w];
            if (alld) break;
        }
    }
    float inv = 1.f;
    if constexpr (KIND != 2) { l += __shfl_xor(l, 32); inv = 1.f / l; }
    f16* orow = T.o + (rowbase + t) * DM;
    if constexpr (PM == 0)
#pragma unroll
    for (int g = 0; g < 4; ++g) {
        u32x2 w0, w1;
        w0.x = pk_f16(o0[4 * g] * inv, o0[4 * g + 1] * inv); w0.y = pk_f16(o0[4 * g + 2] * inv, o0[4 * g + 3] * inv);
        w1.x = pk_f16(o1[4 * g] * inv, o1[4 * g + 1] * inv); w1.y = pk_f16(o1[4 * g + 2] * inv, o1[4 * g + 3] * inv);
        *(u32x2*)(orow + 8 * g + 4 * hi) = w0; *(u32x2*)(orow + 32 + 8 * g + 4 * hi) = w1;
    }
    __syncthreads();
}
}
namespace dil {
typedef float f32x16 __attribute__((ext_vector_type(16)));
constexpr int KPW = 72, VPW = 96;
constexpr int WAVE_LDS = 32 * KPW * 2 + 32 * VPW * 2;
constexpr int OFF_BIASD = 8 * WAVE_LDS;
constexpr int OFF_STML = OFF_BIASD + 2048;
constexpr int OFF_STO = OFF_STML + 4096;
constexpr int SPW = 68, ST_SPLIT = (RING_BYTES - OFF_STO) / (SPW * 2), ST_GAP = RING_BYTES + 1024 - (OFF_STO + ST_SPLIT * SPW * 2);
static_assert(OFF_STO + ST_SPLIT * SPW * 2 <= RING_BYTES && OFF_STO + 512 * SPW * 2 + ST_GAP <= LDS_BYTES, "dilated state does not fit");
constexpr float LOG2E = 1.4426950408889634f;

__device__ __forceinline__ void dilated_unit(LAS unsigned char* lds, const f16* PROJ, const float* relb, f16* ATT, int b, int h, int sp, int tid) {
    const int lane = tid & 63, r32 = lane & 31, hi = lane >> 5; const int wid = __builtin_amdgcn_readfirstlane(tid >> 6);
    LAS float* biasd = (LAS float*)(lds + OFF_BIASD);
    for (int e = tid; e < 3 * 129; e += NTHR) { const int br = e / 129, mm = e % 129; const int dl = br == 0 ? 16 : (br == 1 ? 4 : 1); biasd[br * 132 + mm] = relb[(8 + h) * 32 + t5_bucket(dl * mm)] * LOG2E; }
    __syncthreads();
    LAS f16* Kb = (LAS f16*)(lds + wid * WAVE_LDS); LAS f16* Vb = Kb + 32 * KPW;
    LAS float* stml = (LAS float*)(lds + OFF_STML);
    const size_t rowbase = (size_t)b * SEQ; const int T0 = sp * 512;
    const f16* Kg = PROJ + 2048 + h * 64; const f16* Vg = PROJ + 2560 + h * 64; const f16* Qg = PROJ + 1536 + h * 64;
    const float csc = 0.125f * LOG2E;
    auto tile_dl = [&](int i) { const int pass = i >> 1; return pass == 0 ? 16 : (pass == 1 ? 4 : 1); };
    auto tile_tq0 = [&](int i) { const int pass = i >> 1, j = wid + 8 * (i & 1); return pass == 0 ? T0 + j : (pass == 1 ? T0 + (j >> 2) + 128 * (j & 3) : T0 + 32 * j); };
    auto tile_kb0 = [&](int i) { const int tq0 = tile_tq0(i), dl = tile_dl(i); int k = 0; while (k < 4 && tq0 + dl * (-128 + 32 * k + 31) < 0) ++k; return k; };
    auto adv = [&](int& i, int& k) { if (++k >= 5) { ++i; k = (i < 6) ? tile_kb0(i) : 0; return true; } return false; };
    f16x8 kA[4], vA[4], kB[4], vB[4];
    auto gload = [&](int ti, int kbk, f16x8 (&kreg)[4], f16x8 (&vreg)[4]) {
        const int tq0 = tile_tq0(ti), dl = tile_dl(ti);
#pragma unroll
        for (int i = 0; i < 4; ++i) { const int id = lane + 64 * i, c = id >> 3, ch = id & 7; int pos = tq0 + dl * (-128 + 32 * kbk + c); pos = pos < 0 ? 0 : pos;
            kreg[i] = *(const f16x8*)(Kg + (rowbase + pos) * AB_IN + 8 * ch); vreg[i] = *(const f16x8*)(Vg + (rowbase + pos) * AB_IN + 8 * ch); }
    };
    auto lstore = [&](const f16x8 (&kreg)[4], const f16x8 (&vreg)[4]) {
#pragma unroll
        for (int i = 0; i < 4; ++i) { const int id = lane + 64 * i, c = id >> 3, ch = id & 7;
            *(LAS f16x8*)(Kb + c * KPW + 8 * ch) = kreg[i];
            *(LAS f16x8*)(Vb + c * VPW + 8 * ch) = vreg[i]; }
    };
    auto loadq = [&](int ti, f16x8 (&q)[4]) {
        const int t = tile_tq0(ti) + tile_dl(ti) * r32; const f16* qrow = Qg + (rowbase + t) * AB_IN;
#pragma unroll
        for (int s = 0; s < 4; ++s) q[s] = *(const f16x8*)(qrow + 16 * s + 8 * hi);
    };
    auto strow = [&](int tt) { return (LAS f16*)(lds + OFF_STO + tt * (SPW * 2) + (tt >= ST_SPLIT ? ST_GAP : 0)); };
    int ci = 0, ck = tile_kb0(0); bool cstart = true;
    int pi = 0, pk = ck;
    f16x8 qf[4], qn[4];
    loadq(0, qn);
    gload(pi, pk, kA, vA); adv(pi, pk); gload(pi, pk, kB, vB); adv(pi, pk);
    f32x16 o0, o1; float m = 0.f, l = 0.f;
#pragma unroll
    for (int r = 0; r < 16; ++r) { o0[r] = 0.f; o1[r] = 0.f; }
    auto step = [&](f16x8 (&kreg)[4], f16x8 (&vreg)[4]) {
        const int ti = ci, kbk = ck, pass = ti >> 1; const int dl = tile_dl(ti), tq0 = tile_tq0(ti);
        const int tt = tq0 - T0 + dl * r32;
        const LAS float* bt = biasd + pass * 132;
        if (cstart) {
            cstart = false;
            if (pass > 0 && (ti & 1) == 0) { asm volatile("s_waitcnt lgkmcnt(0)" ::: "memory"); __builtin_amdgcn_s_barrier(); }
#pragma unroll
            for (int s = 0; s < 4; ++s) qf[s] = qn[s];
            if (ti + 1 < 6) loadq(ti + 1, qn);
            if (pass == 0) {
#pragma unroll
                for (int r = 0; r < 16; ++r) { o0[r] = 0.f; o1[r] = 0.f; }
                m = -1e30f; l = 0.f;
            } else {
                const LAS f16* srow = strow(tt);
                const f32x2 ml = *(const LAS f32x2*)(stml + tt * 2); m = ml[0]; const float L = ml[1]; l = hi == 0 ? L : 0.f;
#pragma unroll
                for (int g = 0; g < 4; ++g) { const f16x4 a = *(const LAS f16x4*)(srow + 8 * g + 4 * hi), c = *(const LAS f16x4*)(srow + 32 + 8 * g + 4 * hi);
#pragma unroll
                    for (int e = 0; e < 4; ++e) { o0[4 * g + e] = (float)a[e] * L; o1[4 * g + e] = (float)c[e] * L; } }
            }
        }
        asm volatile("s_waitcnt lgkmcnt(0)" ::: "memory");
        lstore(kreg, vreg);
        if (pi < 6) { gload(pi, pk, kreg, vreg); adv(pi, pk); }
        asm volatile("s_waitcnt lgkmcnt(0)" ::: "memory");
        f32x16 p;
#pragma unroll
        for (int r = 0; r < 16; ++r) p[r] = 0.f;
        f16x4 vlo[4], vhh[4];
        {
            f16x8 kf[4];
#pragma unroll
            for (int s = 0; s < 4; ++s) kf[s] = *(const LAS f16x8*)(Kb + r32 * KPW + 16 * s + 8 * hi);
#pragma unroll
            for (int s2 = 0; s2 < 2; ++s2)
#pragma unroll
                for (int db = 0; db < 2; ++db) { const LAS f16* vp = Vb + (16 * s2 + 4 * hi + ((lane & 15) >> 2)) * VPW + 32 * db + (r32 & 16) + 4 * (lane & 3); vlo[s2 * 2 + db] = att::tr_read(vp); vhh[s2 * 2 + db] = att::tr_read(vp + 8 * VPW); }
            __builtin_amdgcn_sched_barrier(0);
#pragma unroll
            for (int s = 0; s < 4; ++s) p = __builtin_amdgcn_mfma_f32_32x32x16_f16(kf[s], qf[s], p, 0, 0, 0);
        }
        const int basepos = tq0 + dl * (-128 + 32 * kbk);
        const int bmm = r32 + 128 - 32 * kbk - 4 * hi;
        const int bpos = basepos + dl * 4 * hi;
        const bool edge = (kbk == 0) || (kbk == 4) || (basepos < 0);
        if (edge) {
#pragma unroll
            for (int r = 0; r < 16; ++r) { const int c = (r & 3) + 8 * (r >> 2); const int mm = bmm - c; const bool ok = (mm >= 0) && (mm <= 128) && (bpos + dl * c >= 0);
                const int mc = mm < 0 ? 0 : (mm > 128 ? 128 : mm);
                p[r] = ok ? p[r] * csc + bt[mc] : -INFINITY; }
        } else {
            float bb[16];
#pragma unroll
            for (int r = 0; r < 16; ++r) { const int c = (r & 3) + 8 * (r >> 2); bb[r] = bt[bmm - c]; }
            __builtin_amdgcn_sched_barrier(0);
#pragma unroll
            for (int r = 0; r < 16; ++r) p[r] = p[r] * csc + bb[r];
        }
        float mx = p[0];
#pragma unroll
        for (int r = 1; r < 16; ++r) mx = fmaxf(mx, p[r]);
        mx = fmaxf(mx, __shfl_xor(mx, 32));
        if (__any(mx > m + 8.0f)) {
            const float mn = fmaxf(m, mx), alpha = __builtin_amdgcn_exp2f(m - mn);
            m = mn; l *= alpha;
#pragma unroll
            for (int r = 0; r < 16; ++r) { o0[r] *= alpha; o1[r] *= alpha; }
        }
        float sum = 0.f;
#pragma unroll
        for (int r = 0; r < 16; ++r) { p[r] = __builtin_amdgcn_exp2f(p[r] - m); sum += p[r]; }
        l += sum;
#pragma unroll
        for (int s2 = 0; s2 < 2; ++s2) {
            f16x8 bf;
#pragma unroll
            for (int e = 0; e < 8; ++e) bf[e] = (f16)p[8 * s2 + e];
#pragma unroll
            for (int db = 0; db < 2; ++db) {
                const f16x4 lo = vlo[s2 * 2 + db], hh = vhh[s2 * 2 + db];
                const f16x8 af = {lo[0], lo[1], lo[2], lo[3], hh[0], hh[1], hh[2], hh[3]};
                if (db == 0) o0 = __builtin_amdgcn_mfma_f32_32x32x16_f16(af, bf, o0, 0, 0, 0); else o1 = __builtin_amdgcn_mfma_f32_32x32x16_f16(af, bf, o1, 0, 0, 0);
            }
        }
        if (kbk == 4) {
            const float L = l + __shfl_xor(l, 32); const float inv = 1.f / L;
            if (pass < 2) {
                LAS f16* srow = strow(tt);
#pragma unroll
                for (int g = 0; g < 4; ++g) {
                    u32x2 w0, w1;
                    w0.x = pk_f16(o0[4 * g] * inv, o0[4 * g + 1] * inv); w0.y = pk_f16(o0[4 * g + 2] * inv, o0[4 * g + 3] * inv);
                    w1.x = pk_f16(o1[4 * g] * inv, o1[4 * g + 1] * inv); w1.y = pk_f16(o1[4 * g + 2] * inv, o1[4 * g + 3] * inv);
                    *(LAS u32x2*)(srow + 8 * g + 4 * hi) = w0; *(LAS u32x2*)(srow + 32 + 8 * g + 4 * hi) = w1;
                }
                if (hi == 0) *(LAS f32x2*)(stml + tt * 2) = (f32x2){m, L};
            } else {
                f16* orow = ATT + (rowbase + T0 + tt) * DM + 512 + h * 64;
#pragma unroll
                for (int g = 0; g < 4; ++g) {
                    u32x2 w0, w1;
                    w0.x = pk_f16(o0[4 * g] * inv, o0[4 * g + 1] * inv); w0.y = pk_f16(o0[4 * g + 2] * inv, o0[4 * g + 3] * inv);
                    w1.x = pk_f16(o1[4 * g] * inv, o1[4 * g + 1] * inv); w1.y = pk_f16(o1[4 * g + 2] * inv, o1[4 * g + 3] * inv);
                    *(u32x2*)(orow + 8 * g + 4 * hi) = w0; *(u32x2*)(orow + 32 + 8 * g + 4 * hi) = w1;
                }
            }
        }
        if (adv(ci, ck)) cstart = true;
    };
#pragma unroll 1
    for (;;) { step(kA, vA); if (ci >= 6) break; step(kB, vB); if (ci >= 6) break; }
    asm volatile("s_waitcnt lgkmcnt(0)" ::: "memory");
    __syncthreads();
}
}
#ifndef USE_MFMA_MOBA
#define USE_MFMA_MOBA 1
#endif
#ifndef USE_MFMA_MLA
#define USE_MFMA_MLA 1
#endif
#ifndef USE_MFMA_SB
#define USE_MFMA_SB 1
#endif
#ifndef USE_MFMA_DIL
#define USE_MFMA_DIL 1
#endif
#ifndef REP_MOBA
#define REP_MOBA 1
#endif
#ifndef REP_DIL
#define REP_DIL 1
#endif
#ifndef REP_MLA
#define REP_MLA 1
#endif
#ifndef REP_SB
#define REP_SB 1
#endif
#ifndef REP_P0
#define REP_P0 1
#endif
#ifndef REP_THIN
#define REP_THIN 1
#endif
#ifndef REP_INPROJ
#define REP_INPROJ 1
#endif
#ifndef REP_OUTPROJ
#define REP_OUTPROJ 1
#endif
#ifndef REP_FUP
#define REP_FUP 1
#endif
#ifndef REP_FDN
#define REP_FDN 1
#endif
#ifndef PROBE_XBAR
#define PROBE_XBAR 0
#endif
#ifndef HALO_IN_THIN1
#define HALO_IN_THIN1 0
#endif
#ifndef HALO_IN_FUP
#define HALO_IN_FUP 1
#endif
#ifndef PROBE_PM
#define PROBE_PM 0
#endif
#ifndef DEFER_W
#ifndef REP_DIL
#define REP_DIL 1
#endif
#ifndef P0_SPLIT
#define P0_SPLIT 1
#endif
#define DEFER_W 1
#endif
#ifndef PROBE_STAMP
#define PROBE_STAMP (-1)
#endif
#ifndef PROBE_BLK
#define PROBE_BLK 0
#endif
#ifndef PROBE_FUP
#define PROBE_FUP 0
#endif
#ifndef SEAM_FUSE
#define SEAM_FUSE 2
#endif
#ifndef MK_SPLIT
#define MK_SPLIT 0
#endif
constexpr int N_PHASES = 2 + DEPTH * 12;

__device__ __forceinline__ void panel_wait(unsigned* cnt, unsigned want, int tid) {
    if (tid < 64) { unsigned spins = 0;
        while ((unsigned)__builtin_amdgcn_readfirstlane(__hip_atomic_load(cnt, __ATOMIC_RELAXED, __HIP_MEMORY_SCOPE_AGENT)) < want) { __builtin_amdgcn_s_sleep(2); if (++spins > (1u << 16)) break; }
        __builtin_amdgcn_fence(__ATOMIC_ACQUIRE, "agent");
        asm volatile("s_waitcnt vmcnt(0)" ::: "memory"); }
    __syncthreads();
}
__device__ __forceinline__ int lane_now() { int l; asm volatile("v_mbcnt_lo_u32_b32 %0, -1, 0\n\tv_mbcnt_hi_u32_b32 %0, -1, %0" : "=v"(l)); return l; }
__global__ void __launch_bounds__(NTHR, 2) fwd_kernel(Args a) {
    extern __shared__ __attribute__((aligned(16))) unsigned char lds_raw[];
    LAS unsigned char* lds = (LAS unsigned char*)lds_raw;
    const int wave0 = __builtin_amdgcn_readfirstlane((int)threadIdx.x >> 6);
#define TID_NOW (wave0 * 64 + lane_now())
    const int bid = blockIdx.x, G = gridDim.x; const int NGT = G * NTHR;
    for (int u = TID_NOW; u < (LDS_BYTES - LDSCTL_OFF) / 4; u += NTHR) ((LAS unsigned*)(lds + LDSCTL_OFF))[u] = 0u;
    __syncthreads();
    volatile LAS unsigned* MISC = (volatile LAS unsigned*)(lds + MISC_OFF);
    XcdBarrier bar = xcd_barrier_post((unsigned*)(a.ws + WS_CTL) + CW_BAR, MISC + 8, TID_NOW);
    const int lo = a.ph_lo, hi = a.ph_hi; const bool seams = (hi - lo) > 1;
    int ph = 0;
    unsigned long long pacc = 0ull; int pkind = 0; (void)pkind;
    unsigned char* const ws0 = a.ws;
#define X16B ((f16*)(ws + WS_R2 + 32 * MiB))
#define X16 ((f16*)xout0)
#define MOD ((float*)(ws + WS_MOD))
#define H ((f16*)(ws + WS_H))
#define ATT ((f16*)(ws + WS_ATT))
#define HHALO ((f16*)(ws + WS_HHALO))
#define PROJ ((f16*)(ws + WS_R1))
#define Qb ((f16*)(ws + WS_R2))
#define KVb ((f16*)(ws + WS_R2 + 24 * MiB))
#define KPE ((f16*)(ws + WS_R2 + 56 * MiB))
#define rc ((const float*)(ws + WS_ROPE))
#define rs (((const float*)(ws + WS_ROPE)) + SEQ * 16)
#define ctl ((unsigned*)(ws + WS_CTL))
#define Y1 ((f16*)(ws + WS_R2))
#define Y2 ((f16*)(ws + WS_R2))
#define ACT ((f16*)(ws + WS_R1))
    float* const xout0 = a.out;
#define PH_ON (lo <= ph && ph < hi)
#define PH_LOC int tid = TID_NOW; asm volatile("" : "+v"(tid)); const int gt = bid * NTHR + tid; (void)gt; unsigned char* ws = ws0; asm volatile("" : "+s"(ws)); const unsigned long long t_ph0 = (PROBE_STAMP >= 0) ? rt() : 0ull; (void)t_ph0
#define PH_END do { const unsigned long long t1_ = (PROBE_STAMP >= 0) ? rt() : 0ull; if (seams) xcd_barrier(bar, TID_NOW); if (PROBE_STAMP >= 0) { const unsigned long long t2_ = rt(); if (PROBE_STAMP == 0) pacc += t2_ - t1_; else if (PROBE_STAMP == 20) pacc += t2_ - t_ph0; else if (PROBE_STAMP >= 100) { if (pkind == PROBE_STAMP - 100) pacc += t2_ - t1_; } else if (pkind == PROBE_STAMP) pacc += t1_ - t_ph0; } } while (0)

    pkind = 1;
    const int nmodw = (P0_SPLIT && DEFER_W && G >= 192) ? 96 : 0;
    if (PH_ON) { PH_LOC;
        if (nmodw == 0) { for (int ll = 0; ll < (DEFER_W ? 1 : DEPTH); ++ll) layer_mod(a, lds, tid, bid, G, ll); }
        else if (bid < nmodw) layer_mod(a, lds, tid, bid, nmodw, 0);
        else { layer_weights(a, lds, tid, bid - nmodw, G - nmodw, 0, 1); p0_misc(a, tid, bid - nmodw, G - nmodw); }
        PH_END; } ++ph;
    pkind = 2;
    if (PH_ON) { PH_LOC; if (gt < BATCH * 16 * 512) ((float*)(ws + WS_KMEAN))[gt] = 0.f;
        if (nmodw == 0) { for (int ll = 0; ll < (DEFER_W ? 1 : DEPTH); ++ll) { layer_weights(a, lds, tid, bid, G, ll, 3); __syncthreads(); } p0_misc(a, tid, bid, G); }
        else layer_weights(a, lds, tid, bid, G, 0, 2);
        __syncthreads();
        thin_phase<true, false, false, true>(a.in[I_X], nullptr, X16, nullptr, nullptr, nullptr, nullptr, a.in[I_MIXPRE], MOD, H, nullptr, lds, tid, bid * NWAVES + (tid >> 6), G * NWAVES); PH_END; } ++ph;

    for (int l = 0; l < DEPTH; ++l) {
        const int li = l >> 1; const bool odd = (l & 1) != 0;
#define modl (MOD + (size_t)l * BATCH * 6144)
        for (int xb = 0; xb < PROBE_XBAR; ++xb) if (seams) xcd_barrier(bar, TID_NOW);
        pkind = 3;
        if (PH_ON) { PH_LOC;
            const int N = odd ? CD_INP : AB_IN;
            const f16* Bt = odd ? (const f16*)(ws + WS_W_INCD) + (size_t)li * CD_INP * DM : (const f16*)(ws + WS_W_INAB) + (size_t)li * AB_IN * DM;
            pg8::Gemm g{H, Bt, M, N, DM, DM}; pg8::StaticOrder S; S.init(M, N, G, bid);
            pg8::EpiF16 E{PROJ, N, 0, nullptr, 0, odd ? nullptr : (float*)(ws + WS_KMEAN), 512, 1024, odd ? (PG8_LAS float*)(lds + XCH_OFF) : (PG8_LAS float*)nullptr, KPE, rc, rs, nullptr};
            for (int rep = 0; rep < REP_INPROJ; ++rep) pg8::gemm_phase<pg8::EpiF16, pg8::StaticOrder, true, true>(lds, g, S, E, tid);
            if (DEFER_W && odd) {
                const int total = (M / 256) * (N / 256), rounds = (total + G - 1) / G; int first_short = total - (rounds - 1) * G; if (first_short >= G) first_short = 0;
                if (bid >= first_short) { const int tid2 = TID_NOW; layer_weights(a, lds, tid2, bid - first_short, G - first_short, l, 2); if (l == 1) layer_weights(a, lds, tid2, bid - first_short, G - first_short, 2, 2); }
            }
            PH_END; } ++ph;
        pkind = 4;
        if (PH_ON) { PH_LOC;
            (void)tid; } ++ph;
        if (PH_ON) { PH_LOC;
            if (odd) {
                pg8::Gemm g{PROJ, (const f16*)(ws + WS_W_UP2) + (size_t)li * UP_N * UP_K, M, UP_N, UP_K, CD_INP}; pg8::UpOrder S; S.init(M, UP_N, G, bid, QW / 256);
                pg8::EpiF16 E{Qb, QW, QW, KVb, KVW, nullptr, 0, 0, nullptr, nullptr, nullptr, nullptr, nullptr};
                pg8::gemm_phase<pg8::EpiF16, pg8::UpOrder, true, true>(lds, g, S, E, tid);
                PH_END; }
        } ++ph;
        pkind = odd ? 6 : 5;
        if (PH_ON) { PH_LOC;
            const int vcu = (G % 8 == 0) ? (bid % 8) * (G / 8) + bid / 8 : bid;
            if (!odd) {
#pragma unroll 1
                for (int step = 0; step < 2; ++step) {
                    if ((step == 0) == ((vcu & 1) != 0)) {
                        for (int rep = 0; rep < REP_DIL; ++rep)
                        for (int u = vcu; u < 256; u += G) { const int bh = u >> 3, sp = u & 7;
                            dil::dilated_unit(lds, PROJ, a.in[I_RELB], ATT, bh >> 3, bh & 7, sp, tid); }
                    } else {
                        for (int p = vcu; p < 256; p += G) { const int bh = p >> 3, s = p & 7, b = bh >> 3, h = bh & 7;
                            att::Src T{PROJ + h * 64, AB_IN, PROJ + 512 + h * 64, AB_IN, nullptr, PROJ + 1024 + h * 64, AB_IN, ATT + h * 64};
                            att::attn_unit<1>(lds, T, b, h, s, rc, rs, (const float*)(ws + WS_KMEAN), a.in[I_RELB], tid);
                            att::attn_unit<1>(lds, T, b, h, 15 - s, rc, rs, (const float*)(ws + WS_KMEAN), a.in[I_RELB], tid); }
                    }
                }
            } else {
#if USE_MFMA_MLA
                for (int rep = 1; rep < REP_MLA; ++rep)
                for (int p = vcu; p < 256; p += G) { const int bh = p >> 3, s = p & 7, b = bh >> 3, h = bh & 7;
                    att::Src T{Qb + h * 96, QW, KVb + h * 128, KVW, KPE, KVb + h * 128 + 64, KVW, ATT + h * 64};
                    att::attn_unit<0, PROBE_PM>(lds, T, b, h, s, rc, rs, nullptr, nullptr, tid);
                    att::attn_unit<0, PROBE_PM>(lds, T, b, h, 15 - s, rc, rs, nullptr, nullptr, tid); }
                for (int p = vcu; p < 256; p += G) { const int bh = p >> 3, s = p & 7, b = bh >> 3, h = bh & 7;
                    att::Src T{Qb + h * 96, QW, KVb + h * 128, KVW, KPE, KVb + h * 128 + 64, KVW, ATT + h * 64};
                    att::attn_unit<0>(lds, T, b, h, s, rc, rs, nullptr, nullptr, tid);
                    att::attn_unit<0>(lds, T, b, h, 15 - s, rc, rs, nullptr, nullptr, tid); }
#else
                naive_mla(Qb, KVb, KPE, rc, rs, ATT, gt, NGT);
#endif
#if USE_MFMA_SB
                for (int rep = 0; rep < REP_SB; ++rep)
                for (int p = vcu; p < 256; p += G) { const int bh = p >> 3, s = p & 7, b = bh >> 3, h = bh & 7;
                    att::Src T{PROJ + 544 + h * 64, CD_INP, PROJ + 1056 + h * 64, CD_INP, nullptr, PROJ + 1568 + h * 64, CD_INP, ATT + 512 + h * 64};
                    att::attn_unit<2>(lds, T, b, h, s, rc, rs, nullptr, nullptr, tid);
                    att::attn_unit<2>(lds, T, b, h, 15 - s, rc, rs, nullptr, nullptr, tid); }
#else
                naive_sb(PROJ, ATT, gt, NGT);
#endif
            }
            PH_END; } ++ph;
        pkind = 7;
        if (PH_ON) { PH_LOC;
            const f16* Bt = odd ? (const f16*)(ws + WS_W_OUTCD) + (size_t)li * DM * DM : (const f16*)(ws + WS_W_OUTAB) + (size_t)li * DM * DM;
            pg8::Gemm g{ATT, Bt, M, DM, DM, DM}; pg8::StaticOrder S; S.init(M, DM, G, bid);
#if SEAM_FUSE == 2
            if (G == 256) {
                pg8::EpiRow ER{X16, (l + 1 == DEPTH) ? X16B : X16, nullptr, modl + 2 * DM, a.in[I_MIXPOST] + l * DM, a.in[I_FFNPRE] + l * DM, modl + 3 * DM, H, HHALO,
                               (float*)(ws + WS_XB), (float*)(ws + WS_XB + 256 * 1024), ctl + CW_PANEL + 64 * (((2 * l + 0) * 2 + 0) * 64), ctl + CW_PANEL + 64 * (((2 * l + 0) * 2 + 1) * 64)};
                pg8::gemm_phase<pg8::EpiRow, pg8::StaticOrder, false, true>(lds, g, S, ER, tid);
            } else
#endif
            {
            const bool fuse = SEAM_FUSE == 1 && G == 256;
            unsigned* pc = ctl + CW_PANEL + 64 * ((2 * l + 0) * 64);
            pg8::EpiF16 E{Y1, DM, 0, nullptr, 0, nullptr, 0, 0, nullptr, nullptr, nullptr, nullptr, fuse ? pc : nullptr};
            pg8::gemm_phase<pg8::EpiF16, pg8::StaticOrder, true, true>(lds, g, S, E, tid);
            if (fuse) { pg8::Unit u; S.next(0, u);
                panel_wait(pc + 64 * u.pm, 32u, tid);
                thin_phase<false, true, false, true>(nullptr, X16, (l + 1 == DEPTH) ? X16B : X16, nullptr, Y1, modl + 2 * DM, a.in[I_MIXPOST] + l * DM, a.in[I_FFNPRE] + l * DM, modl + 3 * DM, H, HHALO, lds, tid,
                                                     u.pm * 256 + u.pn * 64 + (tid >> 6), NWAVES, u.pm * 256 + u.pn * 64 + 64); }
            }
            PH_END; } ++ph;
        pkind = 2;
        if (PH_ON) { PH_LOC;
            if (!(SEAM_FUSE != 0 && G == 256)) {
            const float* gpost = a.in[I_MIXPOST] + l * DM; const float* gpre = a.in[I_FFNPRE] + l * DM;
            thin_phase<false, true, false, true>(nullptr, X16, (l + 1 == DEPTH) ? X16B : X16, nullptr, Y1, modl + 2 * DM, gpost, gpre, modl + 3 * DM, H, HHALO, lds, tid, bid * NWAVES + (tid >> 6), G * NWAVES);
            PH_END; } } ++ph;
#if !HALO_IN_FUP
        if (PH_ON) { PH_LOC;
            pg8::Gemm g{HHALO, (const f16*)(ws + WS_W_FUP) + (size_t)l * DFF2 * DM, 256, DFF2, DM, DM}; pg8::StaticOrder S; S.init(256, DFF2, G, bid);
            pg8::EpiF32 E{(float*)(ws + WS_UHALO), DFF2, 128};
            pg8::gemm_phase<pg8::EpiF32, pg8::StaticOrder, true, true>(lds, g, S, E, tid);
            PH_END; }
#endif
        ++ph;
        pkind = 8;
        if (PH_ON) { PH_LOC;
            pg8::Gemm g{H, (const f16*)(ws + WS_W_FUP) + (size_t)l * DFF2 * DM, M, DFF2, DM, DM};
#if HALO_IN_FUP
            pg8::FfnUpOrder S; S.init(M, DFF2, G, bid);
            pg8::EpiConv E{ACT, (float*)(ws + WS_UHALO), a.in[I_CONVW] + (size_t)l * 3 * DFF2, a.in[I_CONVB] + (size_t)l * DFF2, (PG8_LAS float*)(lds + XCH_OFF), (PG8_LAS float*)(lds + XCH_OFF + 8192), ctl + CW_HALO + 64 * 22 * l, M / 256};
            pg8::gemm_phase<pg8::EpiConv, pg8::FfnUpOrder, true, true>(lds, g, S, E, tid);
#if PROBE_FUP == 1
            pg8::gemm_phase<pg8::EpiConv, pg8::FfnUpOrder, true, true>(lds, g, S, E, tid);
#elif PROBE_FUP == 3
            { pg8::StaticOrder S2; S2.init(M, DFF2, G, bid); pg8::EpiNull E2{}; pg8::gemm_phase<pg8::EpiNull, pg8::StaticOrder, true, true>(lds, g, S2, E2, tid); }
#elif PROBE_FUP == 2
            { pg8::StaticOrder S2; S2.init(M, DFF2, G, bid); pg8::EpiF16 E2{(f16*)(ws + WS_R2), 1024, 0, nullptr, 0, nullptr, 0, 0, nullptr, nullptr, nullptr, nullptr, nullptr};
              pg8::gemm_phase<pg8::EpiF16, pg8::StaticOrder, true, true>(lds, g, S2, E2, tid); }
#endif
            if (DEFER_W && l + 1 < DEPTH) {
                const int total = (M / 256) * (DFF2 / 256) + DFF2 / 256, rounds = (total + G - 1) / G; int first_short = total - (rounds - 1) * G; if (first_short >= G) first_short = 0;
                if (bid >= first_short) { const int tid2 = TID_NOW;
                    layer_mod(a, lds, tid2, bid - first_short, G - first_short, l + 1); layer_weights(a, lds, tid2, bid - first_short, G - first_short, l + 1, 1); }
            }
#else
            pg8::StaticOrder S; S.init(M, DFF2, G, bid);
            pg8::EpiConv E{ACT, (float*)(ws + WS_UHALO), a.in[I_CONVW] + (size_t)l * 3 * DFF2, a.in[I_CONVB] + (size_t)l * DFF2, (PG8_LAS float*)(lds + XCH_OFF), (PG8_LAS float*)(lds + XCH_OFF + 8192), ctl + CW_HALO, -1};
            for (int rep = 0; rep < REP_FUP; ++rep) pg8::gemm_phase<pg8::EpiConv, pg8::StaticOrder, true, true>(lds, g, S, E, tid);
#endif
            PH_END; } ++ph;
        ++ph; ++ph;
        pkind = 9;
        if (PH_ON) { PH_LOC;
            pg8::Gemm g{ACT, (const f16*)(ws + WS_W_FDN) + (size_t)l * DM * DFF, M, DM, DFF, DFF}; pg8::StaticOrder S; S.init(M, DM, G, bid);
#if SEAM_FUSE == 2
            if (G == 256) {
                const int ln2 = (l + 1 < DEPTH) ? l + 1 : l; const bool last = l + 1 == DEPTH;
                pg8::EpiRow ER{last ? X16B : X16, last ? (f16*)nullptr : X16, last ? xout0 : (float*)nullptr, modl + 5 * DM, a.in[I_FFNPOST] + l * DM, a.in[I_MIXPRE] + ln2 * DM, MOD + (size_t)ln2 * BATCH * 6144, H, nullptr,
                               (float*)(ws + WS_XB), (float*)(ws + WS_XB + 256 * 1024), ctl + CW_PANEL + 64 * (((2 * l + 1) * 2 + 0) * 64), ctl + CW_PANEL + 64 * (((2 * l + 1) * 2 + 1) * 64)};
                pg8::gemm_phase<pg8::EpiRow, pg8::StaticOrder, false, true>(lds, g, S, ER, tid);
                if (gt < BATCH * 16 * 512) ((float*)(ws + WS_KMEAN))[gt] = 0.f;
            } else
#endif
            {
            const bool fuse = SEAM_FUSE == 1 && G == 256;
            unsigned* pc = ctl + CW_PANEL + 64 * ((2 * l + 1) * 64);
            pg8::EpiF16 E{Y2, DM, 0, nullptr, 0, nullptr, 0, 0, nullptr, nullptr, nullptr, nullptr, fuse ? pc : nullptr};
            pg8::gemm_phase<pg8::EpiF16, pg8::StaticOrder, true, true>(lds, g, S, E, tid);
            if (fuse) { pg8::Unit u; S.next(0, u);
                panel_wait(pc + 64 * u.pm, 32u, tid);
                const int ln = (l + 1 < DEPTH) ? l + 1 : l; const int r0 = u.pm * 256 + u.pn * 64;
                if (l + 1 < DEPTH) thin_phase<false, true, false, true>(nullptr, X16, X16, nullptr, Y2, modl + 5 * DM, a.in[I_FFNPOST] + l * DM, a.in[I_MIXPRE] + ln * DM, MOD + (size_t)ln * BATCH * 6144, H, nullptr, lds, tid, r0 + (tid >> 6), NWAVES, r0 + 64);
                else thin_phase<false, true, true, false>(nullptr, X16B, nullptr, xout0, Y2, modl + 5 * DM, a.in[I_FFNPOST] + l * DM, nullptr, nullptr, nullptr, nullptr, lds, tid, r0 + (tid >> 6), NWAVES, r0 + 64);
                if (gt < BATCH * 16 * 512) ((float*)(ws + WS_KMEAN))[gt] = 0.f; }
            }
            PH_END; } ++ph;
        pkind = 2;
        if (PH_ON) { PH_LOC;
            if (!(SEAM_FUSE != 0 && G == 256)) {
            const int ln = (l + 1 < DEPTH) ? l + 1 : l;
            if (gt < BATCH * 16 * 512) ((float*)(ws + WS_KMEAN))[gt] = 0.f;
            if (l + 1 < DEPTH) thin_phase<false, true, false, true>(nullptr, X16, X16, nullptr, Y2, modl + 5 * DM, a.in[I_FFNPOST] + l * DM, a.in[I_MIXPRE] + ln * DM, MOD + (size_t)ln * BATCH * 6144, H, nullptr, lds, tid, bid * NWAVES + (tid >> 6), G * NWAVES);
            else thin_phase<false, true, true, false>(nullptr, X16B, nullptr, xout0, Y2, modl + 5 * DM, a.in[I_FFNPOST] + l * DM, nullptr, nullptr, nullptr, nullptr, lds, tid, bid * NWAVES + (tid >> 6), G * NWAVES);
            PH_END; } } ++ph;
    }
    if (PROBE_STAMP >= 0 && bid == PROBE_BLK) { const unsigned long long t0_ = rt(); while (rt() - t0_ < pacc) __builtin_amdgcn_s_sleep(10); }
#undef PH_ON
#undef PH_END
#undef X16
#undef X16B
#undef MOD
#undef H
#undef ATT
#undef HHALO
#undef PROJ
#undef Qb
#undef KVb
#undef KPE
#undef rc
#undef rs
#undef ctl
#undef Y1
#undef Y2
#undef ACT
#undef modl
}

extern "C" void kernel_launch(void* const* d_in, const int* in_sizes, int n_in, void* d_out, int out_size, void* d_ws, size_t ws_size, hipStream_t stream) {
    static int grid = 0;
    if (grid == 0) {
        if (n_in != 21 || in_sizes[0] != M * DM || out_size != M * DM || ws_size < WS_END) { fprintf(stderr, "kernel_launch: unexpected shapes (n_in %d, ws %zu); nothing launched\n", n_in, ws_size); grid = -1; return; }
        int dev = 0, cus = 0, per_cu = 0;
        if (hipGetDevice(&dev) != hipSuccess || hipDeviceGetAttribute(&cus, hipDeviceAttributeMultiprocessorCount, dev) != hipSuccess) { grid = -1; return; }
        if (hipFuncSetAttribute((const void*)fwd_kernel, hipFuncAttributeMaxDynamicSharedMemorySize, LDS_BYTES) != hipSuccess) { fprintf(stderr, "kernel_launch: hipFuncSetAttribute failed\n"); grid = -1; return; }
        if (hipOccupancyMaxActiveBlocksPerMultiprocessor(&per_cu, (const void*)fwd_kernel, NTHR, LDS_BYTES) != hipSuccess || per_cu < 1) { fprintf(stderr, "kernel_launch: occupancy query reports %d\n", per_cu); }
        (void)hipGetLastError();
        grid = cus;
        if (grid < 64) { fprintf(stderr, "kernel_launch: %d CUs: too few\n", cus); grid = -1; return; }
    }
    if (grid < 0) return;
    (void)hipMemsetAsync((char*)d_ws + WS_CTL, 0, CTL_ZERO_BYTES, stream);
    Args a{};
    for (int i = 0; i < 21; ++i) a.in[i] = (const float*)d_in[i];
    a.out = (float*)d_out; a.ws = (unsigned char*)d_ws;
#if MK_SPLIT
    for (int p = 0; p < N_PHASES; ++p) { a.ph_lo = p; a.ph_hi = p + 1; hipLaunchKernelGGL(fwd_kernel, dim3(grid), dim3(NTHR), LDS_BYTES, stream, a); }
#else
    a.ph_lo = 0; a.ph_hi = N_PHASES;
    hipLaunchKernelGGL(fwd_kernel, dim3(grid), dim3(NTHR), LDS_BYTES, stream, a);
#endif
}
```

```cpp
#include <hip/hip_runtime.h>
#include <cstdio>
#include <cstdint>

constexpr int BATCH = 4, SEQ = 4096, DM = 1024, M = BATCH * SEQ, DEPTH = 4;
constexpr int NH = 8, HD = 64;
constexpr int AB_IN = 3072, CD_IN = 2080, CD_INP = 2304;
constexpr int DFF = 2816, DFF2 = 5632;
constexpr int UP_N = 1792, UP_K = 256;
constexpr int QW = 768, KVW = 1024;
constexpr float NORM_EPS = 1e-6f;

typedef _Float16 f16;
typedef _Float16 f16x2 __attribute__((ext_vector_type(2)));
typedef _Float16 f16x4 __attribute__((ext_vector_type(4)));
typedef _Float16 f16x8 __attribute__((ext_vector_type(8)));
typedef float f32x2 __attribute__((ext_vector_type(2)));
typedef float f32x4 __attribute__((ext_vector_type(4)));
typedef unsigned u32x2 __attribute__((ext_vector_type(2)));
typedef unsigned u32x4 __attribute__((ext_vector_type(4)));

__device__ __forceinline__ float xsum16(float x) { float a = x, b = x; asm volatile("s_nop 1\n\tv_permlane16_swap_b32 %0, %1\n\ts_nop 1" : "+v"(a), "+v"(b)); return a + b; }
__device__ __forceinline__ float xsum32(float x) { float a = x, b = x; asm volatile("s_nop 1\n\tv_permlane32_swap_b32 %0, %1\n\ts_nop 1" : "+v"(a), "+v"(b)); return a + b; }
__device__ __forceinline__ float xget32(float x, int hi) { float a = x, b = x; asm volatile("s_nop 1\n\tv_permlane32_swap_b32 %0, %1\n\ts_nop 1" : "+v"(a), "+v"(b)); return hi ? a : b; }
__device__ __forceinline__ float max3f(float a, float b, float c) { float r; asm("v_max3_f32 %0, %1, %2, %3" : "=v"(r) : "v"(a), "v"(b), "v"(c)); return r; }
template <int CTRL> __device__ __forceinline__ float dppf(float x) { return __builtin_bit_cast(float, __builtin_amdgcn_update_dpp(__builtin_bit_cast(int, x), __builtin_bit_cast(int, x), CTRL, 0xf, 0xf, true)); }
__device__ __forceinline__ float qsum4(float x) { x += dppf<0xB1>(x); x += dppf<0x4E>(x); return x; }
__device__ __forceinline__ float rsum16(float x) { x = qsum4(x); x += dppf<0x141>(x); x += dppf<0x140>(x); return x; }
__device__ __forceinline__ float wsum64(float x) { return xsum32(xsum16(rsum16(x))); }
__device__ __forceinline__ unsigned pk_f16(float lo, float hi) { f32x2 v = {lo, hi}; f16x2 h = __builtin_convertvector(v, f16x2); return __builtin_bit_cast(unsigned, h); }

constexpr size_t MiB = 1u << 20;
constexpr size_t WS_CTL = 0, CTL_ZERO_BYTES = 1 * MiB;
constexpr size_t WS_MOD = 1 * MiB;
constexpr size_t WS_KMEAN = 1 * MiB + 512 * 1024;
constexpr size_t WS_ROPE = 2 * MiB;
constexpr size_t WS_UHALO = 3 * MiB;
constexpr size_t WS_HHALO = 140 * MiB;
constexpr size_t WS_XB = 6 * MiB;
constexpr size_t WS_W_INAB = 8 * MiB;
constexpr size_t WS_W_OUTAB = 20 * MiB;
constexpr size_t WS_W_INCD = 24 * MiB;
constexpr size_t WS_W_UP2 = 33 * MiB;
constexpr size_t WS_W_OUTCD = 37 * MiB;
constexpr size_t WS_W_FUP = 41 * MiB;
constexpr size_t WS_W_FDN = 85 * MiB;
constexpr size_t WS_H = 108 * MiB;
constexpr size_t WS_ATT = 140 * MiB;
constexpr size_t WS_R2 = 172 * MiB;
constexpr size_t WS_R1 = 236 * MiB;
constexpr size_t WS_END = 332 * MiB;
constexpr int CW_BAR = 4096;
constexpr int CW_PANEL = 32768;
constexpr int CW_HALO = 16384;
namespace pg8 {
__device__ __forceinline__ int lane_hw() { int l; asm volatile("v_mbcnt_lo_u32_b32 %0, -1, 0\n\tv_mbcnt_hi_u32_b32 %0, -1, %0" : "=v"(l)); return l; }
#define PG8_LAS __attribute__((address_space(3)))
constexpr int BM = 256, BK = 64, HALF = 128, HTB = HALF * BK * 2  , STAGE_BYTES = 8 * HTB, NXCD = 8, WGM = 8;

__host__ __device__ __forceinline__ int lds_byte(int r, int c) { const int st = (r >> 4) * 2 + (c >> 5), rr = r & 15, cc = c & 31, ob = rr * 64 + cc * 2; return st * 1024 + (ob ^ (((ob >> 9) & 1) << 5)); }
__host__ __device__ __forceinline__ void stage_rc(int b, int& R, int& C) { const int st = b / 1024, sb = b % 1024, swz = sb ^ (((sb >> 9) & 1) << 5); R = (st >> 1) * 16 + swz / 64; C = (st & 1) * 32 + (swz % 64) / 2; }
__host__ __device__ __forceinline__ int perm32(int rho) { const int n = rho >> 4, i = rho & 15; return 8 * (i >> 2) + 4 * n + (i & 3); }

struct Unit { int pm, pn; };
struct Gemm { const f16* A; const f16* Bt; int M, N, K, lda; };

struct StaticOrder {
    int nM, nN, nwg, G, c;
    __host__ __device__ __forceinline__ void init(int M_, int N_, int G_, int c_) { nM = M_ / BM; nN = N_ / BM; nwg = nM * nN; G = G_; c = c_; }
    __host__ __device__ __forceinline__ void map(int wgid, Unit& u) const {
        { const int q = nwg / NXCD, r = nwg % NXCD, xcd = wgid % NXCD, off = wgid / NXCD; wgid = (xcd < r ? xcd * (q + 1) : r * (q + 1) + (xcd - r) * q) + off; }
        const int nig = WGM * nN, gid = wgid / nig, fm = gid * WGM, gsz = (nM - fm) < WGM ? (nM - fm) : WGM;
        u.pm = fm + ((wgid % nig) % gsz); u.pn = (wgid % nig) / gsz;
    }
    __host__ __device__ __forceinline__ bool next(int i, Unit& u) const { const long L = (long)i * G + c; if (L >= nwg) return false; map((int)L, u); return true; }
    __device__ __forceinline__ void a_ready(const Unit&) const {}
    __device__ __forceinline__ void done(const Unit&) const {}
    __device__ __forceinline__ size_t a_off(const Unit&) const { return 0; }
};

struct FfnUpOrder {
    StaticOrder S; int nh;
    __host__ __device__ __forceinline__ void init(int M_, int N_, int G_, int c_) { S.init(M_, N_, G_, c_); nh = N_ / BM; }
    __host__ __device__ __forceinline__ bool next(int i, Unit& u) const { const long L = (long)i * S.G + S.c; if (L >= S.nwg + nh) return false; if (L < nh) { u.pm = S.nM; u.pn = (int)L; return true; } S.map((int)L - nh, u); return true; }
    __device__ __forceinline__ void a_ready(const Unit&) const {}
    __device__ __forceinline__ void done(const Unit&) const {}
    __device__ __forceinline__ size_t a_off(const Unit&) const { return 0; }
};

struct UpOrder {
    StaticOrder S; int split_pn;
    __host__ __device__ __forceinline__ void init(int M_, int N_, int G_, int c_, int sp) { S.init(M_, N_, G_, c_); split_pn = sp; }
    __host__ __device__ __forceinline__ bool next(int i, Unit& u) const { return S.next(i, u); }
    __device__ __forceinline__ void a_ready(const Unit&) const {}
    __device__ __forceinline__ void done(const Unit&) const {}
    __device__ __forceinline__ size_t a_off(const Unit& u) const { return u.pn >= split_pn ? 512 : 0; }
};

struct NoPre { __device__ __forceinline__ void pin() {} };
struct EpiNull {
    static constexpr bool PERM = true, AFTER_DRAIN = false;
    typedef NoPre Pre; __device__ __forceinline__ void prefetch(Pre&, const Unit&, int) const {}
    __device__ __forceinline__ void operator()(const f32x4 (&acc)[2][2][4][2], const Unit&, int, int, int, int, const Pre&) const {
#pragma unroll
        for (int a = 0; a < 2; ++a)
#pragma unroll
            for (int b = 0; b < 2; ++b)
#pragma unroll
                for (int m = 0; m < 4; ++m) asm volatile("" :: "v"(acc[a][b][m][0]), "v"(acc[a][b][m][1]));
    }
};
struct EpiF32 {
    static constexpr bool PERM = false, AFTER_DRAIN = false;
    float* C; int ldc; int row_limit;
    typedef NoPre Pre; __device__ __forceinline__ void prefetch(Pre&, const Unit&, int) const {}
    __device__ __forceinline__ void operator()(const f32x4 (&acc)[2][2][4][2], const Unit& u, int wr, int wc, int fr_in, int fq_in, const Pre&) const {
        int fr = fr_in, fq = fq_in; asm volatile("" : "+v"(fr), "+v"(fq));
        const int row0 = u.pm * BM + wr * 64 + fr, col0 = u.pn * BM + wc * 32 + 4 * fq;
#pragma unroll
        for (int ai = 0; ai < 2; ++ai)
#pragma unroll
            for (int m = 0; m < 4; ++m) { const int row = row0 + ai * HALF + m * 16; if (row >= row_limit) continue; float* rowp = C + (size_t)row * ldc + col0;
#pragma unroll
                for (int bj = 0; bj < 2; ++bj)
#pragma unroll
                    for (int n = 0; n < 2; ++n) *(f32x4*)(rowp + bj * HALF + n * 16) = acc[ai][bj][m][n]; }
    }
};
struct EpiF16 {
    static constexpr bool PERM = true, AFTER_DRAIN = false;
    f16* O; int ldc; int split_col; f16* O2; int ldc2;
    float* ksum; int ks_lo, ks_hi;
    PG8_LAS float* XR; f16* KPE; const float* rc; const float* rs;
    unsigned* pcnt;
    typedef NoPre Pre; __device__ __forceinline__ void prefetch(Pre&, const Unit&, int) const {}
    __device__ __forceinline__ void operator()(const f32x4 (&acc)[2][2][4][2], const Unit& u, int wr, int wc, int fr_in, int fq_in, const Pre&) const {
        int fr = fr_in, fq = fq_in; asm volatile("" : "+v"(fr), "+v"(fq));
        float rsc[2][4];
#pragma unroll
        for (int ai = 0; ai < 2; ++ai)
#pragma unroll
            for (int m = 0; m < 4; ++m) rsc[ai][m] = 1.0f;
        if (XR != nullptr) {
            const bool nt = u.pn < 2;
            if (nt) {
#pragma unroll
                for (int ai = 0; ai < 2; ++ai)
#pragma unroll
                    for (int m = 0; m < 4; ++m) { float q = 0.f;
#pragma unroll
                        for (int bj = 0; bj < 2; ++bj)
#pragma unroll
                            for (int n = 0; n < 2; ++n) { const f32x4 x = acc[ai][bj][m][n]; q += (x[0] * x[0] + x[1] * x[1]) + (x[2] * x[2] + x[3] * x[3]); }
                        q = xsum32(xsum16(q));
                        if (fq == 0) XR[(ai * HALF + wr * 64 + m * 16 + fr) * 4 + wc] = q; }
            }
            asm volatile("s_waitcnt lgkmcnt(0)" ::: "memory"); __builtin_amdgcn_s_barrier(); asm volatile("" ::: "memory");
            if (nt) {
#pragma unroll
                for (int ai = 0; ai < 2; ++ai)
#pragma unroll
                    for (int m = 0; m < 4; ++m) { const f32x4 q = *(const PG8_LAS f32x4*)(XR + (ai * HALF + wr * 64 + m * 16 + fr) * 4); rsc[ai][m] = __builtin_amdgcn_rsqf(((q[0] + q[1]) + (q[2] + q[3])) * (1.0f / 256.0f) + NORM_EPS); }
            }
            if (u.pn == 2 && wc == 0) {
                const int half = fq >> 1, dd0 = 8 * (fq & 1);
#pragma unroll
                for (int ai = 0; ai < 2; ++ai)
#pragma unroll
                    for (int m = 0; m < 4; ++m) { const int row = u.pm * BM + ai * HALF + wr * 64 + m * 16 + fr, t = row & (SEQ - 1);
#pragma unroll
                        for (int n = 0; n < 2; ++n) { const f32x4 own = acc[ai][0][m][n]; f32x4 par;
#pragma unroll
                            for (int e = 0; e < 4; ++e) par[e] = xget32(own[e], half);
                            const f32x4 cs = *(const f32x4*)(rc + t * 16 + dd0 + 4 * n), sn = *(const f32x4*)(rs + t * 16 + dd0 + 4 * n);
                            const f32x4 o = half ? (par * sn + own * cs) : (own * cs - par * sn);
                            u32x2 w; w.x = pk_f16(o[0], o[1]); w.y = pk_f16(o[2], o[3]);
                            *(u32x2*)(KPE + (size_t)row * 32 + 16 * half + dd0 + 4 * n) = w; } }
            }
        }
        if (ksum != nullptr && u.pn * BM >= ks_lo && u.pn * BM < ks_hi) {
#pragma unroll
            for (int bj = 0; bj < 2; ++bj)
#pragma unroll
                for (int n = 0; n < 2; ++n) { f32x4 cs = (acc[0][bj][0][n] + acc[0][bj][1][n]) + (acc[0][bj][2][n] + acc[0][bj][3][n]); cs = cs + ((acc[1][bj][0][n] + acc[1][bj][1][n]) + (acc[1][bj][2][n] + acc[1][bj][3][n]));
#pragma unroll
                    for (int e = 0; e < 4; ++e) { const float v = rsum16(cs[e]);
                        if (fr == 0) atomicAdd(ksum + (size_t)u.pm * (ks_hi - ks_lo) + (u.pn * BM - ks_lo) + bj * HALF + wc * 32 + 8 * fq + 4 * n + e, v); } }
        }
        const int row0 = u.pm * BM + wr * 64 + fr; int colt = u.pn * BM; f16* base = O; int ld = ldc;
        if (split_col && colt >= split_col) { base = O2; ld = ldc2; colt -= split_col; }
        const int col0 = colt + wc * 32 + 8 * fq;
        if (pcnt == nullptr) {
#pragma unroll
            for (int ai = 0; ai < 2; ++ai)
#pragma unroll
                for (int m = 0; m < 4; ++m) { f16* rowp = base + (size_t)(row0 + ai * HALF + m * 16) * ld + col0;
#pragma unroll
                    for (int bj = 0; bj < 2; ++bj) { const f32x4 v0 = acc[ai][bj][m][0] * rsc[ai][m], v1 = acc[ai][bj][m][1] * rsc[ai][m];
                        u32x4 w; w.x = pk_f16(v0[0], v0[1]); w.y = pk_f16(v0[2], v0[3]); w.z = pk_f16(v1[0], v1[1]); w.w = pk_f16(v1[2], v1[3]);
                        *(u32x4*)(rowp + bj * HALF) = w; } }
        } else {
            const __amdgpu_buffer_rsrc_t rsrc = __builtin_amdgcn_make_buffer_rsrc((void*)base, 0, 0x7fffffff, 0x00020000);
#pragma unroll
            for (int ai = 0; ai < 2; ++ai)
#pragma unroll
                for (int m = 0; m < 4; ++m) { const unsigned boff = (unsigned)(((size_t)(row0 + ai * HALF + m * 16) * ld + col0) * 2);
#pragma unroll
                    for (int bj = 0; bj < 2; ++bj) { const f32x4 v0 = acc[ai][bj][m][0] * rsc[ai][m], v1 = acc[ai][bj][m][1] * rsc[ai][m];
                        u32x4 w; w.x = pk_f16(v0[0], v0[1]); w.y = pk_f16(v0[2], v0[3]); w.z = pk_f16(v1[0], v1[1]); w.w = pk_f16(v1[2], v1[3]);
                        __builtin_amdgcn_raw_buffer_store_b128(w, rsrc, boff + bj * HALF * 2, 0, 16); } }
            asm volatile("s_waitcnt vmcnt(0)" ::: "memory");
            if (fr == 0 && fq == 0) __hip_atomic_fetch_add(pcnt + 64 * u.pm, 1u, __ATOMIC_RELAXED, __HIP_MEMORY_SCOPE_AGENT);
        }
    }
};

struct EpiRow {
    static constexpr bool PERM = true, AFTER_DRAIN = true;
    typedef NoPre Pre; __device__ __forceinline__ void prefetch(Pre&, const Unit&, int) const {}
    const f16* xin; f16* xout; float* out32;
    const float* gate_l; const float* gpost;
    const float* gpre; const float* ss_l;
    f16* H; f16* HHALO;
    float* xb1; float* xb2; unsigned* c1; unsigned* c2;
    template <class F> __device__ __forceinline__ void exchange(float (&q)[2][4], float* xb, unsigned* cnt, const Unit& u, int wr, int wc, int fr, int fq, PG8_LAS unsigned char* lds, int wid, int lane, F&& after_publish) const {
        PG8_LAS float* P = (PG8_LAS float*)lds;
        PG8_LAS float* S = (PG8_LAS float*)(lds + 8192);
#pragma unroll
        for (int ai = 0; ai < 2; ++ai)
#pragma unroll
            for (int m = 0; m < 4; ++m) { float v = xsum32(xsum16(q[ai][m]));
                if (fq == 0) P[(ai * HALF + wr * 64 + m * 16 + fr) * 4 + wc] = v; }
        asm volatile("s_waitcnt lgkmcnt(0)" ::: "memory"); __builtin_amdgcn_s_barrier(); asm volatile("" ::: "memory");
        const int row = wid * 32 + (lane & 31);
        if (lane < 32) { const f32x4 p = *(const PG8_LAS f32x4*)(P + row * 4);
            __hip_atomic_store((unsigned*)(xb + ((size_t)(u.pm * BM + row)) * 4 + u.pn), __builtin_bit_cast(unsigned, (p[0] + p[1]) + (p[2] + p[3])), __ATOMIC_RELAXED, __HIP_MEMORY_SCOPE_AGENT); }
        asm volatile("s_waitcnt vmcnt(0)" ::: "memory");
        if (lane == 0) __hip_atomic_fetch_add(cnt + 64 * u.pm, 1u, __ATOMIC_RELAXED, __HIP_MEMORY_SCOPE_AGENT);
        after_publish();
        if (wid == 0) { unsigned spins = 0;
            while ((unsigned)__builtin_amdgcn_readfirstlane(__hip_atomic_load(cnt + 64 * u.pm, __ATOMIC_RELAXED, __HIP_MEMORY_SCOPE_AGENT)) < 32u) { __builtin_amdgcn_s_sleep(1); if (++spins > (1u << 16)) break; }
            __builtin_amdgcn_fence(__ATOMIC_ACQUIRE, "agent"); }
        asm volatile("s_waitcnt vmcnt(0) lgkmcnt(0)" ::: "memory"); __builtin_amdgcn_s_barrier(); asm volatile("" ::: "memory");
        if (lane < 32) { const unsigned* sl = (const unsigned*)(xb + ((size_t)(u.pm * BM + row)) * 4); float t = 0.f;
#pragma unroll
            for (int k = 0; k < 4; ++k) t += __builtin_bit_cast(float, __hip_atomic_load(sl + k, __ATOMIC_RELAXED, __HIP_MEMORY_SCOPE_AGENT));
            S[row] = t; }
        asm volatile("s_waitcnt lgkmcnt(0)" ::: "memory"); __builtin_amdgcn_s_barrier(); asm volatile("" ::: "memory");
#pragma unroll
        for (int ai = 0; ai < 2; ++ai)
#pragma unroll
            for (int m = 0; m < 4; ++m) q[ai][m] = S[ai * HALF + wr * 64 + m * 16 + fr];
        asm volatile("s_waitcnt lgkmcnt(0)" ::: "memory"); __builtin_amdgcn_s_barrier(); asm volatile("" ::: "memory");
    }
    __device__ __forceinline__ void fused(f32x4 (&acc)[2][2][4][2], const Unit& u, int wr, int wc, int fr, int fq, PG8_LAS unsigned char* lds, int wid, int lane) const {
        const int b = (u.pm * BM) / SEQ;
        const int row0 = u.pm * BM + wr * 64 + fr, col0 = u.pn * BM + wc * 32 + 8 * fq;
        float q[2][4];
#pragma unroll
        for (int ai = 0; ai < 2; ++ai)
#pragma unroll
            for (int m = 0; m < 4; ++m) { float v = 0.f;
#pragma unroll
                for (int bj = 0; bj < 2; ++bj)
#pragma unroll
                    for (int n = 0; n < 2; ++n) { const f32x4 x = acc[ai][bj][m][n]; v += (x[0] * x[0] + x[1] * x[1]) + (x[2] * x[2] + x[3] * x[3]); }
                q[ai][m] = v; }
        const int xl = (wid < 7) ? 9216 + wid * 16384 : 132096;
        f32x4 tap[2][2];
        exchange(q, xb1, c1, u, wr, wc, fr, fq, lds, wid, lane, [&]() {
#pragma unroll
            for (int bj = 0; bj < 2; ++bj) { const int col = col0 + bj * HALF;
                tap[bj][0] = *(const f32x4*)(gate_l + (size_t)b * 6144 + col) * *(const f32x4*)(gpost + col); tap[bj][1] = *(const f32x4*)(gate_l + (size_t)b * 6144 + col + 4) * *(const f32x4*)(gpost + col + 4); }
#pragma unroll
            for (int bj = 0; bj < 2; ++bj)
#pragma unroll
                for (int ai = 0; ai < 2; ++ai)
#pragma unroll
                    for (int m = 0; m < 4; ++m)
                        __builtin_amdgcn_global_load_lds((const unsigned*)(xin + (size_t)(row0 + ai * HALF + m * 16) * 1024 + col0 + bj * HALF), (PG8_LAS unsigned*)(lds + xl + ((bj * 2 + ai) * 4 + m) * 1024), 16, 0, 0); });
#pragma unroll
        for (int ai = 0; ai < 2; ++ai)
#pragma unroll
            for (int m = 0; m < 4; ++m) q[ai][m] = __builtin_amdgcn_rsqf(q[ai][m] * (1.0f / 1024.0f) + NORM_EPS);
#pragma unroll
        for (int bj = 0; bj < 2; ++bj) {
            const int col = col0 + bj * HALF;
            const f32x4 ta0 = tap[bj][0], ta1 = tap[bj][1];
#pragma unroll
            for (int ai = 0; ai < 2; ++ai)
#pragma unroll
                for (int m = 0; m < 4; ++m) { const size_t off = (size_t)(row0 + ai * HALF + m * 16) * 1024 + col;
                    const f16x8 xh = *(const PG8_LAS f16x8*)(lds + xl + ((bj * 2 + ai) * 4 + m) * 1024 + lane * 16);
                    f32x4 x0 = {(float)xh[0], (float)xh[1], (float)xh[2], (float)xh[3]}, x1 = {(float)xh[4], (float)xh[5], (float)xh[6], (float)xh[7]};
                    x0 = x0 + ta0 * (acc[ai][bj][m][0] * q[ai][m]); x1 = x1 + ta1 * (acc[ai][bj][m][1] * q[ai][m]);
                    if (out32 != nullptr) { *(f32x4*)(out32 + off) = x0; *(f32x4*)(out32 + off + 4) = x1; }
                    else { u32x4 w; w.x = pk_f16(x0[0], x0[1]); w.y = pk_f16(x0[2], x0[3]); w.z = pk_f16(x1[0], x1[1]); w.w = pk_f16(x1[2], x1[3]);
                        *(u32x4*)(xout + off) = w;
                        const f16x8 r = __builtin_bit_cast(f16x8, w);
                        x0 = (f32x4){(float)r[0], (float)r[1], (float)r[2], (float)r[3]}; x1 = (f32x4){(float)r[4], (float)r[5], (float)r[6], (float)r[7]}; }
                    acc[ai][bj][m][0] = x0; acc[ai][bj][m][1] = x1; }
            asm volatile("" ::: "memory");
        }
        if (out32 != nullptr) return;
#pragma unroll
        for (int ai = 0; ai < 2; ++ai)
#pragma unroll
            for (int m = 0; m < 4; ++m) { float v = 0.f;
#pragma unroll
                for (int bj = 0; bj < 2; ++bj)
#pragma unroll
                    for (int n = 0; n < 2; ++n) { const f32x4 x = acc[ai][bj][m][n]; v += (x[0] * x[0] + x[1] * x[1]) + (x[2] * x[2] + x[3] * x[3]); }
                q[ai][m] = v; }
        f32x4 tbp[2][2], tcp[2][2];
        exchange(q, xb2, c2, u, wr, wc, fr, fq, lds, wid, lane, [&]() {
#pragma unroll
            for (int bj = 0; bj < 2; ++bj) { const int col = col0 + bj * HALF; const float* sp = ss_l + (size_t)b * 6144 + col;
                tbp[bj][0] = *(const f32x4*)(gpre + col) * (*(const f32x4*)(sp + 1024) + 1.0f); tbp[bj][1] = *(const f32x4*)(gpre + col + 4) * (*(const f32x4*)(sp + 1024 + 4) + 1.0f);
                tcp[bj][0] = *(const f32x4*)sp; tcp[bj][1] = *(const f32x4*)(sp + 4); } });
#pragma unroll
        for (int ai = 0; ai < 2; ++ai)
#pragma unroll
            for (int m = 0; m < 4; ++m) q[ai][m] = __builtin_amdgcn_rsqf(q[ai][m] * (1.0f / 1024.0f) + NORM_EPS);
#pragma unroll
        for (int bj = 0; bj < 2; ++bj) {
            const int col = col0 + bj * HALF;
            const f32x4 tb0 = tbp[bj][0], tb1 = tbp[bj][1], tc0 = tcp[bj][0], tc1 = tcp[bj][1];
#pragma unroll
            for (int ai = 0; ai < 2; ++ai)
#pragma unroll
                for (int m = 0; m < 4; ++m) { const int row = row0 + ai * HALF + m * 16;
                    const f32x4 h0 = (acc[ai][bj][m][0] * q[ai][m]) * tb0 + tc0, h1 = (acc[ai][bj][m][1] * q[ai][m]) * tb1 + tc1;
                    u32x4 w; w.x = pk_f16(h0[0], h0[1]); w.y = pk_f16(h0[2], h0[3]); w.z = pk_f16(h1[0], h1[1]); w.w = pk_f16(h1[2], h1[3]);
                    *(u32x4*)(H + (size_t)row * 1024 + col) = w;
                    if (HHALO != nullptr && (row & 255) >= 254 && (((row >> 8) + 1) & 15) != 0) *(u32x4*)(HHALO + (size_t)(2 * ((row >> 8) + 1) + ((row & 255) - 254)) * 1024 + col) = w; }
            asm volatile("" ::: "memory");
        }
    }
};

__device__ __forceinline__ float gelu_tanh_f(float g) { const float u = 0.7978845608028654f * (g + 0.044715f * g * g * g); const float e = __builtin_amdgcn_exp2f(u * 2.885390081777927f); return g * (1.0f - __builtin_amdgcn_rcpf(e + 1.0f)); }
__device__ __forceinline__ f32x2 gelu_mul_pk(f32x2 g, f32x2 v) {
    const f32x2 g2 = g * g, t = g2 * (0.044715f * 2.302208198f) + 2.302208198f, u2 = t * g;
    f32x2 e; e.x = __builtin_amdgcn_exp2f(u2.x); e.y = __builtin_amdgcn_exp2f(u2.y);
    const f32x2 d = e + 1.0f; f32x2 r; r.x = __builtin_amdgcn_rcpf(d.x); r.y = __builtin_amdgcn_rcpf(d.y);
    const f32x2 gv = g * v; return gv - gv * r;
}
template <int N> __device__ __forceinline__ float ror16(float v) { return __builtin_bit_cast(float, __builtin_amdgcn_update_dpp(0, __builtin_bit_cast(int, v), 0x120 + N, 0xf, 0xf, true)); }
__device__ __forceinline__ f32x4 ld_agent_f32x4(const float* p) { typedef unsigned long long u64; const u64 a = __hip_atomic_load((u64*)p, __ATOMIC_RELAXED, __HIP_MEMORY_SCOPE_AGENT), b = __hip_atomic_load((u64*)p + 1, __ATOMIC_RELAXED, __HIP_MEMORY_SCOPE_AGENT);
    return (f32x4){__builtin_bit_cast(float, (unsigned)a), __builtin_bit_cast(float, (unsigned)(a >> 32)), __builtin_bit_cast(float, (unsigned)b), __builtin_bit_cast(float, (unsigned)(b >> 32))}; }
struct EpiConv {
    static constexpr bool PERM = true, AFTER_DRAIN = false;
    f16* ACT; float* UHALO; const float* cw; const float* cb; PG8_LAS float* X;
    PG8_LAS float* WL;
    unsigned* hcnt; int halo_pm;
    struct Pre { float w[2]; unsigned hc; __device__ __forceinline__ void pin() { asm volatile("" : "+v"(w[0]), "+v"(w[1]), "+v"(hc)); } };
    __device__ __forceinline__ void prefetch(Pre& p, const Unit& u, int tid) const {
        if (u.pm == halo_pm) return;
        p.hc = ((u.pm & 15) != 0) ? __hip_atomic_load(hcnt + 64 * u.pn, __ATOMIC_RELAXED, __HIP_MEMORY_SCOPE_AGENT) : 8u;
        asm volatile("" : "+v"(tid));
#pragma unroll
        for (int k = 0; k < 2; ++k) { const int idx = tid + 512 * k, q = idx >> 8, bjw = (idx >> 7) & 1, col = idx & 127; const int oc = bjw * 2816 + u.pn * 128 + col;
            p.w[k] = (q < 3) ? cw[q * 5632 + oc] : cb[oc]; }
    }
    __device__ __forceinline__ void operator()(f32x4 (&acc)[2][2][4][2], const Unit& u, int wr, int wc, int fr_in, int fq_in, const Pre& pre) const {
        int fr = fr_in, fq = fq_in; asm volatile("" : "+v"(fr), "+v"(fq));
        const int lane = fr + 16 * fq;
        const int lc = wc * 32 + 8 * fq;
        if (u.pm == halo_pm) {
#pragma unroll
            for (int m = 0; m < 4; ++m)
#pragma unroll
                for (int bj = 0; bj < 2; ++bj)
#pragma unroll
                    for (int n = 0; n < 2; ++n) *(f32x4*)(UHALO + (size_t)(wr * 64 + m * 16 + fr) * 5632 + u.pn * 256 + bj * 128 + lc + 4 * n) = acc[0][bj][m][n];
            __builtin_amdgcn_fence(__ATOMIC_RELEASE, "agent");
            asm volatile("s_waitcnt vmcnt(0)" ::: "memory");
            if (lane == 0) __hip_atomic_fetch_add(hcnt + 64 * u.pn, 1u, __ATOMIC_RELAXED, __HIP_MEMORY_SCOPE_AGENT);
            return;
        }
        if (wr == 0 && (u.pm & 15) != 0) {
            unsigned c = pre.hc, spins = 0;
            while ((unsigned)__builtin_amdgcn_readfirstlane(c) < 8u) { __builtin_amdgcn_s_sleep(2); c = __hip_atomic_load(hcnt + 64 * u.pn, __ATOMIC_RELAXED, __HIP_MEMORY_SCOPE_AGENT); if (++spins > (1u << 14)) break; }
        }
        {
            const int t512 = (wr * 4 + wc) * 64 + lane;
            WL[t512] = pre.w[0]; WL[t512 + 512] = pre.w[1];
        }
        if (fr >= 14) {
#pragma unroll
            for (int ai = 0; ai < 2; ++ai)
#pragma unroll
                for (int bj = 0; bj < 2; ++bj)
#pragma unroll
                    for (int n = 0; n < 2; ++n) *(PG8_LAS f32x4*)(X + (((2 * ai + wr) * 2 + (fr - 14)) * 2 + bj) * 128 + lc + 4 * n) = acc[ai][bj][3][n];
        }
        asm volatile("s_waitcnt lgkmcnt(0)" ::: "memory"); __builtin_amdgcn_s_barrier(); asm volatile("" ::: "memory");
        const bool batch_start = (u.pm & 15) == 0;
#pragma unroll
        for (int bj = 0; bj < 2; ++bj)
#pragma unroll
            for (int n = 0; n < 2; ++n) {
                asm volatile("" ::: "memory");
                const int cl = bj * 128 + lc + 4 * n;
                const f32x4 w0v = *(const PG8_LAS f32x4*)(WL + 0 * 256 + cl), w1v = *(const PG8_LAS f32x4*)(WL + 1 * 256 + cl), w2v = *(const PG8_LAS f32x4*)(WL + 2 * 256 + cl), bbv = *(const PG8_LAS f32x4*)(WL + 3 * 256 + cl);
                f32x4 hq0[2], hq1[2];
#pragma unroll
                for (int ai = 0; ai < 2; ++ai) { const int g = 2 * ai + wr;
                    if (g > 0) { hq0[ai] = *(const PG8_LAS f32x4*)(X + (((g - 1) * 2 + 0) * 2 + bj) * 128 + lc + 4 * n); hq1[ai] = *(const PG8_LAS f32x4*)(X + (((g - 1) * 2 + 1) * 2 + bj) * 128 + lc + 4 * n); }
                    else if (!batch_start) { const float* hp = UHALO + (size_t)(2 * u.pm) * 5632 + u.pn * 256 + bj * 128 + lc + 4 * n; hq0[ai] = ld_agent_f32x4(hp); hq1[ai] = ld_agent_f32x4(hp + 5632); }
                    else { hq0[ai] = (f32x4){0.f, 0.f, 0.f, 0.f}; hq1[ai] = hq0[ai]; } }
#pragma unroll
                for (int ai = 1; ai >= 0; --ai) {
                    const f32x4 h0v = hq0[ai], h1v = hq1[ai];
#pragma unroll
                    for (int e = 0; e < 4; e += 2) {
                        const f32x2 w0 = {w0v[e], w0v[e + 1]}, w1 = {w1v[e], w1v[e + 1]}, w2 = {w2v[e], w2v[e + 1]}, bb = {bbv[e], bbv[e + 1]}, h0 = {h0v[e], h0v[e + 1]}, h1 = {h1v[e], h1v[e + 1]};
                        f32x2 c1 = {ror16<1>(acc[ai][bj][3][n][e]), ror16<1>(acc[ai][bj][3][n][e + 1])}, c2 = {ror16<2>(acc[ai][bj][3][n][e]), ror16<2>(acc[ai][bj][3][n][e + 1])};
#pragma unroll
                        for (int m = 3; m >= 0; --m) {
                            f32x2 p1, p2;
                            if (m > 0) { p1 = (f32x2){ror16<1>(acc[ai][bj][m - 1][n][e]), ror16<1>(acc[ai][bj][m - 1][n][e + 1])}; p2 = (f32x2){ror16<2>(acc[ai][bj][m - 1][n][e]), ror16<2>(acc[ai][bj][m - 1][n][e + 1])}; }
                            else { p1 = h1; p2 = (fr == 0) ? h0 : h1; }
                            const f32x2 r1 = (fr >= 1) ? c1 : p1, r2 = (fr >= 2) ? c2 : p2;
                            const f32x2 cur = {acc[ai][bj][m][n][e], acc[ai][bj][m][n][e + 1]};
                            const f32x2 o = w0 * r2 + (w1 * r1 + (w2 * cur + bb));
                            acc[ai][bj][m][n][e] = o[0]; acc[ai][bj][m][n][e + 1] = o[1];
                            asm volatile("" : "+v"(acc[ai][bj][m][n]));
                            c1 = p1; c2 = p2;
                        }
                    }
                }
            }
        asm volatile("" ::: "memory");
        const int row0 = u.pm * BM + wr * 64 + fr;
#pragma unroll
        for (int ai = 0; ai < 2; ++ai)
#pragma unroll
            for (int m = 0; m < 4; ++m) {
                const f32x4 g0 = acc[ai][0][m][0], g1 = acc[ai][0][m][1], v0 = acc[ai][1][m][0], v1 = acc[ai][1][m][1];
                const f32x2 a0 = gelu_mul_pk((f32x2){g0[0], g0[1]}, (f32x2){v0[0], v0[1]}), a1 = gelu_mul_pk((f32x2){g0[2], g0[3]}, (f32x2){v0[2], v0[3]});
                const f32x2 a2 = gelu_mul_pk((f32x2){g1[0], g1[1]}, (f32x2){v1[0], v1[1]}), a3 = gelu_mul_pk((f32x2){g1[2], g1[3]}, (f32x2){v1[2], v1[3]});
                u32x4 w; w.x = pk_f16(a0.x, a0.y); w.y = pk_f16(a1.x, a1.y); w.z = pk_f16(a2.x, a2.y); w.w = pk_f16(a3.x, a3.y);
                *(u32x4*)(ACT + (size_t)(row0 + ai * HALF + m * 16) * 2816 + u.pn * 128 + lc) = w;
                asm volatile("" ::: "memory");
            }
    }
};

template <class Epi, class Sched, bool ALIGN_EPI = false, bool SP2 = false>
__device__ __forceinline__ void gemm_phase(PG8_LAS unsigned char* lds, const Gemm g, const Sched& S, const Epi& E, int tid_in) {
    const int wid = __builtin_amdgcn_readfirstlane(tid_in >> 6), wr = wid >> 2, wc = wid & 3;
    const int K = g.K, nt = K / BK;
    unsigned voffA[2], voffB[2]; int aoff, boff;
    auto lane_consts = [&]() {
        const int lane = lane_hw(), tid = wid * 64 + lane, fr = lane & 15, fq = lane >> 4;
#pragma unroll
        for (int i = 0; i < 2; ++i) { int R, C; stage_rc(tid * 16 + i * 8192, R, C); const int Rb = Epi::PERM ? ((R & ~31) + perm32(R & 31)) : R;
            voffA[i] = (unsigned)(R * g.lda + C) * 2u; voffB[i] = (unsigned)(Rb * K + C) * 2u; }
        aoff = lds_byte(wr * 64 + fr, fq * 8); boff = lds_byte(wc * 32 + fr, fq * 8);
    };
    lane_consts();
    const size_t kstep = (size_t)(BK * 2);
    const size_t hstep = (size_t)HALF * K * 2;
    const size_t tstep = 2 * hstep;
    const size_t hstepA = (size_t)HALF * g.lda * 2, tstepA = 2 * hstepA;
    const unsigned ldsw = (unsigned)wid * 1024u;
#define PG8_SA(b, h) (((b) * 2 + (h)) * HTB)
#define PG8_SB(b, h) ((4 + (b) * 2 + (h)) * HTB)
#define PG8_STAGE(bufoff, gbase, voff) do { _Pragma("unroll") for (int _i = 0; _i < 2; ++_i) \
        __builtin_amdgcn_global_load_lds((const unsigned*)((const char*)(gbase) + (voff)[_i]), (PG8_LAS unsigned*)(lds + (bufoff) + ldsw + _i * 8192), 16, 0, 0); } while (0)
#define PG8_LDA(dst, b, h) do { _Pragma("unroll") for (int m = 0; m < 4; ++m) _Pragma("unroll") for (int k = 0; k < 2; ++k) dst[m][k] = *(const PG8_LAS f16x8*)(lds + PG8_SA(b, h) + aoff + m * 2048 + k * 1024); } while (0)
#define PG8_LDB(dst, b, h) do { _Pragma("unroll") for (int n = 0; n < 2; ++n) _Pragma("unroll") for (int k = 0; k < 2; ++k) dst[n][k] = *(const PG8_LAS f16x8*)(lds + PG8_SB(b, h) + boff + n * 2048 + k * 1024); } while (0)
#define PG8_MMA(ai, bj, At, Bt) do { __builtin_amdgcn_s_setprio(1); _Pragma("unroll") for (int m = 0; m < 4; ++m) _Pragma("unroll") for (int n = 0; n < 2; ++n) _Pragma("unroll") for (int k = 0; k < 2; ++k) \
        acc[ai][bj][m][n] = __builtin_amdgcn_mfma_f32_16x16x32_f16(Bt[n][k], At[m][k], acc[ai][bj][m][n], 0, 0, 0); __builtin_amdgcn_s_setprio(0); } while (0)
#define PG8_WAIT_V(n) asm volatile("s_waitcnt vmcnt(" #n ")" ::: "memory")
#define PG8_WAIT_L(n) asm volatile("s_waitcnt lgkmcnt(" #n ")" ::: "memory")
#define PG8_BAR __builtin_amdgcn_s_barrier()
#define PG8_SCHED __builtin_amdgcn_sched_barrier(0)
    Unit cur, nxt; int ui = 0;
    if (!S.next(0, cur)) return;
    typename Epi::Pre pre; E.prefetch(pre, cur, wid * 64 + lane_hw());
    f32x4 acc[2][2][4][2];
#pragma unroll
    for (int a = 0; a < 2; ++a)
#pragma unroll
        for (int b = 0; b < 2; ++b)
#pragma unroll
            for (int m = 0; m < 4; ++m)
#pragma unroll
                for (int n = 0; n < 2; ++n) acc[a][b][m][n] = (f32x4){0.f, 0.f, 0.f, 0.f};
    f16x8 At[4][2], B0[2][2], B1[2][2];
    const char* cA = (const char*)g.A + (size_t)cur.pm * tstepA + S.a_off(cur); const char* cB = (const char*)g.Bt + (size_t)cur.pn * tstep;
    S.a_ready(cur);
    if constexpr (SP2) {
        PG8_STAGE(PG8_SB(0, 0), cB, voffB); PG8_STAGE(PG8_SB(0, 1), cB + hstep, voffB); PG8_STAGE(PG8_SA(0, 0), cA, voffA); PG8_STAGE(PG8_SA(0, 1), cA + hstepA, voffA);
        if (wr == 1) PG8_BAR;
        PG8_WAIT_V(2); PG8_BAR;
        PG8_STAGE(PG8_SB(1, 0), cB + kstep, voffB); PG8_STAGE(PG8_SA(1, 0), cA + kstep, voffA); PG8_STAGE(PG8_SB(1, 1), cB + hstep + kstep, voffB);
        PG8_WAIT_V(6); PG8_BAR;
    } else {
        PG8_STAGE(PG8_SB(0, 0), cB, voffB); PG8_STAGE(PG8_SA(0, 0), cA, voffA); PG8_STAGE(PG8_SB(0, 1), cB + hstep, voffB); PG8_STAGE(PG8_SA(0, 1), cA + hstepA, voffA);
        if (wr == 1) PG8_BAR;
        PG8_WAIT_V(4); PG8_BAR;
        PG8_STAGE(PG8_SB(1, 0), cB + kstep, voffB); PG8_STAGE(PG8_SA(1, 0), cA + kstep, voffA); PG8_STAGE(PG8_SB(1, 1), cB + hstep + kstep, voffB);
        PG8_WAIT_V(6); PG8_BAR;
    }
    for (;;) {
        const bool has_next = S.next(ui + 1, nxt);
        const char* nA = has_next ? (const char*)g.A + (size_t)nxt.pm * tstepA + S.a_off(nxt) : cA; const char* nB = has_next ? (const char*)g.Bt + (size_t)nxt.pn * tstep : cB;
#pragma unroll 1
        for (int t = 0; t < nt; t += 2) {
            const bool last = (t == nt - 2);
            const char* a1 = cA + (size_t)(t + 1) * kstep;
            const char* a2 = last ? nA : cA + (size_t)(t + 2) * kstep; const char* b2 = last ? nB : cB + (size_t)(t + 2) * kstep;
            const char* a3 = a2 + kstep; const char* b3 = b2 + kstep;
            if (last && has_next) S.a_ready(nxt);
            if constexpr (SP2) {
            PG8_LDB(B0, 0, 0); PG8_LDB(B1, 0, 1); PG8_SCHED; PG8_LDA(At, 0, 0); PG8_STAGE(PG8_SA(1, 1), a1 + hstepA, voffA);
            PG8_WAIT_V(8); PG8_WAIT_L(0); PG8_BAR; PG8_MMA(0, 0, At, B0); PG8_MMA(0, 1, At, B1); PG8_BAR; PG8_SCHED;
            PG8_LDA(At, 0, 1); PG8_STAGE(PG8_SB(0, 0), b2, voffB); PG8_STAGE(PG8_SB(0, 1), b2 + hstep, voffB); PG8_STAGE(PG8_SA(0, 0), a2, voffA);
            PG8_WAIT_V(8); PG8_WAIT_L(0); PG8_BAR; PG8_MMA(1, 0, At, B0); PG8_MMA(1, 1, At, B1); PG8_BAR; PG8_SCHED;
            PG8_LDB(B0, 1, 0); PG8_LDB(B1, 1, 1); PG8_SCHED; PG8_LDA(At, 1, 0); PG8_STAGE(PG8_SA(0, 1), a2 + hstepA, voffA);
            PG8_WAIT_V(8); PG8_WAIT_L(0); PG8_BAR; PG8_MMA(0, 0, At, B0); PG8_MMA(0, 1, At, B1); PG8_BAR; PG8_SCHED;
            PG8_LDA(At, 1, 1); PG8_STAGE(PG8_SB(1, 0), b3, voffB); PG8_STAGE(PG8_SB(1, 1), b3 + hstep, voffB); PG8_STAGE(PG8_SA(1, 0), a3, voffA);
            PG8_WAIT_V(8); PG8_WAIT_L(0); PG8_BAR; PG8_MMA(1, 0, At, B0); PG8_MMA(1, 1, At, B1); PG8_BAR; PG8_SCHED;
            } else {
            PG8_LDB(B0, 0, 0); PG8_SCHED; PG8_LDA(At, 0, 0); PG8_STAGE(PG8_SA(1, 1), a1 + hstepA, voffA);
            PG8_WAIT_L(8); PG8_BAR; PG8_WAIT_L(0); PG8_MMA(0, 0, At, B0); PG8_BAR; PG8_SCHED;
            PG8_LDB(B1, 0, 1); PG8_STAGE(PG8_SB(0, 0), b2, voffB);
            PG8_BAR; PG8_WAIT_L(0); PG8_MMA(0, 1, At, B1); PG8_BAR;
            PG8_LDA(At, 0, 1); PG8_STAGE(PG8_SA(0, 0), a2, voffA);
            PG8_BAR; PG8_WAIT_L(0); PG8_MMA(1, 0, At, B0); PG8_BAR; PG8_SCHED;
            PG8_STAGE(PG8_SB(0, 1), b2 + hstep, voffB);
            PG8_WAIT_V(6); PG8_BAR; PG8_MMA(1, 1, At, B1); PG8_BAR;
            PG8_LDB(B0, 1, 0); PG8_SCHED; PG8_LDA(At, 1, 0); PG8_STAGE(PG8_SA(0, 1), a2 + hstepA, voffA);
            PG8_WAIT_L(8); PG8_BAR; PG8_WAIT_L(0); PG8_MMA(0, 0, At, B0); PG8_BAR; PG8_SCHED;
            PG8_LDB(B1, 1, 1); PG8_STAGE(PG8_SB(1, 0), b3, voffB);
            PG8_BAR; PG8_WAIT_L(0); PG8_MMA(0, 1, At, B1); PG8_BAR;
            PG8_LDA(At, 1, 1); PG8_STAGE(PG8_SA(1, 0), a3, voffA);
            PG8_BAR; PG8_WAIT_L(0); PG8_MMA(1, 0, At, B0); PG8_BAR; PG8_SCHED;
            PG8_STAGE(PG8_SB(1, 1), b3 + hstep, voffB);
            PG8_WAIT_V(6); PG8_BAR; PG8_MMA(1, 1, At, B1); PG8_BAR;
            }
        }
        if constexpr (ALIGN_EPI) { if (wr == 0) PG8_BAR; }
        pre.pin();
        if constexpr (!Epi::AFTER_DRAIN) { const int le = lane_hw(); E(acc, cur, wr, wc, le & 15, le >> 4, pre); S.done(cur); }
        if (!has_next) break;
#pragma unroll
        for (int a = 0; a < 2; ++a)
#pragma unroll
            for (int b = 0; b < 2; ++b)
#pragma unroll
                for (int m = 0; m < 4; ++m)
#pragma unroll
                    for (int n = 0; n < 2; ++n) acc[a][b][m][n] = (f32x4){0.f, 0.f, 0.f, 0.f};
        cur = nxt; cA = nA; cB = nB; ++ui; E.prefetch(pre, cur, wid * 64 + lane_hw()); lane_consts();
        if constexpr (ALIGN_EPI) { if (wr == 1) PG8_BAR; }
    }
    PG8_WAIT_V(0);
    if constexpr (!ALIGN_EPI) { if (wr == 0) PG8_BAR; }
    PG8_BAR;
    if constexpr (Epi::AFTER_DRAIN) { const int le = lane_hw(); E.fused(acc, cur, wr, wc, le & 15, le >> 4, lds, wid, le); S.done(cur); }
#undef PG8_SA
#undef PG8_SB
#undef PG8_STAGE
#undef PG8_LDA
#undef PG8_LDB
#undef PG8_MMA
#undef PG8_WAIT_V
#undef PG8_WAIT_L
#undef PG8_BAR
#undef PG8_SCHED
}
}
#define GAS __attribute__((address_space(1)))
#define LAS __attribute__((address_space(3)))
typedef GAS unsigned gu32;
typedef GAS unsigned long long gu64;
#define RLX_AGENT __ATOMIC_RELAXED, __HIP_MEMORY_SCOPE_AGENT
#define LDS_WAIT() asm volatile("s_waitcnt lgkmcnt(0)" ::: "memory")
#define VM_WAIT() asm volatile("s_waitcnt vmcnt(0)" ::: "memory")
__device__ __forceinline__ unsigned long long rt() { return __builtin_amdgcn_s_memrealtime(); }
#define XB_TMO      128
#define XB_XCNT(j)  (256  + 64 * (j))
#define XB_XSUB(j)  (1280 + 64 * (j))
#define XB_XGEN(j)  (2304 + 64 * (j))
#define XB_TOP      3328
#define XB_TOPGEN   3392
#define XCD_BAR_WORDS 3456
#define XB_SPIN_CAP (1u << 18)

__device__ __forceinline__ unsigned xb_ld(unsigned* p)              { return __hip_atomic_load(p, __ATOMIC_RELAXED, __HIP_MEMORY_SCOPE_AGENT); }
__device__ __forceinline__ unsigned xb_add(unsigned* p, unsigned v) { return __hip_atomic_fetch_add(p, v, __ATOMIC_RELAXED, __HIP_MEMORY_SCOPE_AGENT); }
__device__ __forceinline__ unsigned xb_xcc_id() { return (unsigned)__builtin_amdgcn_s_getreg((3 << 11) | 20) & 0xFu; }
#define XB_SPIN(cond, bar) do { unsigned _sp = 0; while (cond) { __builtin_amdgcn_s_sleep(1); \
    if ((++_sp & 255u) == 0u) { if (xb_ld(&(bar)[XB_TMO])) break; if (_sp > XB_SPIN_CAP) { atomicAdd(&(bar)[XB_TMO], 1u); break; } } } } while (0)

struct XcdBarrier {
    unsigned* bar; unsigned x;
    volatile LAS unsigned* st;
};

__device__ __forceinline__ XcdBarrier xcd_barrier_post(unsigned* bar, volatile LAS unsigned* st, int tid) {
    XcdBarrier b; b.bar = bar; b.x = xb_xcc_id(); b.st = st;
    if (tid == 0) (void)xb_add(&bar[XB_XCNT(b.x)], 1u);
    return b;
}
__device__ __forceinline__ void xcd_barrier_complete(unsigned* bar, unsigned x, unsigned& nloc, unsigned& nx) {
    const unsigned G = gridDim.x * gridDim.y * gridDim.z;
    unsigned sum, cnt, mine, sp = 0u;
    for (;;) {
        sum = 0u; cnt = 0u; mine = 0u;
#pragma unroll
        for (unsigned j = 0; j < 16; ++j) { const unsigned c = xb_ld(&bar[XB_XCNT(j)]); sum += c; cnt += (c > 0u) ? 1u : 0u; mine = (j == x) ? c : mine; }
        if (sum == G) break;
        __builtin_amdgcn_s_sleep(1);
        if ((++sp & 255u) == 0u) { if (xb_ld(&bar[XB_TMO])) break; if (sp > XB_SPIN_CAP) { atomicAdd(&bar[XB_TMO], 1u); break; } }
    }
    nloc = mine > 0u ? mine : 1u; nx = cnt > 0u ? cnt : 1u;
}

__device__ __forceinline__ void xcd_barrier(const XcdBarrier& b, int tid) {
    asm volatile("s_waitcnt vmcnt(0)" ::: "memory");
    __syncthreads();
    if (tid == 0) {
        unsigned* bar = b.bar;
        __builtin_amdgcn_s_waitcnt(0);
        unsigned nloc = b.st[0], nx = b.st[1];
        if (nloc == 0u) { xcd_barrier_complete(bar, b.x, nloc, nx); b.st[0] = nloc; b.st[1] = nx; }
        const unsigned old = xb_add(&bar[XB_XSUB(b.x)], 1u);
        const unsigned gen = old / nloc;
        if (old + 1u == (gen + 1u) * nloc) {
            __builtin_amdgcn_fence(__ATOMIC_RELEASE, "agent");
            asm volatile("s_waitcnt vmcnt(0)" ::: "memory");
            const unsigned og = xb_add(&bar[XB_TOP], 1u);
            const unsigned tg = og / nx;
            if (og + 1u == (tg + 1u) * nx) xb_add(&bar[XB_TOPGEN], 1u);
            else XB_SPIN(xb_ld(&bar[XB_TOPGEN]) == tg, bar);
            __builtin_amdgcn_fence(__ATOMIC_ACQUIRE, "agent");
            xb_add(&bar[XB_XGEN(b.x)], 1u);
            asm volatile("s_waitcnt vmcnt(0)" ::: "memory");
        } else {
            XB_SPIN(xb_ld(&bar[XB_XGEN(b.x)]) == gen, bar);
            __builtin_amdgcn_fence(__ATOMIC_ACQUIRE, "agent");
            asm volatile("s_waitcnt vmcnt(0)" ::: "memory");
        }
    }
    __syncthreads();
}
constexpr int NWAVES = 8, NTHR = NWAVES * 64;
constexpr int RING_BYTES = 131072;
constexpr int LDSCTL_OFF = RING_BYTES, MISC_OFF = LDSCTL_OFF + 320;
constexpr int XCH_OFF = RING_BYTES + 1024;
constexpr int LDS_BYTES = 163840;

struct Args { const float* in[21]; float* out; unsigned char* ws; int ph_lo, ph_hi; };

enum { I_X = 0, I_C, I_RELB, I_ADAW, I_ADAB, I_MIXPRE, I_MIXPOST, I_FFNPRE, I_FFNPOST, I_ABWIN, I_ABWOUT, I_CDWIN, I_QNG, I_KVNG, I_WUQ, I_WUKV, I_CDWOUT, I_WUP, I_CONVW, I_CONVB, I_WDN };

__device__ __forceinline__ float wave_sum(float v) { return wsum64(v); }
__device__ __forceinline__ float quad_sum(float v) { return qsum4(v); }
__device__ __forceinline__ void load16(const f16* p, float (&o)[16]) {
    const f16x8 a = *(const f16x8*)p, b = *(const f16x8*)(p + 8);
#pragma unroll
    for (int i = 0; i < 8; ++i) { o[i] = (float)a[i]; o[8 + i] = (float)b[i]; }
}
__device__ __forceinline__ void load8(const f16* p, float (&o)[8]) {
    const f16x8 a = *(const f16x8*)p;
#pragma unroll
    for (int i = 0; i < 8; ++i) o[i] = (float)a[i];
}
__device__ __forceinline__ int t5_bucket(int d) {
    if (d < 16) return d;
    return 16 + (d >= 22) + (d >= 30) + (d >= 40) + (d >= 54) + (d >= 73) + (d >= 99) + (d >= 134) + (d >= 182) + (d >= 246) + (d >= 332) + (d >= 450) + (d >= 609) + (d >= 825) + (d >= 1117) + (d >= 1513);
}

__device__ __forceinline__ void layer_mod(const Args& a, LAS unsigned char* lds, int tid, int slot, int nslots, int l) {
    LAS float* sc = (LAS float*)lds; LAS float* red = (LAS float*)(lds + 16384);
    const float* c = a.in[I_C];
    for (int i = tid; i < BATCH * DM; i += NTHR) { const float v = c[i]; sc[i] = v / (1.f + expf(-v)); }
    __syncthreads();
    const int wave = tid >> 6, lane = tid & 63;
    float* MOD = (float*)(a.ws + WS_MOD);
    for (int cg = slot; cg < 96; cg += nslots) {
        const int n = cg * 64 + lane;
        const float* W = a.in[I_ADAW] + (size_t)l * DM * 6144 + n;
        float a0 = 0.f, a1 = 0.f, a2 = 0.f, a3 = 0.f;
        const int k0 = wave * 128;
#pragma unroll 1
        for (int kb = k0; kb < k0 + 128; kb += 64) {
            float wv[64];
#pragma unroll
            for (int j = 0; j < 64; ++j) wv[j] = W[(size_t)(kb + j) * 6144];
#pragma unroll
            for (int j = 0; j < 64; ++j) { const int k = kb + j; a0 += sc[k] * wv[j]; a1 += sc[DM + k] * wv[j]; a2 += sc[2 * DM + k] * wv[j]; a3 += sc[3 * DM + k] * wv[j]; }
        }
        red[(wave * 4 + 0) * 64 + lane] = a0; red[(wave * 4 + 1) * 64 + lane] = a1; red[(wave * 4 + 2) * 64 + lane] = a2; red[(wave * 4 + 3) * 64 + lane] = a3;
        __syncthreads();
        if (tid < 256) { const int b = tid >> 6; float s = 0.f;
#pragma unroll
            for (int w = 0; w < 8; ++w) s += red[(w * 4 + b) * 64 + lane];
            MOD[(size_t)(l * BATCH + b) * 6144 + n] = s + a.in[I_ADAB][l * 6144 + n]; }
        __syncthreads();
    }
}
struct TD { const float* W; int N; f16* dst; int pitch, coloff; const float* gk; int mode, nblk; int nlo, nhi; float nsc; };
__device__ __forceinline__ void transpose_item(const TD& d, LAS float* scr, int item, int lane) {
    const int kb = item / d.nblk, nb = item % d.nblk, k0 = 64 * kb, n0 = 32 * nb;
    float wv[32];
#pragma unroll
    for (int i = 0; i < 32; ++i) { const int kk = 2 * i + (lane >> 5); wv[i] = d.W[(size_t)(k0 + kk) * d.N + n0 + (lane & 31)]; }
#pragma unroll
    for (int i = 0; i < 32; ++i) { const int kk = 2 * i + (lane >> 5); scr[kk * 33 + (lane & 31)] = wv[i]; }
    LDS_WAIT(); asm volatile("" ::: "memory");
    const int c = lane & 7;
    float gs[8];
#pragma unroll
    for (int i = 0; i < 8; ++i) gs[i] = d.gk ? d.gk[k0 + 8 * c + i] : 1.f;
#pragma unroll
    for (int j = 0; j < 4; ++j) { const int n = (lane >> 3) + 8 * j; const LAS float* s = scr + (8 * c) * 33 + n;
        u32x4 o; o.x = pk_f16(s[0 * 33] * gs[0], s[1 * 33] * gs[1]); o.y = pk_f16(s[2 * 33] * gs[2], s[3 * 33] * gs[3]); o.z = pk_f16(s[4 * 33] * gs[4], s[5 * 33] * gs[5]); o.w = pk_f16(s[6 * 33] * gs[6], s[7 * 33] * gs[7]);
        const int col = n0 + n; int row = col;
        if (col >= d.nlo && col < d.nhi) { o.x = pk_f16(s[0 * 33] * gs[0] * d.nsc, s[1 * 33] * gs[1] * d.nsc); o.y = pk_f16(s[2 * 33] * gs[2] * d.nsc, s[3 * 33] * gs[3] * d.nsc); o.z = pk_f16(s[4 * 33] * gs[4] * d.nsc, s[5 * 33] * gs[5] * d.nsc); o.w = pk_f16(s[6 * 33] * gs[6] * d.nsc, s[7 * 33] * gs[7] * d.nsc); }
        if (d.mode == 1) { const int half = col / DFF, jj = col % DFF; row = (jj >> 7) * 256 + half * 128 + (jj & 127); }
        *(GAS u32x4*)(d.dst + (size_t)row * d.pitch + d.coloff + k0 + 8 * c) = o; }
    LDS_WAIT(); asm volatile("" ::: "memory");
}
__device__ __forceinline__ void layer_weights(const Args& a, LAS unsigned char* lds, int tid, int slot, int nslots, int l, int part  ) {
    const int wave = tid >> 6, lane = tid & 63;
    LAS float* scr = (LAS float*)(lds + wave * 16384);
    const int gw = slot * NWAVES + wave, NGW = nslots * NWAVES;
    constexpr int C0 = 16 * 96, C1 = 16 * 32, C2 = 16 * 65, C3 = 4 * 24, C4 = 4 * 32, C5 = 16 * 32, C6 = 16 * 176, C7 = 44 * 32;
    const int i = l >> 1; const bool odd = (l & 1) != 0;
    const int nmix = odd ? (C2 + C3 + C4 + C5) : (C0 + C1);
    unsigned char* ws = a.ws;
    int it_lo = (part & 1) ? 0 : nmix, it_hi = (part & 2) ? nmix + C6 + C7 : nmix;
    if (part == 4) { it_lo = 0; it_hi = nmix + 1088; } else if (part == 5) { it_lo = nmix + 1088; it_hi = nmix + C6 + C7; }
    for (int it = it_lo + gw; it < it_hi; it += NGW) {
        int r = it; TD d; d.gk = nullptr; d.mode = 0; d.coloff = 0; d.nlo = 0; d.nhi = 0; d.nsc = 1.f;
        if (r >= nmix) { r -= nmix;
            if (r < C6) { d.W = a.in[I_WUP] + (size_t)l * DM * DFF2; d.N = DFF2; d.dst = (f16*)(ws + WS_W_FUP) + (size_t)l * DFF2 * DM; d.pitch = DM; d.nblk = 176; d.mode = 1; }
            else { r -= C6; d.W = a.in[I_WDN] + (size_t)l * DFF * DM; d.N = DM; d.dst = (f16*)(ws + WS_W_FDN) + (size_t)l * DM * DFF; d.pitch = DFF; d.nblk = 32; } }
        else if (!odd) {
            if (r < C0) { d.W = a.in[I_ABWIN] + (size_t)i * DM * AB_IN; d.N = AB_IN; d.dst = (f16*)(ws + WS_W_INAB) + (size_t)i * AB_IN * DM; d.pitch = DM; d.nblk = 96; }
            else { r -= C0; d.W = a.in[I_ABWOUT] + (size_t)i * DM * DM; d.N = DM; d.dst = (f16*)(ws + WS_W_OUTAB) + (size_t)i * DM * DM; d.pitch = DM; d.nblk = 32; } }
        else {
            if (r < C2) { d.W = a.in[I_CDWIN] + (size_t)i * DM * CD_IN; d.N = CD_IN; d.dst = (f16*)(ws + WS_W_INCD) + (size_t)i * CD_INP * DM; d.pitch = DM; d.nblk = 65;
                d.nlo = 544; d.nhi = 1056; d.nsc = 0.125f * 1.4426950408889634f; }
            else if ((r -= C2) < C3) { d.W = a.in[I_WUQ] + (size_t)i * 256 * QW; d.N = QW; d.dst = (f16*)(ws + WS_W_UP2) + (size_t)i * UP_N * UP_K; d.pitch = UP_K; d.nblk = 24; d.gk = a.in[I_QNG] + i * 256; }
            else if ((r -= C3) < C4) { d.W = a.in[I_WUKV] + (size_t)i * 256 * KVW; d.N = KVW; d.dst = (f16*)(ws + WS_W_UP2) + (size_t)i * UP_N * UP_K + (size_t)QW * UP_K; d.pitch = UP_K; d.nblk = 32; d.gk = a.in[I_KVNG] + i * 256; }
            else { r -= C4; d.W = a.in[I_CDWOUT] + (size_t)i * DM * DM; d.N = DM; d.dst = (f16*)(ws + WS_W_OUTCD) + (size_t)i * DM * DM; d.pitch = DM; d.nblk = 32; } }
        transpose_item(d, scr, r, lane);
    }
}
__device__ __forceinline__ void p0_misc(const Args& a, int tid, int bid, int G) {
    unsigned char* ws = a.ws;
    const int gt = bid * NTHR + tid, NGT = G * NTHR;
    const u32x4 z = {0u, 0u, 0u, 0u};
    for (int i = 0; i < 2; ++i) {
        GAS u32x4* p = (GAS u32x4*)((f16*)(ws + WS_W_INCD) + (size_t)i * CD_INP * DM + (size_t)CD_IN * DM);
        for (int e = gt; e < (CD_INP - CD_IN) * DM / 8; e += NGT) p[e] = z;
    }
    float* rc = (float*)(ws + WS_ROPE); float* rs = rc + SEQ * 16;
    for (int e = gt; e < SEQ * 16; e += NGT) { const int t = e >> 4, i = e & 15; const float inv = (float)(1.0 / pow(10000.0, (double)i / 16.0)); const float ang = (float)t * inv;
        rc[e] = (float)cos((double)ang); rs[e] = (float)sin((double)ang); }
}

__device__ __forceinline__ void thin_row(int row, const float* xin32, const f16* xin16, f16* xout16, float* xout32, const f16* y, const float* gate_l  , const float* gpost,
                                         const float* gpre, const float* ss_l  , f16* Hrow, f16* H2row, bool has_y, int lane) {
    const int b = row / SEQ;
    f32x4 xv[4];
    if (xin32 != nullptr) {
#pragma unroll
        for (int j = 0; j < 4; ++j) xv[j] = *(const f32x4*)(xin32 + (size_t)row * DM + 4 * lane + 256 * j);
    } else {
#pragma unroll
        for (int j = 0; j < 4; ++j) { const f16x4 xh = *(const f16x4*)(xin16 + (size_t)row * DM + 4 * lane + 256 * j); xv[j] = (f32x4){(float)xh[0], (float)xh[1], (float)xh[2], (float)xh[3]}; }
    }
    if (has_y) {
        f32x4 yv[4]; float s = 0.f;
#pragma unroll
        for (int j = 0; j < 4; ++j) { const f16x4 yh = *(const f16x4*)(y + (size_t)row * DM + 4 * lane + 256 * j); yv[j] = (f32x4){(float)yh[0], (float)yh[1], (float)yh[2], (float)yh[3]}; s += (yv[j].x * yv[j].x + yv[j].y * yv[j].y) + (yv[j].z * yv[j].z + yv[j].w * yv[j].w); }
        const float rstd = __builtin_amdgcn_rsqf(wave_sum(s) * (1.f / DM) + NORM_EPS);
#pragma unroll
        for (int j = 0; j < 4; ++j) { const f32x4 g = *(const f32x4*)(gpost + 4 * lane + 256 * j); const f32x4 gt = *(const f32x4*)(gate_l + (size_t)b * 6144 + 4 * lane + 256 * j);
            xv[j] = xv[j] + gt * ((yv[j] * rstd) * g); }
    }
    if (xout16 != nullptr) {
#pragma unroll
        for (int j = 0; j < 4; ++j) { u32x2 w; w.x = pk_f16(xv[j].x, xv[j].y); w.y = pk_f16(xv[j].z, xv[j].w); *(u32x2*)(xout16 + (size_t)row * DM + 4 * lane + 256 * j) = w;
            if (Hrow != nullptr) { const f16x4 r = __builtin_bit_cast(f16x4, w); xv[j] = (f32x4){(float)r[0], (float)r[1], (float)r[2], (float)r[3]}; } }
    }
    if (xout32 != nullptr) {
#pragma unroll
        for (int j = 0; j < 4; ++j) *(f32x4*)(xout32 + (size_t)row * DM + 4 * lane + 256 * j) = xv[j];
    }
    if (Hrow != nullptr) {
        float s = 0.f;
#pragma unroll
        for (int j = 0; j < 4; ++j) s += (xv[j].x * xv[j].x + xv[j].y * xv[j].y) + (xv[j].z * xv[j].z + xv[j].w * xv[j].w);
        const float rstd = __builtin_amdgcn_rsqf(wave_sum(s) * (1.f / DM) + NORM_EPS);
#pragma unroll
        for (int j = 0; j < 4; ++j) { const int col = 4 * lane + 256 * j; const f32x4 g = *(const f32x4*)(gpre + col);
            const f32x4 sh = *(const f32x4*)(ss_l + (size_t)b * 6144 + col), sc = *(const f32x4*)(ss_l + (size_t)b * 6144 + DM + col);
            const f32x4 hv = ((xv[j] * rstd) * g) * (sc + 1.0f) + sh;
            u32x2 w; w.x = pk_f16(hv.x, hv.y); w.y = pk_f16(hv.z, hv.w);
            *(u32x2*)(Hrow + col) = w;
            if (H2row != nullptr) *(u32x2*)(H2row + col) = w; }
    }
}
__device__ __forceinline__ bool is_halo_row(int row) { return (row & 255) >= 254 && (((row >> 8) + 1) & 15) != 0; }
__device__ __forceinline__ int halo_row_of(int hidx) { const int pm = hidx >> 1; return (pm == 0 || (pm & 15) == 0) ? -1 : 256 * pm - 2 + (hidx & 1); }
template <bool X32IN, bool HAS_Y, bool OUT32, bool WH, int NR = 2  >
__device__ __forceinline__ void thin_phase(const float* xin32, const f16* X16in, f16* X16out, float* out32, const f16* y, const float* gate_l, const float* gpost, const float* gpre, const float* ss_l, f16* H, f16* HHALO  ,
                                           LAS unsigned char* lds, int tid, int gw0, int ngw, int row_end = M) {
    const int lane = tid & 63;
    LAS float* TA = (LAS float*)lds; LAS float* TB = TA + BATCH * DM; LAS float* TC = TB + BATCH * DM;
    for (int idx = tid; idx < BATCH * DM; idx += NTHR) { const int b = idx >> 10, col = idx & (DM - 1);
        if constexpr (HAS_Y) TA[idx] = gate_l[(size_t)b * 6144 + col] * gpost[col];
        if constexpr (WH) { TB[idx] = gpre[col] * (1.0f + ss_l[(size_t)b * 6144 + DM + col]); TC[idx] = ss_l[(size_t)b * 6144 + col]; } }
    __syncthreads();
    for (int row0 = gw0; row0 < row_end; row0 += NR * ngw) {
        int row[NR], bq[NR];
#pragma unroll
        for (int q = 0; q < NR; ++q) { row[q] = row0 + q * ngw; if (row[q] >= row_end) row[q] = row0; bq[q] = row[q] / SEQ; }
        float xv[NR][16], yv[NR][16];
#pragma unroll
        for (int q = 0; q < NR; ++q)
#pragma unroll
            for (int j = 0; j < 2; ++j) { const size_t off = (size_t)row[q] * DM + 512 * j + 8 * lane;
                if constexpr (X32IN) { const f32x4 a0 = *(const f32x4*)(xin32 + off), a1 = *(const f32x4*)(xin32 + off + 4);
#pragma unroll
                    for (int e = 0; e < 4; ++e) { xv[q][8 * j + e] = a0[e]; xv[q][8 * j + 4 + e] = a1[e]; } }
                else { const f16x8 xh = *(const f16x8*)(X16in + off);
#pragma unroll
                    for (int e = 0; e < 8; ++e) xv[q][8 * j + e] = (float)xh[e]; }
                if constexpr (HAS_Y) { const f16x8 yh = *(const f16x8*)(y + off);
#pragma unroll
                    for (int e = 0; e < 8; ++e) yv[q][8 * j + e] = (float)yh[e]; }
            }
        if constexpr (HAS_Y) {
            float s[NR];
#pragma unroll
            for (int q = 0; q < NR; ++q) s[q] = 0.f;
#pragma unroll
            for (int q = 0; q < NR; ++q)
#pragma unroll
                for (int e = 0; e < 16; ++e) s[q] += yv[q][e] * yv[q][e];

#pragma unroll
            for (int q = 0; q < NR; ++q) s[q] = wsum64(s[q]);
#pragma unroll
            for (int q = 0; q < NR; ++q) { const float rstd = __builtin_amdgcn_rsqf(s[q] * (1.f / DM) + NORM_EPS);
#pragma unroll
                for (int j = 0; j < 2; ++j) { const LAS float* ta = TA + bq[q] * DM + 512 * j + 8 * lane; const f32x4 t0 = *(const LAS f32x4*)ta, t1 = *(const LAS f32x4*)(ta + 4);
#pragma unroll
                    for (int e = 0; e < 4; ++e) { xv[q][8 * j + e] += t0[e] * (yv[q][8 * j + e] * rstd); xv[q][8 * j + 4 + e] += t1[e] * (yv[q][8 * j + 4 + e] * rstd); } } }
        }
#pragma unroll
        for (int q = 0; q < NR; ++q)
#pragma unroll
            for (int j = 0; j < 2; ++j) { const size_t off = (size_t)row[q] * DM + 512 * j + 8 * lane;
                if constexpr (OUT32) { float* o32 = out32;
                    *(f32x4*)(o32 + off) = (f32x4){xv[q][8 * j], xv[q][8 * j + 1], xv[q][8 * j + 2], xv[q][8 * j + 3]}; *(f32x4*)(o32 + off + 4) = (f32x4){xv[q][8 * j + 4], xv[q][8 * j + 5], xv[q][8 * j + 6], xv[q][8 * j + 7]}; }
                else { u32x4 w; w.x = pk_f16(xv[q][8 * j], xv[q][8 * j + 1]); w.y = pk_f16(xv[q][8 * j + 2], xv[q][8 * j + 3]); w.z = pk_f16(xv[q][8 * j + 4], xv[q][8 * j + 5]); w.w = pk_f16(xv[q][8 * j + 6], xv[q][8 * j + 7]);
                    *(u32x4*)(X16out + off) = w;
                    const f16x8 r = __builtin_bit_cast(f16x8, w);
#pragma unroll
                    for (int e = 0; e < 8; ++e) xv[q][8 * j + e] = (float)r[e]; }
            }
        if constexpr (WH) {
            float s[NR];
#pragma unroll
            for (int q = 0; q < NR; ++q) s[q] = 0.f;
#pragma unroll
            for (int q = 0; q < NR; ++q)
#pragma unroll
                for (int e = 0; e < 16; ++e) s[q] += xv[q][e] * xv[q][e];

#pragma unroll
            for (int q = 0; q < NR; ++q) s[q] = wsum64(s[q]);
#pragma unroll
            for (int q = 0; q < NR; ++q) { const float rstd = __builtin_amdgcn_rsqf(s[q] * (1.f / DM) + NORM_EPS);
                f16* h2 = (HHALO != nullptr && is_halo_row(row[q])) ? HHALO + (size_t)(2 * ((row[q] >> 8) + 1) + ((row[q] & 255) - 254)) * DM : nullptr;
#pragma unroll
                for (int j = 0; j < 2; ++j) { const int col = 512 * j + 8 * lane; const LAS float* tb = TB + bq[q] * DM + col; const LAS float* tc = TC + bq[q] * DM + col;
                    const f32x4 b0 = *(const LAS f32x4*)tb, b1 = *(const LAS f32x4*)(tb + 4), c0 = *(const LAS f32x4*)tc, c1 = *(const LAS f32x4*)(tc + 4);
                    float hv[8];
#pragma unroll
                    for (int e = 0; e < 4; ++e) { hv[e] = (xv[q][8 * j + e] * rstd) * b0[e] + c0[e]; hv[4 + e] = (xv[q][8 * j + 4 + e] * rstd) * b1[e] + c1[e]; }
                    u32x4 w; w.x = pk_f16(hv[0], hv[1]); w.y = pk_f16(hv[2], hv[3]); w.z = pk_f16(hv[4], hv[5]); w.w = pk_f16(hv[6], hv[7]);
                    *(u32x4*)(H + (size_t)row[q] * DM + col) = w;
                    if (h2 != nullptr) *(u32x4*)(h2 + col) = w; } }
        }
    }
}

__device__ __forceinline__ void naive_kmean(const f16* PROJ, float* KMEAN, int gt, int NGT) {
    for (int e = gt; e < BATCH * 16 * 512; e += NGT) { const int col = e & 511, blk = (e >> 9) & 15, b = e >> 13;
        const f16* p = PROJ + ((size_t)b * SEQ + blk * 256) * AB_IN + 512 + col; float s = 0.f;
        for (int r = 0; r < 256; ++r) s += (float)p[(size_t)r * AB_IN];
        KMEAN[e] = s * (1.f / 256.f); }
}
#define OS_UPDATE(s_, vv_) do { const float mn_ = fmaxf(m, (s_)), al_ = expf(m - mn_), pe_ = expf((s_) - mn_); l = l * al_ + pe_; \
    _Pragma("unroll") for (int i_ = 0; i_ < 16; ++i_) acc[i_] = acc[i_] * al_ + pe_ * (vv_)[i_]; m = mn_; } while (0)
__device__ __forceinline__ void naive_moba(const f16* PROJ, const float* KMEAN, const float* relb, f16* ATT, int gt, int NGT) {
    const int sub = gt & 3, ngr = NGT >> 2;
    for (int item = gt >> 2; item < BATCH * NH * SEQ; item += ngr) {
        const int t = item & (SEQ - 1), h = (item >> 12) & 7, b = item >> 15;
        const size_t row = (size_t)b * SEQ + t;
        float q[16]; load16(PROJ + row * AB_IN + h * 64 + sub * 16, q);
        const int own = t >> 8;
        unsigned selmask = 0u;
        {
            float g[16];
#pragma unroll
            for (int j = 0; j < 16; ++j) { float p = 0.f;
                if (j < own) { const float* km = KMEAN + ((size_t)(b * 16 + j) * 512) + h * 64 + sub * 16;
#pragma unroll
                    for (int i = 0; i < 16; ++i) p += q[i] * km[i]; }
                p = quad_sum(p); g[j] = (j < own) ? p : -INFINITY; }
#pragma unroll
            for (int r = 0; r < 3; ++r) { float best = -INFINITY; int bi = -1;
#pragma unroll
                for (int j = 0; j < 16; ++j) { const bool ok = !((selmask >> j) & 1u) && (j < own) && (g[j] > best); if (ok) { best = g[j]; bi = j; } }
                if (bi >= 0) selmask |= 1u << bi; }
        }
        float m = -INFINITY, l = 0.f, acc[16];
#pragma unroll
        for (int i = 0; i < 16; ++i) acc[i] = 0.f;
        const f16* Kb = PROJ + (size_t)b * SEQ * AB_IN + 512 + h * 64 + sub * 16;
        const float* rb = relb + h * 32;
        for (int pos = own * 256; pos <= t; ++pos) { float kk[16], vv[16]; load16(Kb + (size_t)pos * AB_IN, kk); load16(Kb + (size_t)pos * AB_IN + 512, vv); float p = 0.f;
#pragma unroll
            for (int i = 0; i < 16; ++i) p += q[i] * kk[i];
            const float s = quad_sum(p) * 0.125f + rb[t5_bucket(t - pos)]; OS_UPDATE(s, vv); }
        for (int j = 0; j < own; ++j) { if (!((selmask >> j) & 1u)) continue;
            for (int pos = j * 256; pos < j * 256 + 256; ++pos) { float kk[16], vv[16]; load16(Kb + (size_t)pos * AB_IN, kk); load16(Kb + (size_t)pos * AB_IN + 512, vv); float p = 0.f;
#pragma unroll
                for (int i = 0; i < 16; ++i) p += q[i] * kk[i];
                const float s = quad_sum(p) * 0.125f + rb[t5_bucket(t - pos)]; OS_UPDATE(s, vv); } }
        const float il = 1.f / l; u32x4 w0, w1;
        w0.x = pk_f16(acc[0] * il, acc[1] * il); w0.y = pk_f16(acc[2] * il, acc[3] * il); w0.z = pk_f16(acc[4] * il, acc[5] * il); w0.w = pk_f16(acc[6] * il, acc[7] * il);
        w1.x = pk_f16(acc[8] * il, acc[9] * il); w1.y = pk_f16(acc[10] * il, acc[11] * il); w1.z = pk_f16(acc[12] * il, acc[13] * il); w1.w = pk_f16(acc[14] * il, acc[15] * il);
        f16* o = ATT + row * DM + h * 64 + sub * 16; *(u32x4*)o = w0; *(u32x4*)(o + 8) = w1;
    }
}
__device__ __forceinline__ void naive_dilated(const f16* PROJ, const float* relb, f16* ATT, int gt, int NGT) {
    const int sub = gt & 3, ngr = NGT >> 2;
    for (int item = gt >> 2; item < BATCH * NH * SEQ; item += ngr) {
        const int t = item & (SEQ - 1), h = (item >> 12) & 7, b = item >> 15;
        const size_t row = (size_t)b * SEQ + t;
        float q[16]; load16(PROJ + row * AB_IN + 1536 + h * 64 + sub * 16, q);
        float m = -INFINITY, l = 0.f, acc[16];
#pragma unroll
        for (int i = 0; i < 16; ++i) acc[i] = 0.f;
        const f16* Kb = PROJ + (size_t)b * SEQ * AB_IN + 2048 + h * 64 + sub * 16;
        const float* rb = relb + (8 + h) * 32;
        for (int br = 0; br < 3; ++br) { const int dil = br == 0 ? 1 : (br == 1 ? 4 : 16);
            for (int mm = 0; mm <= 128; ++mm) { const int pos = t - dil * mm; if (pos < 0) break;
                float kk[16], vv[16]; load16(Kb + (size_t)pos * AB_IN, kk); load16(Kb + (size_t)pos * AB_IN + 512, vv); float p = 0.f;
#pragma unroll
                for (int i = 0; i < 16; ++i) p += q[i] * kk[i];
                const float s = quad_sum(p) * 0.125f + rb[t5_bucket(dil * mm)]; OS_UPDATE(s, vv); } }
        const float il = 1.f / l; u32x4 w0, w1;
        w0.x = pk_f16(acc[0] * il, acc[1] * il); w0.y = pk_f16(acc[2] * il, acc[3] * il); w0.z = pk_f16(acc[4] * il, acc[5] * il); w0.w = pk_f16(acc[6] * il, acc[7] * il);
        w1.x = pk_f16(acc[8] * il, acc[9] * il); w1.y = pk_f16(acc[10] * il, acc[11] * il); w1.z = pk_f16(acc[12] * il, acc[13] * il); w1.w = pk_f16(acc[14] * il, acc[15] * il);
        f16* o = ATT + row * DM + 512 + h * 64 + sub * 16; *(u32x4*)o = w0; *(u32x4*)(o + 8) = w1;
    }
}
__device__ __forceinline__ void mla_norm_phase(f16* PROJ, f16* KPE, const float* rc, const float* rs, int tid, int bid, int G) {
    const int wave = tid >> 6, lane = tid & 63;
    const int gw = bid * NWAVES + wave, NGW = G * NWAVES;
    for (int row = gw; row < M; row += NGW) {
        f16* p = PROJ + (size_t)row * CD_INP;
        const int t = row & (SEQ - 1);
#pragma unroll
        for (int part = 0; part < 2; ++part) {
            f16x4 v = *(const f16x4*)(p + part * 256 + 4 * lane);
            float f[4] = {(float)v[0], (float)v[1], (float)v[2], (float)v[3]};
            const float s = wave_sum((f[0] * f[0] + f[1] * f[1]) + (f[2] * f[2] + f[3] * f[3]));
            const float rstd = __builtin_amdgcn_rsqf(s * (1.f / 256.f) + NORM_EPS);
            u32x2 w; w.x = pk_f16(f[0] * rstd, f[1] * rstd); w.y = pk_f16(f[2] * rstd, f[3] * rstd);
            *(u32x2*)(p + part * 256 + 4 * lane) = w;
        }
        if (lane < 16) { const float x1 = (float)p[512 + lane], x2 = (float)p[528 + lane]; const float c = rc[t * 16 + lane], s = rs[t * 16 + lane];
            KPE[(size_t)row * 32 + lane] = (f16)(x1 * c - x2 * s); KPE[(size_t)row * 32 + 16 + lane] = (f16)(x1 * s + x2 * c); }
    }
}
__device__ __forceinline__ void naive_mla(const f16* Q, const f16* KV, const f16* KPE, const float* rc, const float* rs, f16* ATT, int gt, int NGT) {
    const int sub = gt & 3, ngr = NGT >> 2;
    const float scale = 0.10206207261596575f;
    for (int item = gt >> 2; item < BATCH * NH * SEQ; item += ngr) {
        const int t = item & (SEQ - 1), h = (item >> 12) & 7, b = item >> 15;
        const size_t row = (size_t)b * SEQ + t;
        const f16* qp = Q + row * QW + h * 96;
        float q[16], qr[8]; load16(qp + sub * 16, q);
#pragma unroll
        for (int i = 0; i < 8; ++i) { const int d = 8 * sub + i, dd = d & 15; const float x1 = (float)qp[64 + dd], x2 = (float)qp[80 + dd]; const float c = rc[t * 16 + dd], s = rs[t * 16 + dd];
            qr[i] = (d < 16) ? (x1 * c - x2 * s) : (x1 * s + x2 * c); }
        float m = -INFINITY, l = 0.f, acc[16];
#pragma unroll
        for (int i = 0; i < 16; ++i) acc[i] = 0.f;
        const f16* Kb = KV + (size_t)b * SEQ * KVW + h * 128 + sub * 16;
        const f16* Pb = KPE + (size_t)b * SEQ * 32 + sub * 8;
        for (int pos = 0; pos <= t; ++pos) { float kk[16], kr[8], vv[16]; load16(Kb + (size_t)pos * KVW, kk); load8(Pb + (size_t)pos * 32, kr); load16(Kb + (size_t)pos * KVW + 64, vv); float p = 0.f;
#pragma unroll
            for (int i = 0; i < 16; ++i) p += q[i] * kk[i];
#pragma unroll
            for (int i = 0; i < 8; ++i) p += qr[i] * kr[i];
            const float s = quad_sum(p) * scale; OS_UPDATE(s, vv); }
        const float il = 1.f / l; u32x4 w0, w1;
        w0.x = pk_f16(acc[0] * il, acc[1] * il); w0.y = pk_f16(acc[2] * il, acc[3] * il); w0.z = pk_f16(acc[4] * il, acc[5] * il); w0.w = pk_f16(acc[6] * il, acc[7] * il);
        w1.x = pk_f16(acc[8] * il, acc[9] * il); w1.y = pk_f16(acc[10] * il, acc[11] * il); w1.z = pk_f16(acc[12] * il, acc[13] * il); w1.w = pk_f16(acc[14] * il, acc[15] * il);
        f16* o = ATT + row * DM + h * 64 + sub * 16; *(u32x4*)o = w0; *(u32x4*)(o + 8) = w1;
    }
}
__device__ __forceinline__ float softplusf(float x) { return fmaxf(x, 0.f) + log1pf(expf(-fabsf(x))); }
__device__ __forceinline__ void naive_sb(const f16* PROJ, f16* ATT, int gt, int NGT) {
    const int sub = gt & 3, ngr = NGT >> 2;
    for (int item = gt >> 2; item < BATCH * NH * SEQ; item += ngr) {
        const int t = item & (SEQ - 1), h = (item >> 12) & 7, b = item >> 15;
        const size_t row = (size_t)b * SEQ + t;
        float q[16]; load16(PROJ + row * CD_INP + 544 + h * 64 + sub * 16, q);
        float R = 0.f, acc[16];
#pragma unroll
        for (int i = 0; i < 16; ++i) acc[i] = 0.f;
        const f16* Kb = PROJ + (size_t)b * SEQ * CD_INP + 1056 + h * 64 + sub * 16;
        for (int pos = t - 1; pos >= 0; --pos) { float kk[16], vv[16]; load16(Kb + (size_t)pos * CD_INP, kk); load16(Kb + (size_t)pos * CD_INP + 512, vv); float p = 0.f;
#pragma unroll
            for (int i = 0; i < 16; ++i) p += q[i] * kk[i];
            const float z = quad_sum(p) * 0.125f;
            const float aw = expf(R - softplusf(-z));
#pragma unroll
            for (int i = 0; i < 16; ++i) acc[i] += aw * vv[i];
            R -= softplusf(z); }
        u32x4 w0, w1;
        w0.x = pk_f16(acc[0], acc[1]); w0.y = pk_f16(acc[2], acc[3]); w0.z = pk_f16(acc[4], acc[5]); w0.w = pk_f16(acc[6], acc[7]);
        w1.x = pk_f16(acc[8], acc[9]); w1.y = pk_f16(acc[10], acc[11]); w1.z = pk_f16(acc[12], acc[13]); w1.w = pk_f16(acc[14], acc[15]);
        f16* o = ATT + row * DM + 512 + h * 64 + sub * 16; *(u32x4*)o = w0; *(u32x4*)(o + 8) = w1;
    }
}
__device__ __forceinline__ float gelu_tanh(float g) { return 0.5f * g * (1.f + tanhf(0.7978845608028654f * (g + 0.044715f * g * g * g))); }
__device__ __forceinline__ void naive_convact(const f16* U, int half, const float* cw, const float* cb, f16* ACT, int gt, int NGT) {
    for (int e = gt; e < (M / 2) * DFF; e += NGT) { const int rl = e / DFF, j = e % DFF; const int row = half * (M / 2) + rl, t = row & (SEQ - 1);
        const int ucol = (j >> 7) * 256 + (j & 127);
        float g = cb[j], v = cb[DFF + j];
#pragma unroll
        for (int tap = 0; tap < 3; ++tap) { const int dt = 2 - tap; if (t - dt < 0) continue;
            const f16* up = U + (size_t)(rl - dt) * DFF2 + ucol;
            g += cw[tap * DFF2 + j] * (float)up[0]; v += cw[tap * DFF2 + DFF + j] * (float)up[128]; }
        ACT[(size_t)row * DFF + j] = (f16)(gelu_tanh(g) * v); }
}
#ifndef ATT_SKEW
#define ATT_SKEW 0
#endif
namespace att {
typedef float f32x16 __attribute__((ext_vector_type(16)));
typedef short s16x4 __attribute__((ext_vector_type(4)));
__device__ __forceinline__ f16x4 tr_read(const LAS f16* p) { return __builtin_bit_cast(f16x4, __builtin_amdgcn_ds_read_tr16_b64_v4i16((LAS s16x4*)p)); }
__device__ __forceinline__ void half_swap(float x, float& lo, float& hi) { lo = x; hi = x; asm volatile("s_nop 1\n\tv_permlane32_swap_b32 %0, %1\n\ts_nop 1" : "+v"(lo), "+v"(hi)); }
constexpr int VP = 96;
constexpr int OFF_K = 0, KBUF = 128 * 104 * 2;
constexpr int OFF_V = 2 * KBUF, VBUF = 128 * VP * 2;
constexpr int OFF_BIAS = OFF_V + 2 * VBUF;
constexpr int OFF_KMEAN = OFF_BIAS + 16384;
constexpr int OFF_FLAG = OFF_KMEAN + 4096;
constexpr int ATT_LDS = OFF_FLAG + 64;
constexpr float LOG2E = 1.4426950408889634f, LN2 = 0.6931471805599453f;

struct Src {
    const f16* q; int qp;
    const f16* k; int kp;
    const f16* k2;
    const f16* v; int vp;
    f16* o;
};

template <int KIND  , int PM = 0  >
__device__ __forceinline__ void attn_unit(LAS unsigned char* lds, const Src& T, int b, int h, int qb, const float* rc, const float* rs, const float* KMEAN, const float* relb, int tid, bool tables_ready = false  ) {
    constexpr int DQ = (KIND == 0) ? 96 : 64, NS = DQ / 16, KP = DQ + 8;
    const int lane = tid & 63, r32 = lane & 31, hi = lane >> 5; const int wid = __builtin_amdgcn_readfirstlane(tid >> 6);
    const size_t rowbase = (size_t)b * SEQ;
    const int q0w = qb * 256 + wid * 32;
    const int t = q0w + r32;
    const int NT = 4 * qb + 4;
    auto tile_start = [&](int i) -> int {
        if constexpr (KIND == 0) return 64 * i;
        else if constexpr (KIND == 1) return i < 4 ? 256 * qb + 64 * i : 64 * (i - 4);
        else return 64 * (NT - 1 - i);
    };
    const int kr = tid >> 3, kc = tid & 7;
    const int k2r = tid >> 2, k2c = tid & 3;
    f16x8 kr0, vr0, k2r0, kr1, vr1, k2r1;
    auto gload = [&](int d) {
        const int ts0 = tile_start(2 * d), ts1 = tile_start(2 * d + 1);
        kr0 = *(const GAS f16x8*)(T.k + (rowbase + ts0 + kr) * T.kp + 8 * kc); vr0 = *(const GAS f16x8*)(T.v + (rowbase + ts0 + kr) * T.vp + 8 * kc);
        kr1 = *(const GAS f16x8*)(T.k + (rowbase + ts1 + kr) * T.kp + 8 * kc); vr1 = *(const GAS f16x8*)(T.v + (rowbase + ts1 + kr) * T.vp + 8 * kc);
        if constexpr (KIND == 0) { if (tid < 256) { k2r0 = *(const GAS f16x8*)(T.k2 + (rowbase + ts0 + k2r) * 32 + 8 * k2c); k2r1 = *(const GAS f16x8*)(T.k2 + (rowbase + ts1 + k2r) * 32 + 8 * k2c); } }
    };
    auto lstore = [&](int buf) {
        LAS f16* Kb = (LAS f16*)(lds + OFF_K + buf * KBUF); LAS f16* Vb = (LAS f16*)(lds + OFF_V + buf * VBUF);
        *(LAS f16x8*)(Kb + kr * KP + 8 * kc) = kr0; *(LAS f16x8*)(Kb + (64 + kr) * KP + 8 * kc) = kr1;
        if constexpr (KIND == 0) { if (tid < 256) { *(LAS f16x8*)(Kb + k2r * KP + 64 + 8 * k2c) = k2r0; *(LAS f16x8*)(Kb + (64 + k2r) * KP + 64 + 8 * k2c) = k2r1; } }
        *(LAS f16x8*)(Vb + kr * VP + 8 * kc) = vr0; *(LAS f16x8*)(Vb + (64 + kr) * VP + 8 * kc) = vr1;
    };
    gload(0);
    f16x8 qf[NS];
    {
        const f16* qrow = T.q + (rowbase + t) * T.qp;
#pragma unroll
        for (int s = 0; s < 4; ++s) qf[s] = *(const GAS f16x8*)(qrow + 16 * s + 8 * hi);
        if constexpr (KIND == 0) {
            const f16x8 xa = *(const GAS f16x8*)(qrow + 64 + 8 * hi), xb = *(const GAS f16x8*)(qrow + 80 + 8 * hi);
            const f32x4 c0 = *(const GAS f32x4*)(rc + t * 16 + 8 * hi), c1 = *(const GAS f32x4*)(rc + t * 16 + 8 * hi + 4), s0 = *(const GAS f32x4*)(rs + t * 16 + 8 * hi), s1 = *(const GAS f32x4*)(rs + t * 16 + 8 * hi + 4);
#pragma unroll
            for (int j = 0; j < 8; ++j) { const float a = (float)xa[j], bb = (float)xb[j], c = j < 4 ? c0[j & 3] : c1[j & 3], s = j < 4 ? s0[j & 3] : s1[j & 3];
                qf[4][j] = (f16)(a * c - bb * s); qf[5][j] = (f16)(a * s + bb * c); }
        }
    }
    unsigned selmask = 0u;
    LAS float* biasl = (LAS float*)(lds + OFF_BIAS);
    if constexpr (KIND == 1) {
        LAS float* kml = (LAS float*)(lds + OFF_KMEAN);
        if (!tables_ready) {
        for (int d = tid; d < SEQ; d += NTHR) biasl[d] = ((const GAS float*)relb)[h * 32 + t5_bucket(d)] * LOG2E;
        for (int e = tid; e < 16 * 64; e += NTHR) kml[e] = ((const GAS float*)KMEAN)[((size_t)(b * 16 + (e >> 6)) * 512) + h * 64 + (e & 63)] * (1.f / 256.f);
        __syncthreads(); }
        float g[16];
#pragma unroll
        for (int j = 0; j < 16; ++j) { float p = 0.f;
            if (j < qb) {
#pragma unroll
                for (int s = 0; s < 4; ++s)
#pragma unroll
                    for (int i = 0; i < 8; ++i) p += (float)qf[s][i] * kml[j * 64 + 16 * s + 8 * hi + i]; }
            p = xsum32(p); g[j] = (j < qb) ? p : -INFINITY; }
#pragma unroll
        for (int r = 0; r < 3; ++r) { float best = -INFINITY; int bi = -1;
#pragma unroll
            for (int j = 0; j < 16; ++j) { const bool ok = !((selmask >> j) & 1u) && (j < qb) && (g[j] > best); if (ok) { best = g[j]; bi = j; } }
            if (bi >= 0) selmask |= 1u << bi; }
    }
    f32x16 o0, o1;
#pragma unroll
    for (int r = 0; r < 16; ++r) { o0[r] = 0.f; o1[r] = 0.f; }
    float m = -1e30f, l = 0.f, R = (KIND == 2) ? 1.f : 0.f;
    const float csc = (KIND == 0 ? 0.10206207261596575f : 0.125f) * (KIND == 2 ? 1.0f : LOG2E);
    LAS unsigned* flags = (LAS unsigned*)(lds + OFF_FLAG);

    const int ND = NT / 2;
    lstore(0); gload(1);
    __syncthreads();
    auto tile = [&](int i, int buf, int sub) {
        const int ts = tile_start(i);
        bool active, need_mask;
        if constexpr (KIND == 2) { active = ts < q0w + 31; need_mask = ts + 63 >= q0w; }
        else if constexpr (KIND == 1) { if (i < 4) { active = ts <= q0w + 31; need_mask = ts + 63 > q0w; } else { active = true; need_mask = false; } }
        else { active = ts <= q0w + 31; need_mask = ts + 63 > q0w; }
        bool wave_done = false;
        if constexpr (KIND == 2) { wave_done = __all(R == 0.f) != 0; if (wave_done) active = false; }
        if (active && PM != 1) {
            const LAS f16* Kb = (const LAS f16*)(lds + OFF_K + buf * KBUF) + sub * 64 * KP; const LAS f16* Vb = (const LAS f16*)(lds + OFF_V + buf * VBUF) + sub * 64 * VP;
            f32x16 p0, p1;
#pragma unroll
            for (int r = 0; r < 16; ++r) { p0[r] = 0.f; p1[r] = 0.f; }
            {
                f16x8 kf[2 * NS];
#pragma unroll
                for (int s = 0; s < NS; ++s) { kf[2 * s] = *(const LAS f16x8*)(Kb + r32 * KP + 16 * s + 8 * hi); kf[2 * s + 1] = *(const LAS f16x8*)(Kb + (32 + r32) * KP + 16 * s + 8 * hi); }
                __builtin_amdgcn_sched_barrier(0);
#pragma unroll
                for (int s = 0; s < NS; ++s) { p0 = __builtin_amdgcn_mfma_f32_32x32x16_f16(kf[2 * s], qf[s], p0, 0, 0, 0); p1 = __builtin_amdgcn_mfma_f32_32x32x16_f16(kf[2 * s + 1], qf[s], p1, 0, 0, 0); }
            }
            f16x4 vlo[8], vhh[8];
            auto vfrag_load = [&]() {
#pragma unroll
            for (int kb = 0; kb < 2; ++kb)
#pragma unroll
                for (int s2 = 0; s2 < 2; ++s2)
#pragma unroll
                    for (int db = 0; db < 2; ++db) {
                        const LAS f16* vp = Vb + (32 * kb + 16 * s2 + 4 * hi + ((lane & 15) >> 2)) * VP + 32 * db + (r32 & 16) + 4 * (lane & 3);
                        vlo[(kb * 2 + s2) * 2 + db] = tr_read(vp); vhh[(kb * 2 + s2) * 2 + db] = tr_read(vp + 8 * VP); }
            };
            if constexpr (PM < 2 && KIND != 2) vfrag_load();
            __builtin_amdgcn_sched_barrier(0);
            const int lim = t - ts - 4 * hi;
            if constexpr (PM == 3) { asm volatile("" :: "v"(p0), "v"(p1)); }
            else if constexpr (KIND != 2) {
                if constexpr (KIND == 1) {
                    const int dbase = lim;
                    const int dminw = q0w - ts - 63;
                    if (i >= 4 && dminw >= 332) {
                        const int dmaxw = dminw + 94;
                        const int B = dminw < 450 ? 450 : (dminw < 609 ? 609 : (dminw < 825 ? 825 : (dminw < 1117 ? 1117 : (dminw < 1513 ? 1513 : 0x7fffffff))));
                        const bool sel = (selmask >> (ts >> 8)) & 1u;
                        const float blo = sel ? biasl[dminw] : -INFINITY;
                        if (B > dmaxw) {
                            const f32x2 bb = {blo, blo};
#pragma unroll
                            for (int r = 0; r < 16; r += 2) { const f32x2 q0 = (f32x2){p0[r], p0[r + 1]} * csc + bb, q1 = (f32x2){p1[r], p1[r + 1]} * csc + bb;
                                p0[r] = q0.x; p0[r + 1] = q0.y; p1[r] = q1.x; p1[r + 1] = q1.y; }
                        } else {
                            const float bhi = sel ? biasl[dmaxw] : -INFINITY;
                            const int thr0 = dbase - B, thr1 = thr0 - 32;
#pragma unroll
                            for (int r = 0; r < 16; r += 2) { const int c = (r & 3) + 8 * (r >> 2);
                                const f32x2 ba = {c <= thr0 ? bhi : blo, c + 1 <= thr0 ? bhi : blo}, bc = {c <= thr1 ? bhi : blo, c + 1 <= thr1 ? bhi : blo};
                                const f32x2 q0 = (f32x2){p0[r], p0[r + 1]} * csc + ba, q1 = (f32x2){p1[r], p1[r + 1]} * csc + bc;
                                p0[r] = q0.x; p0[r + 1] = q0.y; p1[r] = q1.x; p1[r + 1] = q1.y; }
                        }
                    } else {
                    float b0[16], b1[16];
                    if (i < 4) {
#pragma unroll
                        for (int r = 0; r < 16; ++r) { const int c = (r & 3) + 8 * (r >> 2); int d0 = dbase - c, d1 = dbase - 32 - c; d0 = d0 < 0 ? 0 : d0; d1 = d1 < 0 ? 0 : d1; b0[r] = biasl[d0]; b1[r] = biasl[d1]; }
                    } else {
#pragma unroll
                        for (int r = 0; r < 16; ++r) { const int c = (r & 3) + 8 * (r >> 2); b0[r] = biasl[dbase - c]; b1[r] = biasl[dbase - 32 - c]; }
                    }
                    __builtin_amdgcn_sched_barrier(0);
#pragma unroll
                    for (int r = 0; r < 16; r += 2) { const f32x2 q0 = (f32x2){p0[r], p0[r + 1]} * csc + (f32x2){b0[r], b0[r + 1]}, q1 = (f32x2){p1[r], p1[r + 1]} * csc + (f32x2){b1[r], b1[r + 1]};
                        p0[r] = q0.x; p0[r + 1] = q0.y; p1[r] = q1.x; p1[r + 1] = q1.y; }
                    if (i >= 4) { const bool sel = (selmask >> (ts >> 8)) & 1u;
                        if (!sel) {
#pragma unroll
                            for (int r = 0; r < 16; ++r) { p0[r] = -INFINITY; p1[r] = -INFINITY; } } }
                    }
                }
                if (need_mask) {
#pragma unroll
                    for (int r = 0; r < 16; ++r) { const int c = (r & 3) + 8 * (r >> 2); if (c > lim) p0[r] = -INFINITY; if (c + 32 > lim) p1[r] = -INFINITY; }
                }
                const float esc = (KIND == 1) ? 1.0f : csc;
                float mx = max3f(p0[0], p0[1], p0[2]), my = max3f(p1[0], p1[1], p1[2]);
#pragma unroll
                for (int r = 3; r < 15; r += 2) { mx = max3f(mx, p0[r], p0[r + 1]); my = max3f(my, p1[r], p1[r + 1]); }
                mx = max3f(mx, my, p0[15]); mx = max3f(mx, p1[15], p1[15]);
                { float mlo, mhi; half_swap(mx, mlo, mhi); mx = max3f(mlo, mhi, mhi) * esc; }
                if (__any(mx > m + 8.0f)) {
                    const float mn = fmaxf(m, mx), alpha = __builtin_amdgcn_exp2f(m - mn);
                    m = mn; l *= alpha;
#pragma unroll
                    for (int r = 0; r < 16; ++r) { o0[r] *= alpha; o1[r] *= alpha; }
                }
                f32x2 sum2 = {0.f, 0.f};
#pragma unroll
                for (int r = 0; r < 16; r += 2) {
                    const f32x2 t0 = (f32x2){p0[r], p0[r + 1]} * esc - m, t1 = (f32x2){p1[r], p1[r + 1]} * esc - m;
                    f32x2 e0, e1; e0.x = __builtin_amdgcn_exp2f(t0.x); e0.y = __builtin_amdgcn_exp2f(t0.y); e1.x = __builtin_amdgcn_exp2f(t1.x); e1.y = __builtin_amdgcn_exp2f(t1.y);
                    p0[r] = e0.x; p0[r + 1] = e0.y; p1[r] = e1.x; p1[r + 1] = e1.y; sum2 += e0 + e1; }
                l += sum2.x + sum2.y;
            } else {
                float lk0[16], lk1[16];
                if (need_mask) {
#pragma unroll
                    for (int r = 0; r < 16; ++r) { const int c = (r & 3) + 8 * (r >> 2);
                        const float z0 = fminf(p0[r], 126.f), z1 = fminf(p1[r], 126.f);
                        const float e0 = __builtin_amdgcn_exp2f(z0), e1 = __builtin_amdgcn_exp2f(z1);
                        const float r0 = __builtin_amdgcn_rcpf(1.f + e0), r1 = __builtin_amdgcn_rcpf(1.f + e1);
                        const bool v0 = c < lim, v1 = c + 32 < lim;
                        lk0[r] = v0 ? r0 : 1.f; lk1[r] = v1 ? r1 : 1.f;
                        p0[r] = v0 ? e0 * r0 : 0.f; p1[r] = v1 ? e1 * r1 : 0.f; }
                } else {
#pragma unroll
                    for (int r = 0; r < 16; r += 2) {
                        f32x2 z0 = (f32x2){p0[r], p0[r + 1]}, z1 = (f32x2){p1[r], p1[r + 1]};
                        z0.x = fminf(z0.x, 126.f); z0.y = fminf(z0.y, 126.f); z1.x = fminf(z1.x, 126.f); z1.y = fminf(z1.y, 126.f);
                        f32x2 e0, e1; e0.x = __builtin_amdgcn_exp2f(z0.x); e0.y = __builtin_amdgcn_exp2f(z0.y); e1.x = __builtin_amdgcn_exp2f(z1.x); e1.y = __builtin_amdgcn_exp2f(z1.y);
                        const f32x2 d0 = e0 + 1.f, d1 = e1 + 1.f;
                        f32x2 r0, r1; r0.x = __builtin_amdgcn_rcpf(d0.x); r0.y = __builtin_amdgcn_rcpf(d0.y); r1.x = __builtin_amdgcn_rcpf(d1.x); r1.y = __builtin_amdgcn_rcpf(d1.y);
                        const f32x2 s0 = e0 * r0, s1 = e1 * r1;
                        lk0[r] = r0.x; lk0[r + 1] = r0.y; lk1[r] = r1.x; lk1[r + 1] = r1.y;
                        p0[r] = s0.x; p0[r + 1] = s0.y; p1[r] = s1.x; p1[r + 1] = s1.y; }
                }
                float gs[8], gp[8];
#pragma unroll
                for (int g = 0; g < 4; ++g) { gs[g] = (lk0[4 * g] * lk0[4 * g + 1]) * (lk0[4 * g + 2] * lk0[4 * g + 3]); gs[4 + g] = (lk1[4 * g] * lk1[4 * g + 1]) * (lk1[4 * g + 2] * lk1[4 * g + 3]); }
#pragma unroll
                for (int c4 = 0; c4 < 8; ++c4) half_swap(gs[c4], gs[c4], gp[c4]);
                float suf = R;
#pragma unroll
                for (int c4 = 7; c4 >= 0; --c4) {
                    const float ev = gs[c4], od = gp[c4];
                    const float base = hi ? suf : suf * od;
                    if (c4 < 4) { const int g = c4; float acc = base;
                        p0[4 * g + 3] *= acc; acc *= lk0[4 * g + 3]; p0[4 * g + 2] *= acc; acc *= lk0[4 * g + 2]; p0[4 * g + 1] *= acc; acc *= lk0[4 * g + 1]; p0[4 * g] *= acc; }
                    else { const int g = c4 - 4; float acc = base;
                        p1[4 * g + 3] *= acc; acc *= lk1[4 * g + 3]; p1[4 * g + 2] *= acc; acc *= lk1[4 * g + 2]; p1[4 * g + 1] *= acc; acc *= lk1[4 * g + 1]; p1[4 * g] *= acc; }
                    suf *= ev * od;
                }
                R = suf;
            }
            if constexpr (PM < 2 && KIND == 2) { vfrag_load(); __builtin_amdgcn_sched_barrier(0); }
            if constexpr (PM >= 2) { asm volatile("" :: "v"(p0), "v"(p1)); }
            else
#pragma unroll
            for (int kb = 0; kb < 2; ++kb)
#pragma unroll
                for (int s2 = 0; s2 < 2; ++s2) {
                    f16x8 bf;
#pragma unroll
                    for (int j = 0; j < 8; ++j) bf[j] = (f16)(kb ? p1[8 * s2 + j] : p0[8 * s2 + j]);
#pragma unroll
                    for (int db = 0; db < 2; ++db) {
                        const f16x4 lo = vlo[(kb * 2 + s2) * 2 + db], hh = vhh[(kb * 2 + s2) * 2 + db];
                        const f16x8 af = {lo[0], lo[1], lo[2], lo[3], hh[0], hh[1], hh[2], hh[3]};
                        if (db == 0) o0 = __builtin_amdgcn_mfma_f32_32x32x16_f16(af, bf, o0, 0, 0, 0); else o1 = __builtin_amdgcn_mfma_f32_32x32x16_f16(af, bf, o1, 0, 0, 0);
                    }
                }
        }
    };
    for (int d = 0; d < ND; ++d) {
        const int buf = d & 1;
        if constexpr (ATT_SKEW > 0 && KIND != 2) { if (wid >= 4) __builtin_amdgcn_s_sleep(ATT_SKEW); }

        tile(2 * d, buf, 0);
        tile(2 * d + 1, buf, 1);
        if constexpr (KIND == 2) { if (lane == 0) flags[buf * 8 + wid] = (__all(R == 0.f) != 0) ? 1u : 0u; }
        if (d + 1 < ND) lstore(buf ^ 1);
        if (d + 2 < ND) gload(d + 2);
        __syncthreads();
        if constexpr (KIND == 2) {
            unsigned alld = 1u;
#pragma unroll
            for (int w = 0; w < 8; ++w) alld &= flags[buf * 8 + w];
            if (alld) break;
        }
    }
    float inv = 1.f;
    if constexpr (KIND != 2) { l = xsum32(l); inv = __builtin_amdgcn_rcpf(l); }
    f16* orow = T.o + (rowbase + t) * DM;
    if constexpr (PM == 0)
#pragma unroll
    for (int g = 0; g < 4; ++g) {
        u32x2 w0, w1;
        w0.x = pk_f16(o0[4 * g] * inv, o0[4 * g + 1] * inv); w0.y = pk_f16(o0[4 * g + 2] * inv, o0[4 * g + 3] * inv);
        w1.x = pk_f16(o1[4 * g] * inv, o1[4 * g + 1] * inv); w1.y = pk_f16(o1[4 * g + 2] * inv, o1[4 * g + 3] * inv);
        *(GAS u32x2*)(orow + 8 * g + 4 * hi) = w0; *(GAS u32x2*)(orow + 32 + 8 * g + 4 * hi) = w1;
    }
    __syncthreads();
}
}
namespace dil {
typedef float f32x16 __attribute__((ext_vector_type(16)));
constexpr int KPW = 72, VPW = 96;
constexpr int WAVE_LDS = 32 * KPW * 2 + 32 * VPW * 2;
constexpr int OFF_BIASD = 8 * WAVE_LDS;
constexpr int BTP = 196;
constexpr int OFF_STML = OFF_BIASD + 2560;
constexpr int OFF_STO = OFF_STML + 4096;
constexpr int SPW = 68, ST_SPLIT = (RING_BYTES - OFF_STO) / (SPW * 2), ST_GAP = RING_BYTES + 1024 - (OFF_STO + ST_SPLIT * SPW * 2);
static_assert(OFF_STO + ST_SPLIT * SPW * 2 <= RING_BYTES && OFF_STO + 512 * SPW * 2 + ST_GAP <= LDS_BYTES, "dilated state does not fit");
constexpr float LOG2E = 1.4426950408889634f;

__device__ __forceinline__ void dilated_unit(LAS unsigned char* lds, const f16* PROJ, const float* relb, f16* ATT, int b, int h, int sp, int tid) {
    const int lane = tid & 63, lane0 = lane, r32 = lane & 31, hi = lane >> 5; const int wid = __builtin_amdgcn_readfirstlane(tid >> 6);
    LAS float* biasd = (LAS float*)(lds + OFF_BIASD);
    int tid_f = tid; asm volatile("" : "+v"(tid_f));
    for (int e = tid_f; e < 3 * BTP; e += NTHR) { const int br = e / BTP, mm = e % BTP - 32; const int dl = br == 0 ? 16 : (br == 1 ? 4 : 1);
        biasd[e] = (mm >= 0 && mm <= 128) ? ((const GAS float*)relb)[(8 + h) * 32 + t5_bucket(dl * mm)] * LOG2E : 0.f; }
    __syncthreads();
    LAS f16* Kb = (LAS f16*)(lds + wid * WAVE_LDS); LAS f16* Vb = Kb + 32 * KPW;
    LAS float* stml = (LAS float*)(lds + OFF_STML);
    const size_t rowbase = (size_t)b * SEQ; const int T0 = sp * 512;
    const f16* Kg = PROJ + 2048 + h * 64; const f16* Vg = PROJ + 2560 + h * 64; const f16* Qg = PROJ + 1536 + h * 64;
    const float csc = 0.125f * LOG2E;
    auto tile_dl = [&](int i) { const int pass = i >> 1; return pass == 0 ? 16 : (pass == 1 ? 4 : 1); };
    auto tile_tq0 = [&](int i) { const int pass = i >> 1, j = pass == 0 ? wid + 8 * (i & 1) : 2 * wid + (i & 1); return pass == 0 ? T0 + j : (pass == 1 ? T0 + (j >> 2) + 128 * (j & 3) : T0 + 32 * j); };
    auto tile_kb0 = [&](int i) { const int tq0 = tile_tq0(i), dl = tile_dl(i); int k = 0; while (k < 4 && tq0 + dl * (-128 + 32 * k + 31) < 0) ++k; return k; };
    auto adv = [&](int& i, int& k) { if (++k >= 5) { ++i; k = (i < 6) ? tile_kb0(i) : 0; return true; } return false; };
    f16x8 kA[4], vA[4], kB[4], vB[4];
    auto gload = [&](int ti, int kbk, f16x8 (&kreg)[4], f16x8 (&vreg)[4]) {
        const int tq0 = tile_tq0(ti), dl = tile_dl(ti); const int basepos = tq0 + dl * (-128 + 32 * kbk);
        int lane = lane0; asm volatile("" : "+v"(lane));
        if (basepos >= 0) {
            const unsigned voff = (unsigned)(lane >> 3) * (unsigned)(dl * AB_IN * 2) + (unsigned)(lane & 7) * 16u;
            const GAS char* kb = (const GAS char*)(Kg + (rowbase + basepos) * AB_IN); const GAS char* vb = (const GAS char*)(Vg + (rowbase + basepos) * AB_IN);
#pragma unroll
            for (int i = 0; i < 4; ++i) { const size_t so = (size_t)(i * 8 * dl) * (AB_IN * 2); kreg[i] = *(const GAS f16x8*)(kb + so + voff); vreg[i] = *(const GAS f16x8*)(vb + so + voff); }
        } else {
#pragma unroll
            for (int i = 0; i < 4; ++i) { const int id = lane + 64 * i, c = id >> 3, ch = id & 7; int pos = basepos + dl * c; pos = pos < 0 ? 0 : pos;
                kreg[i] = *(const GAS f16x8*)(Kg + (rowbase + pos) * AB_IN + 8 * ch); vreg[i] = *(const GAS f16x8*)(Vg + (rowbase + pos) * AB_IN + 8 * ch); }
        }
    };
    auto lstore = [&](const f16x8 (&kreg)[4], const f16x8 (&vreg)[4]) {
        int lane = lane0; asm volatile("" : "+v"(lane));
#pragma unroll
        for (int i = 0; i < 4; ++i) { const int id = lane + 64 * i, c = id >> 3, ch = id & 7;
            *(LAS f16x8*)(Kb + c * KPW + 8 * ch) = kreg[i];
            *(LAS f16x8*)(Vb + c * VPW + 8 * ch) = vreg[i]; }
    };
    auto loadq = [&](int ti, f16x8 (&q)[4]) {
        int lane = lane0; asm volatile("" : "+v"(lane)); const int r32 = lane & 31, hi = lane >> 5;
        const GAS char* qb = (const GAS char*)(Qg + (rowbase + tile_tq0(ti)) * AB_IN); const unsigned qoff = (unsigned)r32 * (unsigned)(tile_dl(ti) * AB_IN * 2) + (unsigned)hi * 16u;
#pragma unroll
        for (int s = 0; s < 4; ++s) q[s] = *(const GAS f16x8*)(qb + qoff + 32 * s);
    };
    auto strow = [&](int tt) { return (LAS f16*)(lds + OFF_STO + tt * (SPW * 2) + (tt >= ST_SPLIT ? ST_GAP : 0)); };
    int ci = 0, ck = tile_kb0(0); bool cstart = true;
    int pi = 0, pk = ck;
    f16x8 qf[4], qn[4];
    loadq(0, qn);
    gload(pi, pk, kA, vA); adv(pi, pk); gload(pi, pk, kB, vB); adv(pi, pk);
    f32x16 o0, o1; float m = 0.f, l = 0.f;
#pragma unroll
    for (int r = 0; r < 16; ++r) { o0[r] = 0.f; o1[r] = 0.f; }
    auto step = [&](f16x8 (&kreg)[4], f16x8 (&vreg)[4]) {
        const int ti = ci, kbk = ck, pass = ti >> 1; const int dl = tile_dl(ti), tq0 = tile_tq0(ti);
        const int tt = tq0 - T0 + dl * r32;
        const LAS float* bt = biasd + pass * BTP + 32;
        if (cstart) {
            cstart = false;
            if (pass > 0 && (ti & 1) == 0) { asm volatile("s_waitcnt lgkmcnt(0)" ::: "memory"); __builtin_amdgcn_s_barrier(); }
#pragma unroll
            for (int s = 0; s < 4; ++s) qf[s] = qn[s];
            if (ti + 1 < 6) loadq(ti + 1, qn);
            if (pass == 0) {
#pragma unroll
                for (int r = 0; r < 16; ++r) { o0[r] = 0.f; o1[r] = 0.f; }
                m = -1e30f; l = 0.f;
            } else {
                const LAS f16* srow = strow(tt);
                const f32x2 ml = *(const LAS f32x2*)(stml + tt * 2); m = ml[0]; const float L = ml[1]; l = hi == 0 ? L : 0.f;
#pragma unroll
                for (int g = 0; g < 4; ++g) { const f16x4 a = *(const LAS f16x4*)(srow + 8 * g + 4 * hi), c = *(const LAS f16x4*)(srow + 32 + 8 * g + 4 * hi);
#pragma unroll
                    for (int e = 0; e < 4; ++e) { o0[4 * g + e] = (float)a[e] * L; o1[4 * g + e] = (float)c[e] * L; } }
            }
        }
        asm volatile("s_waitcnt lgkmcnt(0)" ::: "memory");
        lstore(kreg, vreg);
        if (pi < 6) { gload(pi, pk, kreg, vreg); adv(pi, pk); }
        asm volatile("s_waitcnt lgkmcnt(0)" ::: "memory");
        f32x16 p;
#pragma unroll
        for (int r = 0; r < 16; ++r) p[r] = 0.f;
        f16x4 vlo[4], vhh[4];
        {
            f16x8 kf[4];
#pragma unroll
            for (int s = 0; s < 4; ++s) kf[s] = *(const LAS f16x8*)(Kb + r32 * KPW + 16 * s + 8 * hi);
#pragma unroll
            for (int s2 = 0; s2 < 2; ++s2)
#pragma unroll
                for (int db = 0; db < 2; ++db) { const LAS f16* vp = Vb + (16 * s2 + 4 * hi + ((lane & 15) >> 2)) * VPW + 32 * db + (r32 & 16) + 4 * (lane & 3); vlo[s2 * 2 + db] = att::tr_read(vp); vhh[s2 * 2 + db] = att::tr_read(vp + 8 * VPW); }
            __builtin_amdgcn_sched_barrier(0);
#pragma unroll
            for (int s = 0; s < 4; ++s) p = __builtin_amdgcn_mfma_f32_32x32x16_f16(kf[s], qf[s], p, 0, 0, 0);
        }
        const int basepos = tq0 + dl * (-128 + 32 * kbk);
        const int bmm = r32 + 128 - 32 * kbk - 4 * hi;
        const int bpos = basepos + dl * 4 * hi;
        const bool edge = (kbk == 0) || (kbk == 4) || (basepos < 0);
        {
            float bb[16];
#pragma unroll
            for (int r = 0; r < 16; ++r) { const int c = (r & 3) + 8 * (r >> 2); bb[r] = bt[bmm - c]; }
            __builtin_amdgcn_sched_barrier(0);
            if (!edge) {
#pragma unroll
                for (int r = 0; r < 16; ++r) p[r] = p[r] * csc + bb[r];
            } else if (basepos >= 0) {
#pragma unroll
                for (int r = 0; r < 16; ++r) { const int c = (r & 3) + 8 * (r >> 2); const bool ok = (unsigned)(bmm - c) <= 128u; const float v = p[r] * csc + bb[r]; p[r] = ok ? v : -INFINITY; }
            } else {
#pragma unroll
                for (int r = 0; r < 16; ++r) { const int c = (r & 3) + 8 * (r >> 2); const bool ok = ((unsigned)(bmm - c) <= 128u) && (bpos + dl * c >= 0); const float v = p[r] * csc + bb[r]; p[r] = ok ? v : -INFINITY; }
            }
        }
        float mx = max3f(p[0], p[1], p[2]);
#pragma unroll
        for (int r = 3; r < 15; r += 2) mx = max3f(mx, p[r], p[r + 1]);
        mx = max3f(mx, p[15], p[15]);
        { float mlo, mhi; att::half_swap(mx, mlo, mhi); mx = max3f(mlo, mhi, mhi); }
        if (__any(mx > m + 8.0f)) {
            const float mn = fmaxf(m, mx), alpha = __builtin_amdgcn_exp2f(m - mn);
            m = mn; l *= alpha;
#pragma unroll
            for (int r = 0; r < 16; ++r) { o0[r] *= alpha; o1[r] *= alpha; }
        }
        float sum = 0.f;
#pragma unroll
        for (int r = 0; r < 16; ++r) { p[r] = __builtin_amdgcn_exp2f(p[r] - m); sum += p[r]; }
        l += sum;
#pragma unroll
        for (int s2 = 0; s2 < 2; ++s2) {
            f16x8 bf;
#pragma unroll
            for (int e = 0; e < 8; ++e) bf[e] = (f16)p[8 * s2 + e];
#pragma unroll
            for (int db = 0; db < 2; ++db) {
                const f16x4 lo = vlo[s2 * 2 + db], hh = vhh[s2 * 2 + db];
                const f16x8 af = {lo[0], lo[1], lo[2], lo[3], hh[0], hh[1], hh[2], hh[3]};
                if (db == 0) o0 = __builtin_amdgcn_mfma_f32_32x32x16_f16(af, bf, o0, 0, 0, 0); else o1 = __builtin_amdgcn_mfma_f32_32x32x16_f16(af, bf, o1, 0, 0, 0);
            }
        }
        if (kbk == 4) {
            const float L = xsum32(l); const float inv = __builtin_amdgcn_rcpf(L);
            if (pass < 2) {
                LAS f16* srow = strow(tt);
#pragma unroll
                for (int g = 0; g < 4; ++g) {
                    u32x2 w0, w1;
                    w0.x = pk_f16(o0[4 * g] * inv, o0[4 * g + 1] * inv); w0.y = pk_f16(o0[4 * g + 2] * inv, o0[4 * g + 3] * inv);
                    w1.x = pk_f16(o1[4 * g] * inv, o1[4 * g + 1] * inv); w1.y = pk_f16(o1[4 * g + 2] * inv, o1[4 * g + 3] * inv);
                    *(LAS u32x2*)(srow + 8 * g + 4 * hi) = w0; *(LAS u32x2*)(srow + 32 + 8 * g + 4 * hi) = w1;
                }
                if (hi == 0) *(LAS f32x2*)(stml + tt * 2) = (f32x2){m, L};
            } else {
                f16* orow = ATT + (rowbase + T0 + tt) * DM + 512 + h * 64;
#pragma unroll
                for (int g = 0; g < 4; ++g) {
                    u32x2 w0, w1;
                    w0.x = pk_f16(o0[4 * g] * inv, o0[4 * g + 1] * inv); w0.y = pk_f16(o0[4 * g + 2] * inv, o0[4 * g + 3] * inv);
                    w1.x = pk_f16(o1[4 * g] * inv, o1[4 * g + 1] * inv); w1.y = pk_f16(o1[4 * g + 2] * inv, o1[4 * g + 3] * inv);
                    *(GAS u32x2*)(orow + 8 * g + 4 * hi) = w0; *(GAS u32x2*)(orow + 32 + 8 * g + 4 * hi) = w1;
                }
            }
        }
        if (adv(ci, ck)) cstart = true;
    };
#pragma unroll 1
    for (;;) { step(kA, vA); if (ci >= 6) break; step(kB, vB); if (ci >= 6) break; }
    asm volatile("s_waitcnt lgkmcnt(0)" ::: "memory");
    __syncthreads();
}
}
#ifndef USE_MFMA_MOBA
#define USE_MFMA_MOBA 1
#endif
#ifndef USE_MFMA_MLA
#define USE_MFMA_MLA 1
#endif
#ifndef USE_MFMA_SB
#define USE_MFMA_SB 1
#endif
#ifndef USE_MFMA_DIL
#define USE_MFMA_DIL 1
#endif
#ifndef REP_MOBA
#define REP_MOBA 1
#endif
#ifndef REP_DIL
#define REP_DIL 1
#endif
#ifndef REP_MLA
#define REP_MLA 1
#endif
#ifndef REP_SB
#define REP_SB 1
#endif
#ifndef REP_P0
#define REP_P0 1
#endif
#ifndef REP_THIN
#define REP_THIN 1
#endif
#ifndef REP_INPROJ
#define REP_INPROJ 1
#endif
#ifndef REP_OUTPROJ
#define REP_OUTPROJ 1
#endif
#ifndef REP_FUP
#define REP_FUP 1
#endif
#ifndef REP_FDN
#define REP_FDN 1
#endif
#ifndef PROBE_XBAR
#define PROBE_XBAR 0
#endif
#ifndef HALO_IN_THIN1
#define HALO_IN_THIN1 0
#endif
#ifndef HALO_IN_FUP
#define HALO_IN_FUP 1
#endif
#ifndef PROBE_PM
#define PROBE_PM 0
#endif
#ifndef DEFER_W
#ifndef REP_DIL
#define REP_DIL 1
#endif
#ifndef PEEL_CD
#define PEEL_CD 1
#endif
#ifndef P0_SPLIT
#define P0_SPLIT 1
#endif
#define DEFER_W 1
#endif
#ifndef PROBE_STAMP
#define PROBE_STAMP (-1)
#endif
#ifndef PROBE_BLK
#define PROBE_BLK 0
#endif
#ifndef PROBE_FUP
#define PROBE_FUP 0
#endif
#ifndef SEAM_FUSE
#define SEAM_FUSE 2
#endif
#ifndef MK_SPLIT
#define MK_SPLIT 0
#endif
constexpr int N_PHASES = 2 + DEPTH * 12;

__device__ __forceinline__ void panel_wait(unsigned* cnt, unsigned want, int tid) {
    if (tid < 64) { unsigned spins = 0;
        while ((unsigned)__builtin_amdgcn_readfirstlane(__hip_atomic_load(cnt, __ATOMIC_RELAXED, __HIP_MEMORY_SCOPE_AGENT)) < want) { __builtin_amdgcn_s_sleep(2); if (++spins > (1u << 16)) break; }
        __builtin_amdgcn_fence(__ATOMIC_ACQUIRE, "agent");
        asm volatile("s_waitcnt vmcnt(0)" ::: "memory"); }
    __syncthreads();
}
__device__ __forceinline__ int lane_now() { int l; asm volatile("v_mbcnt_lo_u32_b32 %0, -1, 0\n\tv_mbcnt_hi_u32_b32 %0, -1, %0" : "=v"(l)); return l; }
__global__ void __launch_bounds__(NTHR, 2) fwd_kernel(Args a) {
    extern __shared__ __attribute__((aligned(16))) unsigned char lds_raw[];
    LAS unsigned char* lds = (LAS unsigned char*)lds_raw;
    const int wave0 = __builtin_amdgcn_readfirstlane((int)threadIdx.x >> 6);
#define TID_NOW (wave0 * 64 + lane_now())
    const int bid = blockIdx.x, G = gridDim.x; const int NGT = G * NTHR;
    for (int u = TID_NOW; u < (LDS_BYTES - LDSCTL_OFF) / 4; u += NTHR) ((LAS unsigned*)(lds + LDSCTL_OFF))[u] = 0u;
    __syncthreads();
    volatile LAS unsigned* MISC = (volatile LAS unsigned*)(lds + MISC_OFF);
    XcdBarrier bar = xcd_barrier_post((unsigned*)(a.ws + WS_CTL) + CW_BAR, MISC + 8, TID_NOW);
    const int lo = a.ph_lo, hi = a.ph_hi; const bool seams = (hi - lo) > 1;
    int ph = 0;
    unsigned long long pacc = 0ull; int pkind = 0; (void)pkind;
    unsigned char* const ws0 = a.ws;
#define X16B ((f16*)(ws + WS_R2 + 32 * MiB))
#define X16 ((f16*)xout0)
#define MOD ((float*)(ws + WS_MOD))
#define H ((f16*)(ws + WS_H))
#define ATT ((f16*)(ws + WS_ATT))
#define HHALO ((f16*)(ws + WS_HHALO))
#define PROJ ((f16*)(ws + WS_R1))
#define Qb ((f16*)(ws + WS_R2))
#define KVb ((f16*)(ws + WS_R2 + 24 * MiB))
#define KPE ((f16*)(ws + WS_R2 + 56 * MiB))
#define rc ((const float*)(ws + WS_ROPE))
#define rs (((const float*)(ws + WS_ROPE)) + SEQ * 16)
#define ctl ((unsigned*)(ws + WS_CTL))
#define Y1 ((f16*)(ws + WS_R2))
#define Y2 ((f16*)(ws + WS_R2))
#define ACT ((f16*)(ws + WS_R1))
    float* const xout0 = a.out;
#define PH_ON (lo <= ph && ph < hi)
#define PH_LOC int tid = TID_NOW; asm volatile("" : "+v"(tid)); const int gt = bid * NTHR + tid; (void)gt; GAS unsigned char* wsg_ = (GAS unsigned char*)ws0; asm volatile("" : "+s"(wsg_)); unsigned char* ws = (unsigned char*)wsg_;     const unsigned long long t_ph0 = (PROBE_STAMP >= 0) ? rt() : 0ull; (void)t_ph0
#define PH_END do { const unsigned long long t1_ = (PROBE_STAMP >= 0) ? rt() : 0ull; if (seams) xcd_barrier(bar, TID_NOW); if (PROBE_STAMP >= 0) { const unsigned long long t2_ = rt(); if (PROBE_STAMP == 0) pacc += t2_ - t1_; else if (PROBE_STAMP == 20) pacc += t2_ - t_ph0; else if (PROBE_STAMP >= 100) { if (pkind == PROBE_STAMP - 100) pacc += t2_ - t1_; } else if (pkind == PROBE_STAMP) pacc += t1_ - t_ph0; } } while (0)

    pkind = 1;
    const int nmodw = (P0_SPLIT && DEFER_W && G >= 192) ? 96 : 0;
    if (PH_ON) { PH_LOC;
        if (nmodw == 0) { for (int ll = 0; ll < (DEFER_W ? 1 : DEPTH); ++ll) layer_mod(a, lds, tid, bid, G, ll); }
        else if (bid < nmodw) layer_mod(a, lds, tid, bid, nmodw, 0);
        else { layer_weights(a, lds, tid, bid - nmodw, G - nmodw, 0, 4); p0_misc(a, tid, bid - nmodw, G - nmodw); }
        PH_END; } ++ph;
    pkind = 2;
    if (PH_ON) { PH_LOC; if (gt < BATCH * 16 * 512) ((float*)(ws + WS_KMEAN))[gt] = 0.f;
        if (nmodw == 0) { for (int ll = 0; ll < (DEFER_W ? 1 : DEPTH); ++ll) { layer_weights(a, lds, tid, bid, G, ll, 3); __syncthreads(); } p0_misc(a, tid, bid, G); }
        else layer_weights(a, lds, tid, bid, G, 0, 5);
        __syncthreads();
        thin_phase<true, false, false, true, 4>(a.in[I_X], nullptr, X16, nullptr, nullptr, nullptr, nullptr, a.in[I_MIXPRE], MOD, H, nullptr, lds, tid, bid * NWAVES + (tid >> 6), G * NWAVES); PH_END; } ++ph;

    for (int l = 0; l < DEPTH; ++l) {
        const int li = l >> 1; const bool odd = (l & 1) != 0;
#define modl (MOD + (size_t)l * BATCH * 6144)
        for (int xb = 0; xb < PROBE_XBAR; ++xb) if (seams) xcd_barrier(bar, TID_NOW);
        pkind = 3;
        if (PH_ON) { PH_LOC;
            const bool peel = PEEL_CD && odd && DEFER_W && G == 256;
            const int N = odd ? (peel ? 2048 : CD_INP) : AB_IN;
            const f16* Bt = odd ? (const f16*)(ws + WS_W_INCD) + (size_t)li * CD_INP * DM : (const f16*)(ws + WS_W_INAB) + (size_t)li * AB_IN * DM;
            pg8::Gemm g{H, Bt, M, N, DM, DM}; pg8::StaticOrder S; S.init(M, N, G, bid);
            pg8::EpiF16 E{PROJ, odd ? CD_INP : N, 0, nullptr, 0, odd ? nullptr : (float*)(ws + WS_KMEAN), 512, 1024, odd ? (PG8_LAS float*)(lds + XCH_OFF) : (PG8_LAS float*)nullptr, KPE, rc, rs, nullptr};
            for (int rep = 0; rep < REP_INPROJ; ++rep) pg8::gemm_phase<pg8::EpiF16, pg8::StaticOrder, true, true>(lds, g, S, E, tid);
            if (DEFER_W && odd) {
                const int total = (M / 256) * (N / 256), rounds = (total + G - 1) / G; int first_short = total - (rounds - 1) * G; if (first_short >= G) first_short = 0;
                if (peel) {
                    const int tid2 = TID_NOW; const int lane = tid2 & 63, n = lane & 31, hi = lane >> 5, wv = tid2 >> 6, rg = wv >> 2, kq = wv & 3; const int r0 = bid * 64 + rg * 32;
                    const GAS f16* hp = (const GAS f16*)H + (size_t)(r0 + n) * DM + kq * 256 + 8 * hi; const GAS f16* wp = (const GAS f16*)Bt + (size_t)(2048 + n) * DM + kq * 256 + 8 * hi;
                    dil::f32x16 acc;
#pragma unroll
                    for (int r = 0; r < 16; ++r) acc[r] = 0.f;
                    {
                        f16x8 hf[16], wf[16];
#pragma unroll
                        for (int j = 0; j < 16; ++j) { hf[j] = *(const GAS f16x8*)(hp + 16 * j); wf[j] = *(const GAS f16x8*)(wp + 16 * j); }
#pragma unroll
                        for (int j = 0; j < 16; ++j) acc = __builtin_amdgcn_mfma_f32_32x32x16_f16(wf[j], hf[j], acc, 0, 0, 0);
                    }
                    LAS float* red = (LAS float*)lds + wv * 1024;
#pragma unroll
                    for (int r = 0; r < 16; ++r) red[r * 64 + lane] = acc[r];
                    __syncthreads();
                    if (kq == 0) {
                        const LAS float* rb = (const LAS float*)lds + (rg * 4) * 1024;
#pragma unroll
                        for (int r = 0; r < 16; ++r) acc[r] = (rb[r * 64 + lane] + rb[1024 + r * 64 + lane]) + (rb[2048 + r * 64 + lane] + rb[3072 + r * 64 + lane]);
                        GAS f16* orow = (GAS f16*)PROJ + (size_t)(r0 + n) * CD_INP + 2048;
#pragma unroll
                        for (int gq = 0; gq < 4; ++gq) { u32x2 w; w.x = pk_f16(acc[4 * gq], acc[4 * gq + 1]); w.y = pk_f16(acc[4 * gq + 2], acc[4 * gq + 3]); *(GAS u32x2*)(orow + 8 * gq + 4 * hi) = w; }
                    }
                    __syncthreads();
                    first_short = 0;
                }
                if (bid >= first_short) { const int tid2 = TID_NOW; layer_weights(a, lds, tid2, bid - first_short, G - first_short, l, 2); if (l == 1) layer_weights(a, lds, tid2, bid - first_short, G - first_short, 2, 2); }
            }
            PH_END; } ++ph;
        pkind = 4;
        if (PH_ON) { PH_LOC;
            (void)tid; } ++ph;
        if (PH_ON) { PH_LOC;
            if (odd) {
                pg8::Gemm g{PROJ, (const f16*)(ws + WS_W_UP2) + (size_t)li * UP_N * UP_K, M, UP_N, UP_K, CD_INP}; pg8::UpOrder S; S.init(M, UP_N, G, bid, QW / 256);
                pg8::EpiF16 E{Qb, QW, QW, KVb, KVW, nullptr, 0, 0, nullptr, nullptr, nullptr, nullptr, nullptr};
                pg8::gemm_phase<pg8::EpiF16, pg8::UpOrder, true, true>(lds, g, S, E, tid);
                PH_END; }
        } ++ph;
        pkind = odd ? 6 : 5;
        if (PH_ON) { PH_LOC;
            const int vcu = (G % 8 == 0) ? (bid % 8) * (G / 8) + bid / 8 : bid;
            if (!odd) {
#pragma unroll 1
                for (int step = 0; step < 2; ++step) {
                    if ((step == 0) == ((vcu & 1) != 0)) {
                        for (int rep = 0; rep < REP_DIL; ++rep)
                        for (int u = vcu; u < 256; u += G) { const int bh = u >> 3, sp = u & 7;
                            dil::dilated_unit(lds, PROJ, a.in[I_RELB], ATT, bh >> 3, bh & 7, sp, TID_NOW); }
                    } else {
                        for (int rep = 0; rep < REP_MOBA; ++rep)
                        for (int p = vcu; p < 256; p += G) { const int bh = p >> 3, s = p & 7, b = bh >> 3, h = bh & 7;
                            att::Src T{PROJ + h * 64, AB_IN, PROJ + 512 + h * 64, AB_IN, nullptr, PROJ + 1024 + h * 64, AB_IN, ATT + h * 64};
                            const int tidm = TID_NOW;
                            att::attn_unit<1>(lds, T, b, h, s, rc, rs, (const float*)(ws + WS_KMEAN), a.in[I_RELB], tidm);
                            att::attn_unit<1>(lds, T, b, h, 15 - s, rc, rs, (const float*)(ws + WS_KMEAN), a.in[I_RELB], tidm, true); }
                    }
                }
            } else {
#if USE_MFMA_MLA
                for (int rep = 1; rep < REP_MLA; ++rep)
                for (int p = vcu; p < 256; p += G) { const int bh = p >> 3, s = p & 7, b = bh >> 3, h = bh & 7;
                    att::Src T{Qb + h * 96, QW, KVb + h * 128, KVW, KPE, KVb + h * 128 + 64, KVW, ATT + h * 64};
                    att::attn_unit<0, PROBE_PM>(lds, T, b, h, s, rc, rs, nullptr, nullptr, tid);
                    att::attn_unit<0, PROBE_PM>(lds, T, b, h, 15 - s, rc, rs, nullptr, nullptr, tid); }
                for (int p = vcu; p < 256; p += G) { const int bh = p >> 3, s = p & 7, b = bh >> 3, h = bh & 7;
                    att::Src T{Qb + h * 96, QW, KVb + h * 128, KVW, KPE, KVb + h * 128 + 64, KVW, ATT + h * 64};
                    att::attn_unit<0>(lds, T, b, h, s, rc, rs, nullptr, nullptr, tid);
                    att::attn_unit<0>(lds, T, b, h, 15 - s, rc, rs, nullptr, nullptr, tid); }
#else
                naive_mla(Qb, KVb, KPE, rc, rs, ATT, gt, NGT);
#endif
#if USE_MFMA_SB
                for (int rep = 0; rep < REP_SB; ++rep)
                for (int p = vcu; p < 256; p += G) { const int bh = p >> 3, s = p & 7, b = bh >> 3, h = bh & 7;
                    att::Src T{PROJ + 544 + h * 64, CD_INP, PROJ + 1056 + h * 64, CD_INP, nullptr, PROJ + 1568 + h * 64, CD_INP, ATT + 512 + h * 64};
                    att::attn_unit<2>(lds, T, b, h, s, rc, rs, nullptr, nullptr, tid);
                    att::attn_unit<2>(lds, T, b, h, 15 - s, rc, rs, nullptr, nullptr, tid); }
#else
                naive_sb(PROJ, ATT, gt, NGT);
#endif
            }
            PH_END; } ++ph;
        pkind = 7;
        if (PH_ON) { PH_LOC;
            const f16* Bt = odd ? (const f16*)(ws + WS_W_OUTCD) + (size_t)li * DM * DM : (const f16*)(ws + WS_W_OUTAB) + (size_t)li * DM * DM;
            pg8::Gemm g{ATT, Bt, M, DM, DM, DM}; pg8::StaticOrder S; S.init(M, DM, G, bid);
#if SEAM_FUSE == 2
            if (G == 256) {
                pg8::EpiRow ER{X16, (l + 1 == DEPTH) ? X16B : X16, nullptr, modl + 2 * DM, a.in[I_MIXPOST] + l * DM, a.in[I_FFNPRE] + l * DM, modl + 3 * DM, H, HHALO,
                               (float*)(ws + WS_XB), (float*)(ws + WS_XB + 256 * 1024), ctl + CW_PANEL + 64 * (((2 * l + 0) * 2 + 0) * 64), ctl + CW_PANEL + 64 * (((2 * l + 0) * 2 + 1) * 64)};
                pg8::gemm_phase<pg8::EpiRow, pg8::StaticOrder, false, true>(lds, g, S, ER, tid);
            } else
#endif
            {
            const bool fuse = SEAM_FUSE == 1 && G == 256;
            unsigned* pc = ctl + CW_PANEL + 64 * ((2 * l + 0) * 64);
            pg8::EpiF16 E{Y1, DM, 0, nullptr, 0, nullptr, 0, 0, nullptr, nullptr, nullptr, nullptr, fuse ? pc : nullptr};
            pg8::gemm_phase<pg8::EpiF16, pg8::StaticOrder, true, true>(lds, g, S, E, tid);
            if (fuse) { pg8::Unit u; S.next(0, u);
                panel_wait(pc + 64 * u.pm, 32u, tid);
                thin_phase<false, true, false, true>(nullptr, X16, (l + 1 == DEPTH) ? X16B : X16, nullptr, Y1, modl + 2 * DM, a.in[I_MIXPOST] + l * DM, a.in[I_FFNPRE] + l * DM, modl + 3 * DM, H, HHALO, lds, tid,
                                                     u.pm * 256 + u.pn * 64 + (tid >> 6), NWAVES, u.pm * 256 + u.pn * 64 + 64); }
            }
            PH_END; } ++ph;
        pkind = 2;
        if (PH_ON) { PH_LOC;
            if (!(SEAM_FUSE != 0 && G == 256)) {
            const float* gpost = a.in[I_MIXPOST] + l * DM; const float* gpre = a.in[I_FFNPRE] + l * DM;
            thin_phase<false, true, false, true>(nullptr, X16, (l + 1 == DEPTH) ? X16B : X16, nullptr, Y1, modl + 2 * DM, gpost, gpre, modl + 3 * DM, H, HHALO, lds, tid, bid * NWAVES + (tid >> 6), G * NWAVES);
            PH_END; } } ++ph;
#if !HALO_IN_FUP
        if (PH_ON) { PH_LOC;
            pg8::Gemm g{HHALO, (const f16*)(ws + WS_W_FUP) + (size_t)l * DFF2 * DM, 256, DFF2, DM, DM}; pg8::StaticOrder S; S.init(256, DFF2, G, bid);
            pg8::EpiF32 E{(float*)(ws + WS_UHALO), DFF2, 128};
            pg8::gemm_phase<pg8::EpiF32, pg8::StaticOrder, true, true>(lds, g, S, E, tid);
            PH_END; }
#endif
        ++ph;
        pkind = 8;
        if (PH_ON) { PH_LOC;
            pg8::Gemm g{H, (const f16*)(ws + WS_W_FUP) + (size_t)l * DFF2 * DM, M, DFF2, DM, DM};
#if HALO_IN_FUP
            pg8::FfnUpOrder S; S.init(M, DFF2, G, bid);
            pg8::EpiConv E{ACT, (float*)(ws + WS_UHALO), a.in[I_CONVW] + (size_t)l * 3 * DFF2, a.in[I_CONVB] + (size_t)l * DFF2, (PG8_LAS float*)(lds + XCH_OFF), (PG8_LAS float*)(lds + XCH_OFF + 8192), ctl + CW_HALO + 64 * 22 * l, M / 256};
            pg8::gemm_phase<pg8::EpiConv, pg8::FfnUpOrder, true, true>(lds, g, S, E, tid);
#if PROBE_FUP == 1
            pg8::gemm_phase<pg8::EpiConv, pg8::FfnUpOrder, true, true>(lds, g, S, E, tid);
#elif PROBE_FUP == 3
            { pg8::StaticOrder S2; S2.init(M, DFF2, G, bid); pg8::EpiNull E2{}; pg8::gemm_phase<pg8::EpiNull, pg8::StaticOrder, true, true>(lds, g, S2, E2, tid); }
#elif PROBE_FUP == 2
            { pg8::StaticOrder S2; S2.init(M, DFF2, G, bid); pg8::EpiF16 E2{(f16*)(ws + WS_R2), 1024, 0, nullptr, 0, nullptr, 0, 0, nullptr, nullptr, nullptr, nullptr, nullptr};
              pg8::gemm_phase<pg8::EpiF16, pg8::StaticOrder, true, true>(lds, g, S2, E2, tid); }
#endif
            if (DEFER_W && l + 1 < DEPTH) {
                const int total = (M / 256) * (DFF2 / 256) + DFF2 / 256, rounds = (total + G - 1) / G; int first_short = total - (rounds - 1) * G; if (first_short >= G) first_short = 0;
                if (bid >= first_short) { const int tid2 = TID_NOW;
                    layer_mod(a, lds, tid2, bid - first_short, G - first_short, l + 1); layer_weights(a, lds, tid2, bid - first_short, G - first_short, l + 1, 1); }
            }
#else
            pg8::StaticOrder S; S.init(M, DFF2, G, bid);
            pg8::EpiConv E{ACT, (float*)(ws + WS_UHALO), a.in[I_CONVW] + (size_t)l * 3 * DFF2, a.in[I_CONVB] + (size_t)l * DFF2, (PG8_LAS float*)(lds + XCH_OFF), (PG8_LAS float*)(lds + XCH_OFF + 8192), ctl + CW_HALO, -1};
            for (int rep = 0; rep < REP_FUP; ++rep) pg8::gemm_phase<pg8::EpiConv, pg8::StaticOrder, true, true>(lds, g, S, E, tid);
#endif
            PH_END; } ++ph;
        ++ph; ++ph;
        pkind = 9;
        if (PH_ON) { PH_LOC;
            pg8::Gemm g{ACT, (const f16*)(ws + WS_W_FDN) + (size_t)l * DM * DFF, M, DM, DFF, DFF}; pg8::StaticOrder S; S.init(M, DM, G, bid);
#if SEAM_FUSE == 2
            if (G == 256) {
                const int ln2 = (l + 1 < DEPTH) ? l + 1 : l; const bool last = l + 1 == DEPTH;
                pg8::EpiRow ER{last ? X16B : X16, last ? (f16*)nullptr : X16, last ? xout0 : (float*)nullptr, modl + 5 * DM, a.in[I_FFNPOST] + l * DM, a.in[I_MIXPRE] + ln2 * DM, MOD + (size_t)ln2 * BATCH * 6144, H, nullptr,
                               (float*)(ws + WS_XB), (float*)(ws + WS_XB + 256 * 1024), ctl + CW_PANEL + 64 * (((2 * l + 1) * 2 + 0) * 64), ctl + CW_PANEL + 64 * (((2 * l + 1) * 2 + 1) * 64)};
                pg8::gemm_phase<pg8::EpiRow, pg8::StaticOrder, false, true>(lds, g, S, ER, tid);
                if (gt < BATCH * 16 * 512) ((float*)(ws + WS_KMEAN))[gt] = 0.f;
            } else
#endif
            {
            const bool fuse = SEAM_FUSE == 1 && G == 256;
            unsigned* pc = ctl + CW_PANEL + 64 * ((2 * l + 1) * 64);
            pg8::EpiF16 E{Y2, DM, 0, nullptr, 0, nullptr, 0, 0, nullptr, nullptr, nullptr, nullptr, fuse ? pc : nullptr};
            pg8::gemm_phase<pg8::EpiF16, pg8::StaticOrder, true, true>(lds, g, S, E, tid);
            if (fuse) { pg8::Unit u; S.next(0, u);
                panel_wait(pc + 64 * u.pm, 32u, tid);
                const int ln = (l + 1 < DEPTH) ? l + 1 : l; const int r0 = u.pm * 256 + u.pn * 64;
                if (l + 1 < DEPTH) thin_phase<false, true, false, true>(nullptr, X16, X16, nullptr, Y2, modl + 5 * DM, a.in[I_FFNPOST] + l * DM, a.in[I_MIXPRE] + ln * DM, MOD + (size_t)ln * BATCH * 6144, H, nullptr, lds, tid, r0 + (tid >> 6), NWAVES, r0 + 64);
                else thin_phase<false, true, true, false>(nullptr, X16B, nullptr, xout0, Y2, modl + 5 * DM, a.in[I_FFNPOST] + l * DM, nullptr, nullptr, nullptr, nullptr, lds, tid, r0 + (tid >> 6), NWAVES, r0 + 64);
                if (gt < BATCH * 16 * 512) ((float*)(ws + WS_KMEAN))[gt] = 0.f; }
            }
            PH_END; } ++ph;
        pkind = 2;
        if (PH_ON) { PH_LOC;
            if (!(SEAM_FUSE != 0 && G == 256)) {
            const int ln = (l + 1 < DEPTH) ? l + 1 : l;
            if (gt < BATCH * 16 * 512) ((float*)(ws + WS_KMEAN))[gt] = 0.f;
            if (l + 1 < DEPTH) thin_phase<false, true, false, true>(nullptr, X16, X16, nullptr, Y2, modl + 5 * DM, a.in[I_FFNPOST] + l * DM, a.in[I_MIXPRE] + ln * DM, MOD + (size_t)ln * BATCH * 6144, H, nullptr, lds, tid, bid * NWAVES + (tid >> 6), G * NWAVES);
            else thin_phase<false, true, true, false>(nullptr, X16B, nullptr, xout0, Y2, modl + 5 * DM, a.in[I_FFNPOST] + l * DM, nullptr, nullptr, nullptr, nullptr, lds, tid, bid * NWAVES + (tid >> 6), G * NWAVES);
            PH_END; } } ++ph;
    }
    if (PROBE_STAMP >= 0 && bid == PROBE_BLK) { const unsigned long long t0_ = rt(); while (rt() - t0_ < pacc) __builtin_amdgcn_s_sleep(10); }
#undef PH_ON
#undef PH_END
#undef X16
#undef X16B
#undef MOD
#undef H
#undef ATT
#undef HHALO
#undef PROJ
#undef Qb
#undef KVb
#undef KPE
#undef rc
#undef rs
#undef ctl
#undef Y1
#undef Y2
#undef ACT
#undef modl
}

extern "C" void kernel_launch(void* const* d_in, const int* in_sizes, int n_in, void* d_out, int out_size, void* d_ws, size_t ws_size, hipStream_t stream) {
    static int grid = 0;
    if (grid == 0) {
        if (n_in != 21 || in_sizes[0] != M * DM || out_size != M * DM || ws_size < WS_END) { fprintf(stderr, "kernel_launch: unexpected shapes (n_in %d, ws %zu); nothing launched\n", n_in, ws_size); grid = -1; return; }
        int dev = 0, cus = 0, per_cu = 0;
        if (hipGetDevice(&dev) != hipSuccess || hipDeviceGetAttribute(&cus, hipDeviceAttributeMultiprocessorCount, dev) != hipSuccess) { grid = -1; return; }
        if (hipFuncSetAttribute((const void*)fwd_kernel, hipFuncAttributeMaxDynamicSharedMemorySize, LDS_BYTES) != hipSuccess) { fprintf(stderr, "kernel_launch: hipFuncSetAttribute failed\n"); grid = -1; return; }
        if (hipOccupancyMaxActiveBlocksPerMultiprocessor(&per_cu, (const void*)fwd_kernel, NTHR, LDS_BYTES) != hipSuccess || per_cu < 1) { fprintf(stderr, "kernel_launch: occupancy query reports %d\n", per_cu); }
        (void)hipGetLastError();
        grid = cus;
        if (grid < 64) { fprintf(stderr, "kernel_launch: %d CUs: too few\n", cus); grid = -1; return; }
    }
    if (grid < 0) return;
    (void)hipMemsetAsync((char*)d_ws + WS_CTL, 0, CTL_ZERO_BYTES, stream);
    Args a{};
    for (int i = 0; i < 21; ++i) a.in[i] = (const float*)d_in[i];
    a.out = (float*)d_out; a.ws = (unsigned char*)d_ws;
#if MK_SPLIT
    for (int p = 0; p < N_PHASES; ++p) { a.ph_lo = p; a.ph_hi = p + 1; hipLaunchKernelGGL(fwd_kernel, dim3(grid), dim3(NTHR), LDS_BYTES, stream, a); }
#else
    a.ph_lo = 0; a.ph_hi = N_PHASES;
    hipLaunchKernelGGL(fwd_kernel, dim3(grid), dim3(NTHR), LDS_BYTES, stream, a);
#endif
}
```
